# Optimizing an MI355X kernel written in HIP

```python
import jax, jax.numpy as jnp
from jax import lax
import numpy as np

D_MODEL = 1024
BATCH = 32
SEQ = 2048
DEPTH = 1

CHUNK = 64
Q_BLOCK = 128
FOX_HEADS = 8
FOX_HEAD_DIM = D_MODEL // 16
FOX_WIDTH = FOX_HEADS * FOX_HEAD_DIM
MLSTM_HEADS = 4
MLSTM_HEAD_DIM = D_MODEL // 8
MLSTM_WIDTH = MLSTM_HEADS * MLSTM_HEAD_DIM
CONV_WIDTH = 4
D_FF = 128 * ((8 * D_MODEL // 3 + 127) // 128)
RMS_EPS = 1e-6
IN_COLS = 3 * FOX_WIDTH + FOX_HEADS + 4 * MLSTM_WIDTH + 2 * MLSTM_HEADS + 2 * D_MODEL

kernel_name = 'fox_mlstm_macaron_gated_hybrid'


def _split_points():
    sizes = [FOX_WIDTH, FOX_WIDTH, FOX_WIDTH, FOX_HEADS,
             2 * MLSTM_WIDTH, MLSTM_WIDTH, MLSTM_HEADS, MLSTM_HEADS, MLSTM_WIDTH]
    pts, acc = [], 0
    for s in sizes:
        acc += s
        pts.append(acc)
    return pts


def rms_norm(x, g):
    xf = x.astype(jnp.float32)
    y = xf * lax.rsqrt(jnp.mean(xf * xf, axis=-1, keepdims=True) + RMS_EPS)
    return (y * g.astype(jnp.float32)).astype(x.dtype)


def swiglu_ffn(x, w_in, w_out):
    gate, up = jnp.split(x @ w_in, 2, axis=-1)
    return (jax.nn.silu(gate) * up) @ w_out


def causal_depthwise_conv(x, w, b):
    K, C = w.shape
    y = lax.conv_general_dilated(x, w[:, None, :].astype(x.dtype), window_strides=(1,),
                                 padding=[(K - 1, 0)], dimension_numbers=('NWC', 'WIO', 'NWC'),
                                 feature_group_count=C)
    return y + b.astype(x.dtype)


def forgetting_attention(q, k, v, log_f):
    B, S, H, Dh = q.shape
    c = jnp.cumsum(log_f, axis=1).transpose(0, 2, 1)
    scale = Dh ** -0.5
    outs = []
    for i in range(S // Q_BLOCK):
        q0, q1 = i * Q_BLOCK, (i + 1) * Q_BLOCK
        s = jnp.einsum('bqhd,bkhd->bhqk', q[:, q0:q1], k[:, :q1]) * scale
        s = s + c[:, :, q0:q1, None] - c[:, :, None, :q1]
        t_pos = jnp.arange(q0, q1)[:, None]
        s_pos = jnp.arange(q1)[None, :]
        s = jnp.where(s_pos <= t_pos, s, -jnp.inf)
        p = jax.nn.softmax(s, axis=-1)
        outs.append(jnp.einsum('bhqk,bkhd->bqhd', p, v[:, :q1]))
    return jnp.concatenate(outs, axis=1)


def mlstm_chunkwise(q, k, v, i_pre, log_f):
    B, S, H, Dk = q.shape
    Dv = v.shape[-1]
    nc = S // CHUNK

    def to_chunks(a):
        a = a.reshape((B, nc, CHUNK, H) + a.shape[3:])
        return jnp.moveaxis(a, (1, 3), (0, 2))

    xs = (to_chunks(q * Dk ** -0.5), to_chunks(k), to_chunks(v), to_chunks(i_pre), to_chunks(log_f))
    causal = jnp.tril(jnp.ones((CHUNK, CHUNK), dtype=bool))

    def step(carry, xs_c):
        C, n, m = carry
        qb, kb, vb, ib, fb = xs_c
        b = jnp.cumsum(fb, axis=-1)
        g = b[..., -1]
        dmat = jnp.where(causal, b[..., :, None] - b[..., None, :] + ib[..., None, :], -jnp.inf)
        m_inter = b + m[..., None]
        m_t = jnp.maximum(jnp.max(dmat, axis=-1), m_inter)
        s = jnp.einsum('bhld,bhsd->bhls', qb, kb) * jnp.exp(dmat - m_t[..., None])
        inter = jnp.exp(m_inter - m_t)
        num = jnp.einsum('bhls,bhse->bhle', s, vb) + inter[..., None] * jnp.einsum('bhld,bhde->bhle', qb, C)
        den = jnp.sum(s, axis=-1) + inter * jnp.einsum('bhld,bhd->bhl', qb, n)
        h = num / jnp.maximum(jnp.abs(den), jnp.exp(-m_t))[..., None]
        kdec = g[..., None] - b + ib
        m_new = jnp.maximum(g + m, jnp.max(kdec, axis=-1))
        wk = jnp.exp(kdec - m_new[..., None])
        carry_dec = jnp.exp(g + m - m_new)
        C_new = carry_dec[..., None, None] * C + jnp.einsum('bhs,bhsd,bhse->bhde', wk, kb, vb)
        n_new = carry_dec[..., None] * n + jnp.einsum('bhs,bhsd->bhd', wk, kb)
        return (C_new, n_new, m_new), h

    init = (jnp.zeros((B, H, Dk, Dv), jnp.float32), jnp.zeros((B, H, Dk), jnp.float32),
            jnp.zeros((B, H), jnp.float32))
    _, hs = lax.scan(step, init, xs)
    return jnp.moveaxis(hs, (0, 2), (1, 3)).reshape(B, S, H * Dv)


def hybrid_mixer(h, w_in, fox_f_bias, mlstm_conv_w, mlstm_conv_b, mlstm_i_bias, mlstm_f_bias,
                 w_up_fox, w_up_mlstm, w_out):
    B, S, _ = h.shape
    proj = (h @ w_in).astype(jnp.float32)
    fq, fk, fv, ff, mqk, mv, mi, mf, mo, gates = jnp.split(proj, _split_points(), axis=-1)
    fox_log_f = jax.nn.log_sigmoid(ff + fox_f_bias.astype(jnp.float32))
    a = forgetting_attention(fq.reshape(B, S, FOX_HEADS, FOX_HEAD_DIM),
                             fk.reshape(B, S, FOX_HEADS, FOX_HEAD_DIM),
                             fv.reshape(B, S, FOX_HEADS, FOX_HEAD_DIM), fox_log_f)
    a = a.reshape(B, S, FOX_WIDTH) @ w_up_fox.astype(jnp.float32)
    mqk = jax.nn.silu(causal_depthwise_conv(mqk, mlstm_conv_w.astype(jnp.float32), mlstm_conv_b))
    mq, mk = jnp.split(mqk, 2, axis=-1)
    hm = mlstm_chunkwise(mq.reshape(B, S, MLSTM_HEADS, MLSTM_HEAD_DIM),
                         mk.reshape(B, S, MLSTM_HEADS, MLSTM_HEAD_DIM),
                         mv.reshape(B, S, MLSTM_HEADS, MLSTM_HEAD_DIM),
                         mi + mlstm_i_bias.astype(jnp.float32),
                         jax.nn.log_sigmoid(mf + mlstm_f_bias.astype(jnp.float32)))
    bm = (jax.nn.sigmoid(mo) * hm) @ w_up_mlstm.astype(jnp.float32)
    g_a, g_b = jnp.split(gates, 2, axis=-1)
    merged = jax.nn.sigmoid(g_a) * a + jax.nn.sigmoid(g_b) * bm
    return (merged @ w_out.astype(jnp.float32)).astype(h.dtype)


def setup_inputs(seed: int = 0) -> dict:
    key = jax.random.key(seed)
    ks = jax.random.split(key, 20)
    L, D = DEPTH, D_MODEL

    def nrm(k, shape, fan_in):
        return jax.random.normal(k, shape, jnp.float32) * fan_in ** -0.5

    def gain(k, shape):
        return 1.0 + 0.05 * jax.random.normal(k, shape, jnp.float32)

    return {
        'x': jax.random.normal(ks[0], (BATCH, SEQ, D), jnp.float32),
        'ffn1_norm': gain(ks[1], (L, D)),
        'ffn1_w_in': nrm(ks[2], (L, D, 2 * D_FF), D),
        'ffn1_w_out': nrm(ks[3], (L, D_FF, D), D_FF),
        'mix_norm': gain(ks[4], (L, D)),
        'w_in': nrm(ks[5], (L, D, IN_COLS), D),
        'fox_f_bias': 1.0 + 0.1 * jax.random.normal(ks[6], (L, FOX_HEADS), jnp.float32),
        'mlstm_conv_w': nrm(ks[7], (L, CONV_WIDTH, 2 * MLSTM_WIDTH), CONV_WIDTH),
        'mlstm_conv_b': 0.02 * jax.random.normal(ks[8], (L, 2 * MLSTM_WIDTH), jnp.float32),
        'mlstm_i_bias': 0.1 * jax.random.normal(ks[9], (L, MLSTM_HEADS), jnp.float32),
        'mlstm_f_bias': jnp.linspace(3.0, 6.0, MLSTM_HEADS, dtype=jnp.float32)[None, :]
                        + 0.1 * jax.random.normal(ks[10], (L, MLSTM_HEADS), jnp.float32),
        'w_up_fox': nrm(ks[11], (L, FOX_WIDTH, D), FOX_WIDTH),
        'w_up_mlstm': nrm(ks[12], (L, MLSTM_WIDTH, D), MLSTM_WIDTH),
        'w_out': nrm(ks[13], (L, D, D), D),
        'ffn2_norm': gain(ks[14], (L, D)),
        'ffn2_w_in': nrm(ks[15], (L, D, 2 * D_FF), D),
        'ffn2_w_out': nrm(ks[16], (L, D_FF, D), D_FF),
        'final_norm': gain(ks[17], (D,)),
    }


def reference(x, ffn1_norm, ffn1_w_in, ffn1_w_out, mix_norm, w_in, fox_f_bias, mlstm_conv_w,
              mlstm_conv_b, mlstm_i_bias, mlstm_f_bias, w_up_fox, w_up_mlstm, w_out,
              ffn2_norm, ffn2_w_in, ffn2_w_out, final_norm):
    for l in range(DEPTH):
        x = x + 0.5 * swiglu_ffn(rms_norm(x, ffn1_norm[l]), ffn1_w_in[l], ffn1_w_out[l])
        x = x + hybrid_mixer(rms_norm(x, mix_norm[l]), w_in[l], fox_f_bias[l], mlstm_conv_w[l],
                             mlstm_conv_b[l], mlstm_i_bias[l], mlstm_f_bias[l],
                             w_up_fox[l], w_up_mlstm[l], w_out[l])
        x = x + 0.5 * swiglu_ffn(rms_norm(x, ffn2_norm[l]), ffn2_w_in[l], ffn2_w_out[l])
    return rms_norm(x, final_norm)
```

```cpp
#include <hip/hip_runtime.h>
#include <cstdio>
#include <cstdint>

#define GAS __attribute__((address_space(1)))
#define LAS __attribute__((address_space(3)))
typedef unsigned short bf16;
typedef unsigned v4u __attribute__((ext_vector_type(4)));
typedef float f32x4 __attribute__((ext_vector_type(4)));
typedef GAS unsigned gu32;
#define RLX_AGENT __ATOMIC_RELAXED, __HIP_MEMORY_SCOPE_AGENT

constexpr int BATCH = 32, SEQ = 2048, D = 1024, M = BATCH * SEQ;
constexpr int DFF = 2816, NFF = 2 * DFF;
constexpr int INC = 5648;
constexpr int PJ = 5632;
constexpr int FOXH = 8, FHD = 64, MLH = 4, MHD = 128;
constexpr int PC_FQ = 0, PC_FK = 512, PC_FV = 1024, PC_MQ = 1536, PC_MK = 2048, PC_MV = 2560, PC_MO = 3072, PC_GA = 3584, PC_GB = 4608;
constexpr float RMS_EPS = 1e-6f;
constexpr float LOG2E = 1.4426950408889634f;
constexpr float QSCALE2 = 0.125f * LOG2E;
constexpr int NWAVES = 8, NTHR = 512;

constexpr size_t MiB = 1u << 20;
constexpr size_t WS_CTL = 0, CTL_ZERO_BYTES = 1 * MiB;
constexpr size_t WS_SG = 52 * MiB;
constexpr size_t WS_CUM = 56 * MiB;
constexpr size_t WS_XN = 64 * MiB;
constexpr size_t WS_AO = 192 * MiB;
constexpr size_t WS_BIG = 320 * MiB;
constexpr size_t WS_END = 1024 * MiB;
constexpr int CW_BAR = 4096;

constexpr int LDS_BYTES = 147456;
constexpr int RING_BYTES = 131072, LDSCTL_OFF = RING_BYTES, MISC_OFF = LDSCTL_OFF + 320;

__device__ __forceinline__ float bf2f(bf16 v) { return __builtin_bit_cast(float, (unsigned)v << 16); }
__device__ __forceinline__ unsigned f2bf(float f) { unsigned u = __builtin_bit_cast(unsigned, f); return (u + 0x7fffu + ((u >> 16) & 1u)) >> 16; }
__device__ __forceinline__ unsigned pk2(float lo, float hi) { return f2bf(lo) | (f2bf(hi) << 16); }
__device__ __forceinline__ float sigmoidf_(float v) { return 1.f / (1.f + __expf(-v)); }
__device__ __forceinline__ float logsigmoidf_(float v) { return fminf(v, 0.f) - log1pf(__expf(-fabsf(v))); }
__device__ __forceinline__ float siluf_(float v) { return v / (1.f + __expf(-v)); }

#define XB_TMO      128
#define XB_XCNT(j)  (256  + 64 * (j))
#define XB_XSUB(j)  (1280 + 64 * (j))
#define XB_XGEN(j)  (2304 + 64 * (j))
#define XB_TOP      3328
#define XB_TOPGEN   3392
#define XCD_BAR_WORDS 3456
#define XB_SPIN_CAP (1u << 22)

__device__ __forceinline__ unsigned xb_ld(unsigned* p)              { return __hip_atomic_load(p, __ATOMIC_RELAXED, __HIP_MEMORY_SCOPE_AGENT); }
__device__ __forceinline__ unsigned xb_add(unsigned* p, unsigned v) { return __hip_atomic_fetch_add(p, v, __ATOMIC_RELAXED, __HIP_MEMORY_SCOPE_AGENT); }
__device__ __forceinline__ unsigned xb_xcc_id() { return (unsigned)__builtin_amdgcn_s_getreg((3 << 11) | 20) & 0xFu; }
#define XB_SPIN(cond, bar) do { unsigned _sp = 0; while (cond) { __builtin_amdgcn_s_sleep(1); \
    if ((++_sp & 255u) == 0u) { if (xb_ld(&(bar)[XB_TMO])) break; if (_sp > XB_SPIN_CAP) { atomicAdd(&(bar)[XB_TMO], 1u); break; } } } } while (0)

struct XcdBarrier { unsigned* bar; unsigned x; volatile LAS unsigned* st; };

__device__ __forceinline__ XcdBarrier xcd_barrier_post(unsigned* bar, volatile LAS unsigned* st) {
    XcdBarrier b; b.bar = bar; b.x = xb_xcc_id(); b.st = st;
    if (threadIdx.x == 0) (void)xb_add(&bar[XB_XCNT(b.x)], 1u);
    return b;
}
__device__ __forceinline__ void xcd_barrier_complete(unsigned* bar, unsigned x, unsigned& nloc, unsigned& nx) {
    const unsigned G = gridDim.x * gridDim.y * gridDim.z;
    unsigned sum, cnt, mine, sp = 0u;
    for (;;) {
        sum = 0u; cnt = 0u; mine = 0u;
#pragma unroll
        for (unsigned j = 0; j < 16; ++j) { const unsigned c = xb_ld(&bar[XB_XCNT(j)]); sum += c; cnt += (c > 0u) ? 1u : 0u; mine = (j == x) ? c : mine; }
        if (sum == G) break;
        __builtin_amdgcn_s_sleep(1);
        if ((++sp & 255u) == 0u) { if (xb_ld(&bar[XB_TMO])) break; if (sp > XB_SPIN_CAP) { atomicAdd(&bar[XB_TMO], 1u); break; } }
    }
    nloc = mine > 0u ? mine : 1u; nx = cnt > 0u ? cnt : 1u;
}
__device__ __forceinline__ void xcd_barrier(const XcdBarrier& b) {
    asm volatile("s_waitcnt vmcnt(0)" ::: "memory");
    __syncthreads();
    if (threadIdx.x == 0) {
        unsigned* bar = b.bar;
        __builtin_amdgcn_s_waitcnt(0);
        unsigned nloc = b.st[0], nx = b.st[1];
        if (nloc == 0u) { xcd_barrier_complete(bar, b.x, nloc, nx); b.st[0] = nloc; b.st[1] = nx; }
        const unsigned old = xb_add(&bar[XB_XSUB(b.x)], 1u);
        const unsigned gen = old / nloc;
        if (old + 1u == (gen + 1u) * nloc) {
            __builtin_amdgcn_fence(__ATOMIC_RELEASE, "agent");
            asm volatile("s_waitcnt vmcnt(0)" ::: "memory");
            const unsigned og = xb_add(&bar[XB_TOP], 1u);
            const unsigned tg = og / nx;
            if (og + 1u == (tg + 1u) * nx) xb_add(&bar[XB_TOPGEN], 1u);
            else XB_SPIN(xb_ld(&bar[XB_TOPGEN]) == tg, bar);
            __builtin_amdgcn_fence(__ATOMIC_ACQUIRE, "agent");
            xb_add(&bar[XB_XGEN(b.x)], 1u);
            asm volatile("s_waitcnt vmcnt(0)" ::: "memory");
        } else {
            XB_SPIN(xb_ld(&bar[XB_XGEN(b.x)]) == gen, bar);
            __builtin_amdgcn_fence(__ATOMIC_ACQUIRE, "agent");
            asm volatile("s_waitcnt vmcnt(0)" ::: "memory");
        }
    }
    __syncthreads();
}

struct Frame {
    LAS unsigned char* lds;
    volatile LAS unsigned* MISC;
    gu32* ctl;
    int tid, lane, wave, G;
    const float* in[18];
    float* out;
    unsigned char* ws;
};
struct Args { const float* in[18]; float* out; unsigned char* ws; };

__device__ __forceinline__ float wave_sum(float v) {
#pragma unroll
    for (int o = 1; o < 64; o <<= 1) v += __shfl_xor(v, o);
    return v;
}

__device__ __forceinline__ void phase_rmsnorm_bf16(Frame& F, const float* X, const float* gain, bf16* O) {
    const int gw = blockIdx.x * NWAVES + F.wave, NGW = F.G * NWAVES;
    f32x4 g[4];
#pragma unroll
    for (int j = 0; j < 4; ++j) g[j] = *((const GAS f32x4*)gain + F.lane + 64 * j);
    for (int m = gw; m < M; m += NGW) {
        const GAS f32x4* xr = (const GAS f32x4*)(X + (size_t)m * D) + F.lane;
        f32x4 v[4]; float s = 0.f;
#pragma unroll
        for (int j = 0; j < 4; ++j) { v[j] = xr[64 * j]; s += (v[j].x * v[j].x + v[j].y * v[j].y) + (v[j].z * v[j].z + v[j].w * v[j].w); }
        const float r = 1.0f / sqrtf(wave_sum(s) * (1.f / D) + RMS_EPS);
        GAS unsigned long long* o8 = (GAS unsigned long long*)(O + (size_t)m * D) + F.lane;
#pragma unroll
        for (int j = 0; j < 4; ++j) o8[64 * j] = (unsigned long long)pk2(v[j].x * r * g[j].x, v[j].y * r * g[j].y) | ((unsigned long long)pk2(v[j].z * r * g[j].z, v[j].w * r * g[j].w) << 32);
    }
}
__device__ __forceinline__ void phase_rmsnorm_f32(Frame& F, float* X, const float* gain) {
    const int gw = blockIdx.x * NWAVES + F.wave, NGW = F.G * NWAVES;
    f32x4 g[4];
#pragma unroll
    for (int j = 0; j < 4; ++j) g[j] = *((const GAS f32x4*)gain + F.lane + 64 * j);
    for (int m = gw; m < M; m += NGW) {
        GAS f32x4* xr = (GAS f32x4*)(X + (size_t)m * D) + F.lane;
        f32x4 v[4]; float s = 0.f;
#pragma unroll
        for (int j = 0; j < 4; ++j) { v[j] = xr[64 * j]; s += (v[j].x * v[j].x + v[j].y * v[j].y) + (v[j].z * v[j].z + v[j].w * v[j].w); }
        const float r = 1.0f / sqrtf(wave_sum(s) * (1.f / D) + RMS_EPS);
#pragma unroll
        for (int j = 0; j < 4; ++j) xr[64 * j] = v[j] * r * g[j];
    }
}

struct NGemm { const bf16* A; int lda; const float* W; int ldw; int off; int K; };
template <bool TWO, class Epi>
__device__ __forceinline__ void naive_gemm(Frame& F, const NGemm g1, const NGemm g2, int Nout, const Epi& epi) {
    LAS float* As = (LAS float*)F.lds;
    LAS float* Ws = (LAS float*)(F.lds + 32 * 132 * 4);
    const int tid = F.tid, ty = tid >> 4, tx = tid & 15;
    const int nNt = (Nout + 63) / 64, nMt = M / 128;
    for (int it = blockIdx.x; it < nMt * nNt; it += F.G) {
        const int mt = it / nNt, nt = it % nNt, m0 = mt * 128, c0 = nt * 64;
        float acc[2][4][4];
#pragma unroll
        for (int t = 0; t < 2; ++t)
#pragma unroll
            for (int i = 0; i < 4; ++i)
#pragma unroll
                for (int j = 0; j < 4; ++j) acc[t][i][j] = 0.f;
#pragma unroll
        for (int term = 0; term < (TWO ? 2 : 1); ++term) {
            const NGemm g = term ? g2 : g1;
            for (int k0 = 0; k0 < g.K; k0 += 32) {
                {
                    const int row = tid >> 2, kq = (tid & 3) * 8;
                    const v4u raw = *(const GAS v4u*)(g.A + (size_t)(m0 + row) * g.lda + k0 + kq);
                    const unsigned w[4] = {raw.x, raw.y, raw.z, raw.w};
#pragma unroll
                    for (int i = 0; i < 4; ++i) { As[(kq + 2 * i) * 132 + row] = __builtin_bit_cast(float, w[i] << 16); As[(kq + 2 * i + 1) * 132 + row] = __builtin_bit_cast(float, w[i] & 0xffff0000u); }
                }
                {
                    const int k = tid >> 4, c4 = (tid & 15) * 4;
#pragma unroll
                    for (int i = 0; i < 4; ++i) { const int c = c0 + c4 + i; Ws[k * 64 + c4 + i] = (c < Nout) ? g.W[(size_t)(k0 + k) * g.ldw + g.off + c] : 0.f; }
                }
                __syncthreads();
#pragma unroll 8
                for (int kk = 0; kk < 32; ++kk) {
                    const f32x4 a = *(const LAS f32x4*)(As + kk * 132 + 4 * ty);
                    const f32x4 w = *(const LAS f32x4*)(Ws + kk * 64 + 4 * tx);
#pragma unroll
                    for (int i = 0; i < 4; ++i)
#pragma unroll
                        for (int j = 0; j < 4; ++j) acc[term][i][j] += a[i] * w[j];
                }
                __syncthreads();
            }
        }
#pragma unroll
        for (int i = 0; i < 4; ++i)
#pragma unroll
            for (int j = 0; j < 4; ++j) { const int c = c0 + 4 * tx + j; if (c < Nout) epi(m0 + 4 * ty + i, c, acc[0][i][j], acc[1][i][j]); }
    }
}

struct EpiSwiglu { bf16* H; __device__ __forceinline__ void operator()(int m, int c, float g, float u) const { H[(size_t)m * DFF + c] = (bf16)f2bf(siluf_(g) * u); } };
struct EpiResid { const float* R; float* O; float coef; __device__ __forceinline__ void operator()(int m, int c, float v, float) const { O[(size_t)m * D + c] = R[(size_t)m * D + c] + coef * v; } };
struct EpiProj { bf16* P; float* SG; const float* fb; const float* ib; const float* mfb;
    __device__ __forceinline__ void operator()(int m, int c, float v, float) const {
        if (c < 512) P[(size_t)m * PJ + c] = (bf16)f2bf(v * QSCALE2);
        else if (c < 1536) P[(size_t)m * PJ + c] = (bf16)f2bf(v);
        else if (c < 1544) SG[(size_t)m * 16 + (c - 1536)] = logsigmoidf_(v + fb[c - 1536]);
        else if (c < 3080) P[(size_t)m * PJ + c - 8] = (bf16)f2bf(v);
        else if (c < 3084) SG[(size_t)m * 16 + 8 + (c - 3080)] = v + ib[c - 3080];
        else if (c < 3088) SG[(size_t)m * 16 + 12 + (c - 3084)] = logsigmoidf_(v + mfb[c - 3084]);
        else P[(size_t)m * PJ + c - 16] = (bf16)f2bf(sigmoidf_(v));
    } };
struct EpiMerge { const bf16* P; bf16* MG; __device__ __forceinline__ void operator()(int m, int c, float a, float b) const {
        MG[(size_t)m * D + c] = (bf16)f2bf(bf2f(P[(size_t)m * PJ + PC_GA + c]) * a + bf2f(P[(size_t)m * PJ + PC_GB + c]) * b); } };

__device__ __forceinline__ void phase_cumsum(Frame& F, const float* SG, float* CUM) {
    const int gw = blockIdx.x * NWAVES + F.wave, NGW = F.G * NWAVES;
    for (int it = gw; it < BATCH * FOXH; it += NGW) {
        const int b = it / FOXH, h = it % FOXH;
        float v[32]; float s = 0.f;
#pragma unroll
        for (int i = 0; i < 32; ++i) { s += SG[(size_t)(b * SEQ + F.lane * 32 + i) * 16 + h]; v[i] = s; }
        float incl = s;
#pragma unroll
        for (int o = 1; o < 64; o <<= 1) { const float t = __shfl_up(incl, o); if (F.lane >= o) incl += t; }
        const float excl = incl - s;
#pragma unroll
        for (int i = 0; i < 32; ++i) CUM[(size_t)it * SEQ + F.lane * 32 + i] = v[i] + excl;
    }
}

__device__ __forceinline__ void phase_attn_naive(Frame& F, const bf16* P, const float* CUM, bf16* AO) {
    LAS float* Ks = (LAS float*)F.lds;
    LAS float* Vs = (LAS float*)(F.lds + 16384);
    LAS float* Cs = (LAS float*)(F.lds + 32768);
    const int tid = F.tid, qi = tid >> 2, sub = tid & 3;
    for (int it = blockIdx.x; it < BATCH * FOXH * (SEQ / 128); it += F.G) {
        const int qt = it % (SEQ / 128), bh = it / (SEQ / 128), b = bh / FOXH, h = bh % FOXH;
        const int qpos = qt * 128 + qi;
        float q[16], o[16];
        { const bf16* qp = P + (size_t)(b * SEQ + qpos) * PJ + PC_FQ + h * 64 + sub * 16;
#pragma unroll
          for (int i = 0; i < 16; ++i) { q[i] = bf2f(qp[i]); o[i] = 0.f; } }
        const float ct = CUM[(size_t)bh * SEQ + qpos];
        float mx = -1e30f, l = 0.f;
        const int nkt = (qt * 128 + 127) / 64 + 1;
        for (int kt = 0; kt < nkt; ++kt) {
            __syncthreads();
            { const int row = tid >> 3, c8 = (tid & 7) * 8;
              const bf16* kp = P + (size_t)(b * SEQ + kt * 64 + row) * PJ + PC_FK + h * 64 + c8;
              const bf16* vp = P + (size_t)(b * SEQ + kt * 64 + row) * PJ + PC_FV + h * 64 + c8;
#pragma unroll
              for (int i = 0; i < 8; ++i) { Ks[row * 64 + c8 + i] = bf2f(kp[i]); Vs[row * 64 + c8 + i] = bf2f(vp[i]); }
              if (tid < 64) Cs[tid] = CUM[(size_t)bh * SEQ + kt * 64 + tid]; }
            __syncthreads();
            for (int j = 0; j < 64; ++j) {
                const int kpos = kt * 64 + j;
                float dot = 0.f;
#pragma unroll
                for (int i = 0; i < 16; ++i) dot += q[i] * Ks[j * 64 + sub * 16 + i];
                dot += __shfl_xor(dot, 1); dot += __shfl_xor(dot, 2);
                if (kpos <= qpos) {
                    const float s2 = dot + (ct - Cs[j]) * LOG2E;
                    if (s2 > mx) { const float sc = exp2f(mx - s2); l *= sc;
#pragma unroll
                        for (int i = 0; i < 16; ++i) o[i] *= sc;
                        mx = s2; }
                    const float p = exp2f(s2 - mx); l += p;
#pragma unroll
                    for (int i = 0; i < 16; ++i) o[i] += p * Vs[j * 64 + sub * 16 + i];
                }
            }
        }
        const float rl = 1.f / l;
        bf16* op = AO + (size_t)(b * SEQ + qpos) * D + h * 64 + sub * 16;
#pragma unroll
        for (int i = 0; i < 16; ++i) op[i] = (bf16)f2bf(o[i] * rl);
    }
}

__device__ __forceinline__ void phase_mlstm_naive(Frame& F, const bf16* P, const float* SG, const float* convw, const float* convb, bf16* AO) {
    LAS float* qs = (LAS float*)F.lds;
    LAS float* ks = qs + 128;
    LAS float* vs = ks + 128;
    LAS float* sc = vs + 128;
    LAS float* nump = sc + 4;
    LAS float* denp = nump + 512;
    const int tid = F.tid, e = tid & 127, dg = tid >> 7;
    for (int it = blockIdx.x; it < BATCH * MLH; it += F.G) {
        const int b = it / MLH, h = it % MLH;
        float C[32]; float nst = 0.f, mprev = 0.f;
#pragma unroll
        for (int i = 0; i < 32; ++i) C[i] = 0.f;
        int pcol = 0, cch = 0; float w0 = 0.f, w1 = 0.f, w2 = 0.f, w3 = 0.f, cb = 0.f, r0 = 0.f, r1 = 0.f, r2 = 0.f;
        if (tid < 256) { const bool isk = tid >= 128; const int i = tid & 127; pcol = (isk ? PC_MK : PC_MQ) + h * 128 + i; cch = (isk ? 512 : 0) + h * 128 + i;
            w0 = convw[0 * 1024 + cch]; w1 = convw[1 * 1024 + cch]; w2 = convw[2 * 1024 + cch]; w3 = convw[3 * 1024 + cch]; cb = convb[cch]; }
        else if (tid < 384) pcol = PC_MV + h * 128 + (tid - 256);
        float cur = 0.f, cur2 = 0.f;
        { const size_t row = (size_t)b * SEQ;
          if (tid < 384) cur = bf2f(P[row * PJ + pcol]);
          if (tid == 384) { cur = SG[row * 16 + 8 + h]; cur2 = SG[row * 16 + 12 + h]; } }
        for (int t = 0; t < SEQ; ++t) {
            const size_t row = (size_t)b * SEQ + t;
            float nxt = 0.f, nxt2 = 0.f;
            if (t + 1 < SEQ) { if (tid < 384) nxt = bf2f(P[(row + 1) * PJ + pcol]); if (tid == 384) { nxt = SG[(row + 1) * 16 + 8 + h]; nxt2 = SG[(row + 1) * 16 + 12 + h]; } }
            const float og = (tid < 128) ? bf2f(P[row * PJ + PC_MO + h * 128 + tid]) : 0.f;
            if (tid < 256) { float cv = w0 * r0 + w1 * r1 + w2 * r2 + w3 * cur + cb; cv = siluf_(cv); r0 = r1; r1 = r2; r2 = cur;
                if (tid < 128) qs[tid] = cv * 0.08838834764831845f; else ks[tid - 128] = cv; }
            else if (tid < 384) vs[tid - 256] = cur;
            else if (tid == 384) { const float ig = cur, lf = cur2; const float mn = fmaxf(lf + mprev, ig);
                sc[0] = __expf(lf + mprev - mn); sc[1] = __expf(ig - mn); sc[2] = __expf(-mn); mprev = mn; }
            __syncthreads();
            const float fdec = sc[0], iw = sc[1], emn = sc[2];
            const float ve = vs[e] * iw;
            float part = 0.f;
#pragma unroll
            for (int dd = 0; dd < 32; ++dd) { const int d = dg * 32 + dd; C[dd] = fdec * C[dd] + ks[d] * ve; part += qs[d] * C[dd]; }
            nump[dg * 128 + e] = part;
            if (tid < 128) { nst = fdec * nst + iw * ks[tid]; float dp = wave_sum(qs[tid] * nst); if (F.lane == 0) denp[tid >> 6] = dp; }
            __syncthreads();
            if (tid < 128) { const float num = (nump[tid] + nump[128 + tid]) + (nump[256 + tid] + nump[384 + tid]); const float den = denp[0] + denp[1];
                const float hv = num / fmaxf(fabsf(den), emn);
                AO[row * D + 512 + h * 128 + tid] = (bf16)f2bf(hv * og); }
            __syncthreads();
            cur = nxt; cur2 = nxt2;
        }
    }
}

__global__ void __launch_bounds__(NTHR, 2) fwd_kernel(Args args) {
    extern __shared__ __attribute__((aligned(16))) unsigned char lds[];
    Frame F;
    F.lds = (LAS unsigned char*)lds;
    F.MISC = (volatile LAS unsigned*)(F.lds + MISC_OFF);
    F.tid = threadIdx.x; F.lane = F.tid & 63; F.wave = __builtin_amdgcn_readfirstlane(F.tid >> 6);
    F.G = gridDim.x;
    F.ws = args.ws; F.out = args.out;
#pragma unroll
    for (int i = 0; i < 18; ++i) F.in[i] = args.in[i];
    F.ctl = (gu32*)(F.ws + WS_CTL);
    for (int u = F.tid; u < (LDS_BYTES - LDSCTL_OFF) / 4; u += NTHR) ((LAS unsigned*)(F.lds + LDSCTL_OFF))[u] = 0u;
    __syncthreads();
    XcdBarrier bar = xcd_barrier_post((unsigned*)(F.ctl + CW_BAR), F.MISC + 8);
#define GRID_BAR() xcd_barrier(bar)

    const float* x = F.in[0];
    bf16* XN = (bf16*)(F.ws + WS_XN); bf16* AO = (bf16*)(F.ws + WS_AO); bf16* BIG = (bf16*)(F.ws + WS_BIG);
    float* SG = (float*)(F.ws + WS_SG); float* CUM = (float*)(F.ws + WS_CUM);
    float* out = F.out;

    phase_rmsnorm_bf16(F, x, F.in[1], XN);
    GRID_BAR();
    { NGemm g1{XN, D, F.in[2], NFF, 0, D}, g2{XN, D, F.in[2], NFF, DFF, D}; EpiSwiglu E{BIG}; naive_gemm<true>(F, g1, g2, DFF, E); }
    GRID_BAR();
    { NGemm g1{BIG, DFF, F.in[3], D, 0, DFF}; EpiResid E{x, out, 0.5f}; naive_gemm<false>(F, g1, g1, D, E); }
    GRID_BAR();
    phase_rmsnorm_bf16(F, out, F.in[4], XN);
    GRID_BAR();
    { NGemm g1{XN, D, F.in[5], INC, 0, D}; EpiProj E{BIG, SG, F.in[6], F.in[9], F.in[10]}; naive_gemm<false>(F, g1, g1, INC, E); }
    GRID_BAR();
    phase_cumsum(F, SG, CUM);
    GRID_BAR();
    phase_mlstm_naive(F, BIG, SG, F.in[7], F.in[8], AO);
    phase_attn_naive(F, BIG, CUM, AO);
    GRID_BAR();
    { NGemm g1{AO, D, F.in[11], D, 0, 512}, g2{AO + 512, D, F.in[12], D, 0, 512}; EpiMerge E{BIG, XN}; naive_gemm<true>(F, g1, g2, D, E); }
    GRID_BAR();
    { NGemm g1{XN, D, F.in[13], D, 0, D}; EpiResid E{out, out, 1.0f}; naive_gemm<false>(F, g1, g1, D, E); }
    GRID_BAR();
    phase_rmsnorm_bf16(F, out, F.in[14], XN);
    GRID_BAR();
    { NGemm g1{XN, D, F.in[15], NFF, 0, D}, g2{XN, D, F.in[15], NFF, DFF, D}; EpiSwiglu E{BIG}; naive_gemm<true>(F, g1, g2, DFF, E); }
    GRID_BAR();
    { NGemm g1{BIG, DFF, F.in[16], D, 0, DFF}; EpiResid E{out, out, 0.5f}; naive_gemm<false>(F, g1, g1, D, E); }
    GRID_BAR();
    phase_rmsnorm_f32(F, out, F.in[17]);
}

extern "C" void kernel_launch(void* const* d_in, const int* in_sizes, int n_in, void* d_out, int out_size, void* d_ws, size_t ws_size, hipStream_t stream) {
    static int grid = 0;
    if (grid == 0) {
        if (n_in != 18 || in_sizes[0] != M * D || out_size != M * D || ws_size < WS_END) { fprintf(stderr, "kernel_launch: unexpected shapes (n_in %d, in0 %d, out %d, ws %zu)\n", n_in, n_in > 0 ? in_sizes[0] : -1, out_size, ws_size); grid = -1; return; }
        int dev = 0, cus = 0, per_cu = 0;
        if (hipGetDevice(&dev) != hipSuccess || hipDeviceGetAttribute(&cus, hipDeviceAttributeMultiprocessorCount, dev) != hipSuccess) { grid = -1; return; }
        if (hipFuncSetAttribute((const void*)fwd_kernel, hipFuncAttributeMaxDynamicSharedMemorySize, LDS_BYTES) != hipSuccess) { grid = -1; return; }
        if (hipOccupancyMaxActiveBlocksPerMultiprocessor(&per_cu, (const void*)fwd_kernel, NTHR, LDS_BYTES) != hipSuccess || per_cu < 1) { fprintf(stderr, "occupancy query says %d\n", per_cu); }
        (void)hipGetLastError();
        grid = cus;
    }
    if (grid < 0) return;
    if (hipMemsetAsync((char*)d_ws + WS_CTL, 0, CTL_ZERO_BYTES, stream) != hipSuccess) return;
    Args a{};
    for (int i = 0; i < 18; ++i) a.in[i] = (const float*)d_in[i];
    a.out = (float*)d_out; a.ws = (unsigned char*)d_ws;
    hipLaunchKernelGGL(fwd_kernel, dim3(grid), dim3(NTHR), LDS_BYTES, stream, a);
}
```

```cpp
#include <hip/hip_runtime.h>
#include <cstdio>
#include <cstdint>

#define GAS __attribute__((address_space(1)))
#define LAS __attribute__((address_space(3)))
typedef unsigned short bf16;
typedef unsigned v4u __attribute__((ext_vector_type(4)));
typedef float f32x4 __attribute__((ext_vector_type(4)));
typedef GAS unsigned gu32;
#define RLX_AGENT __ATOMIC_RELAXED, __HIP_MEMORY_SCOPE_AGENT

constexpr int BATCH = 32, SEQ = 2048, D = 1024, M = BATCH * SEQ;
constexpr int DFF = 2816, NFF = 2 * DFF;
constexpr int INC = 5648;
constexpr int PJ = 5632;
constexpr int FOXH = 8, FHD = 64, MLH = 4, MHD = 128;
constexpr int PC_FQ = 0, PC_FK = 512, PC_FV = 1024, PC_MQ = 1536, PC_MK = 2048, PC_MV = 2560, PC_MO = 3072, PC_GA = 3584, PC_GB = 4608;
constexpr float RMS_EPS = 1e-6f;
constexpr float LOG2E = 1.4426950408889634f;
constexpr float QSCALE2 = 0.125f * LOG2E;
constexpr int NWAVES = 8, NTHR = 512;
#ifndef FAST_MASK
#define FAST_MASK 0x7f
#endif

constexpr size_t MiB = 1u << 20;
constexpr size_t WS_CTL = 0, CTL_ZERO_BYTES = 1 * MiB;
constexpr size_t WS_W1IN = 2 * MiB, WS_W1OUT = 13 * MiB, WS_WIN = 19 * MiB, WS_WCAT = 31 * MiB, WS_WOUT = 33 * MiB, WS_W2IN = 35 * MiB, WS_W2OUT = 46 * MiB;
constexpr int NPJ = 5888;
constexpr size_t WS_SG = 52 * MiB;
constexpr size_t WS_CUM = 56 * MiB;
constexpr size_t WS_XN = 64 * MiB;
constexpr size_t WS_AO = 192 * MiB;
constexpr size_t WS_BIG = 320 * MiB;
constexpr size_t WS_END = 1024 * MiB;
constexpr int CW_BAR = 4096;

constexpr int LDS_BYTES = 147456;
constexpr int RING_BYTES = 131072, LDSCTL_OFF = RING_BYTES, MISC_OFF = LDSCTL_OFF + 320;

__device__ __forceinline__ float bf2f(bf16 v) { return __builtin_bit_cast(float, (unsigned)v << 16); }
__device__ __forceinline__ unsigned f2bf(float f) { unsigned u = __builtin_bit_cast(unsigned, f); return (u + 0x7fffu + ((u >> 16) & 1u)) >> 16; }
__device__ __forceinline__ unsigned pk2(float lo, float hi) { return f2bf(lo) | (f2bf(hi) << 16); }
__device__ __forceinline__ float sigmoidf_(float v) { return 1.f / (1.f + __expf(-v)); }
__device__ __forceinline__ float logsigmoidf_(float v) { return fminf(v, 0.f) - log1pf(__expf(-fabsf(v))); }
__device__ __forceinline__ float siluf_(float v) { return v / (1.f + __expf(-v)); }

#define XB_TMO      128
#define XB_XCNT(j)  (256  + 64 * (j))
#define XB_XSUB(j)  (1280 + 64 * (j))
#define XB_XGEN(j)  (2304 + 64 * (j))
#define XB_TOP      3328
#define XB_TOPGEN   3392
#define XCD_BAR_WORDS 3456
#define XB_SPIN_CAP (1u << 22)

__device__ __forceinline__ unsigned xb_ld(unsigned* p)              { return __hip_atomic_load(p, __ATOMIC_RELAXED, __HIP_MEMORY_SCOPE_AGENT); }
__device__ __forceinline__ unsigned xb_add(unsigned* p, unsigned v) { return __hip_atomic_fetch_add(p, v, __ATOMIC_RELAXED, __HIP_MEMORY_SCOPE_AGENT); }
__device__ __forceinline__ unsigned xb_xcc_id() { return (unsigned)__builtin_amdgcn_s_getreg((3 << 11) | 20) & 0xFu; }
#define XB_SPIN(cond, bar) do { unsigned _sp = 0; while (cond) { __builtin_amdgcn_s_sleep(1); \
    if ((++_sp & 255u) == 0u) { if (xb_ld(&(bar)[XB_TMO])) break; if (_sp > XB_SPIN_CAP) { atomicAdd(&(bar)[XB_TMO], 1u); break; } } } } while (0)

struct XcdBarrier { unsigned* bar; unsigned x; volatile LAS unsigned* st; };

__device__ __forceinline__ XcdBarrier xcd_barrier_post(unsigned* bar, volatile LAS unsigned* st) {
    XcdBarrier b; b.bar = bar; b.x = xb_xcc_id(); b.st = st;
    if (threadIdx.x == 0) (void)xb_add(&bar[XB_XCNT(b.x)], 1u);
    return b;
}
__device__ __forceinline__ void xcd_barrier_complete(unsigned* bar, unsigned x, unsigned& nloc, unsigned& nx) {
    const unsigned G = gridDim.x * gridDim.y * gridDim.z;
    unsigned sum, cnt, mine, sp = 0u;
    for (;;) {
        sum = 0u; cnt = 0u; mine = 0u;
#pragma unroll
        for (unsigned j = 0; j < 16; ++j) { const unsigned c = xb_ld(&bar[XB_XCNT(j)]); sum += c; cnt += (c > 0u) ? 1u : 0u; mine = (j == x) ? c : mine; }
        if (sum == G) break;
        __builtin_amdgcn_s_sleep(1);
        if ((++sp & 255u) == 0u) { if (xb_ld(&bar[XB_TMO])) break; if (sp > XB_SPIN_CAP) { atomicAdd(&bar[XB_TMO], 1u); break; } }
    }
    nloc = mine > 0u ? mine : 1u; nx = cnt > 0u ? cnt : 1u;
}
__device__ __forceinline__ void xcd_barrier(const XcdBarrier& b) {
    asm volatile("s_waitcnt vmcnt(0)" ::: "memory");
    __syncthreads();
    if (threadIdx.x == 0) {
        unsigned* bar = b.bar;
        __builtin_amdgcn_s_waitcnt(0);
        unsigned nloc = b.st[0], nx = b.st[1];
        if (nloc == 0u) { xcd_barrier_complete(bar, b.x, nloc, nx); b.st[0] = nloc; b.st[1] = nx; }
        const unsigned old = xb_add(&bar[XB_XSUB(b.x)], 1u);
        const unsigned gen = old / nloc;
        if (old + 1u == (gen + 1u) * nloc) {
            __builtin_amdgcn_fence(__ATOMIC_RELEASE, "agent");
            asm volatile("s_waitcnt vmcnt(0)" ::: "memory");
            const unsigned og = xb_add(&bar[XB_TOP], 1u);
            const unsigned tg = og / nx;
            if (og + 1u == (tg + 1u) * nx) xb_add(&bar[XB_TOPGEN], 1u);
            else XB_SPIN(xb_ld(&bar[XB_TOPGEN]) == tg, bar);
            __builtin_amdgcn_fence(__ATOMIC_ACQUIRE, "agent");
            xb_add(&bar[XB_XGEN(b.x)], 1u);
            asm volatile("s_waitcnt vmcnt(0)" ::: "memory");
        } else {
            XB_SPIN(xb_ld(&bar[XB_XGEN(b.x)]) == gen, bar);
            __builtin_amdgcn_fence(__ATOMIC_ACQUIRE, "agent");
            asm volatile("s_waitcnt vmcnt(0)" ::: "memory");
        }
    }
    __syncthreads();
}

struct Frame {
    LAS unsigned char* lds;
    volatile LAS unsigned* MISC;
    gu32* ctl;
    int tid, lane, wave, G;
    const float* in[18];
    float* out;
    unsigned char* ws;
};
struct Args { const float* in[18]; float* out; unsigned char* ws; };

__device__ __forceinline__ float wave_sum(float v) {
#pragma unroll
    for (int o = 1; o < 64; o <<= 1) v += __shfl_xor(v, o);
    return v;
}

__device__ __forceinline__ void phase_rmsnorm_bf16(Frame& F, const float* X, const float* gain, bf16* O) {
    const int gw = blockIdx.x * NWAVES + F.wave, NGW = F.G * NWAVES;
    f32x4 g[4];
#pragma unroll
    for (int j = 0; j < 4; ++j) g[j] = *((const GAS f32x4*)gain + F.lane + 64 * j);
    for (int m = gw; m < M; m += NGW) {
        const GAS f32x4* xr = (const GAS f32x4*)(X + (size_t)m * D) + F.lane;
        f32x4 v[4]; float s = 0.f;
#pragma unroll
        for (int j = 0; j < 4; ++j) { v[j] = xr[64 * j]; s += (v[j].x * v[j].x + v[j].y * v[j].y) + (v[j].z * v[j].z + v[j].w * v[j].w); }
        const float r = 1.0f / sqrtf(wave_sum(s) * (1.f / D) + RMS_EPS);
        GAS unsigned long long* o8 = (GAS unsigned long long*)(O + (size_t)m * D) + F.lane;
#pragma unroll
        for (int j = 0; j < 4; ++j) o8[64 * j] = (unsigned long long)pk2(v[j].x * r * g[j].x, v[j].y * r * g[j].y) | ((unsigned long long)pk2(v[j].z * r * g[j].z, v[j].w * r * g[j].w) << 32);
    }
}
__device__ __forceinline__ void phase_rmsnorm_f32(Frame& F, float* X, const float* gain) {
    const int gw = blockIdx.x * NWAVES + F.wave, NGW = F.G * NWAVES;
    f32x4 g[4];
#pragma unroll
    for (int j = 0; j < 4; ++j) g[j] = *((const GAS f32x4*)gain + F.lane + 64 * j);
    for (int m = gw; m < M; m += NGW) {
        GAS f32x4* xr = (GAS f32x4*)(X + (size_t)m * D) + F.lane;
        f32x4 v[4]; float s = 0.f;
#pragma unroll
        for (int j = 0; j < 4; ++j) { v[j] = xr[64 * j]; s += (v[j].x * v[j].x + v[j].y * v[j].y) + (v[j].z * v[j].z + v[j].w * v[j].w); }
        const float r = 1.0f / sqrtf(wave_sum(s) * (1.f / D) + RMS_EPS);
#pragma unroll
        for (int j = 0; j < 4; ++j) xr[64 * j] = v[j] * r * g[j];
    }
}

struct NGemm { const bf16* A; int lda; const float* W; int ldw; int off; int K; };
template <bool TWO, class Epi>
__device__ __forceinline__ void naive_gemm(Frame& F, const NGemm g1, const NGemm g2, int Nout, const Epi& epi) {
    LAS float* As = (LAS float*)F.lds;
    LAS float* Ws = (LAS float*)(F.lds + 32 * 132 * 4);
    const int tid = F.tid, ty = tid >> 4, tx = tid & 15;
    const int nNt = (Nout + 63) / 64, nMt = M / 128;
    for (int it = blockIdx.x; it < nMt * nNt; it += F.G) {
        const int mt = it / nNt, nt = it % nNt, m0 = mt * 128, c0 = nt * 64;
        float acc[2][4][4];
#pragma unroll
        for (int t = 0; t < 2; ++t)
#pragma unroll
            for (int i = 0; i < 4; ++i)
#pragma unroll
                for (int j = 0; j < 4; ++j) acc[t][i][j] = 0.f;
#pragma unroll
        for (int term = 0; term < (TWO ? 2 : 1); ++term) {
            const NGemm g = term ? g2 : g1;
            for (int k0 = 0; k0 < g.K; k0 += 32) {
                {
                    const int row = tid >> 2, kq = (tid & 3) * 8;
                    const v4u raw = *(const GAS v4u*)(g.A + (size_t)(m0 + row) * g.lda + k0 + kq);
                    const unsigned w[4] = {raw.x, raw.y, raw.z, raw.w};
#pragma unroll
                    for (int i = 0; i < 4; ++i) { As[(kq + 2 * i) * 132 + row] = __builtin_bit_cast(float, w[i] << 16); As[(kq + 2 * i + 1) * 132 + row] = __builtin_bit_cast(float, w[i] & 0xffff0000u); }
                }
                {
                    const int k = tid >> 4, c4 = (tid & 15) * 4;
#pragma unroll
                    for (int i = 0; i < 4; ++i) { const int c = c0 + c4 + i; Ws[k * 64 + c4 + i] = (c < Nout) ? g.W[(size_t)(k0 + k) * g.ldw + g.off + c] : 0.f; }
                }
                __syncthreads();
#pragma unroll 8
                for (int kk = 0; kk < 32; ++kk) {
                    const f32x4 a = *(const LAS f32x4*)(As + kk * 132 + 4 * ty);
                    const f32x4 w = *(const LAS f32x4*)(Ws + kk * 64 + 4 * tx);
#pragma unroll
                    for (int i = 0; i < 4; ++i)
#pragma unroll
                        for (int j = 0; j < 4; ++j) acc[term][i][j] += a[i] * w[j];
                }
                __syncthreads();
            }
        }
#pragma unroll
        for (int i = 0; i < 4; ++i)
#pragma unroll
            for (int j = 0; j < 4; ++j) { const int c = c0 + 4 * tx + j; if (c < Nout) epi(m0 + 4 * ty + i, c, acc[0][i][j], acc[1][i][j]); }
    }
}

struct EpiSwiglu { bf16* H; __device__ __forceinline__ void operator()(int m, int c, float g, float u) const { H[(size_t)m * DFF + c] = (bf16)f2bf(siluf_(g) * u); } };
struct EpiResid { const float* R; float* O; float coef; __device__ __forceinline__ void operator()(int m, int c, float v, float) const { O[(size_t)m * D + c] = R[(size_t)m * D + c] + coef * v; } };
struct EpiProj { bf16* P; float* SG; const float* fb; const float* ib; const float* mfb;
    __device__ __forceinline__ void operator()(int m, int c, float v, float) const {
        if (c < 512) P[(size_t)m * PJ + c] = (bf16)f2bf(v * QSCALE2);
        else if (c < 1536) P[(size_t)m * PJ + c] = (bf16)f2bf(v);
        else if (c < 1544) SG[(size_t)m * 16 + (c - 1536)] = logsigmoidf_(v + fb[c - 1536]);
        else if (c < 3080) P[(size_t)m * PJ + c - 8] = (bf16)f2bf(v);
        else if (c < 3084) SG[(size_t)m * 16 + 8 + (c - 3080)] = v + ib[c - 3080];
        else if (c < 3088) SG[(size_t)m * 16 + 12 + (c - 3084)] = logsigmoidf_(v + mfb[c - 3084]);
        else P[(size_t)m * PJ + c - 16] = (bf16)f2bf(sigmoidf_(v));
    } };
struct EpiMerge { const bf16* P; bf16* MG; __device__ __forceinline__ void operator()(int m, int c, float a, float b) const {
        MG[(size_t)m * D + c] = (bf16)f2bf(bf2f(P[(size_t)m * PJ + PC_GA + c]) * a + bf2f(P[(size_t)m * PJ + PC_GB + c]) * b); } };

__device__ __forceinline__ void phase_cumsum(Frame& F, const float* SG, float* CUM) {
    const int gw = blockIdx.x * NWAVES + F.wave, NGW = F.G * NWAVES;
    for (int it = gw; it < BATCH * FOXH; it += NGW) {
        const int b = it / FOXH, h = it % FOXH;
        float v[32]; float s = 0.f;
#pragma unroll
        for (int i = 0; i < 32; ++i) { s += SG[(size_t)(b * SEQ + F.lane * 32 + i) * 16 + h]; v[i] = s; }
        float incl = s;
#pragma unroll
        for (int o = 1; o < 64; o <<= 1) { const float t = __shfl_up(incl, o); if (F.lane >= o) incl += t; }
        const float excl = incl - s;
#pragma unroll
        for (int i = 0; i < 32; ++i) CUM[(size_t)it * SEQ + F.lane * 32 + i] = v[i] + excl;
    }
}

__device__ __forceinline__ void phase_attn_naive(Frame& F, const bf16* P, const float* CUM, bf16* AO) {
    LAS float* Ks = (LAS float*)F.lds;
    LAS float* Vs = (LAS float*)(F.lds + 16384);
    LAS float* Cs = (LAS float*)(F.lds + 32768);
    const int tid = F.tid, qi = tid >> 2, sub = tid & 3;
    for (int it = blockIdx.x; it < BATCH * FOXH * (SEQ / 128); it += F.G) {
        const int qt = it % (SEQ / 128), bh = it / (SEQ / 128), b = bh / FOXH, h = bh % FOXH;
        const int qpos = qt * 128 + qi;
        float q[16], o[16];
        { const bf16* qp = P + (size_t)(b * SEQ + qpos) * PJ + PC_FQ + h * 64 + sub * 16;
#pragma unroll
          for (int i = 0; i < 16; ++i) { q[i] = bf2f(qp[i]); o[i] = 0.f; } }
        const float ct = CUM[(size_t)bh * SEQ + qpos];
        float mx = -1e30f, l = 0.f;
        const int nkt = (qt * 128 + 127) / 64 + 1;
        for (int kt = 0; kt < nkt; ++kt) {
            __syncthreads();
            { const int row = tid >> 3, c8 = (tid & 7) * 8;
              const bf16* kp = P + (size_t)(b * SEQ + kt * 64 + row) * PJ + PC_FK + h * 64 + c8;
              const bf16* vp = P + (size_t)(b * SEQ + kt * 64 + row) * PJ + PC_FV + h * 64 + c8;
#pragma unroll
              for (int i = 0; i < 8; ++i) { Ks[row * 64 + c8 + i] = bf2f(kp[i]); Vs[row * 64 + c8 + i] = bf2f(vp[i]); }
              if (tid < 64) Cs[tid] = CUM[(size_t)bh * SEQ + kt * 64 + tid]; }
            __syncthreads();
            for (int j = 0; j < 64; ++j) {
                const int kpos = kt * 64 + j;
                float dot = 0.f;
#pragma unroll
                for (int i = 0; i < 16; ++i) dot += q[i] * Ks[j * 64 + sub * 16 + i];
                dot += __shfl_xor(dot, 1); dot += __shfl_xor(dot, 2);
                if (kpos <= qpos) {
                    const float s2 = dot + (ct - Cs[j]) * LOG2E;
                    if (s2 > mx) { const float sc = exp2f(mx - s2); l *= sc;
#pragma unroll
                        for (int i = 0; i < 16; ++i) o[i] *= sc;
                        mx = s2; }
                    const float p = exp2f(s2 - mx); l += p;
#pragma unroll
                    for (int i = 0; i < 16; ++i) o[i] += p * Vs[j * 64 + sub * 16 + i];
                }
            }
        }
        const float rl = 1.f / l;
        bf16* op = AO + (size_t)(b * SEQ + qpos) * D + h * 64 + sub * 16;
#pragma unroll
        for (int i = 0; i < 16; ++i) op[i] = (bf16)f2bf(o[i] * rl);
    }
}

__device__ __forceinline__ void phase_mlstm_naive(Frame& F, const bf16* P, const float* SG, const float* convw, const float* convb, bf16* AO) {
    LAS float* qs = (LAS float*)F.lds;
    LAS float* ks = qs + 128;
    LAS float* vs = ks + 128;
    LAS float* sc = vs + 128;
    LAS float* nump = sc + 4;
    LAS float* denp = nump + 512;
    const int tid = F.tid, e = tid & 127, dg = tid >> 7;
    for (int it = blockIdx.x; it < BATCH * MLH; it += F.G) {
        const int b = it / MLH, h = it % MLH;
        float C[32]; float nst = 0.f, mprev = 0.f;
#pragma unroll
        for (int i = 0; i < 32; ++i) C[i] = 0.f;
        int pcol = 0, cch = 0; float w0 = 0.f, w1 = 0.f, w2 = 0.f, w3 = 0.f, cb = 0.f, r0 = 0.f, r1 = 0.f, r2 = 0.f;
        if (tid < 256) { const bool isk = tid >= 128; const int i = tid & 127; pcol = (isk ? PC_MK : PC_MQ) + h * 128 + i; cch = (isk ? 512 : 0) + h * 128 + i;
            w0 = convw[0 * 1024 + cch]; w1 = convw[1 * 1024 + cch]; w2 = convw[2 * 1024 + cch]; w3 = convw[3 * 1024 + cch]; cb = convb[cch]; }
        else if (tid < 384) pcol = PC_MV + h * 128 + (tid - 256);
        float cur = 0.f, cur2 = 0.f;
        { const size_t row = (size_t)b * SEQ;
          if (tid < 384) cur = bf2f(P[row * PJ + pcol]);
          if (tid == 384) { cur = SG[row * 16 + 8 + h]; cur2 = SG[row * 16 + 12 + h]; } }
        for (int t = 0; t < SEQ; ++t) {
            const size_t row = (size_t)b * SEQ + t;
            float nxt = 0.f, nxt2 = 0.f;
            if (t + 1 < SEQ) { if (tid < 384) nxt = bf2f(P[(row + 1) * PJ + pcol]); if (tid == 384) { nxt = SG[(row + 1) * 16 + 8 + h]; nxt2 = SG[(row + 1) * 16 + 12 + h]; } }
            const float og = (tid < 128) ? bf2f(P[row * PJ + PC_MO + h * 128 + tid]) : 0.f;
            if (tid < 256) { float cv = w0 * r0 + w1 * r1 + w2 * r2 + w3 * cur + cb; cv = siluf_(cv); r0 = r1; r1 = r2; r2 = cur;
                if (tid < 128) qs[tid] = cv * 0.08838834764831845f; else ks[tid - 128] = cv; }
            else if (tid < 384) vs[tid - 256] = cur;
            else if (tid == 384) { const float ig = cur, lf = cur2; const float mn = fmaxf(lf + mprev, ig);
                sc[0] = __expf(lf + mprev - mn); sc[1] = __expf(ig - mn); sc[2] = __expf(-mn); mprev = mn; }
            __syncthreads();
            const float fdec = sc[0], iw = sc[1], emn = sc[2];
            const float ve = vs[e] * iw;
            float part = 0.f;
#pragma unroll
            for (int dd = 0; dd < 32; ++dd) { const int d = dg * 32 + dd; C[dd] = fdec * C[dd] + ks[d] * ve; part += qs[d] * C[dd]; }
            nump[dg * 128 + e] = part;
            if (tid < 128) { nst = fdec * nst + iw * ks[tid]; float dp = wave_sum(qs[tid] * nst); if (F.lane == 0) denp[tid >> 6] = dp; }
            __syncthreads();
            if (tid < 128) { const float num = (nump[tid] + nump[128 + tid]) + (nump[256 + tid] + nump[384 + tid]); const float den = denp[0] + denp[1];
                const float hv = num / fmaxf(fabsf(den), emn);
                AO[row * D + 512 + h * 128 + tid] = (bf16)f2bf(hv * og); }
            __syncthreads();
            cur = nxt; cur2 = nxt2;
        }
    }
}


namespace pg8 {
#define PG8_LAS __attribute__((address_space(3)))
typedef unsigned short bf16_t;
typedef short bf16x8 __attribute__((ext_vector_type(8)));
typedef float f32x4 __attribute__((ext_vector_type(4)));
typedef unsigned u32x4 __attribute__((ext_vector_type(4)));
constexpr int BM = 256, BK = 64, HALF = 128, HTB = HALF * BK * 2  , STAGE_BYTES = 8 * HTB, NXCD = 8, WGM = 8;

__host__ __device__ __forceinline__ int lds_byte(int r, int c) { const int st = (r >> 4) * 2 + (c >> 5), rr = r & 15, cc = c & 31, ob = rr * 64 + cc * 2; return st * 1024 + (ob ^ (((ob >> 9) & 1) << 5)); }
__host__ __device__ __forceinline__ void stage_rc(int b, int& R, int& C) { const int st = b / 1024, sb = b % 1024, swz = sb ^ (((sb >> 9) & 1) << 5); R = (st >> 1) * 16 + swz / 64; C = (st & 1) * 32 + (swz % 64) / 2; }
__host__ __device__ __forceinline__ int perm32(int rho) { const int n = rho >> 4, i = rho & 15; return 8 * (i >> 2) + 4 * n + (i & 3); }

struct Unit { int pm, pn; };
struct Gemm { const bf16_t* A; const bf16_t* Bt; int M, N, K, lda, ldb; };

struct StaticOrder {
    int nM, nN, nwg, G, c;
    __host__ __device__ void init(int M, int N, int G_, int c_) { nM = M / BM; nN = N / BM; nwg = nM * nN; G = G_; c = c_; }
    __host__ __device__ bool next(int i, Unit& u) const {
        const long L = (long)i * G + c; if (L >= nwg) return false;
        int wgid = (int)L; { const int q = nwg / NXCD, r = nwg % NXCD, xcd = wgid % NXCD, off = wgid / NXCD; wgid = (xcd < r ? xcd * (q + 1) : r * (q + 1) + (xcd - r) * q) + off; }
        const int nig = WGM * nN, gid = wgid / nig, fm = gid * WGM, gsz = (nM - fm) < WGM ? (nM - fm) : WGM;
        u.pm = fm + ((wgid % nig) % gsz); u.pn = (wgid % nig) / gsz; return true;
    }
    __device__ __forceinline__ void a_ready(const Unit&) const {}
    __device__ __forceinline__ void done(const Unit&) const {}
};

__device__ __forceinline__ unsigned cvt_pk_bf16(float lo, float hi) { unsigned r; asm volatile("v_cvt_pk_bf16_f32 %0, %1, %2" : "=v"(r) : "v"(lo), "v"(hi)); return r; }
template <class Epi, class Sched, bool ALIGN_EPI = false, bool SP2 = false>
__device__ __forceinline__ void gemm_phase(PG8_LAS unsigned char* lds, const Gemm g, const Sched& S, const Epi& E) {
    const int tid = threadIdx.x, wid = __builtin_amdgcn_readfirstlane(tid >> 6), lane = tid & 63, wr = wid >> 2, wc = wid & 3, fr = lane & 15, fq = lane >> 4;
    const int K = g.K, nt = K / BK;
    unsigned voffA[2], voffB[2];
#pragma unroll
    for (int i = 0; i < 2; ++i) { int R, C; stage_rc(tid * 16 + i * 8192, R, C); const int Rb = Epi::PERM ? ((R & ~31) + perm32(R & 31)) : R;
        voffA[i] = (unsigned)(R * g.lda + C) * 2u; voffB[i] = (unsigned)(Rb * g.ldb + C) * 2u; }
    const size_t kstep = (size_t)(BK * 2);
    const size_t hstepA = (size_t)HALF * g.lda * 2, hstepB = (size_t)HALF * g.ldb * 2;
    const size_t tstepA = 2 * hstepA, tstepB = 2 * hstepB;
    const unsigned ldsw = (unsigned)wid * 1024u;
    const int aoff = lds_byte(wr * 64 + fr, fq * 8), boff = lds_byte(wc * 32 + fr, fq * 8);
#define PG8_SA(b, h) (((b) * 2 + (h)) * HTB)
#define PG8_SB(b, h) ((4 + (b) * 2 + (h)) * HTB)
#define PG8_STAGE(bufoff, gbase, voff) do { _Pragma("unroll") for (int _i = 0; _i < 2; ++_i) \
        __builtin_amdgcn_global_load_lds((const unsigned*)((const char*)(gbase) + (voff)[_i]), (PG8_LAS unsigned*)(lds + (bufoff) + ldsw + _i * 8192), 16, 0, 0); } while (0)
#define PG8_LDA(dst, b, h) do { _Pragma("unroll") for (int m = 0; m < 4; ++m) _Pragma("unroll") for (int k = 0; k < 2; ++k) dst[m][k] = *(const PG8_LAS bf16x8*)(lds + PG8_SA(b, h) + aoff + m * 2048 + k * 1024); } while (0)
#define PG8_LDB(dst, b, h) do { _Pragma("unroll") for (int n = 0; n < 2; ++n) _Pragma("unroll") for (int k = 0; k < 2; ++k) dst[n][k] = *(const PG8_LAS bf16x8*)(lds + PG8_SB(b, h) + boff + n * 2048 + k * 1024); } while (0)
#define PG8_MMA(ai, bj, At, Bt) do { __builtin_amdgcn_s_setprio(1); _Pragma("unroll") for (int m = 0; m < 4; ++m) _Pragma("unroll") for (int n = 0; n < 2; ++n) _Pragma("unroll") for (int k = 0; k < 2; ++k) \
        acc[ai][bj][m][n] = __builtin_amdgcn_mfma_f32_16x16x32_bf16(Bt[n][k], At[m][k], acc[ai][bj][m][n], 0, 0, 0); __builtin_amdgcn_s_setprio(0); } while (0)
#define PG8_WAIT_V(n) asm volatile("s_waitcnt vmcnt(" #n ")" ::: "memory")
#define PG8_WAIT_L(n) asm volatile("s_waitcnt lgkmcnt(" #n ")" ::: "memory")
#define PG8_BAR __builtin_amdgcn_s_barrier()
#define PG8_SCHED __builtin_amdgcn_sched_barrier(0)
    Unit cur, nxt; int ui = 0;
    if (!S.next(0, cur)) return;
    f32x4 acc[2][2][4][2];
#pragma unroll
    for (int a = 0; a < 2; ++a)
#pragma unroll
        for (int b = 0; b < 2; ++b)
#pragma unroll
            for (int m = 0; m < 4; ++m)
#pragma unroll
                for (int n = 0; n < 2; ++n) acc[a][b][m][n] = (f32x4){0.f, 0.f, 0.f, 0.f};
    bf16x8 At[4][2], B0[2][2], B1[2][2];
    const char* cA = (const char*)g.A + (size_t)cur.pm * tstepA; const char* cB = (const char*)g.Bt + (size_t)cur.pn * tstepB;
    S.a_ready(cur);
    if constexpr (SP2) {
        PG8_STAGE(PG8_SB(0, 0), cB, voffB); PG8_STAGE(PG8_SB(0, 1), cB + hstepB, voffB); PG8_STAGE(PG8_SA(0, 0), cA, voffA); PG8_STAGE(PG8_SA(0, 1), cA + hstepA, voffA);
        if (wr == 1) PG8_BAR;
        PG8_WAIT_V(2); PG8_BAR;
        PG8_STAGE(PG8_SB(1, 0), cB + kstep, voffB); PG8_STAGE(PG8_SA(1, 0), cA + kstep, voffA); PG8_STAGE(PG8_SB(1, 1), cB + hstepB + kstep, voffB);
        PG8_WAIT_V(6); PG8_BAR;
    } else {
        PG8_STAGE(PG8_SB(0, 0), cB, voffB); PG8_STAGE(PG8_SA(0, 0), cA, voffA); PG8_STAGE(PG8_SB(0, 1), cB + hstepB, voffB); PG8_STAGE(PG8_SA(0, 1), cA + hstepA, voffA);
        if (wr == 1) PG8_BAR;
        PG8_WAIT_V(4); PG8_BAR;
        PG8_STAGE(PG8_SB(1, 0), cB + kstep, voffB); PG8_STAGE(PG8_SA(1, 0), cA + kstep, voffA); PG8_STAGE(PG8_SB(1, 1), cB + hstepB + kstep, voffB);
        PG8_WAIT_V(6); PG8_BAR;
    }
    for (;;) {
        const bool has_next = S.next(ui + 1, nxt);
        const char* nA = has_next ? (const char*)g.A + (size_t)nxt.pm * tstepA : cA; const char* nB = has_next ? (const char*)g.Bt + (size_t)nxt.pn * tstepB : cB;
        for (int t = 0; t < nt; t += 2) {
            const bool last = (t == nt - 2);
            const char* a1 = cA + (size_t)(t + 1) * kstep;
            const char* a2 = last ? nA : cA + (size_t)(t + 2) * kstep; const char* b2 = last ? nB : cB + (size_t)(t + 2) * kstep;
            const char* a3 = a2 + kstep; const char* b3 = b2 + kstep;
            if (last && has_next) S.a_ready(nxt);
            if constexpr (SP2) {
            PG8_LDB(B0, 0, 0); PG8_LDB(B1, 0, 1); PG8_SCHED; PG8_LDA(At, 0, 0); PG8_STAGE(PG8_SA(1, 1), a1 + hstepA, voffA);
            PG8_WAIT_V(8); PG8_WAIT_L(0); PG8_BAR; PG8_MMA(0, 0, At, B0); PG8_MMA(0, 1, At, B1); PG8_BAR; PG8_SCHED;
            PG8_LDA(At, 0, 1); PG8_STAGE(PG8_SB(0, 0), b2, voffB); PG8_STAGE(PG8_SB(0, 1), b2 + hstepB, voffB); PG8_STAGE(PG8_SA(0, 0), a2, voffA);
            PG8_WAIT_V(8); PG8_WAIT_L(0); PG8_BAR; PG8_MMA(1, 0, At, B0); PG8_MMA(1, 1, At, B1); PG8_BAR; PG8_SCHED;
            PG8_LDB(B0, 1, 0); PG8_LDB(B1, 1, 1); PG8_SCHED; PG8_LDA(At, 1, 0); PG8_STAGE(PG8_SA(0, 1), a2 + hstepA, voffA);
            PG8_WAIT_V(8); PG8_WAIT_L(0); PG8_BAR; PG8_MMA(0, 0, At, B0); PG8_MMA(0, 1, At, B1); PG8_BAR; PG8_SCHED;
            PG8_LDA(At, 1, 1); PG8_STAGE(PG8_SB(1, 0), b3, voffB); PG8_STAGE(PG8_SB(1, 1), b3 + hstepB, voffB); PG8_STAGE(PG8_SA(1, 0), a3, voffA);
            PG8_WAIT_V(8); PG8_WAIT_L(0); PG8_BAR; PG8_MMA(1, 0, At, B0); PG8_MMA(1, 1, At, B1); PG8_BAR; PG8_SCHED;
            } else {
            PG8_LDB(B0, 0, 0); PG8_SCHED; PG8_LDA(At, 0, 0); PG8_STAGE(PG8_SA(1, 1), a1 + hstepA, voffA);
            PG8_WAIT_L(8); PG8_BAR; PG8_WAIT_L(0); PG8_MMA(0, 0, At, B0); PG8_BAR; PG8_SCHED;
            PG8_LDB(B1, 0, 1); PG8_STAGE(PG8_SB(0, 0), b2, voffB);
            PG8_BAR; PG8_WAIT_L(0); PG8_MMA(0, 1, At, B1); PG8_BAR;
            PG8_LDA(At, 0, 1); PG8_STAGE(PG8_SA(0, 0), a2, voffA);
            PG8_BAR; PG8_WAIT_L(0); PG8_MMA(1, 0, At, B0); PG8_BAR; PG8_SCHED;
            PG8_STAGE(PG8_SB(0, 1), b2 + hstepB, voffB);
            PG8_WAIT_V(6); PG8_BAR; PG8_MMA(1, 1, At, B1); PG8_BAR;
            PG8_LDB(B0, 1, 0); PG8_SCHED; PG8_LDA(At, 1, 0); PG8_STAGE(PG8_SA(0, 1), a2 + hstepA, voffA);
            PG8_WAIT_L(8); PG8_BAR; PG8_WAIT_L(0); PG8_MMA(0, 0, At, B0); PG8_BAR; PG8_SCHED;
            PG8_LDB(B1, 1, 1); PG8_STAGE(PG8_SB(1, 0), b3, voffB);
            PG8_BAR; PG8_WAIT_L(0); PG8_MMA(0, 1, At, B1); PG8_BAR;
            PG8_LDA(At, 1, 1); PG8_STAGE(PG8_SA(1, 0), a3, voffA);
            PG8_BAR; PG8_WAIT_L(0); PG8_MMA(1, 0, At, B0); PG8_BAR; PG8_SCHED;
            PG8_STAGE(PG8_SB(1, 1), b3 + hstepB, voffB);
            PG8_WAIT_V(6); PG8_BAR; PG8_MMA(1, 1, At, B1); PG8_BAR;
            }
        }
        if constexpr (ALIGN_EPI) { if (wr == 0) PG8_BAR; }
        if constexpr (!Epi::AFTER_DRAIN) { E(acc, cur, wr, wc, fr, fq); S.done(cur); }
        if (!has_next) break;
#pragma unroll
        for (int a = 0; a < 2; ++a)
#pragma unroll
            for (int b = 0; b < 2; ++b)
#pragma unroll
                for (int m = 0; m < 4; ++m)
#pragma unroll
                    for (int n = 0; n < 2; ++n) acc[a][b][m][n] = (f32x4){0.f, 0.f, 0.f, 0.f};
        cur = nxt; cA = nA; cB = nB; ++ui;
        if constexpr (ALIGN_EPI) { if (wr == 1) PG8_BAR; }
    }
    PG8_WAIT_V(0);
    if constexpr (!ALIGN_EPI) { if (wr == 0) PG8_BAR; }
    PG8_BAR;
    if constexpr (Epi::AFTER_DRAIN) { E.fused(acc, cur, wr, wc, fr, fq, lds, wid, lane); S.done(cur); }
#undef PG8_SA
#undef PG8_SB
#undef PG8_STAGE
#undef PG8_LDA
#undef PG8_LDB
#undef PG8_MMA
#undef PG8_WAIT_V
#undef PG8_WAIT_L
#undef PG8_BAR
#undef PG8_SCHED
}
}

namespace pg8 {
__device__ __forceinline__ float fsig(float v) { return __builtin_amdgcn_rcpf(1.f + __builtin_amdgcn_exp2f(-1.4426950408889634f * v)); }
__device__ __forceinline__ u32x4 pack8(const f32x4 a, const f32x4 b) { u32x4 w; w.x = cvt_pk_bf16(a[0], a[1]); w.y = cvt_pk_bf16(a[2], a[3]); w.z = cvt_pk_bf16(b[0], b[1]); w.w = cvt_pk_bf16(b[2], b[3]); return w; }
__device__ __forceinline__ void unpack8(const u32x4 w, f32x4& a, f32x4& b) {
    a[0] = __builtin_bit_cast(float, w.x << 16); a[1] = __builtin_bit_cast(float, w.x & 0xffff0000u); a[2] = __builtin_bit_cast(float, w.y << 16); a[3] = __builtin_bit_cast(float, w.y & 0xffff0000u);
    b[0] = __builtin_bit_cast(float, w.z << 16); b[1] = __builtin_bit_cast(float, w.z & 0xffff0000u); b[2] = __builtin_bit_cast(float, w.w << 16); b[3] = __builtin_bit_cast(float, w.w & 0xffff0000u); }
struct EpiSwigluF { static constexpr bool PERM = true, AFTER_DRAIN = false; bf16_t* H;
    __device__ __forceinline__ void operator()(const f32x4 (&acc)[2][2][4][2], const Unit& u, int wr, int wc, int fr, int fq) const {
        const int row0 = u.pm * BM + wr * 64 + fr, col0 = u.pn * 128 + wc * 32 + 8 * fq;
#pragma unroll
        for (int ai = 0; ai < 2; ++ai)
#pragma unroll
            for (int m = 0; m < 4; ++m) { bf16_t* rowp = H + (size_t)(row0 + ai * HALF + m * 16) * DFF + col0;
                f32x4 h0, h1;
#pragma unroll
                for (int i = 0; i < 4; ++i) { const float g0 = acc[ai][0][m][0][i], g1 = acc[ai][0][m][1][i]; h0[i] = g0 * fsig(g0) * acc[ai][1][m][0][i]; h1[i] = g1 * fsig(g1) * acc[ai][1][m][1][i]; }
                *(u32x4*)rowp = pack8(h0, h1); }
    } };
struct EpiResidF { static constexpr bool PERM = false, AFTER_DRAIN = false; const float* R; float* O; float coef;
    __device__ __forceinline__ void operator()(const f32x4 (&acc)[2][2][4][2], const Unit& u, int wr, int wc, int fr, int fq) const {
        const int row0 = u.pm * BM + wr * 64 + fr, col0 = u.pn * BM + wc * 32 + 4 * fq;
#pragma unroll
        for (int ai = 0; ai < 2; ++ai)
#pragma unroll
            for (int m = 0; m < 4; ++m) { const size_t off = (size_t)(row0 + ai * HALF + m * 16) * D + col0;
#pragma unroll
                for (int bj = 0; bj < 2; ++bj)
#pragma unroll
                    for (int n = 0; n < 2; ++n) { const size_t p = off + bj * HALF + n * 16; const f32x4 r = *(const f32x4*)(R + p); *(f32x4*)(O + p) = r + acc[ai][bj][m][n] * coef; } }
    } };
struct EpiProjF { static constexpr bool PERM = true, AFTER_DRAIN = false; bf16_t* P; float* SG; const float* fb; const float* ib; const float* mfb;
    __device__ __forceinline__ void operator()(const f32x4 (&acc)[2][2][4][2], const Unit& u, int wr, int wc, int fr, int fq) const {
        const int row0 = u.pm * BM + wr * 64 + fr;
        if (u.pn < 22) {
            const int act = u.pn < 2 ? 0 : (u.pn < 12 ? 1 : 2); const int col0 = u.pn * BM + wc * 32 + 8 * fq;
#pragma unroll
            for (int ai = 0; ai < 2; ++ai)
#pragma unroll
                for (int m = 0; m < 4; ++m) { bf16_t* rowp = P + (size_t)(row0 + ai * HALF + m * 16) * PJ + col0;
#pragma unroll
                    for (int bj = 0; bj < 2; ++bj) { f32x4 v0 = acc[ai][bj][m][0], v1 = acc[ai][bj][m][1];
                        if (act == 0) { v0 = v0 * QSCALE2; v1 = v1 * QSCALE2; }
                        else if (act == 2) {
#pragma unroll
                            for (int i = 0; i < 4; ++i) { v0[i] = fsig(v0[i]); v1[i] = fsig(v1[i]); } }
                        *(u32x4*)(rowp + bj * HALF) = pack8(v0, v1); } }
        } else if (wc == 0 && fq < 2) {
            const f32x4 b0 = fq == 0 ? *(const f32x4*)fb : *(const f32x4*)ib, b1 = fq == 0 ? *(const f32x4*)(fb + 4) : *(const f32x4*)mfb;
#pragma unroll
            for (int ai = 0; ai < 2; ++ai)
#pragma unroll
                for (int m = 0; m < 4; ++m) { float* sp = SG + (size_t)(row0 + ai * HALF + m * 16) * 16 + 8 * fq;
                    f32x4 v0 = acc[ai][0][m][0] + b0, v1 = acc[ai][0][m][1] + b1;
#pragma unroll
                    for (int i = 0; i < 4; ++i) { if (fq == 0) v0[i] = logsigmoidf_(v0[i]); v1[i] = logsigmoidf_(v1[i]); }
                    *(f32x4*)sp = v0; *(f32x4*)(sp + 4) = v1; }
        }
    } };
template <bool SECOND> struct EpiGateF { static constexpr bool PERM = true, AFTER_DRAIN = false; const bf16_t* P; bf16_t* T;
    __device__ __forceinline__ void operator()(const f32x4 (&acc)[2][2][4][2], const Unit& u, int wr, int wc, int fr, int fq) const {
        const int row0 = u.pm * BM + wr * 64 + fr, col0 = u.pn * BM + wc * 32 + 8 * fq;
#pragma unroll
        for (int ai = 0; ai < 2; ++ai)
#pragma unroll
            for (int m = 0; m < 4; ++m) { const size_t row = (size_t)(row0 + ai * HALF + m * 16);
#pragma unroll
                for (int bj = 0; bj < 2; ++bj) { const int c = col0 + bj * HALF;
                    f32x4 g0, g1; unpack8(*(const u32x4*)(P + row * PJ + (SECOND ? PC_GB : PC_GA) + c), g0, g1);
                    f32x4 o0 = g0 * acc[ai][bj][m][0], o1 = g1 * acc[ai][bj][m][1];
                    if (SECOND) { f32x4 t0, t1; unpack8(*(const u32x4*)(T + row * D + c), t0, t1); o0 = o0 + t0; o1 = o1 + t1; }
                    *(u32x4*)(T + row * D + c) = pack8(o0, o1); } }
    } };
}

__device__ __forceinline__ void transpose_item(const float* W, int N, int scol0, bf16* WT, int ldt, int drow0, int k0, int kdst0, LAS float* scr, int lane) {
#pragma unroll 8
    for (int i = 0; i < 32; ++i) { const int kk = 2 * i + (lane >> 5); scr[kk * 33 + (lane & 31)] = W[(size_t)(k0 + kk) * N + scol0 + (lane & 31)]; }
    asm volatile("s_waitcnt lgkmcnt(0)" ::: "memory");
    const int c = lane & 7;
#pragma unroll
    for (int j = 0; j < 4; ++j) { const int n = (lane >> 3) + 8 * j; const LAS float* s = scr + (8 * c) * 33 + n;
        v4u o; o.x = pk2(s[0 * 33], s[1 * 33]); o.y = pk2(s[2 * 33], s[3 * 33]); o.z = pk2(s[4 * 33], s[5 * 33]); o.w = pk2(s[6 * 33], s[7 * 33]);
        *(GAS v4u*)(WT + (size_t)(drow0 + n) * ldt + kdst0 + k0 + 8 * c) = o; }
    asm volatile("s_waitcnt lgkmcnt(0)" ::: "memory");
}
__device__ __forceinline__ void phase_weights(Frame& F) {
    LAS float* scr = (LAS float*)(F.lds + F.wave * 16384);
    const int gw = blockIdx.x * NWAVES + F.wave, NGW = F.G * NWAVES;
    constexpr int I_IN = (D / 64) * (NFF / 32), I_OUT = (DFF / 64) * (D / 32), I_PJ = (D / 64) * (PJ / 32), I_UP = (512 / 64) * (D / 32), I_WO = (D / 64) * (D / 32);
    constexpr int NITEMS = 2 * I_IN + 2 * I_OUT + I_PJ + 2 * I_UP + I_WO;
    for (int it = gw; it < NITEMS; it += NGW) {
        int r = it;
        if (r < 2 * I_IN) { const int which = r / I_IN; r -= which * I_IN; const int ndb = NFF / 32, kb = r / ndb, db = r % ndb, n = db * 32, pn = n >> 8, j = n & 255;
            const int sc = (j < 128) ? pn * 128 + j : DFF + pn * 128 + (j - 128);
            transpose_item(F.in[which ? 15 : 2], NFF, sc, (bf16*)(F.ws + (which ? WS_W2IN : WS_W1IN)), D, n, kb * 64, 0, scr, F.lane); continue; }
        r -= 2 * I_IN;
        if (r < 2 * I_OUT) { const int which = r / I_OUT; r -= which * I_OUT; const int ndb = D / 32, kb = r / ndb, db = r % ndb;
            transpose_item(F.in[which ? 16 : 3], D, db * 32, (bf16*)(F.ws + (which ? WS_W2OUT : WS_W1OUT)), DFF, db * 32, kb * 64, 0, scr, F.lane); continue; }
        r -= 2 * I_OUT;
        if (r < I_PJ) { const int ndb = PJ / 32, kb = r / ndb, db = r % ndb, n = db * 32; const int sc = n + (n < 1536 ? 0 : (n < 3072 ? 8 : 16));
            transpose_item(F.in[5], INC, sc, (bf16*)(F.ws + WS_WIN), D, n, kb * 64, 0, scr, F.lane); continue; }
        r -= I_PJ;
        if (r < 2 * I_UP) { const int which = r / I_UP; r -= which * I_UP; const int ndb = D / 32, kb = r / ndb, db = r % ndb;
            transpose_item(F.in[which ? 12 : 11], D, db * 32, (bf16*)(F.ws + WS_WCAT), D, db * 32, kb * 64, which ? 512 : 0, scr, F.lane); continue; }
        r -= 2 * I_UP;
        { const int ndb = D / 32, kb = r / ndb, db = r % ndb; transpose_item(F.in[13], D, db * 32, (bf16*)(F.ws + WS_WOUT), D, db * 32, kb * 64, 0, scr, F.lane); }
    }
    { bf16* WT = (bf16*)(F.ws + WS_WIN); const float* W = F.in[5];
      for (int idx = blockIdx.x * NTHR + F.tid; idx < 256 * 128; idx += F.G * NTHR) { const int row = idx >> 7, k8 = (idx & 127) * 8; v4u o = {0u, 0u, 0u, 0u};
          if (row < 16) { const int sc = row < 8 ? 1536 + row : (row < 12 ? 3080 + (row - 8) : 3084 + (row - 12)); float v[8];
#pragma unroll
              for (int i = 0; i < 8; ++i) v[i] = W[(size_t)(k8 + i) * INC + sc];
              o.x = pk2(v[0], v[1]); o.y = pk2(v[2], v[3]); o.z = pk2(v[4], v[5]); o.w = pk2(v[6], v[7]); }
          *(GAS v4u*)(WT + (size_t)(PJ + row) * D + k8) = o; } }
}

__global__ void __launch_bounds__(NTHR, 2) fwd_kernel(Args args) {
    extern __shared__ __attribute__((aligned(16))) unsigned char lds[];
    Frame F;
    F.lds = (LAS unsigned char*)lds;
    F.MISC = (volatile LAS unsigned*)(F.lds + MISC_OFF);
    F.tid = threadIdx.x; F.lane = F.tid & 63; F.wave = __builtin_amdgcn_readfirstlane(F.tid >> 6);
    F.G = gridDim.x;
    F.ws = args.ws; F.out = args.out;
#pragma unroll
    for (int i = 0; i < 18; ++i) F.in[i] = args.in[i];
    F.ctl = (gu32*)(F.ws + WS_CTL);
    for (int u = F.tid; u < (LDS_BYTES - LDSCTL_OFF) / 4; u += NTHR) ((LAS unsigned*)(F.lds + LDSCTL_OFF))[u] = 0u;
    __syncthreads();
    XcdBarrier bar = xcd_barrier_post((unsigned*)(F.ctl + CW_BAR), F.MISC + 8);
#define GRID_BAR() xcd_barrier(bar)

    const float* x = F.in[0];
    bf16* XN = (bf16*)(F.ws + WS_XN); bf16* AO = (bf16*)(F.ws + WS_AO); bf16* BIG = (bf16*)(F.ws + WS_BIG);
    float* SG = (float*)(F.ws + WS_SG); float* CUM = (float*)(F.ws + WS_CUM);
    float* out = F.out;

    const bf16* W1IN = (const bf16*)(F.ws + WS_W1IN); const bf16* W1OUT = (const bf16*)(F.ws + WS_W1OUT); const bf16* WIN = (const bf16*)(F.ws + WS_WIN);
    const bf16* WCAT = (const bf16*)(F.ws + WS_WCAT); const bf16* WOUT = (const bf16*)(F.ws + WS_WOUT); const bf16* W2IN = (const bf16*)(F.ws + WS_W2IN); const bf16* W2OUT = (const bf16*)(F.ws + WS_W2OUT);
#define FAST(b) ((FAST_MASK >> (b)) & 1)
#define GEMM_PHASE(EpiT, gobj, eobj) do { pg8::StaticOrder S_; S_.init((gobj).M, (gobj).N, F.G, (int)blockIdx.x); pg8::gemm_phase<EpiT, pg8::StaticOrder, true, true>(F.lds, gobj, S_, eobj); } while (0)

    if (FAST_MASK & 0x7f) phase_weights(F);
    phase_rmsnorm_bf16(F, x, F.in[1], XN);
    GRID_BAR();
    if (FAST(0)) { pg8::Gemm g{XN, W1IN, M, NFF, D, D, D}; pg8::EpiSwigluF E{BIG}; GEMM_PHASE(pg8::EpiSwigluF, g, E); }
    else { NGemm g1{XN, D, F.in[2], NFF, 0, D}, g2{XN, D, F.in[2], NFF, DFF, D}; EpiSwiglu E{BIG}; naive_gemm<true>(F, g1, g2, DFF, E); }
    GRID_BAR();
    if (FAST(1)) { pg8::Gemm g{BIG, W1OUT, M, D, DFF, DFF, DFF}; pg8::EpiResidF E{x, out, 0.5f}; GEMM_PHASE(pg8::EpiResidF, g, E); }
    else { NGemm g1{BIG, DFF, F.in[3], D, 0, DFF}; EpiResid E{x, out, 0.5f}; naive_gemm<false>(F, g1, g1, D, E); }
    GRID_BAR();
    phase_rmsnorm_bf16(F, out, F.in[4], XN);
    GRID_BAR();
    if (FAST(2)) { pg8::Gemm g{XN, WIN, M, NPJ, D, D, D}; pg8::EpiProjF E{BIG, SG, F.in[6], F.in[9], F.in[10]}; GEMM_PHASE(pg8::EpiProjF, g, E); }
    else { NGemm g1{XN, D, F.in[5], INC, 0, D}; EpiProj E{BIG, SG, F.in[6], F.in[9], F.in[10]}; naive_gemm<false>(F, g1, g1, INC, E); }
    GRID_BAR();
    phase_cumsum(F, SG, CUM);
    GRID_BAR();
    phase_mlstm_naive(F, BIG, SG, F.in[7], F.in[8], AO);
    phase_attn_naive(F, BIG, CUM, AO);
    GRID_BAR();
    if (FAST(3)) { pg8::Gemm ga{AO, WCAT, M, D, 512, D, D}; pg8::EpiGateF<false> Ea{BIG, XN}; GEMM_PHASE(pg8::EpiGateF<false>, ga, Ea);
                   pg8::Gemm gb{AO + 512, WCAT + 512, M, D, 512, D, D}; pg8::EpiGateF<true> Eb{BIG, XN}; GEMM_PHASE(pg8::EpiGateF<true>, gb, Eb); }
    else { NGemm g1{AO, D, F.in[11], D, 0, 512}, g2{AO + 512, D, F.in[12], D, 0, 512}; EpiMerge E{BIG, XN}; naive_gemm<true>(F, g1, g2, D, E); }
    GRID_BAR();
    if (FAST(4)) { pg8::Gemm g{XN, WOUT, M, D, D, D, D}; pg8::EpiResidF E{out, out, 1.0f}; GEMM_PHASE(pg8::EpiResidF, g, E); }
    else { NGemm g1{XN, D, F.in[13], D, 0, D}; EpiResid E{out, out, 1.0f}; naive_gemm<false>(F, g1, g1, D, E); }
    GRID_BAR();
    phase_rmsnorm_bf16(F, out, F.in[14], XN);
    GRID_BAR();
    if (FAST(5)) { pg8::Gemm g{XN, W2IN, M, NFF, D, D, D}; pg8::EpiSwigluF E{BIG}; GEMM_PHASE(pg8::EpiSwigluF, g, E); }
    else { NGemm g1{XN, D, F.in[15], NFF, 0, D}, g2{XN, D, F.in[15], NFF, DFF, D}; EpiSwiglu E{BIG}; naive_gemm<true>(F, g1, g2, DFF, E); }
    GRID_BAR();
    if (FAST(6)) { pg8::Gemm g{BIG, W2OUT, M, D, DFF, DFF, DFF}; pg8::EpiResidF E{out, out, 0.5f}; GEMM_PHASE(pg8::EpiResidF, g, E); }
    else { NGemm g1{BIG, DFF, F.in[16], D, 0, DFF}; EpiResid E{out, out, 0.5f}; naive_gemm<false>(F, g1, g1, D, E); }
    GRID_BAR();
    phase_rmsnorm_f32(F, out, F.in[17]);
}

extern "C" void kernel_launch(void* const* d_in, const int* in_sizes, int n_in, void* d_out, int out_size, void* d_ws, size_t ws_size, hipStream_t stream) {
    static int grid = 0;
    if (grid == 0) {
        if (n_in != 18 || in_sizes[0] != M * D || out_size != M * D || ws_size < WS_END) { fprintf(stderr, "kernel_launch: unexpected shapes (n_in %d, in0 %d, out %d, ws %zu)\n", n_in, n_in > 0 ? in_sizes[0] : -1, out_size, ws_size); grid = -1; return; }
        int dev = 0, cus = 0, per_cu = 0;
        if (hipGetDevice(&dev) != hipSuccess || hipDeviceGetAttribute(&cus, hipDeviceAttributeMultiprocessorCount, dev) != hipSuccess) { grid = -1; return; }
        if (hipFuncSetAttribute((const void*)fwd_kernel, hipFuncAttributeMaxDynamicSharedMemorySize, LDS_BYTES) != hipSuccess) { grid = -1; return; }
        if (hipOccupancyMaxActiveBlocksPerMultiprocessor(&per_cu, (const void*)fwd_kernel, NTHR, LDS_BYTES) != hipSuccess || per_cu < 1) { fprintf(stderr, "occupancy query says %d\n", per_cu); }
        (void)hipGetLastError();
        grid = cus;
    }
    if (grid < 0) return;
    if (hipMemsetAsync((char*)d_ws + WS_CTL, 0, CTL_ZERO_BYTES, stream) != hipSuccess) return;
    Args a{};
    for (int i = 0; i < 18; ++i) a.in[i] = (const float*)d_in[i];
    a.out = (float*)d_out; a.ws = (unsigned char*)d_ws;
    hipLaunchKernelGGL(fwd_kernel, dim3(grid), dim3(NTHR), LDS_BYTES, stream, a);
}
```

```cpp
#include <hip/hip_runtime.h>
#include <cstdio>
#include <cstdint>

#define GAS __attribute__((address_space(1)))
#define LAS __attribute__((address_space(3)))
typedef unsigned short bf16;
typedef unsigned v4u __attribute__((ext_vector_type(4)));
typedef float f32x4 __attribute__((ext_vector_type(4)));
typedef GAS unsigned gu32;
#define RLX_AGENT __ATOMIC_RELAXED, __HIP_MEMORY_SCOPE_AGENT

constexpr int BATCH = 32, SEQ = 2048, D = 1024, M = BATCH * SEQ;
constexpr int DFF = 2816, NFF = 2 * DFF;
constexpr int INC = 5648;
constexpr int PJ = 5632;
constexpr int FOXH = 8, FHD = 64, MLH = 4, MHD = 128;
constexpr int PC_FQ = 0, PC_FK = 512, PC_FV = 1024, PC_MQ = 1536, PC_MK = 2048, PC_MV = 2560, PC_MO = 3072, PC_GA = 3584, PC_GB = 4608;
constexpr float RMS_EPS = 1e-6f;
constexpr float LOG2E = 1.4426950408889634f;
constexpr float QSCALE2 = 0.125f * LOG2E;
constexpr int NWAVES = 8, NTHR = 512;
#ifndef FAST_MASK
#define FAST_MASK 0xff
#endif

constexpr size_t MiB = 1u << 20;
constexpr size_t WS_CTL = 0, CTL_ZERO_BYTES = 1 * MiB;
constexpr size_t WS_W1IN = 2 * MiB, WS_W1OUT = 13 * MiB, WS_WIN = 19 * MiB, WS_WCAT = 31 * MiB, WS_WOUT = 33 * MiB, WS_W2IN = 35 * MiB, WS_W2OUT = 46 * MiB;
constexpr int NPJ = 5888;
constexpr size_t WS_SG = 52 * MiB;
constexpr size_t WS_CUM = 56 * MiB;
constexpr size_t WS_XN = 64 * MiB;
constexpr size_t WS_AO = 192 * MiB;
constexpr size_t WS_BIG = 320 * MiB;
constexpr size_t WS_END = 1024 * MiB;
constexpr int CW_BAR = 4096;

constexpr int LDS_BYTES = 147456;
constexpr int RING_BYTES = 131072, LDSCTL_OFF = RING_BYTES, MISC_OFF = LDSCTL_OFF + 320;

__device__ __forceinline__ float bf2f(bf16 v) { return __builtin_bit_cast(float, (unsigned)v << 16); }
__device__ __forceinline__ unsigned f2bf(float f) { unsigned u = __builtin_bit_cast(unsigned, f); return (u + 0x7fffu + ((u >> 16) & 1u)) >> 16; }
__device__ __forceinline__ unsigned pk2(float lo, float hi) { return f2bf(lo) | (f2bf(hi) << 16); }
__device__ __forceinline__ float sigmoidf_(float v) { return 1.f / (1.f + __expf(-v)); }
__device__ __forceinline__ float logsigmoidf_(float v) { return fminf(v, 0.f) - log1pf(__expf(-fabsf(v))); }
__device__ __forceinline__ float siluf_(float v) { return v / (1.f + __expf(-v)); }

#define XB_TMO      128
#define XB_XCNT(j)  (256  + 64 * (j))
#define XB_XSUB(j)  (1280 + 64 * (j))
#define XB_XGEN(j)  (2304 + 64 * (j))
#define XB_TOP      3328
#define XB_TOPGEN   3392
#define XCD_BAR_WORDS 3456
#define XB_SPIN_CAP (1u << 22)

__device__ __forceinline__ unsigned xb_ld(unsigned* p)              { return __hip_atomic_load(p, __ATOMIC_RELAXED, __HIP_MEMORY_SCOPE_AGENT); }
__device__ __forceinline__ unsigned xb_add(unsigned* p, unsigned v) { return __hip_atomic_fetch_add(p, v, __ATOMIC_RELAXED, __HIP_MEMORY_SCOPE_AGENT); }
__device__ __forceinline__ unsigned xb_xcc_id() { return (unsigned)__builtin_amdgcn_s_getreg((3 << 11) | 20) & 0xFu; }
#define XB_SPIN(cond, bar) do { unsigned _sp = 0; while (cond) { __builtin_amdgcn_s_sleep(1); \
    if ((++_sp & 255u) == 0u) { if (xb_ld(&(bar)[XB_TMO])) break; if (_sp > XB_SPIN_CAP) { atomicAdd(&(bar)[XB_TMO], 1u); break; } } } } while (0)

struct XcdBarrier { unsigned* bar; unsigned x; volatile LAS unsigned* st; };

__device__ __forceinline__ XcdBarrier xcd_barrier_post(unsigned* bar, volatile LAS unsigned* st) {
    XcdBarrier b; b.bar = bar; b.x = xb_xcc_id(); b.st = st;
    if (threadIdx.x == 0) (void)xb_add(&bar[XB_XCNT(b.x)], 1u);
    return b;
}
__device__ __forceinline__ void xcd_barrier_complete(unsigned* bar, unsigned x, unsigned& nloc, unsigned& nx) {
    const unsigned G = gridDim.x * gridDim.y * gridDim.z;
    unsigned sum, cnt, mine, sp = 0u;
    for (;;) {
        sum = 0u; cnt = 0u; mine = 0u;
#pragma unroll
        for (unsigned j = 0; j < 16; ++j) { const unsigned c = xb_ld(&bar[XB_XCNT(j)]); sum += c; cnt += (c > 0u) ? 1u : 0u; mine = (j == x) ? c : mine; }
        if (sum == G) break;
        __builtin_amdgcn_s_sleep(1);
        if ((++sp & 255u) == 0u) { if (xb_ld(&bar[XB_TMO])) break; if (sp > XB_SPIN_CAP) { atomicAdd(&bar[XB_TMO], 1u); break; } }
    }
    nloc = mine > 0u ? mine : 1u; nx = cnt > 0u ? cnt : 1u;
}
__device__ __forceinline__ void xcd_barrier(const XcdBarrier& b) {
    asm volatile("s_waitcnt vmcnt(0)" ::: "memory");
    __syncthreads();
    if (threadIdx.x == 0) {
        unsigned* bar = b.bar;
        __builtin_amdgcn_s_waitcnt(0);
        unsigned nloc = b.st[0], nx = b.st[1];
        if (nloc == 0u) { xcd_barrier_complete(bar, b.x, nloc, nx); b.st[0] = nloc; b.st[1] = nx; }
        const unsigned old = xb_add(&bar[XB_XSUB(b.x)], 1u);
        const unsigned gen = old / nloc;
        if (old + 1u == (gen + 1u) * nloc) {
            __builtin_amdgcn_fence(__ATOMIC_RELEASE, "agent");
            asm volatile("s_waitcnt vmcnt(0)" ::: "memory");
            const unsigned og = xb_add(&bar[XB_TOP], 1u);
            const unsigned tg = og / nx;
            if (og + 1u == (tg + 1u) * nx) xb_add(&bar[XB_TOPGEN], 1u);
            else XB_SPIN(xb_ld(&bar[XB_TOPGEN]) == tg, bar);
            __builtin_amdgcn_fence(__ATOMIC_ACQUIRE, "agent");
            xb_add(&bar[XB_XGEN(b.x)], 1u);
            asm volatile("s_waitcnt vmcnt(0)" ::: "memory");
        } else {
            XB_SPIN(xb_ld(&bar[XB_XGEN(b.x)]) == gen, bar);
            __builtin_amdgcn_fence(__ATOMIC_ACQUIRE, "agent");
            asm volatile("s_waitcnt vmcnt(0)" ::: "memory");
        }
    }
    __syncthreads();
}

struct Frame {
    LAS unsigned char* lds;
    volatile LAS unsigned* MISC;
    gu32* ctl;
    int tid, lane, wave, G;
    const float* in[18];
    float* out;
    unsigned char* ws;
};
struct Args { const float* in[18]; float* out; unsigned char* ws; };

__device__ __forceinline__ float wave_sum(float v) {
#pragma unroll
    for (int o = 1; o < 64; o <<= 1) v += __shfl_xor(v, o);
    return v;
}

__device__ __forceinline__ void phase_rmsnorm_bf16(Frame& F, const float* X, const float* gain, bf16* O) {
    const int gw = blockIdx.x * NWAVES + F.wave, NGW = F.G * NWAVES;
    f32x4 g[4];
#pragma unroll
    for (int j = 0; j < 4; ++j) g[j] = *((const GAS f32x4*)gain + F.lane + 64 * j);
    for (int m = gw; m < M; m += NGW) {
        const GAS f32x4* xr = (const GAS f32x4*)(X + (size_t)m * D) + F.lane;
        f32x4 v[4]; float s = 0.f;
#pragma unroll
        for (int j = 0; j < 4; ++j) { v[j] = xr[64 * j]; s += (v[j].x * v[j].x + v[j].y * v[j].y) + (v[j].z * v[j].z + v[j].w * v[j].w); }
        const float r = 1.0f / sqrtf(wave_sum(s) * (1.f / D) + RMS_EPS);
        GAS unsigned long long* o8 = (GAS unsigned long long*)(O + (size_t)m * D) + F.lane;
#pragma unroll
        for (int j = 0; j < 4; ++j) o8[64 * j] = (unsigned long long)pk2(v[j].x * r * g[j].x, v[j].y * r * g[j].y) | ((unsigned long long)pk2(v[j].z * r * g[j].z, v[j].w * r * g[j].w) << 32);
    }
}
__device__ __forceinline__ void phase_rmsnorm_f32(Frame& F, float* X, const float* gain) {
    const int gw = blockIdx.x * NWAVES + F.wave, NGW = F.G * NWAVES;
    f32x4 g[4];
#pragma unroll
    for (int j = 0; j < 4; ++j) g[j] = *((const GAS f32x4*)gain + F.lane + 64 * j);
    for (int m = gw; m < M; m += NGW) {
        GAS f32x4* xr = (GAS f32x4*)(X + (size_t)m * D) + F.lane;
        f32x4 v[4]; float s = 0.f;
#pragma unroll
        for (int j = 0; j < 4; ++j) { v[j] = xr[64 * j]; s += (v[j].x * v[j].x + v[j].y * v[j].y) + (v[j].z * v[j].z + v[j].w * v[j].w); }
        const float r = 1.0f / sqrtf(wave_sum(s) * (1.f / D) + RMS_EPS);
#pragma unroll
        for (int j = 0; j < 4; ++j) xr[64 * j] = v[j] * r * g[j];
    }
}

struct NGemm { const bf16* A; int lda; const float* W; int ldw; int off; int K; };
template <bool TWO, class Epi>
__device__ __forceinline__ void naive_gemm(Frame& F, const NGemm g1, const NGemm g2, int Nout, const Epi& epi) {
    LAS float* As = (LAS float*)F.lds;
    LAS float* Ws = (LAS float*)(F.lds + 32 * 132 * 4);
    const int tid = F.tid, ty = tid >> 4, tx = tid & 15;
    const int nNt = (Nout + 63) / 64, nMt = M / 128;
    for (int it = blockIdx.x; it < nMt * nNt; it += F.G) {
        const int mt = it / nNt, nt = it % nNt, m0 = mt * 128, c0 = nt * 64;
        float acc[2][4][4];
#pragma unroll
        for (int t = 0; t < 2; ++t)
#pragma unroll
            for (int i = 0; i < 4; ++i)
#pragma unroll
                for (int j = 0; j < 4; ++j) acc[t][i][j] = 0.f;
#pragma unroll
        for (int term = 0; term < (TWO ? 2 : 1); ++term) {
            const NGemm g = term ? g2 : g1;
            for (int k0 = 0; k0 < g.K; k0 += 32) {
                {
                    const int row = tid >> 2, kq = (tid & 3) * 8;
                    const v4u raw = *(const GAS v4u*)(g.A + (size_t)(m0 + row) * g.lda + k0 + kq);
                    const unsigned w[4] = {raw.x, raw.y, raw.z, raw.w};
#pragma unroll
                    for (int i = 0; i < 4; ++i) { As[(kq + 2 * i) * 132 + row] = __builtin_bit_cast(float, w[i] << 16); As[(kq + 2 * i + 1) * 132 + row] = __builtin_bit_cast(float, w[i] & 0xffff0000u); }
                }
                {
                    const int k = tid >> 4, c4 = (tid & 15) * 4;
#pragma unroll
                    for (int i = 0; i < 4; ++i) { const int c = c0 + c4 + i; Ws[k * 64 + c4 + i] = (c < Nout) ? g.W[(size_t)(k0 + k) * g.ldw + g.off + c] : 0.f; }
                }
                __syncthreads();
#pragma unroll 8
                for (int kk = 0; kk < 32; ++kk) {
                    const f32x4 a = *(const LAS f32x4*)(As + kk * 132 + 4 * ty);
                    const f32x4 w = *(const LAS f32x4*)(Ws + kk * 64 + 4 * tx);
#pragma unroll
                    for (int i = 0; i < 4; ++i)
#pragma unroll
                        for (int j = 0; j < 4; ++j) acc[term][i][j] += a[i] * w[j];
                }
                __syncthreads();
            }
        }
#pragma unroll
        for (int i = 0; i < 4; ++i)
#pragma unroll
            for (int j = 0; j < 4; ++j) { const int c = c0 + 4 * tx + j; if (c < Nout) epi(m0 + 4 * ty + i, c, acc[0][i][j], acc[1][i][j]); }
    }
}

struct EpiSwiglu { bf16* H; __device__ __forceinline__ void operator()(int m, int c, float g, float u) const { H[(size_t)m * DFF + c] = (bf16)f2bf(siluf_(g) * u); } };
struct EpiResid { const float* R; float* O; float coef; __device__ __forceinline__ void operator()(int m, int c, float v, float) const { O[(size_t)m * D + c] = R[(size_t)m * D + c] + coef * v; } };
struct EpiProj { bf16* P; float* SG; const float* fb; const float* ib; const float* mfb;
    __device__ __forceinline__ void operator()(int m, int c, float v, float) const {
        if (c < 512) P[(size_t)m * PJ + c] = (bf16)f2bf(v * QSCALE2);
        else if (c < 1536) P[(size_t)m * PJ + c] = (bf16)f2bf(v);
        else if (c < 1544) SG[(size_t)m * 16 + (c - 1536)] = logsigmoidf_(v + fb[c - 1536]);
        else if (c < 3080) P[(size_t)m * PJ + c - 8] = (bf16)f2bf(v);
        else if (c < 3084) SG[(size_t)m * 16 + 8 + (c - 3080)] = v + ib[c - 3080];
        else if (c < 3088) SG[(size_t)m * 16 + 12 + (c - 3084)] = logsigmoidf_(v + mfb[c - 3084]);
        else P[(size_t)m * PJ + c - 16] = (bf16)f2bf(sigmoidf_(v));
    } };
struct EpiMerge { const bf16* P; bf16* MG; __device__ __forceinline__ void operator()(int m, int c, float a, float b) const {
        MG[(size_t)m * D + c] = (bf16)f2bf(bf2f(P[(size_t)m * PJ + PC_GA + c]) * a + bf2f(P[(size_t)m * PJ + PC_GB + c]) * b); } };

__device__ __forceinline__ void phase_cumsum(Frame& F, const float* SG, float* CUM) {
    const int gw = blockIdx.x * NWAVES + F.wave, NGW = F.G * NWAVES;
    for (int it = gw; it < BATCH * FOXH; it += NGW) {
        const int b = it / FOXH, h = it % FOXH;
        float v[32]; float s = 0.f;
#pragma unroll
        for (int i = 0; i < 32; ++i) { s += SG[(size_t)(b * SEQ + F.lane * 32 + i) * 16 + h]; v[i] = s; }
        float incl = s;
#pragma unroll
        for (int o = 1; o < 64; o <<= 1) { const float t = __shfl_up(incl, o); if (F.lane >= o) incl += t; }
        const float excl = incl - s;
#pragma unroll
        for (int i = 0; i < 32; ++i) CUM[(size_t)it * SEQ + F.lane * 32 + i] = v[i] + excl;
    }
}

__device__ __forceinline__ void phase_attn_naive(Frame& F, const bf16* P, const float* CUM, bf16* AO) {
    LAS float* Ks = (LAS float*)F.lds;
    LAS float* Vs = (LAS float*)(F.lds + 16384);
    LAS float* Cs = (LAS float*)(F.lds + 32768);
    const int tid = F.tid, qi = tid >> 2, sub = tid & 3;
    for (int it = blockIdx.x; it < BATCH * FOXH * (SEQ / 128); it += F.G) {
        const int qt = it % (SEQ / 128), bh = it / (SEQ / 128), b = bh / FOXH, h = bh % FOXH;
        const int qpos = qt * 128 + qi;
        float q[16], o[16];
        { const bf16* qp = P + (size_t)(b * SEQ + qpos) * PJ + PC_FQ + h * 64 + sub * 16;
#pragma unroll
          for (int i = 0; i < 16; ++i) { q[i] = bf2f(qp[i]); o[i] = 0.f; } }
        const float ct = CUM[(size_t)bh * SEQ + qpos];
        float mx = -1e30f, l = 0.f;
        const int nkt = (qt * 128 + 127) / 64 + 1;
        for (int kt = 0; kt < nkt; ++kt) {
            __syncthreads();
            { const int row = tid >> 3, c8 = (tid & 7) * 8;
              const bf16* kp = P + (size_t)(b * SEQ + kt * 64 + row) * PJ + PC_FK + h * 64 + c8;
              const bf16* vp = P + (size_t)(b * SEQ + kt * 64 + row) * PJ + PC_FV + h * 64 + c8;
#pragma unroll
              for (int i = 0; i < 8; ++i) { Ks[row * 64 + c8 + i] = bf2f(kp[i]); Vs[row * 64 + c8 + i] = bf2f(vp[i]); }
              if (tid < 64) Cs[tid] = CUM[(size_t)bh * SEQ + kt * 64 + tid]; }
            __syncthreads();
            for (int j = 0; j < 64; ++j) {
                const int kpos = kt * 64 + j;
                float dot = 0.f;
#pragma unroll
                for (int i = 0; i < 16; ++i) dot += q[i] * Ks[j * 64 + sub * 16 + i];
                dot += __shfl_xor(dot, 1); dot += __shfl_xor(dot, 2);
                if (kpos <= qpos) {
                    const float s2 = dot + (ct - Cs[j]) * LOG2E;
                    if (s2 > mx) { const float sc = exp2f(mx - s2); l *= sc;
#pragma unroll
                        for (int i = 0; i < 16; ++i) o[i] *= sc;
                        mx = s2; }
                    const float p = exp2f(s2 - mx); l += p;
#pragma unroll
                    for (int i = 0; i < 16; ++i) o[i] += p * Vs[j * 64 + sub * 16 + i];
                }
            }
        }
        const float rl = 1.f / l;
        bf16* op = AO + (size_t)(b * SEQ + qpos) * D + h * 64 + sub * 16;
#pragma unroll
        for (int i = 0; i < 16; ++i) op[i] = (bf16)f2bf(o[i] * rl);
    }
}

__device__ __forceinline__ void phase_mlstm_naive(Frame& F, const bf16* P, const float* SG, const float* convw, const float* convb, bf16* AO) {
    LAS float* qs = (LAS float*)F.lds;
    LAS float* ks = qs + 128;
    LAS float* vs = ks + 128;
    LAS float* sc = vs + 128;
    LAS float* nump = sc + 4;
    LAS float* denp = nump + 512;
    const int tid = F.tid, e = tid & 127, dg = tid >> 7;
    for (int it = blockIdx.x; it < BATCH * MLH; it += F.G) {
        const int b = it / MLH, h = it % MLH;
        float C[32]; float nst = 0.f, mprev = 0.f;
#pragma unroll
        for (int i = 0; i < 32; ++i) C[i] = 0.f;
        int pcol = 0, cch = 0; float w0 = 0.f, w1 = 0.f, w2 = 0.f, w3 = 0.f, cb = 0.f, r0 = 0.f, r1 = 0.f, r2 = 0.f;
        if (tid < 256) { const bool isk = tid >= 128; const int i = tid & 127; pcol = (isk ? PC_MK : PC_MQ) + h * 128 + i; cch = (isk ? 512 : 0) + h * 128 + i;
            w0 = convw[0 * 1024 + cch]; w1 = convw[1 * 1024 + cch]; w2 = convw[2 * 1024 + cch]; w3 = convw[3 * 1024 + cch]; cb = convb[cch]; }
        else if (tid < 384) pcol = PC_MV + h * 128 + (tid - 256);
        float cur = 0.f, cur2 = 0.f;
        { const size_t row = (size_t)b * SEQ;
          if (tid < 384) cur = bf2f(P[row * PJ + pcol]);
          if (tid == 384) { cur = SG[row * 16 + 8 + h]; cur2 = SG[row * 16 + 12 + h]; } }
        for (int t = 0; t < SEQ; ++t) {
            const size_t row = (size_t)b * SEQ + t;
            float nxt = 0.f, nxt2 = 0.f;
            if (t + 1 < SEQ) { if (tid < 384) nxt = bf2f(P[(row + 1) * PJ + pcol]); if (tid == 384) { nxt = SG[(row + 1) * 16 + 8 + h]; nxt2 = SG[(row + 1) * 16 + 12 + h]; } }
            const float og = (tid < 128) ? bf2f(P[row * PJ + PC_MO + h * 128 + tid]) : 0.f;
            if (tid < 256) { float cv = w0 * r0 + w1 * r1 + w2 * r2 + w3 * cur + cb; cv = siluf_(cv); r0 = r1; r1 = r2; r2 = cur;
                if (tid < 128) qs[tid] = cv * 0.08838834764831845f; else ks[tid - 128] = cv; }
            else if (tid < 384) vs[tid - 256] = cur;
            else if (tid == 384) { const float ig = cur, lf = cur2; const float mn = fmaxf(lf + mprev, ig);
                sc[0] = __expf(lf + mprev - mn); sc[1] = __expf(ig - mn); sc[2] = __expf(-mn); mprev = mn; }
            __syncthreads();
            const float fdec = sc[0], iw = sc[1], emn = sc[2];
            const float ve = vs[e] * iw;
            float part = 0.f;
#pragma unroll
            for (int dd = 0; dd < 32; ++dd) { const int d = dg * 32 + dd; C[dd] = fdec * C[dd] + ks[d] * ve; part += qs[d] * C[dd]; }
            nump[dg * 128 + e] = part;
            if (tid < 128) { nst = fdec * nst + iw * ks[tid]; float dp = wave_sum(qs[tid] * nst); if (F.lane == 0) denp[tid >> 6] = dp; }
            __syncthreads();
            if (tid < 128) { const float num = (nump[tid] + nump[128 + tid]) + (nump[256 + tid] + nump[384 + tid]); const float den = denp[0] + denp[1];
                const float hv = num / fmaxf(fabsf(den), emn);
                AO[row * D + 512 + h * 128 + tid] = (bf16)f2bf(hv * og); }
            __syncthreads();
            cur = nxt; cur2 = nxt2;
        }
    }
}


namespace pg8 {
#define PG8_LAS __attribute__((address_space(3)))
typedef unsigned short bf16_t;
typedef short bf16x8 __attribute__((ext_vector_type(8)));
typedef float f32x4 __attribute__((ext_vector_type(4)));
typedef unsigned u32x4 __attribute__((ext_vector_type(4)));
constexpr int BM = 256, BK = 64, HALF = 128, HTB = HALF * BK * 2  , STAGE_BYTES = 8 * HTB, NXCD = 8, WGM = 8;

__host__ __device__ __forceinline__ int lds_byte(int r, int c) { const int st = (r >> 4) * 2 + (c >> 5), rr = r & 15, cc = c & 31, ob = rr * 64 + cc * 2; return st * 1024 + (ob ^ (((ob >> 9) & 1) << 5)); }
__host__ __device__ __forceinline__ void stage_rc(int b, int& R, int& C) { const int st = b / 1024, sb = b % 1024, swz = sb ^ (((sb >> 9) & 1) << 5); R = (st >> 1) * 16 + swz / 64; C = (st & 1) * 32 + (swz % 64) / 2; }
__host__ __device__ __forceinline__ int perm32(int rho) { const int n = rho >> 4, i = rho & 15; return 8 * (i >> 2) + 4 * n + (i & 3); }

struct Unit { int pm, pn; };
struct Gemm { const bf16_t* A; const bf16_t* Bt; int M, N, K, lda, ldb; };

struct StaticOrder {
    int nM, nN, nwg, G, c;
    __host__ __device__ void init(int M, int N, int G_, int c_) { nM = M / BM; nN = N / BM; nwg = nM * nN; G = G_; c = c_; }
    __host__ __device__ bool next(int i, Unit& u) const {
        const long L = (long)i * G + c; if (L >= nwg) return false;
        int wgid = (int)L; { const int q = nwg / NXCD, r = nwg % NXCD, xcd = wgid % NXCD, off = wgid / NXCD; wgid = (xcd < r ? xcd * (q + 1) : r * (q + 1) + (xcd - r) * q) + off; }
        const int nig = WGM * nN, gid = wgid / nig, fm = gid * WGM, gsz = (nM - fm) < WGM ? (nM - fm) : WGM;
        u.pm = fm + ((wgid % nig) % gsz); u.pn = (wgid % nig) / gsz; return true;
    }
    __device__ __forceinline__ void a_ready(const Unit&) const {}
    __device__ __forceinline__ void done(const Unit&) const {}
};

__device__ __forceinline__ unsigned cvt_pk_bf16(float lo, float hi) { unsigned r; asm volatile("v_cvt_pk_bf16_f32 %0, %1, %2" : "=v"(r) : "v"(lo), "v"(hi)); return r; }
template <class Epi, class Sched, bool ALIGN_EPI = false, bool SP2 = false>
__device__ __forceinline__ void gemm_phase(PG8_LAS unsigned char* lds, const Gemm g, const Sched& S, const Epi& E) {
    int tid_ = threadIdx.x; asm volatile("" : "+v"(tid_));
    const int tid = tid_, wid = __builtin_amdgcn_readfirstlane(tid >> 6), lane = tid & 63, wr = wid >> 2, wc = wid & 3, fr = lane & 15, fq = lane >> 4;
    const int K = g.K, nt = K / BK;
    unsigned voffA[2], voffB[2];
#pragma unroll
    for (int i = 0; i < 2; ++i) { int R, C; stage_rc(tid * 16 + i * 8192, R, C); const int Rb = Epi::PERM ? ((R & ~31) + perm32(R & 31)) : R;
        voffA[i] = (unsigned)(R * g.lda + C) * 2u; voffB[i] = (unsigned)(Rb * g.ldb + C) * 2u; }
    const size_t kstep = (size_t)(BK * 2);
    const size_t hstepA = (size_t)HALF * g.lda * 2, hstepB = (size_t)HALF * g.ldb * 2;
    const size_t tstepA = 2 * hstepA, tstepB = 2 * hstepB;
    const unsigned ldsw = (unsigned)wid * 1024u;
    const int aoff = lds_byte(wr * 64 + fr, fq * 8), boff = lds_byte(wc * 32 + fr, fq * 8);
#define PG8_SA(b, h) (((b) * 2 + (h)) * HTB)
#define PG8_SB(b, h) ((4 + (b) * 2 + (h)) * HTB)
#define PG8_STAGE(bufoff, gbase, voff) do { _Pragma("unroll") for (int _i = 0; _i < 2; ++_i) \
        __builtin_amdgcn_global_load_lds((const unsigned*)((const char*)(gbase) + (voff)[_i]), (PG8_LAS unsigned*)(lds + (bufoff) + ldsw + _i * 8192), 16, 0, 0); } while (0)
#define PG8_LDA(dst, b, h) do { _Pragma("unroll") for (int m = 0; m < 4; ++m) _Pragma("unroll") for (int k = 0; k < 2; ++k) dst[m][k] = *(const PG8_LAS bf16x8*)(lds + PG8_SA(b, h) + aoff + m * 2048 + k * 1024); } while (0)
#define PG8_LDB(dst, b, h) do { _Pragma("unroll") for (int n = 0; n < 2; ++n) _Pragma("unroll") for (int k = 0; k < 2; ++k) dst[n][k] = *(const PG8_LAS bf16x8*)(lds + PG8_SB(b, h) + boff + n * 2048 + k * 1024); } while (0)
#define PG8_MMA(ai, bj, At, Bt) do { __builtin_amdgcn_s_setprio(1); _Pragma("unroll") for (int m = 0; m < 4; ++m) _Pragma("unroll") for (int n = 0; n < 2; ++n) _Pragma("unroll") for (int k = 0; k < 2; ++k) \
        acc[ai][bj][m][n] = __builtin_amdgcn_mfma_f32_16x16x32_bf16(Bt[n][k], At[m][k], acc[ai][bj][m][n], 0, 0, 0); __builtin_amdgcn_s_setprio(0); } while (0)
#define PG8_WAIT_V(n) asm volatile("s_waitcnt vmcnt(" #n ")" ::: "memory")
#define PG8_WAIT_L(n) asm volatile("s_waitcnt lgkmcnt(" #n ")" ::: "memory")
#define PG8_BAR __builtin_amdgcn_s_barrier()
#define PG8_SCHED __builtin_amdgcn_sched_barrier(0)
    Unit cur, nxt; int ui = 0;
    if (!S.next(0, cur)) return;
    f32x4 acc[2][2][4][2];
#pragma unroll
    for (int a = 0; a < 2; ++a)
#pragma unroll
        for (int b = 0; b < 2; ++b)
#pragma unroll
            for (int m = 0; m < 4; ++m)
#pragma unroll
                for (int n = 0; n < 2; ++n) acc[a][b][m][n] = (f32x4){0.f, 0.f, 0.f, 0.f};
    bf16x8 At[4][2], B0[2][2], B1[2][2];
    const char* cA = (const char*)g.A + (size_t)cur.pm * tstepA; const char* cB = (const char*)g.Bt + (size_t)cur.pn * tstepB;
    S.a_ready(cur);
    if constexpr (SP2) {
        PG8_STAGE(PG8_SB(0, 0), cB, voffB); PG8_STAGE(PG8_SB(0, 1), cB + hstepB, voffB); PG8_STAGE(PG8_SA(0, 0), cA, voffA); PG8_STAGE(PG8_SA(0, 1), cA + hstepA, voffA);
        if (wr == 1) PG8_BAR;
        PG8_WAIT_V(2); PG8_BAR;
        PG8_STAGE(PG8_SB(1, 0), cB + kstep, voffB); PG8_STAGE(PG8_SA(1, 0), cA + kstep, voffA); PG8_STAGE(PG8_SB(1, 1), cB + hstepB + kstep, voffB);
        PG8_WAIT_V(6); PG8_BAR;
    } else {
        PG8_STAGE(PG8_SB(0, 0), cB, voffB); PG8_STAGE(PG8_SA(0, 0), cA, voffA); PG8_STAGE(PG8_SB(0, 1), cB + hstepB, voffB); PG8_STAGE(PG8_SA(0, 1), cA + hstepA, voffA);
        if (wr == 1) PG8_BAR;
        PG8_WAIT_V(4); PG8_BAR;
        PG8_STAGE(PG8_SB(1, 0), cB + kstep, voffB); PG8_STAGE(PG8_SA(1, 0), cA + kstep, voffA); PG8_STAGE(PG8_SB(1, 1), cB + hstepB + kstep, voffB);
        PG8_WAIT_V(6); PG8_BAR;
    }
    for (;;) {
        const bool has_next = S.next(ui + 1, nxt);
        const char* nA = has_next ? (const char*)g.A + (size_t)nxt.pm * tstepA : cA; const char* nB = has_next ? (const char*)g.Bt + (size_t)nxt.pn * tstepB : cB;
        for (int t = 0; t < nt; t += 2) {
            const bool last = (t == nt - 2);
            const char* a1 = cA + (size_t)(t + 1) * kstep;
            const char* a2 = last ? nA : cA + (size_t)(t + 2) * kstep; const char* b2 = last ? nB : cB + (size_t)(t + 2) * kstep;
            const char* a3 = a2 + kstep; const char* b3 = b2 + kstep;
            if (last && has_next) S.a_ready(nxt);
            if constexpr (SP2) {
            PG8_LDB(B0, 0, 0); PG8_LDB(B1, 0, 1); PG8_SCHED; PG8_LDA(At, 0, 0); PG8_STAGE(PG8_SA(1, 1), a1 + hstepA, voffA);
            PG8_WAIT_V(8); PG8_WAIT_L(0); PG8_BAR; PG8_MMA(0, 0, At, B0); PG8_MMA(0, 1, At, B1); PG8_BAR; PG8_SCHED;
            PG8_LDA(At, 0, 1); PG8_STAGE(PG8_SB(0, 0), b2, voffB); PG8_STAGE(PG8_SB(0, 1), b2 + hstepB, voffB); PG8_STAGE(PG8_SA(0, 0), a2, voffA);
            PG8_WAIT_V(8); PG8_WAIT_L(0); PG8_BAR; PG8_MMA(1, 0, At, B0); PG8_MMA(1, 1, At, B1); PG8_BAR; PG8_SCHED;
            PG8_LDB(B0, 1, 0); PG8_LDB(B1, 1, 1); PG8_SCHED; PG8_LDA(At, 1, 0); PG8_STAGE(PG8_SA(0, 1), a2 + hstepA, voffA);
            PG8_WAIT_V(8); PG8_WAIT_L(0); PG8_BAR; PG8_MMA(0, 0, At, B0); PG8_MMA(0, 1, At, B1); PG8_BAR; PG8_SCHED;
            PG8_LDA(At, 1, 1); PG8_STAGE(PG8_SB(1, 0), b3, voffB); PG8_STAGE(PG8_SB(1, 1), b3 + hstepB, voffB); PG8_STAGE(PG8_SA(1, 0), a3, voffA);
            PG8_WAIT_V(8); PG8_WAIT_L(0); PG8_BAR; PG8_MMA(1, 0, At, B0); PG8_MMA(1, 1, At, B1); PG8_BAR; PG8_SCHED;
            } else {
            PG8_LDB(B0, 0, 0); PG8_SCHED; PG8_LDA(At, 0, 0); PG8_STAGE(PG8_SA(1, 1), a1 + hstepA, voffA);
            PG8_WAIT_L(8); PG8_BAR; PG8_WAIT_L(0); PG8_MMA(0, 0, At, B0); PG8_BAR; PG8_SCHED;
            PG8_LDB(B1, 0, 1); PG8_STAGE(PG8_SB(0, 0), b2, voffB);
            PG8_BAR; PG8_WAIT_L(0); PG8_MMA(0, 1, At, B1); PG8_BAR;
            PG8_LDA(At, 0, 1); PG8_STAGE(PG8_SA(0, 0), a2, voffA);
            PG8_BAR; PG8_WAIT_L(0); PG8_MMA(1, 0, At, B0); PG8_BAR; PG8_SCHED;
            PG8_STAGE(PG8_SB(0, 1), b2 + hstepB, voffB);
            PG8_WAIT_V(6); PG8_BAR; PG8_MMA(1, 1, At, B1); PG8_BAR;
            PG8_LDB(B0, 1, 0); PG8_SCHED; PG8_LDA(At, 1, 0); PG8_STAGE(PG8_SA(0, 1), a2 + hstepA, voffA);
            PG8_WAIT_L(8); PG8_BAR; PG8_WAIT_L(0); PG8_MMA(0, 0, At, B0); PG8_BAR; PG8_SCHED;
            PG8_LDB(B1, 1, 1); PG8_STAGE(PG8_SB(1, 0), b3, voffB);
            PG8_BAR; PG8_WAIT_L(0); PG8_MMA(0, 1, At, B1); PG8_BAR;
            PG8_LDA(At, 1, 1); PG8_STAGE(PG8_SA(1, 0), a3, voffA);
            PG8_BAR; PG8_WAIT_L(0); PG8_MMA(1, 0, At, B0); PG8_BAR; PG8_SCHED;
            PG8_STAGE(PG8_SB(1, 1), b3 + hstepB, voffB);
            PG8_WAIT_V(6); PG8_BAR; PG8_MMA(1, 1, At, B1); PG8_BAR;
            }
        }
        if constexpr (ALIGN_EPI) { if (wr == 0) PG8_BAR; }
        if constexpr (!Epi::AFTER_DRAIN) { E(acc, cur, wr, wc, fr, fq); S.done(cur); }
        if (!has_next) break;
#pragma unroll
        for (int a = 0; a < 2; ++a)
#pragma unroll
            for (int b = 0; b < 2; ++b)
#pragma unroll
                for (int m = 0; m < 4; ++m)
#pragma unroll
                    for (int n = 0; n < 2; ++n) acc[a][b][m][n] = (f32x4){0.f, 0.f, 0.f, 0.f};
        cur = nxt; cA = nA; cB = nB; ++ui;
        if constexpr (ALIGN_EPI) { if (wr == 1) PG8_BAR; }
    }
    PG8_WAIT_V(0);
    if constexpr (!ALIGN_EPI) { if (wr == 0) PG8_BAR; }
    PG8_BAR;
    if constexpr (Epi::AFTER_DRAIN) { E.fused(acc, cur, wr, wc, fr, fq, lds, wid, lane); S.done(cur); }
#undef PG8_SA
#undef PG8_SB
#undef PG8_STAGE
#undef PG8_LDA
#undef PG8_LDB
#undef PG8_MMA
#undef PG8_WAIT_V
#undef PG8_WAIT_L
#undef PG8_BAR
#undef PG8_SCHED
}
}

namespace pg8 {
__device__ __forceinline__ float fsig(float v) { return __builtin_amdgcn_rcpf(1.f + __builtin_amdgcn_exp2f(-1.4426950408889634f * v)); }
__device__ __forceinline__ u32x4 pack8(const f32x4 a, const f32x4 b) { u32x4 w; w.x = cvt_pk_bf16(a[0], a[1]); w.y = cvt_pk_bf16(a[2], a[3]); w.z = cvt_pk_bf16(b[0], b[1]); w.w = cvt_pk_bf16(b[2], b[3]); return w; }
__device__ __forceinline__ void unpack8(const u32x4 w, f32x4& a, f32x4& b) {
    a[0] = __builtin_bit_cast(float, w.x << 16); a[1] = __builtin_bit_cast(float, w.x & 0xffff0000u); a[2] = __builtin_bit_cast(float, w.y << 16); a[3] = __builtin_bit_cast(float, w.y & 0xffff0000u);
    b[0] = __builtin_bit_cast(float, w.z << 16); b[1] = __builtin_bit_cast(float, w.z & 0xffff0000u); b[2] = __builtin_bit_cast(float, w.w << 16); b[3] = __builtin_bit_cast(float, w.w & 0xffff0000u); }
struct EpiSwigluF { static constexpr bool PERM = true, AFTER_DRAIN = false; bf16_t* H;
    __device__ __forceinline__ void operator()(const f32x4 (&acc)[2][2][4][2], const Unit& u, int wr, int wc, int fr, int fq) const {
        const int row0 = u.pm * BM + wr * 64 + fr, col0 = u.pn * 128 + wc * 32 + 8 * fq;
#pragma unroll
        for (int ai = 0; ai < 2; ++ai)
#pragma unroll
            for (int m = 0; m < 4; ++m) { bf16_t* rowp = H + (size_t)(row0 + ai * HALF + m * 16) * DFF + col0;
                f32x4 h0, h1;
#pragma unroll
                for (int i = 0; i < 4; ++i) { const float g0 = acc[ai][0][m][0][i], g1 = acc[ai][0][m][1][i]; h0[i] = g0 * fsig(g0) * acc[ai][1][m][0][i]; h1[i] = g1 * fsig(g1) * acc[ai][1][m][1][i]; }
                *(u32x4*)rowp = pack8(h0, h1); }
    } };
struct EpiResidF { static constexpr bool PERM = false, AFTER_DRAIN = false; const float* R; float* O; float coef;
    __device__ __forceinline__ void operator()(const f32x4 (&acc)[2][2][4][2], const Unit& u, int wr, int wc, int fr, int fq) const {
        const int row0 = u.pm * BM + wr * 64 + fr, col0 = u.pn * BM + wc * 32 + 4 * fq;
#pragma unroll
        for (int ai = 0; ai < 2; ++ai)
#pragma unroll
            for (int m = 0; m < 4; ++m) { const size_t off = (size_t)(row0 + ai * HALF + m * 16) * D + col0;
#pragma unroll
                for (int bj = 0; bj < 2; ++bj)
#pragma unroll
                    for (int n = 0; n < 2; ++n) { const size_t p = off + bj * HALF + n * 16; const f32x4 r = *(const f32x4*)(R + p); *(f32x4*)(O + p) = r + acc[ai][bj][m][n] * coef; } }
    } };
struct EpiProjF { static constexpr bool PERM = true, AFTER_DRAIN = false; bf16_t* P; float* SG; const float* fb; const float* ib; const float* mfb;
    __device__ __forceinline__ void operator()(const f32x4 (&acc)[2][2][4][2], const Unit& u, int wr, int wc, int fr, int fq) const {
        const int row0 = u.pm * BM + wr * 64 + fr;
        if (u.pn < 22) {
            const int act = u.pn < 2 ? 0 : (u.pn < 12 ? 1 : 2); const int col0 = u.pn * BM + wc * 32 + 8 * fq;
#pragma unroll
            for (int ai = 0; ai < 2; ++ai)
#pragma unroll
                for (int m = 0; m < 4; ++m) { bf16_t* rowp = P + (size_t)(row0 + ai * HALF + m * 16) * PJ + col0;
#pragma unroll
                    for (int bj = 0; bj < 2; ++bj) { f32x4 v0 = acc[ai][bj][m][0], v1 = acc[ai][bj][m][1];
                        if (act == 0) { v0 = v0 * QSCALE2; v1 = v1 * QSCALE2; }
                        else if (act == 2) {
#pragma unroll
                            for (int i = 0; i < 4; ++i) { v0[i] = fsig(v0[i]); v1[i] = fsig(v1[i]); } }
                        *(u32x4*)(rowp + bj * HALF) = pack8(v0, v1); } }
        } else if (wc == 0 && fq < 2) {
            const f32x4 b0 = fq == 0 ? *(const f32x4*)fb : *(const f32x4*)ib, b1 = fq == 0 ? *(const f32x4*)(fb + 4) : *(const f32x4*)mfb;
#pragma unroll
            for (int ai = 0; ai < 2; ++ai)
#pragma unroll
                for (int m = 0; m < 4; ++m) { float* sp = SG + (size_t)(row0 + ai * HALF + m * 16) * 16 + 8 * fq;
                    f32x4 v0 = acc[ai][0][m][0] + b0, v1 = acc[ai][0][m][1] + b1;
#pragma unroll
                    for (int i = 0; i < 4; ++i) { if (fq == 0) v0[i] = logsigmoidf_(v0[i]); v1[i] = logsigmoidf_(v1[i]); }
                    *(f32x4*)sp = v0; *(f32x4*)(sp + 4) = v1; }
        }
    } };
template <bool SECOND> struct EpiGateF { static constexpr bool PERM = true, AFTER_DRAIN = false; const bf16_t* P; bf16_t* T;
    __device__ __forceinline__ void operator()(const f32x4 (&acc)[2][2][4][2], const Unit& u, int wr, int wc, int fr, int fq) const {
        const int row0 = u.pm * BM + wr * 64 + fr, col0 = u.pn * BM + wc * 32 + 8 * fq;
#pragma unroll
        for (int ai = 0; ai < 2; ++ai)
#pragma unroll
            for (int m = 0; m < 4; ++m) { const size_t row = (size_t)(row0 + ai * HALF + m * 16);
#pragma unroll
                for (int bj = 0; bj < 2; ++bj) { const int c = col0 + bj * HALF;
                    f32x4 g0, g1; unpack8(*(const u32x4*)(P + row * PJ + (SECOND ? PC_GB : PC_GA) + c), g0, g1);
                    f32x4 o0 = g0 * acc[ai][bj][m][0], o1 = g1 * acc[ai][bj][m][1];
                    if (SECOND) { f32x4 t0, t1; unpack8(*(const u32x4*)(T + row * D + c), t0, t1); o0 = o0 + t0; o1 = o1 + t1; }
                    *(u32x4*)(T + row * D + c) = pack8(o0, o1); } }
    } };
}

__device__ __forceinline__ void transpose_item(const float* W, int N, int scol0, bf16* WT, int ldt, int drow0, int k0, int kdst0, LAS float* scr, int lane) {
#pragma unroll 8
    for (int i = 0; i < 32; ++i) { const int kk = 2 * i + (lane >> 5); scr[kk * 33 + (lane & 31)] = W[(size_t)(k0 + kk) * N + scol0 + (lane & 31)]; }
    asm volatile("s_waitcnt lgkmcnt(0)" ::: "memory");
    const int c = lane & 7;
#pragma unroll
    for (int j = 0; j < 4; ++j) { const int n = (lane >> 3) + 8 * j; const LAS float* s = scr + (8 * c) * 33 + n;
        v4u o; o.x = pk2(s[0 * 33], s[1 * 33]); o.y = pk2(s[2 * 33], s[3 * 33]); o.z = pk2(s[4 * 33], s[5 * 33]); o.w = pk2(s[6 * 33], s[7 * 33]);
        *(GAS v4u*)(WT + (size_t)(drow0 + n) * ldt + kdst0 + k0 + 8 * c) = o; }
    asm volatile("s_waitcnt lgkmcnt(0)" ::: "memory");
}
__device__ __forceinline__ void phase_weights(Frame& F) {
    LAS float* scr = (LAS float*)(F.lds + F.wave * 16384);
    const int gw = blockIdx.x * NWAVES + F.wave, NGW = F.G * NWAVES;
    constexpr int I_IN = (D / 64) * (NFF / 32), I_OUT = (DFF / 64) * (D / 32), I_PJ = (D / 64) * (PJ / 32), I_UP = (512 / 64) * (D / 32), I_WO = (D / 64) * (D / 32);
    constexpr int NITEMS = 2 * I_IN + 2 * I_OUT + I_PJ + 2 * I_UP + I_WO;
    for (int it = gw; it < NITEMS; it += NGW) {
        int r = it;
        if (r < 2 * I_IN) { const int which = r / I_IN; r -= which * I_IN; const int ndb = NFF / 32, kb = r / ndb, db = r % ndb, n = db * 32, pn = n >> 8, j = n & 255;
            const int sc = (j < 128) ? pn * 128 + j : DFF + pn * 128 + (j - 128);
            transpose_item(F.in[which ? 15 : 2], NFF, sc, (bf16*)(F.ws + (which ? WS_W2IN : WS_W1IN)), D, n, kb * 64, 0, scr, F.lane); continue; }
        r -= 2 * I_IN;
        if (r < 2 * I_OUT) { const int which = r / I_OUT; r -= which * I_OUT; const int ndb = D / 32, kb = r / ndb, db = r % ndb;
            transpose_item(F.in[which ? 16 : 3], D, db * 32, (bf16*)(F.ws + (which ? WS_W2OUT : WS_W1OUT)), DFF, db * 32, kb * 64, 0, scr, F.lane); continue; }
        r -= 2 * I_OUT;
        if (r < I_PJ) { const int ndb = PJ / 32, kb = r / ndb, db = r % ndb, n = db * 32; const int sc = n + (n < 1536 ? 0 : (n < 3072 ? 8 : 16));
            transpose_item(F.in[5], INC, sc, (bf16*)(F.ws + WS_WIN), D, n, kb * 64, 0, scr, F.lane); continue; }
        r -= I_PJ;
        if (r < 2 * I_UP) { const int which = r / I_UP; r -= which * I_UP; const int ndb = D / 32, kb = r / ndb, db = r % ndb;
            transpose_item(F.in[which ? 12 : 11], D, db * 32, (bf16*)(F.ws + WS_WCAT), D, db * 32, kb * 64, which ? 512 : 0, scr, F.lane); continue; }
        r -= 2 * I_UP;
        { const int ndb = D / 32, kb = r / ndb, db = r % ndb; transpose_item(F.in[13], D, db * 32, (bf16*)(F.ws + WS_WOUT), D, db * 32, kb * 64, 0, scr, F.lane); }
    }
    { bf16* WT = (bf16*)(F.ws + WS_WIN); const float* W = F.in[5];
      for (int idx = blockIdx.x * NTHR + F.tid; idx < 256 * 128; idx += F.G * NTHR) { const int row = idx >> 7, k8 = (idx & 127) * 8; v4u o = {0u, 0u, 0u, 0u};
          if (row < 16) { const int sc = row < 8 ? 1536 + row : (row < 12 ? 3080 + (row - 8) : 3084 + (row - 12)); float v[8];
#pragma unroll
              for (int i = 0; i < 8; ++i) v[i] = W[(size_t)(k8 + i) * INC + sc];
              o.x = pk2(v[0], v[1]); o.y = pk2(v[2], v[3]); o.z = pk2(v[4], v[5]); o.w = pk2(v[6], v[7]); }
          *(GAS v4u*)(WT + (size_t)(PJ + row) * D + k8) = o; } }
}

#include <hip/hip_bf16.h>
#include <cmath>
namespace attn_body {
using bf16=__hip_bfloat16;
using bf16x8=__attribute__((ext_vector_type(8)))short;
using s16x4=__attribute__((ext_vector_type(4)))short;
using f32x16=__attribute__((ext_vector_type(16)))float;
using u32x4=__attribute__((ext_vector_type(4)))unsigned;
constexpr int BATCH=32,NHEAD=8,SEQ=2048,D=64,DM=5632,OP=1024;
constexpr int NW=8,QBLK=32,QB=QBLK*NW,KVBLK=64,NQB=SEQ/QB;
constexpr int ATTN_PITCH=DM, ATTN_UNIT_ROWS=QB;
__device__ __forceinline__ int crow(int r,int hi){return (r&3)+8*(r>>2)+4*hi;}
#define SBAR() __builtin_amdgcn_sched_barrier(0)
__device__ __forceinline__ void cmask(f32x16&p0,f32x16&p1,int jb,int qrel,int hi){
  const float NEG=-INFINITY; int kb=64*jb+4*hi;
  #pragma unroll
  for(int r=0;r<16;++r){int kv=kb+(r&3)+8*(r>>2); if(kv>qrel)p0[r]=NEG; if(kv+32>qrel)p1[r]=NEG;}
}

constexpr int NSLOT=3, SLOTB=8192;
constexpr int LDS_K=0, LDS_V=NSLOT*SLOTB, LDS_WS=2*NSLOT*SLOTB, LDS_OST=LDS_WS+NW*64*4, LDS_BIAS=LDS_OST+NW*4096, LDS_ROWB=LDS_BIAS+SEQ*8, LDS_BYTES=LDS_ROWB+QB*4;
constexpr float C2=0.125f*1.4426950408889634f;
__device__ __forceinline__ void glds16(const void*gsrc,unsigned lds_dst){unsigned keep;
  asm volatile("s_mov_b32 %0, m0\n\ts_mov_b32 m0, %2\n\ts_nop 0\n\tglobal_load_lds_dwordx4 %1, off\n\ts_mov_b32 m0, %0":"=&s"(keep):"v"(gsrc),"s"(lds_dst):"memory");}
__device__ __forceinline__ float max3f(float a,float b,float c){float r;asm("v_max3_f32 %0, %1, %2, %3":"=v"(r):"v"(a),"v"(b),"v"(c));return r;}
__device__ __forceinline__ float max2f(float a,float b){float r;asm("v_max_f32_e32 %0, %1, %2":"=v"(r):"v"(a),"v"(b));return r;}
__device__ __forceinline__ float fadd_s(float a,float b){float r;asm("v_add_f32_e32 %0, %1, %2":"=v"(r):"v"(a),"v"(b));return r;}
__device__ __forceinline__ float fsub_s(float a,float b){float r;asm("v_sub_f32_e32 %0, %1, %2":"=v"(r):"v"(a),"v"(b));return r;}
typedef float f32x2_t __attribute__((ext_vector_type(2))); typedef __bf16 bf16x2_t __attribute__((ext_vector_type(2)));
__device__ __forceinline__ unsigned cvtpk_s(float lo,float hi){f32x2_t v={lo,hi};bf16x2_t b=__builtin_convertvector(v,bf16x2_t);return __builtin_bit_cast(unsigned,b);}
#define WAIT_BAR(N) asm volatile("s_waitcnt vmcnt(" #N ") lgkmcnt(0)\n\ts_barrier":::"memory")

__device__ __forceinline__ void qkt(f32x16&p0,f32x16&p1,const char*Kslot,const bf16x8*qr,int r32,int hi,bf16x8 kx0,bf16x8 kx1,bf16x8 qx){
  const char*kb=Kslot+hi*1024+r32*16;
  #pragma unroll
  for(int d0=0;d0<4;++d0){
    const bf16x8 b0=*reinterpret_cast<const bf16x8*>(kb+d0*2048);
    const bf16x8 b1=*reinterpret_cast<const bf16x8*>(kb+d0*2048+512);
    if(d0==0){p0=__builtin_amdgcn_mfma_f32_32x32x16_bf16(b0,qr[0],f32x16{},0,0,0);p1=__builtin_amdgcn_mfma_f32_32x32x16_bf16(b1,qr[0],f32x16{},0,0,0);}
    else{p0=__builtin_amdgcn_mfma_f32_32x32x16_bf16(b0,qr[d0],p0,0,0,0);p1=__builtin_amdgcn_mfma_f32_32x32x16_bf16(b1,qr[d0],p1,0,0,0);}}
  p0=__builtin_amdgcn_mfma_f32_32x32x16_bf16(kx0,qx,p0,0,0,0);p1=__builtin_amdgcn_mfma_f32_32x32x16_bf16(kx1,qx,p1,0,0,0);
}
typedef __attribute__((address_space(3))) const char* lds_cptr;
typedef short v4i16_t __attribute__((ext_vector_type(4)));
__device__ __forceinline__ void kload8(bf16x8*kf,lds_cptr kp){
  kf[0]=*(const __attribute__((address_space(3))) bf16x8*)(kp);      kf[1]=*(const __attribute__((address_space(3))) bf16x8*)(kp+512);
  kf[2]=*(const __attribute__((address_space(3))) bf16x8*)(kp+2048); kf[3]=*(const __attribute__((address_space(3))) bf16x8*)(kp+2560);
  kf[4]=*(const __attribute__((address_space(3))) bf16x8*)(kp+4096); kf[5]=*(const __attribute__((address_space(3))) bf16x8*)(kp+4608);
  kf[6]=*(const __attribute__((address_space(3))) bf16x8*)(kp+6144); kf[7]=*(const __attribute__((address_space(3))) bf16x8*)(kp+6656);
}
__device__ __forceinline__ void kload2(bf16x8*kf,lds_cptr kp,int j){ kf[2*j]=*(const __attribute__((address_space(3))) bf16x8*)(kp+j*2048); kf[2*j+1]=*(const __attribute__((address_space(3))) bf16x8*)(kp+j*2048+512); }
typedef unsigned u32x2_t __attribute__((ext_vector_type(2)));
__device__ __forceinline__ bf16x8 kxfrag(lds_cptr tbl,int kv,int hi){ u32x2_t b=*(const __attribute__((address_space(3))) u32x2_t*)(tbl+kv*8); if(hi){b.x=0u;b.y=0u;} const u32x4 w={b.x,b.y,hi?0u:0x3F803F80u,0u}; return __builtin_bit_cast(bf16x8,w); }
__device__ __forceinline__ s16x4 vtr(lds_cptr p){ return __builtin_bit_cast(s16x4,__builtin_amdgcn_ds_read_tr16_b64_v4i16((__attribute__((address_space(3))) v4i16_t*)p)); }
__device__ __forceinline__ float rowmax(const f32x16&p0,const f32x16&p1){
  float a=max3f(p0[0],p0[1],p1[0]),b=max3f(p0[2],p0[3],p1[1]);a=max3f(a,p1[2],p1[3]);
  #pragma unroll
  for(int r=4;r<16;r+=4){a=max3f(a,p0[r],p0[r+1]);b=max3f(b,p0[r+2],p0[r+3]);a=max3f(a,p1[r],p1[r+1]);b=max3f(b,p1[r+2],p1[r+3]);}
  const float m=max2f(a,b);
  auto rr=__builtin_amdgcn_permlane32_swap(__float_as_uint(m),__float_as_uint(m),false,false);
  return max2f(__uint_as_float(rr[0]),__uint_as_float(rr[1]));
}
__device__ __forceinline__ void pv(f32x16*o,int vb,bf16x8 pa0,bf16x8 pa1,bf16x8 pa2,bf16x8 pa3){
  #pragma unroll
  for(int d0=0;d0<2;++d0){s16x4 lo[4],hi[4];
    #pragma unroll
    for(int ks=0;ks<4;++ks){
      asm volatile("ds_read_b64_tr_b16 %0,%1 offset:%c2":"=&v"(lo[ks]):"v"(vb),"i"(d0*4096+ks*1024):"memory");
      asm volatile("ds_read_b64_tr_b16 %0,%1 offset:%c2":"=&v"(hi[ks]):"v"(vb),"i"(d0*4096+ks*1024+512):"memory");}
    asm volatile("s_waitcnt lgkmcnt(0)":::"memory");SBAR();
    #define PK(k) (bf16x8){lo[k][0],lo[k][1],lo[k][2],lo[k][3],hi[k][0],hi[k][1],hi[k][2],hi[k][3]}
    o[d0]=__builtin_amdgcn_mfma_f32_32x32x16_bf16(pa0,PK(0),o[d0],0,0,0);
    o[d0]=__builtin_amdgcn_mfma_f32_32x32x16_bf16(pa1,PK(1),o[d0],0,0,0);
    o[d0]=__builtin_amdgcn_mfma_f32_32x32x16_bf16(pa2,PK(2),o[d0],0,0,0);
    o[d0]=__builtin_amdgcn_mfma_f32_32x32x16_bf16(pa3,PK(3),o[d0],0,0,0);
    #undef PK
  }
}

#ifndef ATTN_STORE16
#define ATTN_STORE16(p,v) (*(u32x4*)(p)=(v))
#endif
template<int THRL> __device__ __forceinline__ void attn_unit(int b,int h,int qb,const bf16*Q,const bf16*__restrict__ K,const bf16*__restrict__ V,bf16*O,const float*CUMh,char*shm){
  int tid_=threadIdx.x; asm volatile("":"+v"(tid_)); const int tid=tid_,lane=tid&63,r32=lane&31,hi=lane>>5; const int wid=__builtin_amdgcn_readfirstlane(tid>>6);
  const long rowbase=(long)b*SEQ; const int q0=qb*QB;
  const bf16*Qw=Q+(rowbase+q0+wid*QBLK)*DM+h*D;
  const bf16*Kh=K+rowbase*DM+h*D,*Vh=V+rowbase*DM+h*D;
  const unsigned lds0=(unsigned)(uintptr_t)shm;
  float*wsf=(float*)(shm+LDS_WS)+wid*64;
  const bf16*ksrc=Kh+(long)lane*DM+wid*8;
  const bf16*vsrc=Vh+(long)(16*(wid&3)+(lane>>2))*DM+(wid>>2)*32+(lane&3)*8;
  const unsigned kdst=lds0+LDS_K+wid*1024, vdst=lds0+LDS_V+wid*1024;
  #define DMA_K(t,slot) glds16(ksrc+(long)(t)*KVBLK*DM,(unsigned)__builtin_amdgcn_readfirstlane(kdst+(slot)))
  #define DMA_V(t,slot) glds16(vsrc+(long)(t)*KVBLK*DM,(unsigned)__builtin_amdgcn_readfirstlane(vdst+(slot)))
  const int vb0=(int)(lds0+LDS_V)+((lane>>4)&1)*32+(lane&3)*8+(4*hi+((lane&15)>>2))*64;
  const char*Kbase=shm+LDS_K; bf16x8 kf[8];
  const lds_cptr shm3=(lds_cptr)shm; const lds_cptr kp0=shm3+LDS_K+hi*1024+r32*16; const lds_cptr vp0=shm3+LDS_V+((lane>>4)&1)*32+(lane&3)*8+(4*hi+((lane&15)>>2))*64;
  const int NT=(q0+QB)/KVBLK;
  DMA_K(0,0);DMA_V(0,0);DMA_K(1,SLOTB);
  bf16x8 qr[4];
  #pragma unroll
  for(int d0=0;d0<4;++d0)qr[d0]=*reinterpret_cast<const bf16x8*>(&Qw[(long)r32*DM+d0*16+hi*8]);
  const int qrel=wid*QBLK+r32;
  { const float cref=CUMh[q0]; __attribute__((address_space(3))) unsigned*bt=(__attribute__((address_space(3))) unsigned*)(shm3+LDS_BIAS); __attribute__((address_space(3))) float*rb=(__attribute__((address_space(3))) float*)(shm3+LDS_ROWB);
    for(int kv=tid;kv<q0+QB;kv+=NW*64){ const float bias=(cref-CUMh[kv])*1.4426950408889634f;
      const unsigned u1=__builtin_bit_cast(unsigned,bias); const unsigned h1=(u1+0x7fffu+((u1>>16)&1u))&0xffff0000u; const float r1=bias-__builtin_bit_cast(float,h1);
      const unsigned u2=__builtin_bit_cast(unsigned,r1);   const unsigned h2=(u2+0x7fffu+((u2>>16)&1u))&0xffff0000u; const float r2=r1-__builtin_bit_cast(float,h2);
      const unsigned u3=__builtin_bit_cast(unsigned,r2);   const unsigned h3=(u3+0x7fffu+((u3>>16)&1u))&0xffff0000u;
      bt[2*kv]=(h1>>16)|h2; bt[2*kv+1]=(h3>>16)|0x3F800000u; if(kv>=q0)rb[kv-q0]=bias; } }
  const lds_cptr btab=shm3+LDS_BIAS; u32x4 qxw={hi?0u:0x3F803F80u,0u,0u,0u};
  #define QX __builtin_bit_cast(bf16x8,qxw)
  #define RNEHI(u) (((u)+0x7fffu+(((u)>>16)&1u))&0xffff0000u)
  #define SETQX() do{ const float nm_=-mhat; const unsigned a1_=RNEHI(__builtin_bit_cast(unsigned,nm_)); const float s1_=nm_-__builtin_bit_cast(float,a1_); \
      const unsigned a2_=RNEHI(__builtin_bit_cast(unsigned,s1_)); const float s2_=s1_-__builtin_bit_cast(float,a2_); const unsigned a3_=RNEHI(__builtin_bit_cast(unsigned,s2_)); \
      qxw.y=hi?0u:(a1_|0x3F80u); qxw.z=hi?0u:((a2_>>16)|a3_); }while(0)
  float mhat=0.f,l_reg=0.f;f32x16 o[2];o[0]=f32x16{};o[1]=f32x16{};
  #define CMASK(P0,P1,t) do{int jb_=(t)-(NT-4); if(jb_>=0)cmask(P0,P1,jb_,qrel,hi);}while(0)
  bool resc=false;
  #define START(P0,P1) do{ const float rm=rowmax(P0,P1); resc=false; \
    { const float dl=max2f(rm,0.f); mhat=fadd_s(mhat,dl); \
      _Pragma("unroll") for(int r=0;r<16;++r){P0[r]=fsub_s(P0[r],dl);P1[r]=fsub_s(P1[r],dl);} \
      SETQX(); } \
    _Pragma("unroll") for(int r=0;r<16;++r)P0[r]=__builtin_amdgcn_exp2f(P0[r]); }while(0)
  #define RESC() do{ if(resc){ asm volatile("s_waitcnt lgkmcnt(0)":::"memory"); \
      _Pragma("unroll") for(int d_=0;d_<2;++d_) _Pragma("unroll") for(int r=0;r<16;++r)o[d_][r]*=wsf[crow(r,hi)]; } }while(0)
  f32x16 pA0,pA1,pB0,pB1;
  int sl_prev=0,sl_cur=0,sl_next=SLOTB;
  #define ROT() do{sl_prev=sl_cur;sl_cur=sl_next;sl_next=(sl_next==(NSLOT-1)*SLOTB)?0:sl_next+SLOTB;}while(0)
  DMA_K(2,2*SLOTB);
  WAIT_BAR(3);
  mhat=*(const __attribute__((address_space(3))) float*)(shm3+LDS_ROWB+qrel*4);
  SETQX();
  qkt(pA0,pA1,Kbase,qr,r32,hi,kxfrag(btab,r32,hi),kxfrag(btab,32+r32,hi),QX);asm volatile("s_nop 15\n\ts_nop 7":"+v"(pA0),"+v"(pA1));CMASK(pA0,pA1,0);
  START(pA0,pA1);
  _Pragma("unroll") for(int r=0;r<16;++r)pA1[r]=__builtin_amdgcn_exp2f(pA1[r]);
  WAIT_BAR(0);
  DMA_K(3,0);DMA_V(1,SLOTB);
  ROT();
  kload8(kf,kp0+sl_cur);
  WAIT_BAR(2);
  s16x4 vlo[8],vhi[8]; u32x4 pw0,pw1,pw2,pw3;
  #define PKW(P,B) cvtpk_s(P[B],P[B+1])
  #define PAF(k) __builtin_bit_cast(bf16x8,pw##k)
  #define VFR(i) (bf16x8){vlo[i][0],vlo[i][1],vlo[i][2],vlo[i][3],vhi[i][0],vhi[i][1],vhi[i][2],vhi[i][3]}
  #define PIN(x) asm volatile("":"+v"(x))
  #define MX3(a,b,c) __builtin_fmaxf(__builtin_fmaxf((a),(b)),(c))
  #define GAPA(MF,A0,A1,A2,A3,W0,W1,PW) do{ MF; sacc+=A0; sacc+=A1; sacc+=A2; sacc+=A3; PIN(sacc); W0; W1; PIN(PW); SBAR(); }while(0)
  #define EX(v) __builtin_amdgcn_exp2f(v)
  #define GAPB(MF,X,B) do{ MF; X[B]=EX(X[B]); X[B+1]=EX(X[B+1]); X[B+2]=EX(X[B+2]); X[B+3]=EX(X[B+3]); PIN(X); SBAR(); }while(0)
  #define VRD(i) do{ vlo[i]=vtr(vp_+(((i)>>2)*4096+((i)&3)*1024)); vhi[i]=vtr(vp_+(((i)>>2)*4096+((i)&3)*1024+512)); }while(0)
  #define KRD(G,j) do{ if(G){ kload2(kf,kp0+sl_next,j); SBAR(); } }while(0)
  #define STEP(C0,C1,P0,P1,t,GK,GV,GL) do{ SBAR(); \
    const lds_cptr vp_=vp0+sl_prev; \
    const bf16x8 kx0_=kxfrag(btab,64*(t)+r32,hi), kx1_=kxfrag(btab,64*(t)+32+r32,hi); \
    VRD(0); SBAR(); float sacc=(P0[0]+P0[1]); \
    GAPA(C0=__builtin_amdgcn_mfma_f32_32x32x16_bf16(kf[0],qr[0],f32x16{},0,0,0), P0[2],P0[3],P0[4],P0[5],     pw0[0]=PKW(P0,0), pw0[1]=PKW(P0,2), pw0); \
    VRD(4); SBAR(); GAPA(C1=__builtin_amdgcn_mfma_f32_32x32x16_bf16(kf[1],qr[0],f32x16{},0,0,0), P0[6],P0[7],P0[8],P0[9],     pw0[2]=PKW(P0,4), pw0[3]=PKW(P0,6), pw0); \
    VRD(1); SBAR(); GAPA(C0=__builtin_amdgcn_mfma_f32_32x32x16_bf16(kf[2],qr[1],C0,0,0,0),   P0[10],P0[11],P0[12],P0[13], pw1[0]=PKW(P0,8), pw1[1]=PKW(P0,10), pw1); \
    VRD(5); SBAR(); GAPA(C1=__builtin_amdgcn_mfma_f32_32x32x16_bf16(kf[3],qr[1],C1,0,0,0),   P0[14],P0[15],P1[0],P1[1],   pw1[2]=PKW(P0,12),pw1[3]=PKW(P0,14), pw1); \
    VRD(2); SBAR(); GAPA(C0=__builtin_amdgcn_mfma_f32_32x32x16_bf16(kf[4],qr[2],C0,0,0,0),   P1[2],P1[3],P1[4],P1[5],     pw2[0]=PKW(P1,0), pw2[1]=PKW(P1,2), pw2); \
    VRD(6); SBAR(); GAPA(C1=__builtin_amdgcn_mfma_f32_32x32x16_bf16(kf[5],qr[2],C1,0,0,0),   P1[6],P1[7],P1[8],P1[9],     pw2[2]=PKW(P1,4), pw2[3]=PKW(P1,6), pw2); \
    VRD(3); SBAR(); GAPA(C0=__builtin_amdgcn_mfma_f32_32x32x16_bf16(kf[6],qr[3],C0,0,0,0),   P1[10],P1[11],P1[12],P1[13], pw3[0]=PKW(P1,8), pw3[1]=PKW(P1,10), pw3); \
    VRD(7); SBAR(); GAPA(C1=__builtin_amdgcn_mfma_f32_32x32x16_bf16(kf[7],qr[3],C1,0,0,0),   P1[14],P1[15],0.f,0.f,       pw3[2]=PKW(P1,12),pw3[3]=PKW(P1,14), pw3); \
    C0=__builtin_amdgcn_mfma_f32_32x32x16_bf16(kx0_,QX,C0,0,0,0); C1=__builtin_amdgcn_mfma_f32_32x32x16_bf16(kx1_,QX,C1,0,0,0); SBAR(); \
    l_reg+=sacc; \
    if(GK){DMA_K((t)+3,sl_cur);} if(GV){DMA_V((t)+1,sl_next);} \
    CMASK(C0,C1,t); \
    { float a=MX3(C0[0],C0[1],C1[0]),b=MX3(C0[2],C0[3],C1[1]); a=MX3(a,C1[2],C1[3]); \
      _Pragma("unroll") for(int r=4;r<16;r+=4){a=MX3(a,C0[r],C0[r+1]);b=MX3(b,C0[r+2],C0[r+3]);a=MX3(a,C1[r],C1[r+1]);b=MX3(b,C1[r+2],C1[r+3]);} \
      float rm=__builtin_fmaxf(a,b); { auto rr=__builtin_amdgcn_permlane32_swap(__float_as_uint(rm),__float_as_uint(rm),false,false); rm=__builtin_fmaxf(__uint_as_float(rr[0]),__uint_as_float(rr[1])); } \
      resc=false; \
      if(__builtin_expect(__any(rm>(float)THRL),0)){ const float dl=__builtin_fmaxf(rm,0.f); mhat+=dl; \
        _Pragma("unroll") for(int r=0;r<16;++r){C0[r]-=dl;C1[r]-=dl;} \
        SETQX(); \
        const float f=__builtin_amdgcn_exp2f(-dl); l_reg*=f; if(hi==0)wsf[r32]=f; resc=true; } } \
    SBAR(); \
    GAPB(o[0]=__builtin_amdgcn_mfma_f32_32x32x16_bf16(PAF(0),VFR(0),o[0],0,0,0), C0,0); \
    GAPB(o[1]=__builtin_amdgcn_mfma_f32_32x32x16_bf16(PAF(0),VFR(4),o[1],0,0,0), C0,4); \
    KRD(GL,0); GAPB(o[0]=__builtin_amdgcn_mfma_f32_32x32x16_bf16(PAF(1),VFR(1),o[0],0,0,0), C0,8); \
    KRD(GL,1); GAPB(o[1]=__builtin_amdgcn_mfma_f32_32x32x16_bf16(PAF(1),VFR(5),o[1],0,0,0), C0,12); \
    KRD(GL,2); GAPB(o[0]=__builtin_amdgcn_mfma_f32_32x32x16_bf16(PAF(2),VFR(2),o[0],0,0,0), C1,0); \
    KRD(GL,3); GAPB(o[1]=__builtin_amdgcn_mfma_f32_32x32x16_bf16(PAF(2),VFR(6),o[1],0,0,0), C1,4); \
    GAPB(o[0]=__builtin_amdgcn_mfma_f32_32x32x16_bf16(PAF(3),VFR(3),o[0],0,0,0), C1,8); \
    GAPB(o[1]=__builtin_amdgcn_mfma_f32_32x32x16_bf16(PAF(3),VFR(7),o[1],0,0,0), C1,12); \
    }while(0)
  int t=1;
  #undef CMASK
  #define CMASK(P0,P1,t) do{}while(0)
  for(;t+5<NT;t+=2){
    STEP(pB0,pB1,pA0,pA1,t,true,true,true);     WAIT_BAR(2); RESC(); ROT();
    STEP(pA0,pA1,pB0,pB1,t+1,true,true,true);   WAIT_BAR(2); RESC(); ROT();
  }
  #undef CMASK
  #define CMASK(P0,P1,t) do{int jb_=(t)-(NT-4); if(jb_>=0)cmask(P0,P1,jb_,qrel,hi);}while(0)
  #define ENDW(tt) do{ if((tt)+3<NT){WAIT_BAR(2);} else if((tt)+2<NT){WAIT_BAR(1);} else {WAIT_BAR(0);} }while(0)
  for(;t+1<NT;t+=2){
    STEP(pB0,pB1,pA0,pA1,t,(t+3<NT),(t+1<NT),(t+1<NT));       ENDW(t);   RESC(); ROT();
    STEP(pA0,pA1,pB0,pB1,t+1,(t+4<NT),(t+2<NT),(t+2<NT));     ENDW(t+1); RESC(); ROT();
  }
  STEP(pB0,pB1,pA0,pA1,NT-1,false,false,false); RESC();
  { float sacc=pB0[0]+pB0[1]; _Pragma("unroll") for(int r=2;r<16;++r)sacc+=pB0[r]; _Pragma("unroll") for(int r=0;r<16;++r)sacc+=pB1[r]; l_reg+=sacc;
    pw0=(u32x4){PKW(pB0,0),PKW(pB0,2),PKW(pB0,4),PKW(pB0,6)};pw1=(u32x4){PKW(pB0,8),PKW(pB0,10),PKW(pB0,12),PKW(pB0,14)};pw2=(u32x4){PKW(pB1,0),PKW(pB1,2),PKW(pB1,4),PKW(pB1,6)};pw3=(u32x4){PKW(pB1,8),PKW(pB1,10),PKW(pB1,12),PKW(pB1,14)};
    SBAR(); pv(o,vb0+sl_cur,PAF(0),PAF(1),PAF(2),PAF(3)); }
  #undef PKW
  #undef PAF
  #undef VFR
  #undef PIN
  #undef MX3
  #undef GAPA
  #undef GAPB
  #undef EX
  #undef VRD
  #undef KRD
  #undef STEP
  #undef ENDW
  {auto rr=__builtin_amdgcn_permlane32_swap(__float_as_uint(l_reg),__float_as_uint(l_reg),false,false);l_reg=__uint_as_float(rr[0])+__uint_as_float(rr[1]);}
  if(hi==0)wsf[32+r32]=l_reg;asm volatile("s_waitcnt lgkmcnt(0)":::"memory");
  float rli[16];
  #pragma unroll
  for(int r=0;r<16;++r)rli[r]=__builtin_amdgcn_rcpf(wsf[32+crow(r,hi)]);
  bf16*Ow=O+(rowbase+q0+wid*QBLK)*OP+h*D;
  { bf16*stg=(bf16*)(shm+LDS_OST)+wid*2048;
    #pragma unroll
    for(int r=0;r<16;++r){const int orow=crow(r,hi);
      #pragma unroll
      for(int d0=0;d0<2;++d0)stg[orow*64+d0*32+r32]=__float2bfloat16(o[d0][r]*rli[r]);}
    asm volatile("s_waitcnt lgkmcnt(0)":::"memory");
    #pragma unroll
    for(int i=0;i<4;++i){const int row=i*8+(lane>>3),ch=lane&7; const u32x4 v=*(const u32x4*)(stg+row*64+ch*8); ATTN_STORE16(Ow+(long)row*OP+ch*8,v);} }
  asm volatile("s_waitcnt lgkmcnt(0)\n\ts_barrier":::"memory");
  #undef DMA_K
  #undef QX
  #undef RNEHI
  #undef SETQX
  #undef DMA_V
  #undef CMASK
  #undef START
  #undef RESC
  #undef ROT
}
constexpr int ATTN_LDS_BYTES=LDS_BYTES;
struct AttnTensors { const bf16* Q; const bf16* K; const bf16* V; bf16* O; const float* CUM; };
struct AttnUnit { int bh; int qb; };
struct StaticOrder {
  int c,G;
  __device__ __forceinline__ StaticOrder(int grid,int block):c(block),G(grid){}
  __device__ __forceinline__ bool next(int i,AttnUnit&u)const{ const int it=i*G+c; if(it>=BATCH*NHEAD*NQB)return false; u.bh=it%(BATCH*NHEAD); u.qb=NQB-1-it/(BATCH*NHEAD); return true; }
};
template<class Sched,int THRL=8> __device__ __forceinline__ void attn_phase(char*lds,const AttnTensors&T,const Sched&S){
  AttnUnit u;
  for(int i=0;S.next(i,u);++i){ attn_unit<THRL>(u.bh/NHEAD,u.bh%NHEAD,u.qb,T.Q,T.K,T.V,T.O,T.CUM+(size_t)u.bh*SEQ,lds); }
}
#undef SBAR
#undef WAIT_BAR
}
__global__ void __launch_bounds__(NTHR, 2) fwd_kernel(Args args) {
    extern __shared__ __attribute__((aligned(16))) unsigned char lds[];
    Frame F;
    F.lds = (LAS unsigned char*)lds;
    F.MISC = (volatile LAS unsigned*)(F.lds + MISC_OFF);
    F.tid = threadIdx.x; F.lane = F.tid & 63; F.wave = __builtin_amdgcn_readfirstlane(F.tid >> 6);
    F.G = gridDim.x;
    F.ws = args.ws; F.out = args.out;
#pragma unroll
    for (int i = 0; i < 18; ++i) F.in[i] = args.in[i];
    F.ctl = (gu32*)(F.ws + WS_CTL);
    for (int u = F.tid; u < (LDS_BYTES - LDSCTL_OFF) / 4; u += NTHR) ((LAS unsigned*)(F.lds + LDSCTL_OFF))[u] = 0u;
    __syncthreads();
    XcdBarrier bar = xcd_barrier_post((unsigned*)(F.ctl + CW_BAR), F.MISC + 8);
#define GRID_BAR() xcd_barrier(bar)

    const float* x = F.in[0];
    bf16* XN = (bf16*)(F.ws + WS_XN); bf16* AO = (bf16*)(F.ws + WS_AO); bf16* BIG = (bf16*)(F.ws + WS_BIG);
    float* SG = (float*)(F.ws + WS_SG); float* CUM = (float*)(F.ws + WS_CUM);
    float* out = F.out;

    const bf16* W1IN = (const bf16*)(F.ws + WS_W1IN); const bf16* W1OUT = (const bf16*)(F.ws + WS_W1OUT); const bf16* WIN = (const bf16*)(F.ws + WS_WIN);
    const bf16* WCAT = (const bf16*)(F.ws + WS_WCAT); const bf16* WOUT = (const bf16*)(F.ws + WS_WOUT); const bf16* W2IN = (const bf16*)(F.ws + WS_W2IN); const bf16* W2OUT = (const bf16*)(F.ws + WS_W2OUT);
#define FAST(b) ((FAST_MASK >> (b)) & 1)
#define GEMM_PHASE(EpiT, gobj, eobj) do { pg8::StaticOrder S_; S_.init((gobj).M, (gobj).N, F.G, (int)blockIdx.x); pg8::gemm_phase<EpiT, pg8::StaticOrder, true, true>(F.lds, gobj, S_, eobj); } while (0)

    if (FAST_MASK & 0x7f) phase_weights(F);
    phase_rmsnorm_bf16(F, x, F.in[1], XN);
    GRID_BAR();
    if (FAST(0)) { pg8::Gemm g{XN, W1IN, M, NFF, D, D, D}; pg8::EpiSwigluF E{BIG}; GEMM_PHASE(pg8::EpiSwigluF, g, E); }
    else { NGemm g1{XN, D, F.in[2], NFF, 0, D}, g2{XN, D, F.in[2], NFF, DFF, D}; EpiSwiglu E{BIG}; naive_gemm<true>(F, g1, g2, DFF, E); }
    GRID_BAR();
    if (FAST(1)) { pg8::Gemm g{BIG, W1OUT, M, D, DFF, DFF, DFF}; pg8::EpiResidF E{x, out, 0.5f}; GEMM_PHASE(pg8::EpiResidF, g, E); }
    else { NGemm g1{BIG, DFF, F.in[3], D, 0, DFF}; EpiResid E{x, out, 0.5f}; naive_gemm<false>(F, g1, g1, D, E); }
    GRID_BAR();
    phase_rmsnorm_bf16(F, out, F.in[4], XN);
    GRID_BAR();
    if (FAST(2)) { pg8::Gemm g{XN, WIN, M, NPJ, D, D, D}; pg8::EpiProjF E{BIG, SG, F.in[6], F.in[9], F.in[10]}; GEMM_PHASE(pg8::EpiProjF, g, E); }
    else { NGemm g1{XN, D, F.in[5], INC, 0, D}; EpiProj E{BIG, SG, F.in[6], F.in[9], F.in[10]}; naive_gemm<false>(F, g1, g1, INC, E); }
    GRID_BAR();
    phase_cumsum(F, SG, CUM);
    GRID_BAR();
    phase_mlstm_naive(F, BIG, SG, F.in[7], F.in[8], AO);
    if (FAST(7)) { const attn_body::AttnTensors AT{(const attn_body::bf16*)(BIG + PC_FQ), (const attn_body::bf16*)(BIG + PC_FK), (const attn_body::bf16*)(BIG + PC_FV), (attn_body::bf16*)AO, CUM};
                   const attn_body::StaticOrder SA((int)F.G, (int)blockIdx.x); attn_body::attn_phase<attn_body::StaticOrder>((char*)lds, AT, SA); }
    else phase_attn_naive(F, BIG, CUM, AO);
    GRID_BAR();
    if (FAST(3)) { pg8::Gemm ga{AO, WCAT, M, D, 512, D, D}; pg8::EpiGateF<false> Ea{BIG, XN}; GEMM_PHASE(pg8::EpiGateF<false>, ga, Ea);
                   pg8::Gemm gb{AO + 512, WCAT + 512, M, D, 512, D, D}; pg8::EpiGateF<true> Eb{BIG, XN}; GEMM_PHASE(pg8::EpiGateF<true>, gb, Eb); }
    else { NGemm g1{AO, D, F.in[11], D, 0, 512}, g2{AO + 512, D, F.in[12], D, 0, 512}; EpiMerge E{BIG, XN}; naive_gemm<true>(F, g1, g2, D, E); }
    GRID_BAR();
    if (FAST(4)) { pg8::Gemm g{XN, WOUT, M, D, D, D, D}; pg8::EpiResidF E{out, out, 1.0f}; GEMM_PHASE(pg8::EpiResidF, g, E); }
    else { NGemm g1{XN, D, F.in[13], D, 0, D}; EpiResid E{out, out, 1.0f}; naive_gemm<false>(F, g1, g1, D, E); }
    GRID_BAR();
    phase_rmsnorm_bf16(F, out, F.in[14], XN);
    GRID_BAR();
    if (FAST(5)) { pg8::Gemm g{XN, W2IN, M, NFF, D, D, D}; pg8::EpiSwigluF E{BIG}; GEMM_PHASE(pg8::EpiSwigluF, g, E); }
    else { NGemm g1{XN, D, F.in[15], NFF, 0, D}, g2{XN, D, F.in[15], NFF, DFF, D}; EpiSwiglu E{BIG}; naive_gemm<true>(F, g1, g2, DFF, E); }
    GRID_BAR();
    if (FAST(6)) { pg8::Gemm g{BIG, W2OUT, M, D, DFF, DFF, DFF}; pg8::EpiResidF E{out, out, 0.5f}; GEMM_PHASE(pg8::EpiResidF, g, E); }
    else { NGemm g1{BIG, DFF, F.in[16], D, 0, DFF}; EpiResid E{out, out, 0.5f}; naive_gemm<false>(F, g1, g1, D, E); }
    GRID_BAR();
    phase_rmsnorm_f32(F, out, F.in[17]);
}

extern "C" void kernel_launch(void* const* d_in, const int* in_sizes, int n_in, void* d_out, int out_size, void* d_ws, size_t ws_size, hipStream_t stream) {
    static int grid = 0;
    if (grid == 0) {
        if (n_in != 18 || in_sizes[0] != M * D || out_size != M * D || ws_size < WS_END) { fprintf(stderr, "kernel_launch: unexpected shapes (n_in %d, in0 %d, out %d, ws %zu)\n", n_in, n_in > 0 ? in_sizes[0] : -1, out_size, ws_size); grid = -1; return; }
        int dev = 0, cus = 0, per_cu = 0;
        if (hipGetDevice(&dev) != hipSuccess || hipDeviceGetAttribute(&cus, hipDeviceAttributeMultiprocessorCount, dev) != hipSuccess) { grid = -1; return; }
        if (hipFuncSetAttribute((const void*)fwd_kernel, hipFuncAttributeMaxDynamicSharedMemorySize, LDS_BYTES) != hipSuccess) { grid = -1; return; }
        if (hipOccupancyMaxActiveBlocksPerMultiprocessor(&per_cu, (const void*)fwd_kernel, NTHR, LDS_BYTES) != hipSuccess || per_cu < 1) { fprintf(stderr, "occupancy query says %d\n", per_cu); }
        (void)hipGetLastError();
        grid = cus;
    }
    if (grid < 0) return;
    if (hipMemsetAsync((char*)d_ws + WS_CTL, 0, CTL_ZERO_BYTES, stream) != hipSuccess) return;
    Args a{};
    for (int i = 0; i < 18; ++i) a.in[i] = (const float*)d_in[i];
    a.out = (float*)d_out; a.ws = (unsigned char*)d_ws;
    hipLaunchKernelGGL(fwd_kernel, dim3(grid), dim3(NTHR), LDS_BYTES, stream, a);
}
```

```cpp
#include <hip/hip_runtime.h>
#include <cstdio>
#include <cstdint>

#define GAS __attribute__((address_space(1)))
#define LAS __attribute__((address_space(3)))
typedef unsigned short bf16;
typedef unsigned v4u __attribute__((ext_vector_type(4)));
typedef float f32x4 __attribute__((ext_vector_type(4)));
typedef GAS unsigned gu32;
#define RLX_AGENT __ATOMIC_RELAXED, __HIP_MEMORY_SCOPE_AGENT

constexpr int BATCH = 32, SEQ = 2048, D = 1024, M = BATCH * SEQ;
constexpr int DFF = 2816, NFF = 2 * DFF;
constexpr int INC = 5648;
constexpr int PJ = 5632;
constexpr int FOXH = 8, FHD = 64, MLH = 4, MHD = 128;
constexpr int PC_FQ = 0, PC_FK = 512, PC_FV = 1024, PC_MQ = 1536, PC_MK = 2048, PC_MV = 2560, PC_MO = 3072, PC_GA = 3584, PC_GB = 4608;
constexpr float RMS_EPS = 1e-6f;
constexpr float LOG2E = 1.4426950408889634f;
constexpr float QSCALE2 = 0.125f * LOG2E;
constexpr int NWAVES = 8, NTHR = 512;
#ifndef FAST_MASK
#define FAST_MASK 0x1ff
#endif

constexpr size_t MiB = 1u << 20;
constexpr size_t WS_CTL = 0, CTL_ZERO_BYTES = 1 * MiB;
constexpr size_t WS_W1IN = 2 * MiB, WS_W1OUT = 13 * MiB, WS_WIN = 19 * MiB, WS_WCAT = 31 * MiB, WS_WOUT = 33 * MiB, WS_W2IN = 35 * MiB, WS_W2OUT = 46 * MiB;
constexpr int NPJ = 5888;
constexpr size_t WS_SG = 52 * MiB;
constexpr size_t WS_CUM = 56 * MiB;
constexpr size_t WS_XN = 64 * MiB;
constexpr size_t WS_AO = 192 * MiB;
constexpr size_t WS_BIG = 320 * MiB;
constexpr size_t WS_END = 1024 * MiB;
constexpr int CW_BAR = 4096;

constexpr int LDS_BYTES = 147456;
constexpr int RING_BYTES = 131072, LDSCTL_OFF = RING_BYTES, MISC_OFF = LDSCTL_OFF + 320;

__device__ __forceinline__ float bf2f(bf16 v) { return __builtin_bit_cast(float, (unsigned)v << 16); }
__device__ __forceinline__ unsigned f2bf(float f) { unsigned u = __builtin_bit_cast(unsigned, f); return (u + 0x7fffu + ((u >> 16) & 1u)) >> 16; }
__device__ __forceinline__ unsigned pk2(float lo, float hi) { return f2bf(lo) | (f2bf(hi) << 16); }
__device__ __forceinline__ float sigmoidf_(float v) { return 1.f / (1.f + __expf(-v)); }
__device__ __forceinline__ float logsigmoidf_(float v) { return fminf(v, 0.f) - log1pf(__expf(-fabsf(v))); }
__device__ __forceinline__ float siluf_(float v) { return v / (1.f + __expf(-v)); }

#define XB_TMO      128
#define XB_XCNT(j)  (256  + 64 * (j))
#define XB_XSUB(j)  (1280 + 64 * (j))
#define XB_XGEN(j)  (2304 + 64 * (j))
#define XB_TOP      3328
#define XB_TOPGEN   3392
#define XCD_BAR_WORDS 3456
#define XB_SPIN_CAP (1u << 22)

__device__ __forceinline__ unsigned xb_ld(unsigned* p)              { return __hip_atomic_load(p, __ATOMIC_RELAXED, __HIP_MEMORY_SCOPE_AGENT); }
__device__ __forceinline__ unsigned xb_add(unsigned* p, unsigned v) { return __hip_atomic_fetch_add(p, v, __ATOMIC_RELAXED, __HIP_MEMORY_SCOPE_AGENT); }
__device__ __forceinline__ unsigned xb_xcc_id() { return (unsigned)__builtin_amdgcn_s_getreg((3 << 11) | 20) & 0xFu; }
#define XB_SPIN(cond, bar) do { unsigned _sp = 0; while (cond) { __builtin_amdgcn_s_sleep(1); \
    if ((++_sp & 255u) == 0u) { if (xb_ld(&(bar)[XB_TMO])) break; if (_sp > XB_SPIN_CAP) { atomicAdd(&(bar)[XB_TMO], 1u); break; } } } } while (0)

struct XcdBarrier { unsigned* bar; unsigned x; volatile LAS unsigned* st; };

__device__ __forceinline__ XcdBarrier xcd_barrier_post(unsigned* bar, volatile LAS unsigned* st) {
    XcdBarrier b; b.bar = bar; b.x = xb_xcc_id(); b.st = st;
    if (threadIdx.x == 0) (void)xb_add(&bar[XB_XCNT(b.x)], 1u);
    return b;
}
__device__ __forceinline__ void xcd_barrier_complete(unsigned* bar, unsigned x, unsigned& nloc, unsigned& nx) {
    const unsigned G = gridDim.x * gridDim.y * gridDim.z;
    unsigned sum, cnt, mine, sp = 0u;
    for (;;) {
        sum = 0u; cnt = 0u; mine = 0u;
#pragma unroll
        for (unsigned j = 0; j < 16; ++j) { const unsigned c = xb_ld(&bar[XB_XCNT(j)]); sum += c; cnt += (c > 0u) ? 1u : 0u; mine = (j == x) ? c : mine; }
        if (sum == G) break;
        __builtin_amdgcn_s_sleep(1);
        if ((++sp & 255u) == 0u) { if (xb_ld(&bar[XB_TMO])) break; if (sp > XB_SPIN_CAP) { atomicAdd(&bar[XB_TMO], 1u); break; } }
    }
    nloc = mine > 0u ? mine : 1u; nx = cnt > 0u ? cnt : 1u;
}
__device__ __forceinline__ void xcd_barrier(const XcdBarrier& b) {
    asm volatile("s_waitcnt vmcnt(0)" ::: "memory");
    __syncthreads();
    if (threadIdx.x == 0) {
        unsigned* bar = b.bar;
        __builtin_amdgcn_s_waitcnt(0);
        unsigned nloc = b.st[0], nx = b.st[1];
        if (nloc == 0u) { xcd_barrier_complete(bar, b.x, nloc, nx); b.st[0] = nloc; b.st[1] = nx; }
        const unsigned old = xb_add(&bar[XB_XSUB(b.x)], 1u);
        const unsigned gen = old / nloc;
        if (old + 1u == (gen + 1u) * nloc) {
            __builtin_amdgcn_fence(__ATOMIC_RELEASE, "agent");
            asm volatile("s_waitcnt vmcnt(0)" ::: "memory");
            const unsigned og = xb_add(&bar[XB_TOP], 1u);
            const unsigned tg = og / nx;
            if (og + 1u == (tg + 1u) * nx) xb_add(&bar[XB_TOPGEN], 1u);
            else XB_SPIN(xb_ld(&bar[XB_TOPGEN]) == tg, bar);
            __builtin_amdgcn_fence(__ATOMIC_ACQUIRE, "agent");
            xb_add(&bar[XB_XGEN(b.x)], 1u);
            asm volatile("s_waitcnt vmcnt(0)" ::: "memory");
        } else {
            XB_SPIN(xb_ld(&bar[XB_XGEN(b.x)]) == gen, bar);
            __builtin_amdgcn_fence(__ATOMIC_ACQUIRE, "agent");
            asm volatile("s_waitcnt vmcnt(0)" ::: "memory");
        }
    }
    __syncthreads();
}

struct Frame {
    LAS unsigned char* lds;
    volatile LAS unsigned* MISC;
    gu32* ctl;
    int tid, lane, wave, G;
    const float* in[18];
    float* out;
    unsigned char* ws;
};
struct Args { const float* in[18]; float* out; unsigned char* ws; };

__device__ __forceinline__ int opaque_tid() { int t = threadIdx.x; asm volatile("" : "+v"(t)); return t; }
__device__ __forceinline__ float wave_sum(float v) {
#pragma unroll
    for (int o = 1; o < 64; o <<= 1) v += __shfl_xor(v, o);
    return v;
}

__device__ __forceinline__ void phase_rmsnorm_bf16(Frame& F, const float* X, const float* gain, bf16* O) {
    const int ptid = opaque_tid(), plane = ptid & 63, pwave = __builtin_amdgcn_readfirstlane(ptid >> 6); (void)plane; (void)pwave;
    const int gw = blockIdx.x * NWAVES + pwave, NGW = F.G * NWAVES;
    f32x4 g[4];
#pragma unroll
    for (int j = 0; j < 4; ++j) g[j] = *((const GAS f32x4*)gain + plane + 64 * j);
    for (int m = gw; m < M; m += NGW) {
        const GAS f32x4* xr = (const GAS f32x4*)(X + (size_t)m * D) + plane;
        f32x4 v[4]; float s = 0.f;
#pragma unroll
        for (int j = 0; j < 4; ++j) { v[j] = xr[64 * j]; s += (v[j].x * v[j].x + v[j].y * v[j].y) + (v[j].z * v[j].z + v[j].w * v[j].w); }
        const float r = 1.0f / sqrtf(wave_sum(s) * (1.f / D) + RMS_EPS);
        GAS unsigned long long* o8 = (GAS unsigned long long*)(O + (size_t)m * D) + plane;
#pragma unroll
        for (int j = 0; j < 4; ++j) o8[64 * j] = (unsigned long long)pk2(v[j].x * r * g[j].x, v[j].y * r * g[j].y) | ((unsigned long long)pk2(v[j].z * r * g[j].z, v[j].w * r * g[j].w) << 32);
    }
}
__device__ __forceinline__ void phase_rmsnorm_f32(Frame& F, float* X, const float* gain) {
    const int ptid = opaque_tid(), plane = ptid & 63, pwave = __builtin_amdgcn_readfirstlane(ptid >> 6); (void)plane; (void)pwave;
    const int gw = blockIdx.x * NWAVES + pwave, NGW = F.G * NWAVES;
    f32x4 g[4];
#pragma unroll
    for (int j = 0; j < 4; ++j) g[j] = *((const GAS f32x4*)gain + plane + 64 * j);
    for (int m = gw; m < M; m += NGW) {
        GAS f32x4* xr = (GAS f32x4*)(X + (size_t)m * D) + plane;
        f32x4 v[4]; float s = 0.f;
#pragma unroll
        for (int j = 0; j < 4; ++j) { v[j] = xr[64 * j]; s += (v[j].x * v[j].x + v[j].y * v[j].y) + (v[j].z * v[j].z + v[j].w * v[j].w); }
        const float r = 1.0f / sqrtf(wave_sum(s) * (1.f / D) + RMS_EPS);
#pragma unroll
        for (int j = 0; j < 4; ++j) xr[64 * j] = v[j] * r * g[j];
    }
}

struct NGemm { const bf16* A; int lda; const float* W; int ldw; int off; int K; };
template <bool TWO, class Epi>
__device__ __forceinline__ void naive_gemm(Frame& F, const NGemm g1, const NGemm g2, int Nout, const Epi& epi) {
    const int ptid = opaque_tid(), plane = ptid & 63, pwave = __builtin_amdgcn_readfirstlane(ptid >> 6); (void)plane; (void)pwave;
    LAS float* As = (LAS float*)F.lds;
    LAS float* Ws = (LAS float*)(F.lds + 32 * 132 * 4);
    const int tid = ptid, ty = tid >> 4, tx = tid & 15;
    const int nNt = (Nout + 63) / 64, nMt = M / 128;
    for (int it = blockIdx.x; it < nMt * nNt; it += F.G) {
        const int mt = it / nNt, nt = it % nNt, m0 = mt * 128, c0 = nt * 64;
        float acc[2][4][4];
#pragma unroll
        for (int t = 0; t < 2; ++t)
#pragma unroll
            for (int i = 0; i < 4; ++i)
#pragma unroll
                for (int j = 0; j < 4; ++j) acc[t][i][j] = 0.f;
#pragma unroll
        for (int term = 0; term < (TWO ? 2 : 1); ++term) {
            const NGemm g = term ? g2 : g1;
            for (int k0 = 0; k0 < g.K; k0 += 32) {
                {
                    const int row = tid >> 2, kq = (tid & 3) * 8;
                    const v4u raw = *(const GAS v4u*)(g.A + (size_t)(m0 + row) * g.lda + k0 + kq);
                    const unsigned w[4] = {raw.x, raw.y, raw.z, raw.w};
#pragma unroll
                    for (int i = 0; i < 4; ++i) { As[(kq + 2 * i) * 132 + row] = __builtin_bit_cast(float, w[i] << 16); As[(kq + 2 * i + 1) * 132 + row] = __builtin_bit_cast(float, w[i] & 0xffff0000u); }
                }
                {
                    const int k = tid >> 4, c4 = (tid & 15) * 4;
#pragma unroll
                    for (int i = 0; i < 4; ++i) { const int c = c0 + c4 + i; Ws[k * 64 + c4 + i] = (c < Nout) ? g.W[(size_t)(k0 + k) * g.ldw + g.off + c] : 0.f; }
                }
                __syncthreads();
#pragma unroll 8
                for (int kk = 0; kk < 32; ++kk) {
                    const f32x4 a = *(const LAS f32x4*)(As + kk * 132 + 4 * ty);
                    const f32x4 w = *(const LAS f32x4*)(Ws + kk * 64 + 4 * tx);
#pragma unroll
                    for (int i = 0; i < 4; ++i)
#pragma unroll
                        for (int j = 0; j < 4; ++j) acc[term][i][j] += a[i] * w[j];
                }
                __syncthreads();
            }
        }
#pragma unroll
        for (int i = 0; i < 4; ++i)
#pragma unroll
            for (int j = 0; j < 4; ++j) { const int c = c0 + 4 * tx + j; if (c < Nout) epi(m0 + 4 * ty + i, c, acc[0][i][j], acc[1][i][j]); }
    }
}

struct EpiSwiglu { bf16* H; __device__ __forceinline__ void operator()(int m, int c, float g, float u) const { H[(size_t)m * DFF + c] = (bf16)f2bf(siluf_(g) * u); } };
struct EpiResid { const float* R; float* O; float coef; __device__ __forceinline__ void operator()(int m, int c, float v, float) const { O[(size_t)m * D + c] = R[(size_t)m * D + c] + coef * v; } };
struct EpiProj { bf16* P; float* SG; const float* fb; const float* ib; const float* mfb;
    __device__ __forceinline__ void operator()(int m, int c, float v, float) const {
        if (c < 512) P[(size_t)m * PJ + c] = (bf16)f2bf(v * QSCALE2);
        else if (c < 1536) P[(size_t)m * PJ + c] = (bf16)f2bf(v);
        else if (c < 1544) SG[(size_t)m * 16 + (c - 1536)] = logsigmoidf_(v + fb[c - 1536]);
        else if (c < 3080) P[(size_t)m * PJ + c - 8] = (bf16)f2bf(v);
        else if (c < 3084) SG[(size_t)m * 16 + 8 + (c - 3080)] = v + ib[c - 3080];
        else if (c < 3088) SG[(size_t)m * 16 + 12 + (c - 3084)] = logsigmoidf_(v + mfb[c - 3084]);
        else P[(size_t)m * PJ + c - 16] = (bf16)f2bf(sigmoidf_(v));
    } };
struct EpiMerge { const bf16* P; bf16* MG; __device__ __forceinline__ void operator()(int m, int c, float a, float b) const {
        MG[(size_t)m * D + c] = (bf16)f2bf(bf2f(P[(size_t)m * PJ + PC_GA + c]) * a + bf2f(P[(size_t)m * PJ + PC_GB + c]) * b); } };

__device__ __forceinline__ void phase_cumsum(Frame& F, const float* SG, float* CUM) {
    const int ptid = opaque_tid(), plane = ptid & 63, pwave = __builtin_amdgcn_readfirstlane(ptid >> 6); (void)plane; (void)pwave;
    const int gw = blockIdx.x * NWAVES + pwave, NGW = F.G * NWAVES;
    for (int it = gw; it < BATCH * FOXH; it += NGW) {
        const int b = it / FOXH, h = it % FOXH;
        float v[32]; float s = 0.f;
#pragma unroll
        for (int i = 0; i < 32; ++i) { s += SG[(size_t)(b * SEQ + plane * 32 + i) * 16 + h]; v[i] = s; }
        float incl = s;
#pragma unroll
        for (int o = 1; o < 64; o <<= 1) { const float t = __shfl_up(incl, o); if (plane >= o) incl += t; }
        const float excl = incl - s;
#pragma unroll
        for (int i = 0; i < 32; ++i) CUM[(size_t)it * SEQ + plane * 32 + i] = v[i] + excl;
    }
}

__device__ __forceinline__ void phase_attn_naive(Frame& F, const bf16* P, const float* CUM, bf16* AO) {
    const int ptid = opaque_tid(), plane = ptid & 63, pwave = __builtin_amdgcn_readfirstlane(ptid >> 6); (void)plane; (void)pwave;
    LAS float* Ks = (LAS float*)F.lds;
    LAS float* Vs = (LAS float*)(F.lds + 16384);
    LAS float* Cs = (LAS float*)(F.lds + 32768);
    const int tid = ptid, qi = tid >> 2, sub = tid & 3;
    for (int it = blockIdx.x; it < BATCH * FOXH * (SEQ / 128); it += F.G) {
        const int qt = it % (SEQ / 128), bh = it / (SEQ / 128), b = bh / FOXH, h = bh % FOXH;
        const int qpos = qt * 128 + qi;
        float q[16], o[16];
        { const bf16* qp = P + (size_t)(b * SEQ + qpos) * PJ + PC_FQ + h * 64 + sub * 16;
#pragma unroll
          for (int i = 0; i < 16; ++i) { q[i] = bf2f(qp[i]); o[i] = 0.f; } }
        const float ct = CUM[(size_t)bh * SEQ + qpos];
        float mx = -1e30f, l = 0.f;
        const int nkt = (qt * 128 + 127) / 64 + 1;
        for (int kt = 0; kt < nkt; ++kt) {
            __syncthreads();
            { const int row = tid >> 3, c8 = (tid & 7) * 8;
              const bf16* kp = P + (size_t)(b * SEQ + kt * 64 + row) * PJ + PC_FK + h * 64 + c8;
              const bf16* vp = P + (size_t)(b * SEQ + kt * 64 + row) * PJ + PC_FV + h * 64 + c8;
#pragma unroll
              for (int i = 0; i < 8; ++i) { Ks[row * 64 + c8 + i] = bf2f(kp[i]); Vs[row * 64 + c8 + i] = bf2f(vp[i]); }
              if (tid < 64) Cs[tid] = CUM[(size_t)bh * SEQ + kt * 64 + tid]; }
            __syncthreads();
            for (int j = 0; j < 64; ++j) {
                const int kpos = kt * 64 + j;
                float dot = 0.f;
#pragma unroll
                for (int i = 0; i < 16; ++i) dot += q[i] * Ks[j * 64 + sub * 16 + i];
                dot += __shfl_xor(dot, 1); dot += __shfl_xor(dot, 2);
                if (kpos <= qpos) {
                    const float s2 = dot + (ct - Cs[j]) * LOG2E;
                    if (s2 > mx) { const float sc = exp2f(mx - s2); l *= sc;
#pragma unroll
                        for (int i = 0; i < 16; ++i) o[i] *= sc;
                        mx = s2; }
                    const float p = exp2f(s2 - mx); l += p;
#pragma unroll
                    for (int i = 0; i < 16; ++i) o[i] += p * Vs[j * 64 + sub * 16 + i];
                }
            }
        }
        const float rl = 1.f / l;
        bf16* op = AO + (size_t)(b * SEQ + qpos) * D + h * 64 + sub * 16;
#pragma unroll
        for (int i = 0; i < 16; ++i) op[i] = (bf16)f2bf(o[i] * rl);
    }
}

__device__ __forceinline__ void phase_mlstm_naive(Frame& F, const bf16* P, const float* SG, const float* convw, const float* convb, bf16* AO) {
    const int ptid = opaque_tid(), plane = ptid & 63, pwave = __builtin_amdgcn_readfirstlane(ptid >> 6); (void)plane; (void)pwave;
    LAS float* qs = (LAS float*)F.lds;
    LAS float* ks = qs + 128;
    LAS float* vs = ks + 128;
    LAS float* sc = vs + 128;
    LAS float* nump = sc + 4;
    LAS float* denp = nump + 512;
    const int tid = ptid, e = tid & 127, dg = tid >> 7;
    for (int it = blockIdx.x; it < BATCH * MLH; it += F.G) {
        const int b = it / MLH, h = it % MLH;
        float C[32]; float nst = 0.f, mprev = 0.f;
#pragma unroll
        for (int i = 0; i < 32; ++i) C[i] = 0.f;
        int pcol = 0, cch = 0; float w0 = 0.f, w1 = 0.f, w2 = 0.f, w3 = 0.f, cb = 0.f, r0 = 0.f, r1 = 0.f, r2 = 0.f;
        if (tid < 256) { const bool isk = tid >= 128; const int i = tid & 127; pcol = (isk ? PC_MK : PC_MQ) + h * 128 + i; cch = (isk ? 512 : 0) + h * 128 + i;
            w0 = convw[0 * 1024 + cch]; w1 = convw[1 * 1024 + cch]; w2 = convw[2 * 1024 + cch]; w3 = convw[3 * 1024 + cch]; cb = convb[cch]; }
        else if (tid < 384) pcol = PC_MV + h * 128 + (tid - 256);
        float cur = 0.f, cur2 = 0.f;
        { const size_t row = (size_t)b * SEQ;
          if (tid < 384) cur = bf2f(P[row * PJ + pcol]);
          if (tid == 384) { cur = SG[row * 16 + 8 + h]; cur2 = SG[row * 16 + 12 + h]; } }
        for (int t = 0; t < SEQ; ++t) {
            const size_t row = (size_t)b * SEQ + t;
            float nxt = 0.f, nxt2 = 0.f;
            if (t + 1 < SEQ) { if (tid < 384) nxt = bf2f(P[(row + 1) * PJ + pcol]); if (tid == 384) { nxt = SG[(row + 1) * 16 + 8 + h]; nxt2 = SG[(row + 1) * 16 + 12 + h]; } }
            const float og = (tid < 128) ? bf2f(P[row * PJ + PC_MO + h * 128 + tid]) : 0.f;
            if (tid < 256) { float cv = w0 * r0 + w1 * r1 + w2 * r2 + w3 * cur + cb; cv = siluf_(cv); r0 = r1; r1 = r2; r2 = cur;
                if (tid < 128) qs[tid] = cv * 0.08838834764831845f; else ks[tid - 128] = cv; }
            else if (tid < 384) vs[tid - 256] = cur;
            else if (tid == 384) { const float ig = cur, lf = cur2; const float mn = fmaxf(lf + mprev, ig);
                sc[0] = __expf(lf + mprev - mn); sc[1] = __expf(ig - mn); sc[2] = __expf(-mn); mprev = mn; }
            __syncthreads();
            const float fdec = sc[0], iw = sc[1], emn = sc[2];
            const float ve = vs[e] * iw;
            float part = 0.f;
#pragma unroll
            for (int dd = 0; dd < 32; ++dd) { const int d = dg * 32 + dd; C[dd] = fdec * C[dd] + ks[d] * ve; part += qs[d] * C[dd]; }
            nump[dg * 128 + e] = part;
            if (tid < 128) { nst = fdec * nst + iw * ks[tid]; float dp = wave_sum(qs[tid] * nst); if (plane == 0) denp[tid >> 6] = dp; }
            __syncthreads();
            if (tid < 128) { const float num = (nump[tid] + nump[128 + tid]) + (nump[256 + tid] + nump[384 + tid]); const float den = denp[0] + denp[1];
                const float hv = num / fmaxf(fabsf(den), emn);
                AO[row * D + 512 + h * 128 + tid] = (bf16)f2bf(hv * og); }
            __syncthreads();
            cur = nxt; cur2 = nxt2;
        }
    }
}


namespace pg8 {
#define PG8_LAS __attribute__((address_space(3)))
typedef unsigned short bf16_t;
typedef short bf16x8 __attribute__((ext_vector_type(8)));
typedef float f32x4 __attribute__((ext_vector_type(4)));
typedef unsigned u32x4 __attribute__((ext_vector_type(4)));
constexpr int BM = 256, BK = 64, HALF = 128, HTB = HALF * BK * 2  , STAGE_BYTES = 8 * HTB, NXCD = 8, WGM = 8;

__host__ __device__ __forceinline__ int lds_byte(int r, int c) { const int st = (r >> 4) * 2 + (c >> 5), rr = r & 15, cc = c & 31, ob = rr * 64 + cc * 2; return st * 1024 + (ob ^ (((ob >> 9) & 1) << 5)); }
__host__ __device__ __forceinline__ void stage_rc(int b, int& R, int& C) { const int st = b / 1024, sb = b % 1024, swz = sb ^ (((sb >> 9) & 1) << 5); R = (st >> 1) * 16 + swz / 64; C = (st & 1) * 32 + (swz % 64) / 2; }
__host__ __device__ __forceinline__ int perm32(int rho) { const int n = rho >> 4, i = rho & 15; return 8 * (i >> 2) + 4 * n + (i & 3); }

struct Unit { int pm, pn; };
struct Gemm { const bf16_t* A; const bf16_t* Bt; int M, N, K, lda, ldb; };

struct StaticOrder {
    int nM, nN, nwg, G, c;
    __host__ __device__ void init(int M, int N, int G_, int c_) { nM = M / BM; nN = N / BM; nwg = nM * nN; G = G_; c = c_; }
    __host__ __device__ bool next(int i, Unit& u) const {
        const long L = (long)i * G + c; if (L >= nwg) return false;
        int wgid = (int)L; { const int q = nwg / NXCD, r = nwg % NXCD, xcd = wgid % NXCD, off = wgid / NXCD; wgid = (xcd < r ? xcd * (q + 1) : r * (q + 1) + (xcd - r) * q) + off; }
        const int nig = WGM * nN, gid = wgid / nig, fm = gid * WGM, gsz = (nM - fm) < WGM ? (nM - fm) : WGM;
        u.pm = fm + ((wgid % nig) % gsz); u.pn = (wgid % nig) / gsz; return true;
    }
    __device__ __forceinline__ void a_ready(const Unit&) const {}
    __device__ __forceinline__ void done(const Unit&) const {}
};

__device__ __forceinline__ unsigned cvt_pk_bf16(float lo, float hi) { unsigned r; asm volatile("v_cvt_pk_bf16_f32 %0, %1, %2" : "=v"(r) : "v"(lo), "v"(hi)); return r; }
template <class Epi, class Sched, bool ALIGN_EPI = false, bool SP2 = false>
__device__ __forceinline__ void gemm_phase(PG8_LAS unsigned char* lds, const Gemm g, const Sched& S, const Epi& E) {
    int tid_ = threadIdx.x; asm volatile("" : "+v"(tid_));
    const int tid = tid_, wid = __builtin_amdgcn_readfirstlane(tid >> 6), lane = tid & 63, wr = wid >> 2, wc = wid & 3, fr = lane & 15, fq = lane >> 4;
    const int K = g.K, nt = K / BK;
    unsigned voffA[2], voffB[2];
#pragma unroll
    for (int i = 0; i < 2; ++i) { int R, C; stage_rc(tid * 16 + i * 8192, R, C); const int Rb = Epi::PERM ? ((R & ~31) + perm32(R & 31)) : R;
        voffA[i] = (unsigned)(R * g.lda + C) * 2u; voffB[i] = (unsigned)(Rb * g.ldb + C) * 2u; }
    const size_t kstep = (size_t)(BK * 2);
    const size_t hstepA = (size_t)HALF * g.lda * 2, hstepB = (size_t)HALF * g.ldb * 2;
    const size_t tstepA = 2 * hstepA, tstepB = 2 * hstepB;
    const unsigned ldsw = (unsigned)wid * 1024u;
    const int aoff = lds_byte(wr * 64 + fr, fq * 8), boff = lds_byte(wc * 32 + fr, fq * 8);
#define PG8_SA(b, h) (((b) * 2 + (h)) * HTB)
#define PG8_SB(b, h) ((4 + (b) * 2 + (h)) * HTB)
#define PG8_STAGE(bufoff, gbase, voff) do { _Pragma("unroll") for (int _i = 0; _i < 2; ++_i) \
        __builtin_amdgcn_global_load_lds((const unsigned*)((const char*)(gbase) + (voff)[_i]), (PG8_LAS unsigned*)(lds + (bufoff) + ldsw + _i * 8192), 16, 0, 0); } while (0)
#define PG8_LDA(dst, b, h) do { _Pragma("unroll") for (int m = 0; m < 4; ++m) _Pragma("unroll") for (int k = 0; k < 2; ++k) dst[m][k] = *(const PG8_LAS bf16x8*)(lds + PG8_SA(b, h) + aoff + m * 2048 + k * 1024); } while (0)
#define PG8_LDB(dst, b, h) do { _Pragma("unroll") for (int n = 0; n < 2; ++n) _Pragma("unroll") for (int k = 0; k < 2; ++k) dst[n][k] = *(const PG8_LAS bf16x8*)(lds + PG8_SB(b, h) + boff + n * 2048 + k * 1024); } while (0)
#define PG8_MMA(ai, bj, At, Bt) do { __builtin_amdgcn_s_setprio(1); _Pragma("unroll") for (int m = 0; m < 4; ++m) _Pragma("unroll") for (int n = 0; n < 2; ++n) _Pragma("unroll") for (int k = 0; k < 2; ++k) \
        acc[ai][bj][m][n] = __builtin_amdgcn_mfma_f32_16x16x32_bf16(Bt[n][k], At[m][k], acc[ai][bj][m][n], 0, 0, 0); __builtin_amdgcn_s_setprio(0); } while (0)
#define PG8_WAIT_V(n) asm volatile("s_waitcnt vmcnt(" #n ")" ::: "memory")
#define PG8_WAIT_L(n) asm volatile("s_waitcnt lgkmcnt(" #n ")" ::: "memory")
#define PG8_BAR __builtin_amdgcn_s_barrier()
#define PG8_SCHED __builtin_amdgcn_sched_barrier(0)
    Unit cur, nxt; int ui = 0;
    if (!S.next(0, cur)) return;
    f32x4 acc[2][2][4][2];
#pragma unroll
    for (int a = 0; a < 2; ++a)
#pragma unroll
        for (int b = 0; b < 2; ++b)
#pragma unroll
            for (int m = 0; m < 4; ++m)
#pragma unroll
                for (int n = 0; n < 2; ++n) acc[a][b][m][n] = (f32x4){0.f, 0.f, 0.f, 0.f};
    bf16x8 At[4][2], B0[2][2], B1[2][2];
    const char* cA = (const char*)g.A + (size_t)cur.pm * tstepA; const char* cB = (const char*)g.Bt + (size_t)cur.pn * tstepB;
    S.a_ready(cur);
    if constexpr (SP2) {
        PG8_STAGE(PG8_SB(0, 0), cB, voffB); PG8_STAGE(PG8_SB(0, 1), cB + hstepB, voffB); PG8_STAGE(PG8_SA(0, 0), cA, voffA); PG8_STAGE(PG8_SA(0, 1), cA + hstepA, voffA);
        if (wr == 1) PG8_BAR;
        PG8_WAIT_V(2); PG8_BAR;
        PG8_STAGE(PG8_SB(1, 0), cB + kstep, voffB); PG8_STAGE(PG8_SA(1, 0), cA + kstep, voffA); PG8_STAGE(PG8_SB(1, 1), cB + hstepB + kstep, voffB);
        PG8_WAIT_V(6); PG8_BAR;
    } else {
        PG8_STAGE(PG8_SB(0, 0), cB, voffB); PG8_STAGE(PG8_SA(0, 0), cA, voffA); PG8_STAGE(PG8_SB(0, 1), cB + hstepB, voffB); PG8_STAGE(PG8_SA(0, 1), cA + hstepA, voffA);
        if (wr == 1) PG8_BAR;
        PG8_WAIT_V(4); PG8_BAR;
        PG8_STAGE(PG8_SB(1, 0), cB + kstep, voffB); PG8_STAGE(PG8_SA(1, 0), cA + kstep, voffA); PG8_STAGE(PG8_SB(1, 1), cB + hstepB + kstep, voffB);
        PG8_WAIT_V(6); PG8_BAR;
    }
    for (;;) {
        const bool has_next = S.next(ui + 1, nxt);
        const char* nA = has_next ? (const char*)g.A + (size_t)nxt.pm * tstepA : cA; const char* nB = has_next ? (const char*)g.Bt + (size_t)nxt.pn * tstepB : cB;
        for (int t = 0; t < nt; t += 2) {
            const bool last = (t == nt - 2);
            const char* a1 = cA + (size_t)(t + 1) * kstep;
            const char* a2 = last ? nA : cA + (size_t)(t + 2) * kstep; const char* b2 = last ? nB : cB + (size_t)(t + 2) * kstep;
            const char* a3 = a2 + kstep; const char* b3 = b2 + kstep;
            if (last && has_next) S.a_ready(nxt);
            if constexpr (SP2) {
            PG8_LDB(B0, 0, 0); PG8_LDB(B1, 0, 1); PG8_SCHED; PG8_LDA(At, 0, 0); PG8_STAGE(PG8_SA(1, 1), a1 + hstepA, voffA);
            PG8_WAIT_V(8); PG8_WAIT_L(0); PG8_BAR; PG8_MMA(0, 0, At, B0); PG8_MMA(0, 1, At, B1); PG8_BAR; PG8_SCHED;
            PG8_LDA(At, 0, 1); PG8_STAGE(PG8_SB(0, 0), b2, voffB); PG8_STAGE(PG8_SB(0, 1), b2 + hstepB, voffB); PG8_STAGE(PG8_SA(0, 0), a2, voffA);
            PG8_WAIT_V(8); PG8_WAIT_L(0); PG8_BAR; PG8_MMA(1, 0, At, B0); PG8_MMA(1, 1, At, B1); PG8_BAR; PG8_SCHED;
            PG8_LDB(B0, 1, 0); PG8_LDB(B1, 1, 1); PG8_SCHED; PG8_LDA(At, 1, 0); PG8_STAGE(PG8_SA(0, 1), a2 + hstepA, voffA);
            PG8_WAIT_V(8); PG8_WAIT_L(0); PG8_BAR; PG8_MMA(0, 0, At, B0); PG8_MMA(0, 1, At, B1); PG8_BAR; PG8_SCHED;
            PG8_LDA(At, 1, 1); PG8_STAGE(PG8_SB(1, 0), b3, voffB); PG8_STAGE(PG8_SB(1, 1), b3 + hstepB, voffB); PG8_STAGE(PG8_SA(1, 0), a3, voffA);
            PG8_WAIT_V(8); PG8_WAIT_L(0); PG8_BAR; PG8_MMA(1, 0, At, B0); PG8_MMA(1, 1, At, B1); PG8_BAR; PG8_SCHED;
            } else {
            PG8_LDB(B0, 0, 0); PG8_SCHED; PG8_LDA(At, 0, 0); PG8_STAGE(PG8_SA(1, 1), a1 + hstepA, voffA);
            PG8_WAIT_L(8); PG8_BAR; PG8_WAIT_L(0); PG8_MMA(0, 0, At, B0); PG8_BAR; PG8_SCHED;
            PG8_LDB(B1, 0, 1); PG8_STAGE(PG8_SB(0, 0), b2, voffB);
            PG8_BAR; PG8_WAIT_L(0); PG8_MMA(0, 1, At, B1); PG8_BAR;
            PG8_LDA(At, 0, 1); PG8_STAGE(PG8_SA(0, 0), a2, voffA);
            PG8_BAR; PG8_WAIT_L(0); PG8_MMA(1, 0, At, B0); PG8_BAR; PG8_SCHED;
            PG8_STAGE(PG8_SB(0, 1), b2 + hstepB, voffB);
            PG8_WAIT_V(6); PG8_BAR; PG8_MMA(1, 1, At, B1); PG8_BAR;
            PG8_LDB(B0, 1, 0); PG8_SCHED; PG8_LDA(At, 1, 0); PG8_STAGE(PG8_SA(0, 1), a2 + hstepA, voffA);
            PG8_WAIT_L(8); PG8_BAR; PG8_WAIT_L(0); PG8_MMA(0, 0, At, B0); PG8_BAR; PG8_SCHED;
            PG8_LDB(B1, 1, 1); PG8_STAGE(PG8_SB(1, 0), b3, voffB);
            PG8_BAR; PG8_WAIT_L(0); PG8_MMA(0, 1, At, B1); PG8_BAR;
            PG8_LDA(At, 1, 1); PG8_STAGE(PG8_SA(1, 0), a3, voffA);
            PG8_BAR; PG8_WAIT_L(0); PG8_MMA(1, 0, At, B0); PG8_BAR; PG8_SCHED;
            PG8_STAGE(PG8_SB(1, 1), b3 + hstepB, voffB);
            PG8_WAIT_V(6); PG8_BAR; PG8_MMA(1, 1, At, B1); PG8_BAR;
            }
        }
        if constexpr (ALIGN_EPI) { if (wr == 0) PG8_BAR; }
        if constexpr (!Epi::AFTER_DRAIN) { E(acc, cur, wr, wc, fr, fq); S.done(cur); }
        if (!has_next) break;
#pragma unroll
        for (int a = 0; a < 2; ++a)
#pragma unroll
            for (int b = 0; b < 2; ++b)
#pragma unroll
                for (int m = 0; m < 4; ++m)
#pragma unroll
                    for (int n = 0; n < 2; ++n) acc[a][b][m][n] = (f32x4){0.f, 0.f, 0.f, 0.f};
        cur = nxt; cA = nA; cB = nB; ++ui;
        if constexpr (ALIGN_EPI) { if (wr == 1) PG8_BAR; }
    }
    PG8_WAIT_V(0);
    if constexpr (!ALIGN_EPI) { if (wr == 0) PG8_BAR; }
    PG8_BAR;
    if constexpr (Epi::AFTER_DRAIN) { E.fused(acc, cur, wr, wc, fr, fq, lds, wid, lane); S.done(cur); }
#undef PG8_SA
#undef PG8_SB
#undef PG8_STAGE
#undef PG8_LDA
#undef PG8_LDB
#undef PG8_MMA
#undef PG8_WAIT_V
#undef PG8_WAIT_L
#undef PG8_BAR
#undef PG8_SCHED
}
}

namespace pg8 {
__device__ __forceinline__ float fsig(float v) { return __builtin_amdgcn_rcpf(1.f + __builtin_amdgcn_exp2f(-1.4426950408889634f * v)); }
__device__ __forceinline__ u32x4 pack8(const f32x4 a, const f32x4 b) { u32x4 w; w.x = cvt_pk_bf16(a[0], a[1]); w.y = cvt_pk_bf16(a[2], a[3]); w.z = cvt_pk_bf16(b[0], b[1]); w.w = cvt_pk_bf16(b[2], b[3]); return w; }
__device__ __forceinline__ void unpack8(const u32x4 w, f32x4& a, f32x4& b) {
    a[0] = __builtin_bit_cast(float, w.x << 16); a[1] = __builtin_bit_cast(float, w.x & 0xffff0000u); a[2] = __builtin_bit_cast(float, w.y << 16); a[3] = __builtin_bit_cast(float, w.y & 0xffff0000u);
    b[0] = __builtin_bit_cast(float, w.z << 16); b[1] = __builtin_bit_cast(float, w.z & 0xffff0000u); b[2] = __builtin_bit_cast(float, w.w << 16); b[3] = __builtin_bit_cast(float, w.w & 0xffff0000u); }
struct EpiSwigluF { static constexpr bool PERM = true, AFTER_DRAIN = false; bf16_t* H;
    __device__ __forceinline__ void operator()(const f32x4 (&acc)[2][2][4][2], const Unit& u, int wr, int wc, int fr, int fq) const {
        const int row0 = u.pm * BM + wr * 64 + fr, col0 = u.pn * 128 + wc * 32 + 8 * fq;
#pragma unroll
        for (int ai = 0; ai < 2; ++ai)
#pragma unroll
            for (int m = 0; m < 4; ++m) { bf16_t* rowp = H + (size_t)(row0 + ai * HALF + m * 16) * DFF + col0;
                f32x4 h0, h1;
#pragma unroll
                for (int i = 0; i < 4; ++i) { const float g0 = acc[ai][0][m][0][i], g1 = acc[ai][0][m][1][i]; h0[i] = g0 * fsig(g0) * acc[ai][1][m][0][i]; h1[i] = g1 * fsig(g1) * acc[ai][1][m][1][i]; }
                *(u32x4*)rowp = pack8(h0, h1); }
    } };
struct EpiResidF { static constexpr bool PERM = false, AFTER_DRAIN = false; const float* R; float* O; float coef;
    __device__ __forceinline__ void operator()(const f32x4 (&acc)[2][2][4][2], const Unit& u, int wr, int wc, int fr, int fq) const {
        const int row0 = u.pm * BM + wr * 64 + fr, col0 = u.pn * BM + wc * 32 + 4 * fq;
#pragma unroll
        for (int ai = 0; ai < 2; ++ai)
#pragma unroll
            for (int m = 0; m < 4; ++m) { const size_t off = (size_t)(row0 + ai * HALF + m * 16) * D + col0;
#pragma unroll
                for (int bj = 0; bj < 2; ++bj)
#pragma unroll
                    for (int n = 0; n < 2; ++n) { const size_t p = off + bj * HALF + n * 16; const f32x4 r = *(const f32x4*)(R + p); *(f32x4*)(O + p) = r + acc[ai][bj][m][n] * coef; } }
    } };
struct EpiProjF { static constexpr bool PERM = true, AFTER_DRAIN = false; bf16_t* P; float* SG; const float* fb; const float* ib; const float* mfb;
    __device__ __forceinline__ void operator()(const f32x4 (&acc)[2][2][4][2], const Unit& u, int wr, int wc, int fr, int fq) const {
        const int row0 = u.pm * BM + wr * 64 + fr;
        if (u.pn < 22) {
            const int act = u.pn < 2 ? 0 : (u.pn < 12 ? 1 : 2); const int col0 = u.pn * BM + wc * 32 + 8 * fq;
#pragma unroll
            for (int ai = 0; ai < 2; ++ai)
#pragma unroll
                for (int m = 0; m < 4; ++m) { bf16_t* rowp = P + (size_t)(row0 + ai * HALF + m * 16) * PJ + col0;
#pragma unroll
                    for (int bj = 0; bj < 2; ++bj) { f32x4 v0 = acc[ai][bj][m][0], v1 = acc[ai][bj][m][1];
                        if (act == 0) { v0 = v0 * QSCALE2; v1 = v1 * QSCALE2; }
                        else if (act == 2) {
#pragma unroll
                            for (int i = 0; i < 4; ++i) { v0[i] = fsig(v0[i]); v1[i] = fsig(v1[i]); } }
                        *(u32x4*)(rowp + bj * HALF) = pack8(v0, v1); } }
        } else if (wc == 0 && fq < 2) {
            const f32x4 b0 = fq == 0 ? *(const f32x4*)fb : *(const f32x4*)ib, b1 = fq == 0 ? *(const f32x4*)(fb + 4) : *(const f32x4*)mfb;
#pragma unroll
            for (int ai = 0; ai < 2; ++ai)
#pragma unroll
                for (int m = 0; m < 4; ++m) { float* sp = SG + (size_t)(row0 + ai * HALF + m * 16) * 16 + 8 * fq;
                    f32x4 v0 = acc[ai][0][m][0] + b0, v1 = acc[ai][0][m][1] + b1;
#pragma unroll
                    for (int i = 0; i < 4; ++i) { if (fq == 0) v0[i] = logsigmoidf_(v0[i]); v1[i] = logsigmoidf_(v1[i]); }
                    *(f32x4*)sp = v0; *(f32x4*)(sp + 4) = v1; }
        }
    } };
template <bool SECOND> struct EpiGateF { static constexpr bool PERM = true, AFTER_DRAIN = false; const bf16_t* P; bf16_t* T;
    __device__ __forceinline__ void operator()(const f32x4 (&acc)[2][2][4][2], const Unit& u, int wr, int wc, int fr, int fq) const {
        const int row0 = u.pm * BM + wr * 64 + fr, col0 = u.pn * BM + wc * 32 + 8 * fq;
#pragma unroll
        for (int ai = 0; ai < 2; ++ai)
#pragma unroll
            for (int m = 0; m < 4; ++m) { const size_t row = (size_t)(row0 + ai * HALF + m * 16);
#pragma unroll
                for (int bj = 0; bj < 2; ++bj) { const int c = col0 + bj * HALF;
                    f32x4 g0, g1; unpack8(*(const u32x4*)(P + row * PJ + (SECOND ? PC_GB : PC_GA) + c), g0, g1);
                    f32x4 o0 = g0 * acc[ai][bj][m][0], o1 = g1 * acc[ai][bj][m][1];
                    if (SECOND) { f32x4 t0, t1; unpack8(*(const u32x4*)(T + row * D + c), t0, t1); o0 = o0 + t0; o1 = o1 + t1; }
                    *(u32x4*)(T + row * D + c) = pack8(o0, o1); } }
    } };
}

__device__ __forceinline__ void transpose_item(const float* W, int N, int scol0, bf16* WT, int ldt, int drow0, int k0, int kdst0, LAS float* scr, int lane) {
#pragma unroll 8
    for (int i = 0; i < 32; ++i) { const int kk = 2 * i + (lane >> 5); scr[kk * 33 + (lane & 31)] = W[(size_t)(k0 + kk) * N + scol0 + (lane & 31)]; }
    asm volatile("s_waitcnt lgkmcnt(0)" ::: "memory");
    const int c = lane & 7;
#pragma unroll
    for (int j = 0; j < 4; ++j) { const int n = (lane >> 3) + 8 * j; const LAS float* s = scr + (8 * c) * 33 + n;
        v4u o; o.x = pk2(s[0 * 33], s[1 * 33]); o.y = pk2(s[2 * 33], s[3 * 33]); o.z = pk2(s[4 * 33], s[5 * 33]); o.w = pk2(s[6 * 33], s[7 * 33]);
        *(GAS v4u*)(WT + (size_t)(drow0 + n) * ldt + kdst0 + k0 + 8 * c) = o; }
    asm volatile("s_waitcnt lgkmcnt(0)" ::: "memory");
}
__device__ __forceinline__ void phase_weights(Frame& F) {
    const int ptid = opaque_tid(), plane = ptid & 63, pwave = __builtin_amdgcn_readfirstlane(ptid >> 6); (void)plane; (void)pwave;
    LAS float* scr = (LAS float*)(F.lds + pwave * 16384);
    const int gw = blockIdx.x * NWAVES + pwave, NGW = F.G * NWAVES;
    constexpr int I_IN = (D / 64) * (NFF / 32), I_OUT = (DFF / 64) * (D / 32), I_PJ = (D / 64) * (PJ / 32), I_UP = (512 / 64) * (D / 32), I_WO = (D / 64) * (D / 32);
    constexpr int NITEMS = 2 * I_IN + 2 * I_OUT + I_PJ + 2 * I_UP + I_WO;
    for (int it = gw; it < NITEMS; it += NGW) {
        int r = it;
        if (r < 2 * I_IN) { const int which = r / I_IN; r -= which * I_IN; const int ndb = NFF / 32, kb = r / ndb, db = r % ndb, n = db * 32, pn = n >> 8, j = n & 255;
            const int sc = (j < 128) ? pn * 128 + j : DFF + pn * 128 + (j - 128);
            transpose_item(F.in[which ? 15 : 2], NFF, sc, (bf16*)(F.ws + (which ? WS_W2IN : WS_W1IN)), D, n, kb * 64, 0, scr, plane); continue; }
        r -= 2 * I_IN;
        if (r < 2 * I_OUT) { const int which = r / I_OUT; r -= which * I_OUT; const int ndb = D / 32, kb = r / ndb, db = r % ndb;
            transpose_item(F.in[which ? 16 : 3], D, db * 32, (bf16*)(F.ws + (which ? WS_W2OUT : WS_W1OUT)), DFF, db * 32, kb * 64, 0, scr, plane); continue; }
        r -= 2 * I_OUT;
        if (r < I_PJ) { const int ndb = PJ / 32, kb = r / ndb, db = r % ndb, n = db * 32; const int sc = n + (n < 1536 ? 0 : (n < 3072 ? 8 : 16));
            transpose_item(F.in[5], INC, sc, (bf16*)(F.ws + WS_WIN), D, n, kb * 64, 0, scr, plane); continue; }
        r -= I_PJ;
        if (r < 2 * I_UP) { const int which = r / I_UP; r -= which * I_UP; const int ndb = D / 32, kb = r / ndb, db = r % ndb;
            transpose_item(F.in[which ? 12 : 11], D, db * 32, (bf16*)(F.ws + WS_WCAT), D, db * 32, kb * 64, which ? 512 : 0, scr, plane); continue; }
        r -= 2 * I_UP;
        { const int ndb = D / 32, kb = r / ndb, db = r % ndb; transpose_item(F.in[13], D, db * 32, (bf16*)(F.ws + WS_WOUT), D, db * 32, kb * 64, 0, scr, plane); }
    }
    { bf16* WT = (bf16*)(F.ws + WS_WIN); const float* W = F.in[5];
      for (int idx = blockIdx.x * NTHR + ptid; idx < 256 * 128; idx += F.G * NTHR) { const int row = idx >> 7, k8 = (idx & 127) * 8; v4u o = {0u, 0u, 0u, 0u};
          if (row < 16) { const int sc = row < 8 ? 1536 + row : (row < 12 ? 3080 + (row - 8) : 3084 + (row - 12)); float v[8];
#pragma unroll
              for (int i = 0; i < 8; ++i) v[i] = W[(size_t)(k8 + i) * INC + sc];
              o.x = pk2(v[0], v[1]); o.y = pk2(v[2], v[3]); o.z = pk2(v[4], v[5]); o.w = pk2(v[6], v[7]); }
          *(GAS v4u*)(WT + (size_t)(PJ + row) * D + k8) = o; } }
}

#include <hip/hip_bf16.h>
#include <cmath>
namespace attn_body {
using bf16=__hip_bfloat16;
using bf16x8=__attribute__((ext_vector_type(8)))short;
using s16x4=__attribute__((ext_vector_type(4)))short;
using f32x16=__attribute__((ext_vector_type(16)))float;
using u32x4=__attribute__((ext_vector_type(4)))unsigned;
constexpr int BATCH=32,NHEAD=8,SEQ=2048,D=64,DM=5632,OP=1024;
constexpr int NW=8,QBLK=32,QB=QBLK*NW,KVBLK=64,NQB=SEQ/QB;
constexpr int ATTN_PITCH=DM, ATTN_UNIT_ROWS=QB;
__device__ __forceinline__ int crow(int r,int hi){return (r&3)+8*(r>>2)+4*hi;}
#define SBAR() __builtin_amdgcn_sched_barrier(0)
__device__ __forceinline__ void cmask(f32x16&p0,f32x16&p1,int jb,int qrel,int hi){
  const float NEG=-INFINITY; int kb=64*jb+4*hi;
  #pragma unroll
  for(int r=0;r<16;++r){int kv=kb+(r&3)+8*(r>>2); if(kv>qrel)p0[r]=NEG; if(kv+32>qrel)p1[r]=NEG;}
}

constexpr int NSLOT=3, SLOTB=8192;
constexpr int LDS_K=0, LDS_V=NSLOT*SLOTB, LDS_WS=2*NSLOT*SLOTB, LDS_OST=LDS_WS+NW*64*4, LDS_BIAS=LDS_OST+NW*4096, LDS_ROWB=LDS_BIAS+SEQ*8, LDS_BYTES=LDS_ROWB+QB*4;
constexpr float C2=0.125f*1.4426950408889634f;
__device__ __forceinline__ void glds16(const void*gsrc,unsigned lds_dst){unsigned keep;
  asm volatile("s_mov_b32 %0, m0\n\ts_mov_b32 m0, %2\n\ts_nop 0\n\tglobal_load_lds_dwordx4 %1, off\n\ts_mov_b32 m0, %0":"=&s"(keep):"v"(gsrc),"s"(lds_dst):"memory");}
__device__ __forceinline__ float max3f(float a,float b,float c){float r;asm("v_max3_f32 %0, %1, %2, %3":"=v"(r):"v"(a),"v"(b),"v"(c));return r;}
__device__ __forceinline__ float max2f(float a,float b){float r;asm("v_max_f32_e32 %0, %1, %2":"=v"(r):"v"(a),"v"(b));return r;}
__device__ __forceinline__ float fadd_s(float a,float b){float r;asm("v_add_f32_e32 %0, %1, %2":"=v"(r):"v"(a),"v"(b));return r;}
__device__ __forceinline__ float fsub_s(float a,float b){float r;asm("v_sub_f32_e32 %0, %1, %2":"=v"(r):"v"(a),"v"(b));return r;}
typedef float f32x2_t __attribute__((ext_vector_type(2))); typedef __bf16 bf16x2_t __attribute__((ext_vector_type(2)));
__device__ __forceinline__ unsigned cvtpk_s(float lo,float hi){f32x2_t v={lo,hi};bf16x2_t b=__builtin_convertvector(v,bf16x2_t);return __builtin_bit_cast(unsigned,b);}
#define WAIT_BAR(N) asm volatile("s_waitcnt vmcnt(" #N ") lgkmcnt(0)\n\ts_barrier":::"memory")

__device__ __forceinline__ void qkt(f32x16&p0,f32x16&p1,const char*Kslot,const bf16x8*qr,int r32,int hi,bf16x8 kx0,bf16x8 kx1,bf16x8 qx){
  const char*kb=Kslot+hi*1024+r32*16;
  #pragma unroll
  for(int d0=0;d0<4;++d0){
    const bf16x8 b0=*reinterpret_cast<const bf16x8*>(kb+d0*2048);
    const bf16x8 b1=*reinterpret_cast<const bf16x8*>(kb+d0*2048+512);
    if(d0==0){p0=__builtin_amdgcn_mfma_f32_32x32x16_bf16(b0,qr[0],f32x16{},0,0,0);p1=__builtin_amdgcn_mfma_f32_32x32x16_bf16(b1,qr[0],f32x16{},0,0,0);}
    else{p0=__builtin_amdgcn_mfma_f32_32x32x16_bf16(b0,qr[d0],p0,0,0,0);p1=__builtin_amdgcn_mfma_f32_32x32x16_bf16(b1,qr[d0],p1,0,0,0);}}
  p0=__builtin_amdgcn_mfma_f32_32x32x16_bf16(kx0,qx,p0,0,0,0);p1=__builtin_amdgcn_mfma_f32_32x32x16_bf16(kx1,qx,p1,0,0,0);
}
typedef __attribute__((address_space(3))) const char* lds_cptr;
typedef short v4i16_t __attribute__((ext_vector_type(4)));
__device__ __forceinline__ void kload8(bf16x8*kf,lds_cptr kp){
  kf[0]=*(const __attribute__((address_space(3))) bf16x8*)(kp);      kf[1]=*(const __attribute__((address_space(3))) bf16x8*)(kp+512);
  kf[2]=*(const __attribute__((address_space(3))) bf16x8*)(kp+2048); kf[3]=*(const __attribute__((address_space(3))) bf16x8*)(kp+2560);
  kf[4]=*(const __attribute__((address_space(3))) bf16x8*)(kp+4096); kf[5]=*(const __attribute__((address_space(3))) bf16x8*)(kp+4608);
  kf[6]=*(const __attribute__((address_space(3))) bf16x8*)(kp+6144); kf[7]=*(const __attribute__((address_space(3))) bf16x8*)(kp+6656);
}
__device__ __forceinline__ void kload2(bf16x8*kf,lds_cptr kp,int j){ kf[2*j]=*(const __attribute__((address_space(3))) bf16x8*)(kp+j*2048); kf[2*j+1]=*(const __attribute__((address_space(3))) bf16x8*)(kp+j*2048+512); }
typedef unsigned u32x2_t __attribute__((ext_vector_type(2)));
__device__ __forceinline__ bf16x8 kxfrag(lds_cptr tbl,int kv,int hi){ u32x2_t b=*(const __attribute__((address_space(3))) u32x2_t*)(tbl+kv*8); if(hi){b.x=0u;b.y=0u;} const u32x4 w={b.x,b.y,hi?0u:0x3F803F80u,0u}; return __builtin_bit_cast(bf16x8,w); }
__device__ __forceinline__ s16x4 vtr(lds_cptr p){ return __builtin_bit_cast(s16x4,__builtin_amdgcn_ds_read_tr16_b64_v4i16((__attribute__((address_space(3))) v4i16_t*)p)); }
__device__ __forceinline__ float rowmax(const f32x16&p0,const f32x16&p1){
  float a=max3f(p0[0],p0[1],p1[0]),b=max3f(p0[2],p0[3],p1[1]);a=max3f(a,p1[2],p1[3]);
  #pragma unroll
  for(int r=4;r<16;r+=4){a=max3f(a,p0[r],p0[r+1]);b=max3f(b,p0[r+2],p0[r+3]);a=max3f(a,p1[r],p1[r+1]);b=max3f(b,p1[r+2],p1[r+3]);}
  const float m=max2f(a,b);
  auto rr=__builtin_amdgcn_permlane32_swap(__float_as_uint(m),__float_as_uint(m),false,false);
  return max2f(__uint_as_float(rr[0]),__uint_as_float(rr[1]));
}
__device__ __forceinline__ void pv(f32x16*o,int vb,bf16x8 pa0,bf16x8 pa1,bf16x8 pa2,bf16x8 pa3){
  #pragma unroll
  for(int d0=0;d0<2;++d0){s16x4 lo[4],hi[4];
    #pragma unroll
    for(int ks=0;ks<4;++ks){
      asm volatile("ds_read_b64_tr_b16 %0,%1 offset:%c2":"=&v"(lo[ks]):"v"(vb),"i"(d0*4096+ks*1024):"memory");
      asm volatile("ds_read_b64_tr_b16 %0,%1 offset:%c2":"=&v"(hi[ks]):"v"(vb),"i"(d0*4096+ks*1024+512):"memory");}
    asm volatile("s_waitcnt lgkmcnt(0)":::"memory");SBAR();
    #define PK(k) (bf16x8){lo[k][0],lo[k][1],lo[k][2],lo[k][3],hi[k][0],hi[k][1],hi[k][2],hi[k][3]}
    o[d0]=__builtin_amdgcn_mfma_f32_32x32x16_bf16(pa0,PK(0),o[d0],0,0,0);
    o[d0]=__builtin_amdgcn_mfma_f32_32x32x16_bf16(pa1,PK(1),o[d0],0,0,0);
    o[d0]=__builtin_amdgcn_mfma_f32_32x32x16_bf16(pa2,PK(2),o[d0],0,0,0);
    o[d0]=__builtin_amdgcn_mfma_f32_32x32x16_bf16(pa3,PK(3),o[d0],0,0,0);
    #undef PK
  }
}

#ifndef ATTN_STORE16
#define ATTN_STORE16(p,v) (*(u32x4*)(p)=(v))
#endif
template<int THRL> __device__ __forceinline__ void attn_unit(int b,int h,int qb,const bf16*Q,const bf16*__restrict__ K,const bf16*__restrict__ V,bf16*O,const float*CUMh,char*shm){
  int tid_=threadIdx.x; asm volatile("":"+v"(tid_)); const int tid=tid_,lane=tid&63,r32=lane&31,hi=lane>>5; const int wid=__builtin_amdgcn_readfirstlane(tid>>6);
  const long rowbase=(long)b*SEQ; const int q0=qb*QB;
  const bf16*Qw=Q+(rowbase+q0+wid*QBLK)*DM+h*D;
  const bf16*Kh=K+rowbase*DM+h*D,*Vh=V+rowbase*DM+h*D;
  const unsigned lds0=(unsigned)(uintptr_t)shm;
  float*wsf=(float*)(shm+LDS_WS)+wid*64;
  const bf16*ksrc=Kh+(long)lane*DM+wid*8;
  const bf16*vsrc=Vh+(long)(16*(wid&3)+(lane>>2))*DM+(wid>>2)*32+(lane&3)*8;
  const unsigned kdst=lds0+LDS_K+wid*1024, vdst=lds0+LDS_V+wid*1024;
  #define DMA_K(t,slot) glds16(ksrc+(long)(t)*KVBLK*DM,(unsigned)__builtin_amdgcn_readfirstlane(kdst+(slot)))
  #define DMA_V(t,slot) glds16(vsrc+(long)(t)*KVBLK*DM,(unsigned)__builtin_amdgcn_readfirstlane(vdst+(slot)))
  const int vb0=(int)(lds0+LDS_V)+((lane>>4)&1)*32+(lane&3)*8+(4*hi+((lane&15)>>2))*64;
  const char*Kbase=shm+LDS_K; bf16x8 kf[8];
  const lds_cptr shm3=(lds_cptr)shm; const lds_cptr kp0=shm3+LDS_K+hi*1024+r32*16; const lds_cptr vp0=shm3+LDS_V+((lane>>4)&1)*32+(lane&3)*8+(4*hi+((lane&15)>>2))*64;
  const int NT=(q0+QB)/KVBLK;
  DMA_K(0,0);DMA_V(0,0);DMA_K(1,SLOTB);
  bf16x8 qr[4];
  #pragma unroll
  for(int d0=0;d0<4;++d0)qr[d0]=*reinterpret_cast<const bf16x8*>(&Qw[(long)r32*DM+d0*16+hi*8]);
  const int qrel=wid*QBLK+r32;
  { const float cref=CUMh[q0]; __attribute__((address_space(3))) unsigned*bt=(__attribute__((address_space(3))) unsigned*)(shm3+LDS_BIAS); __attribute__((address_space(3))) float*rb=(__attribute__((address_space(3))) float*)(shm3+LDS_ROWB);
    for(int kv=tid;kv<q0+QB;kv+=NW*64){ const float bias=(cref-CUMh[kv])*1.4426950408889634f;
      const unsigned u1=__builtin_bit_cast(unsigned,bias); const unsigned h1=(u1+0x7fffu+((u1>>16)&1u))&0xffff0000u; const float r1=bias-__builtin_bit_cast(float,h1);
      const unsigned u2=__builtin_bit_cast(unsigned,r1);   const unsigned h2=(u2+0x7fffu+((u2>>16)&1u))&0xffff0000u; const float r2=r1-__builtin_bit_cast(float,h2);
      const unsigned u3=__builtin_bit_cast(unsigned,r2);   const unsigned h3=(u3+0x7fffu+((u3>>16)&1u))&0xffff0000u;
      bt[2*kv]=(h1>>16)|h2; bt[2*kv+1]=(h3>>16)|0x3F800000u; if(kv>=q0)rb[kv-q0]=bias; } }
  const lds_cptr btab=shm3+LDS_BIAS; u32x4 qxw={hi?0u:0x3F803F80u,0u,0u,0u};
  #define QX __builtin_bit_cast(bf16x8,qxw)
  #define RNEHI(u) (((u)+0x7fffu+(((u)>>16)&1u))&0xffff0000u)
  #define SETQX() do{ const float nm_=-mhat; const unsigned a1_=RNEHI(__builtin_bit_cast(unsigned,nm_)); const float s1_=nm_-__builtin_bit_cast(float,a1_); \
      const unsigned a2_=RNEHI(__builtin_bit_cast(unsigned,s1_)); const float s2_=s1_-__builtin_bit_cast(float,a2_); const unsigned a3_=RNEHI(__builtin_bit_cast(unsigned,s2_)); \
      qxw.y=hi?0u:(a1_|0x3F80u); qxw.z=hi?0u:((a2_>>16)|a3_); }while(0)
  float mhat=0.f,l_reg=0.f;f32x16 o[2];o[0]=f32x16{};o[1]=f32x16{};
  #define CMASK(P0,P1,t) do{int jb_=(t)-(NT-4); if(jb_>=0)cmask(P0,P1,jb_,qrel,hi);}while(0)
  bool resc=false;
  #define START(P0,P1) do{ const float rm=rowmax(P0,P1); resc=false; \
    { const float dl=max2f(rm,0.f); mhat=fadd_s(mhat,dl); \
      _Pragma("unroll") for(int r=0;r<16;++r){P0[r]=fsub_s(P0[r],dl);P1[r]=fsub_s(P1[r],dl);} \
      SETQX(); } \
    _Pragma("unroll") for(int r=0;r<16;++r)P0[r]=__builtin_amdgcn_exp2f(P0[r]); }while(0)
  #define RESC() do{ if(resc){ asm volatile("s_waitcnt lgkmcnt(0)":::"memory"); \
      _Pragma("unroll") for(int d_=0;d_<2;++d_) _Pragma("unroll") for(int r=0;r<16;++r)o[d_][r]*=wsf[crow(r,hi)]; } }while(0)
  f32x16 pA0,pA1,pB0,pB1;
  int sl_prev=0,sl_cur=0,sl_next=SLOTB;
  #define ROT() do{sl_prev=sl_cur;sl_cur=sl_next;sl_next=(sl_next==(NSLOT-1)*SLOTB)?0:sl_next+SLOTB;}while(0)
  DMA_K(2,2*SLOTB);
  WAIT_BAR(3);
  mhat=*(const __attribute__((address_space(3))) float*)(shm3+LDS_ROWB+qrel*4);
  SETQX();
  qkt(pA0,pA1,Kbase,qr,r32,hi,kxfrag(btab,r32,hi),kxfrag(btab,32+r32,hi),QX);asm volatile("s_nop 15\n\ts_nop 7":"+v"(pA0),"+v"(pA1));CMASK(pA0,pA1,0);
  START(pA0,pA1);
  _Pragma("unroll") for(int r=0;r<16;++r)pA1[r]=__builtin_amdgcn_exp2f(pA1[r]);
  WAIT_BAR(0);
  DMA_K(3,0);DMA_V(1,SLOTB);
  ROT();
  kload8(kf,kp0+sl_cur);
  WAIT_BAR(2);
  s16x4 vlo[8],vhi[8]; u32x4 pw0,pw1,pw2,pw3;
  #define PKW(P,B) cvtpk_s(P[B],P[B+1])
  #define PAF(k) __builtin_bit_cast(bf16x8,pw##k)
  #define VFR(i) (bf16x8){vlo[i][0],vlo[i][1],vlo[i][2],vlo[i][3],vhi[i][0],vhi[i][1],vhi[i][2],vhi[i][3]}
  #define PIN(x) asm volatile("":"+v"(x))
  #define MX3(a,b,c) __builtin_fmaxf(__builtin_fmaxf((a),(b)),(c))
  #define GAPA(MF,A0,A1,A2,A3,W0,W1,PW) do{ MF; sacc+=A0; sacc+=A1; sacc+=A2; sacc+=A3; PIN(sacc); W0; W1; PIN(PW); SBAR(); }while(0)
  #define EX(v) __builtin_amdgcn_exp2f(v)
  #define GAPB(MF,X,B) do{ MF; X[B]=EX(X[B]); X[B+1]=EX(X[B+1]); X[B+2]=EX(X[B+2]); X[B+3]=EX(X[B+3]); PIN(X); SBAR(); }while(0)
  #define VRD(i) do{ vlo[i]=vtr(vp_+(((i)>>2)*4096+((i)&3)*1024)); vhi[i]=vtr(vp_+(((i)>>2)*4096+((i)&3)*1024+512)); }while(0)
  #define KRD(G,j) do{ if(G){ kload2(kf,kp0+sl_next,j); SBAR(); } }while(0)
  #define STEP(C0,C1,P0,P1,t,GK,GV,GL) do{ SBAR(); \
    const lds_cptr vp_=vp0+sl_prev; \
    const bf16x8 kx0_=kxfrag(btab,64*(t)+r32,hi), kx1_=kxfrag(btab,64*(t)+32+r32,hi); \
    VRD(0); SBAR(); float sacc=(P0[0]+P0[1]); \
    GAPA(C0=__builtin_amdgcn_mfma_f32_32x32x16_bf16(kf[0],qr[0],f32x16{},0,0,0), P0[2],P0[3],P0[4],P0[5],     pw0[0]=PKW(P0,0), pw0[1]=PKW(P0,2), pw0); \
    VRD(4); SBAR(); GAPA(C1=__builtin_amdgcn_mfma_f32_32x32x16_bf16(kf[1],qr[0],f32x16{},0,0,0), P0[6],P0[7],P0[8],P0[9],     pw0[2]=PKW(P0,4), pw0[3]=PKW(P0,6), pw0); \
    VRD(1); SBAR(); GAPA(C0=__builtin_amdgcn_mfma_f32_32x32x16_bf16(kf[2],qr[1],C0,0,0,0),   P0[10],P0[11],P0[12],P0[13], pw1[0]=PKW(P0,8), pw1[1]=PKW(P0,10), pw1); \
    VRD(5); SBAR(); GAPA(C1=__builtin_amdgcn_mfma_f32_32x32x16_bf16(kf[3],qr[1],C1,0,0,0),   P0[14],P0[15],P1[0],P1[1],   pw1[2]=PKW(P0,12),pw1[3]=PKW(P0,14), pw1); \
    VRD(2); SBAR(); GAPA(C0=__builtin_amdgcn_mfma_f32_32x32x16_bf16(kf[4],qr[2],C0,0,0,0),   P1[2],P1[3],P1[4],P1[5],     pw2[0]=PKW(P1,0), pw2[1]=PKW(P1,2), pw2); \
    VRD(6); SBAR(); GAPA(C1=__builtin_amdgcn_mfma_f32_32x32x16_bf16(kf[5],qr[2],C1,0,0,0),   P1[6],P1[7],P1[8],P1[9],     pw2[2]=PKW(P1,4), pw2[3]=PKW(P1,6), pw2); \
    VRD(3); SBAR(); GAPA(C0=__builtin_amdgcn_mfma_f32_32x32x16_bf16(kf[6],qr[3],C0,0,0,0),   P1[10],P1[11],P1[12],P1[13], pw3[0]=PKW(P1,8), pw3[1]=PKW(P1,10), pw3); \
    VRD(7); SBAR(); GAPA(C1=__builtin_amdgcn_mfma_f32_32x32x16_bf16(kf[7],qr[3],C1,0,0,0),   P1[14],P1[15],0.f,0.f,       pw3[2]=PKW(P1,12),pw3[3]=PKW(P1,14), pw3); \
    C0=__builtin_amdgcn_mfma_f32_32x32x16_bf16(kx0_,QX,C0,0,0,0); C1=__builtin_amdgcn_mfma_f32_32x32x16_bf16(kx1_,QX,C1,0,0,0); SBAR(); \
    l_reg+=sacc; \
    if(GK){DMA_K((t)+3,sl_cur);} if(GV){DMA_V((t)+1,sl_next);} \
    CMASK(C0,C1,t); \
    { float a=MX3(C0[0],C0[1],C1[0]),b=MX3(C0[2],C0[3],C1[1]); a=MX3(a,C1[2],C1[3]); \
      _Pragma("unroll") for(int r=4;r<16;r+=4){a=MX3(a,C0[r],C0[r+1]);b=MX3(b,C0[r+2],C0[r+3]);a=MX3(a,C1[r],C1[r+1]);b=MX3(b,C1[r+2],C1[r+3]);} \
      float rm=__builtin_fmaxf(a,b); { auto rr=__builtin_amdgcn_permlane32_swap(__float_as_uint(rm),__float_as_uint(rm),false,false); rm=__builtin_fmaxf(__uint_as_float(rr[0]),__uint_as_float(rr[1])); } \
      resc=false; \
      if(__builtin_expect(__any(rm>(float)THRL),0)){ const float dl=__builtin_fmaxf(rm,0.f); mhat+=dl; \
        _Pragma("unroll") for(int r=0;r<16;++r){C0[r]-=dl;C1[r]-=dl;} \
        SETQX(); \
        const float f=__builtin_amdgcn_exp2f(-dl); l_reg*=f; if(hi==0)wsf[r32]=f; resc=true; } } \
    SBAR(); \
    GAPB(o[0]=__builtin_amdgcn_mfma_f32_32x32x16_bf16(PAF(0),VFR(0),o[0],0,0,0), C0,0); \
    GAPB(o[1]=__builtin_amdgcn_mfma_f32_32x32x16_bf16(PAF(0),VFR(4),o[1],0,0,0), C0,4); \
    KRD(GL,0); GAPB(o[0]=__builtin_amdgcn_mfma_f32_32x32x16_bf16(PAF(1),VFR(1),o[0],0,0,0), C0,8); \
    KRD(GL,1); GAPB(o[1]=__builtin_amdgcn_mfma_f32_32x32x16_bf16(PAF(1),VFR(5),o[1],0,0,0), C0,12); \
    KRD(GL,2); GAPB(o[0]=__builtin_amdgcn_mfma_f32_32x32x16_bf16(PAF(2),VFR(2),o[0],0,0,0), C1,0); \
    KRD(GL,3); GAPB(o[1]=__builtin_amdgcn_mfma_f32_32x32x16_bf16(PAF(2),VFR(6),o[1],0,0,0), C1,4); \
    GAPB(o[0]=__builtin_amdgcn_mfma_f32_32x32x16_bf16(PAF(3),VFR(3),o[0],0,0,0), C1,8); \
    GAPB(o[1]=__builtin_amdgcn_mfma_f32_32x32x16_bf16(PAF(3),VFR(7),o[1],0,0,0), C1,12); \
    }while(0)
  int t=1;
  #undef CMASK
  #define CMASK(P0,P1,t) do{}while(0)
  for(;t+5<NT;t+=2){
    STEP(pB0,pB1,pA0,pA1,t,true,true,true);     WAIT_BAR(2); RESC(); ROT();
    STEP(pA0,pA1,pB0,pB1,t+1,true,true,true);   WAIT_BAR(2); RESC(); ROT();
  }
  #undef CMASK
  #define CMASK(P0,P1,t) do{int jb_=(t)-(NT-4); if(jb_>=0)cmask(P0,P1,jb_,qrel,hi);}while(0)
  #define ENDW(tt) do{ if((tt)+3<NT){WAIT_BAR(2);} else if((tt)+2<NT){WAIT_BAR(1);} else {WAIT_BAR(0);} }while(0)
  for(;t+1<NT;t+=2){
    STEP(pB0,pB1,pA0,pA1,t,(t+3<NT),(t+1<NT),(t+1<NT));       ENDW(t);   RESC(); ROT();
    STEP(pA0,pA1,pB0,pB1,t+1,(t+4<NT),(t+2<NT),(t+2<NT));     ENDW(t+1); RESC(); ROT();
  }
  STEP(pB0,pB1,pA0,pA1,NT-1,false,false,false); RESC();
  { float sacc=pB0[0]+pB0[1]; _Pragma("unroll") for(int r=2;r<16;++r)sacc+=pB0[r]; _Pragma("unroll") for(int r=0;r<16;++r)sacc+=pB1[r]; l_reg+=sacc;
    pw0=(u32x4){PKW(pB0,0),PKW(pB0,2),PKW(pB0,4),PKW(pB0,6)};pw1=(u32x4){PKW(pB0,8),PKW(pB0,10),PKW(pB0,12),PKW(pB0,14)};pw2=(u32x4){PKW(pB1,0),PKW(pB1,2),PKW(pB1,4),PKW(pB1,6)};pw3=(u32x4){PKW(pB1,8),PKW(pB1,10),PKW(pB1,12),PKW(pB1,14)};
    SBAR(); pv(o,vb0+sl_cur,PAF(0),PAF(1),PAF(2),PAF(3)); }
  #undef PKW
  #undef PAF
  #undef VFR
  #undef PIN
  #undef MX3
  #undef GAPA
  #undef GAPB
  #undef EX
  #undef VRD
  #undef KRD
  #undef STEP
  #undef ENDW
  {auto rr=__builtin_amdgcn_permlane32_swap(__float_as_uint(l_reg),__float_as_uint(l_reg),false,false);l_reg=__uint_as_float(rr[0])+__uint_as_float(rr[1]);}
  if(hi==0)wsf[32+r32]=l_reg;asm volatile("s_waitcnt lgkmcnt(0)":::"memory");
  float rli[16];
  #pragma unroll
  for(int r=0;r<16;++r)rli[r]=__builtin_amdgcn_rcpf(wsf[32+crow(r,hi)]);
  bf16*Ow=O+(rowbase+q0+wid*QBLK)*OP+h*D;
  { bf16*stg=(bf16*)(shm+LDS_OST)+wid*2048;
    #pragma unroll
    for(int r=0;r<16;++r){const int orow=crow(r,hi);
      #pragma unroll
      for(int d0=0;d0<2;++d0)stg[orow*64+d0*32+r32]=__float2bfloat16(o[d0][r]*rli[r]);}
    asm volatile("s_waitcnt lgkmcnt(0)":::"memory");
    #pragma unroll
    for(int i=0;i<4;++i){const int row=i*8+(lane>>3),ch=lane&7; const u32x4 v=*(const u32x4*)(stg+row*64+ch*8); ATTN_STORE16(Ow+(long)row*OP+ch*8,v);} }
  asm volatile("s_waitcnt lgkmcnt(0)\n\ts_barrier":::"memory");
  #undef DMA_K
  #undef QX
  #undef RNEHI
  #undef SETQX
  #undef DMA_V
  #undef CMASK
  #undef START
  #undef RESC
  #undef ROT
}
constexpr int ATTN_LDS_BYTES=LDS_BYTES;
struct AttnTensors { const bf16* Q; const bf16* K; const bf16* V; bf16* O; const float* CUM; };
struct AttnUnit { int bh; int qb; };
struct StaticOrder {
  int c,G;
  __device__ __forceinline__ StaticOrder(int grid,int block):c(block),G(grid){}
  __device__ __forceinline__ bool next(int i,AttnUnit&u)const{ const int it=i*G+c; if(it>=BATCH*NHEAD*NQB)return false; u.bh=it%(BATCH*NHEAD); u.qb=NQB-1-it/(BATCH*NHEAD); return true; }
};
template<class Sched,int THRL=8> __device__ __forceinline__ void attn_phase(char*lds,const AttnTensors&T,const Sched&S){
  AttnUnit u;
  for(int i=0;S.next(i,u);++i){ attn_unit<THRL>(u.bh/NHEAD,u.bh%NHEAD,u.qb,T.Q,T.K,T.V,T.O,T.CUM+(size_t)u.bh*SEQ,lds); }
}
#undef SBAR
#undef WAIT_BAR
}

namespace mls {
typedef short bf16x8 __attribute__((ext_vector_type(8)));
typedef float f32x4v __attribute__((ext_vector_type(4)));
typedef unsigned u32x2v __attribute__((ext_vector_type(2)));
typedef unsigned u32x4v __attribute__((ext_vector_type(4)));
constexpr int QS = 136, TS = 72;
constexpr int L_Q = 0, L_QI = 17408, L_K = 34816, L_KT = 52224, L_VT = 70656, L_WVT = 82176, L_SC = 93696, L_CT = 102912, L_DEN = 124672, L_END = 124928;
constexpr float QK_SCALE = 0.08838834764831845f;
__device__ __forceinline__ float scan_add(float v, int lane) {
#pragma unroll
    for (int o = 1; o < 64; o <<= 1) { const float t = __shfl_up(v, o); if (lane >= o) v += t; }
    return v; }
__device__ __forceinline__ float scan_max(float v, int lane) {
#pragma unroll
    for (int o = 1; o < 64; o <<= 1) { const float t = __shfl_up(v, o); if (lane >= o) v = fmaxf(v, t); }
    return v; }
__device__ __forceinline__ float lo_bf(unsigned w) { return __builtin_bit_cast(float, w << 16); }
__device__ __forceinline__ float hi_bf(unsigned w) { return __builtin_bit_cast(float, w & 0xffff0000u); }
}
__device__ __forceinline__ void phase_mlstm(Frame& F, const bf16* P, const float* SG, const float* convw, const float* convb, bf16* AO) {
    using namespace mls;
    int tid_ = threadIdx.x; asm volatile("" : "+v"(tid_));
    const int tid = tid_, lane = tid & 63, wid = __builtin_amdgcn_readfirstlane(tid >> 6), l15 = lane & 15, q4 = lane >> 4;
    LAS unsigned char* L = F.lds;
    for (int it = blockIdx.x; it < BATCH * MLH * 2; it += F.G) {
        const int vh = it & 1, bh = it >> 1, b = bh / MLH, h = bh % MLH;
        const size_t row00 = (size_t)b * SEQ;
        const int ch2 = tid & 127, tq = __builtin_amdgcn_readfirstlane(tid >> 7); const bool isk = (wid & 1) != 0;
        const int cc = (ch2 & 63) * 2;
        const int pcol = (isk ? PC_MK : PC_MQ) + h * 128 + cc, cch = (isk ? 512 : 0) + h * 128 + cc;
        float w0[2], w1[2], w2[2], w3[2], cb[2];
#pragma unroll
        for (int i = 0; i < 2; ++i) { w0[i] = convw[cch + i]; w1[i] = convw[1024 + cch + i]; w2[i] = convw[2048 + cch + i]; w3[i] = convw[3072 + cch + i]; cb[i] = convb[cch + i]; }
        const int e2 = tid & 31, sg = tid >> 5;
        const int vcol = PC_MV + h * 128 + vh * 64 + 2 * e2;
        f32x4v Cacc[8];
#pragma unroll
        for (int i = 0; i < 8; ++i) Cacc[i] = (f32x4v){0.f, 0.f, 0.f, 0.f};
        float mcar = 0.f;
        __syncthreads();
        for (int i = tid; i < 80 * QS / 2; i += NTHR) ((LAS unsigned*)(L + L_CT))[i] = 0u;
        for (int i = tid; i < 16 * TS / 2; i += NTHR) { ((LAS unsigned*)(L + L_VT + 64 * TS * 2))[i] = (i < TS / 2) ? 0x3F803F80u : 0u; ((LAS unsigned*)(L + L_WVT + 64 * TS * 2))[i] = 0u; }
        unsigned raw[19], vraw[4]; float ig, lf;
        const unsigned lo_raw = (unsigned)pcol * 2u, lo_v = (unsigned)((4 * sg) * PJ + vcol) * 2u, lo_g = (unsigned)lane * 64u, lo_o = (unsigned)((4 * q4) * PJ + l15) * 2u, lo_ao = (unsigned)((4 * q4) * D + l15) * 2u;
        const __amdgpu_buffer_rsrc_t rsP = __builtin_amdgcn_make_buffer_rsrc((void*)P, 0, M * PJ * 2, 0x00020000), rsG = __builtin_amdgcn_make_buffer_rsrc((void*)SG, 0, M * 64, 0x00020000),
                                     rsO = __builtin_amdgcn_make_buffer_rsrc((void*)AO, 0, M * D * 2, 0x00020000);
        const int r00 = (int)row00;
#define MLS_LOAD(c) do { _Pragma("unroll") for (int i_ = 0; i_ < 19; ++i_) { const int tr_ = 64 * (c) + 16 * tq - 3 + i_; raw[i_] = (tr_ >= 0) ? __builtin_amdgcn_raw_buffer_load_b32(rsP, lo_raw, (r00 + tr_) * (PJ * 2), 0) : 0u; } \
        _Pragma("unroll") for (int i_ = 0; i_ < 4; ++i_) vraw[i_] = __builtin_amdgcn_raw_buffer_load_b32(rsP, lo_v, (r00 + 64 * (c) + i_) * (PJ * 2), 0); \
        ig = __builtin_bit_cast(float, __builtin_amdgcn_raw_buffer_load_b32(rsG, lo_g, (r00 + 64 * (c)) * 64 + (8 + h) * 4, 0)); lf = __builtin_bit_cast(float, __builtin_amdgcn_raw_buffer_load_b32(rsG, lo_g, (r00 + 64 * (c)) * 64 + (12 + h) * 4, 0)); } while (0)
        MLS_LOAD(0);
        for (int c = 0; c < SEQ / 64; ++c) {
            const size_t row0 = row00 + 64 * c;
            const float bcum = scan_add(lf, lane), aval = ig - bcum, pm = scan_max(aval, lane);
            const float pm63 = __shfl(pm, 63), gsum = __shfl(bcum, 63);
            const float Mx = fmaxf(mcar, pm63), mrow = fmaxf(pm, mcar);
            const float rowterm = -mrow, inter = __expf(mcar - mrow), emt = __expf(-(bcum + mrow)), wk = __expf(aval - Mx), cdec = __expf(mcar - Mx);
            mcar = gsum + Mx;
            {
                unsigned kt0[8], kt1[8];
#pragma unroll
                for (int i = 0; i < 16; i += 2) {
                    float y[2][2];
#pragma unroll
                    for (int u = 0; u < 2; ++u) {
                        float a0 = w0[0] * lo_bf(raw[i + u]) + w1[0] * lo_bf(raw[i + u + 1]) + w2[0] * lo_bf(raw[i + u + 2]) + w3[0] * lo_bf(raw[i + u + 3]) + cb[0];
                        float a1 = w0[1] * hi_bf(raw[i + u]) + w1[1] * hi_bf(raw[i + u + 1]) + w2[1] * hi_bf(raw[i + u + 2]) + w3[1] * hi_bf(raw[i + u + 3]) + cb[1];
                        y[u][0] = siluf_(a0); y[u][1] = siluf_(a1);
                        const int t = 16 * tq + i + u;
                        if (!isk) { const float q0 = y[u][0] * QK_SCALE, q1 = y[u][1] * QK_SCALE; const float itv = __shfl(inter, t);
                            *(LAS unsigned*)(L + L_Q + (t * QS + cc) * 2) = pk2(q0, q1); *(LAS unsigned*)(L + L_QI + (t * QS + cc) * 2) = pk2(q0 * itv, q1 * itv); }
                        else *(LAS unsigned*)(L + L_K + (t * QS + cc) * 2) = pk2(y[u][0], y[u][1]);
                    }
                    kt0[i >> 1] = pk2(y[0][0], y[1][0]); kt1[i >> 1] = pk2(y[0][1], y[1][1]);
                }
                if (isk) {
                    *(LAS u32x4v*)(L + L_KT + (cc * TS + 16 * tq) * 2) = (u32x4v){kt0[0], kt0[1], kt0[2], kt0[3]}; *(LAS u32x4v*)(L + L_KT + (cc * TS + 16 * tq + 8) * 2) = (u32x4v){kt0[4], kt0[5], kt0[6], kt0[7]};
                    *(LAS u32x4v*)(L + L_KT + ((cc + 1) * TS + 16 * tq) * 2) = (u32x4v){kt1[0], kt1[1], kt1[2], kt1[3]}; *(LAS u32x4v*)(L + L_KT + ((cc + 1) * TS + 16 * tq + 8) * 2) = (u32x4v){kt1[4], kt1[5], kt1[6], kt1[7]};
                }
            }
            {
                float v0[4], v1[4], wv[4];
#pragma unroll
                for (int i = 0; i < 4; ++i) { v0[i] = lo_bf(vraw[i]); v1[i] = hi_bf(vraw[i]); wv[i] = __shfl(wk, 4 * sg + i); }
                *(LAS u32x2v*)(L + L_VT + ((2 * e2) * TS + 4 * sg) * 2) = (u32x2v){pk2(v0[0], v0[1]), pk2(v0[2], v0[3])};
                *(LAS u32x2v*)(L + L_VT + ((2 * e2 + 1) * TS + 4 * sg) * 2) = (u32x2v){pk2(v1[0], v1[1]), pk2(v1[2], v1[3])};
                *(LAS u32x2v*)(L + L_WVT + ((2 * e2) * TS + 4 * sg) * 2) = (u32x2v){pk2(v0[0] * wv[0], v0[1] * wv[1]), pk2(v0[2] * wv[2], v0[3] * wv[3])};
                *(LAS u32x2v*)(L + L_WVT + ((2 * e2 + 1) * TS + 4 * sg) * 2) = (u32x2v){pk2(v1[0] * wv[0], v1[1] * wv[1]), pk2(v1[2] * wv[2], v1[3] * wv[3])};
                if (wid == 0) *(LAS unsigned short*)(L + L_WVT + (64 * TS + lane) * 2) = (unsigned short)f2bf(wk);
            }
            if (c + 1 < SEQ / 64) MLS_LOAD(c + 1);
            __syncthreads();
            {
                const int tt = wid >> 1;
#pragma unroll
                for (int si = 0; si < 2; ++si) {
                    const int ss = 2 * (wid & 1) + si;
                    f32x4v acc = (f32x4v){0.f, 0.f, 0.f, 0.f};
                    if (ss <= tt) {
#pragma unroll
                        for (int kd = 0; kd < 4; ++kd) {
                            const bf16x8 a = *(const LAS bf16x8*)(L + L_Q + ((16 * tt + l15) * QS + 32 * kd + 8 * q4) * 2);
                            const bf16x8 bb = *(const LAS bf16x8*)(L + L_K + ((16 * ss + l15) * QS + 32 * kd + 8 * q4) * 2);
                            acc = __builtin_amdgcn_mfma_f32_16x16x32_bf16(a, bb, acc, 0, 0, 0);
                        }
                    }
                    const int s = 16 * ss + l15; const float as_ = __shfl(aval, s);
#pragma unroll
                    for (int j = 0; j < 4; ++j) { const int t = 16 * tt + 4 * q4 + j; const float rt = __shfl(rowterm, t);
                        const float dv = (s <= t) ? acc[j] * __expf(rt + as_) : 0.f;
                        *(LAS unsigned short*)(L + L_SC + (t * TS + s) * 2) = (unsigned short)f2bf(dv); }
                }
            }
            unsigned short mog[16];
            if (wid < 4) {
#pragma unroll
                for (int tt = 0; tt < 4; ++tt)
#pragma unroll
                    for (int j = 0; j < 4; ++j) mog[tt * 4 + j] = __builtin_amdgcn_raw_buffer_load_b16(rsP, lo_o, (((int)row0 + 16 * tt + j) * PJ + PC_MO + h * 128 + vh * 64 + 16 * wid) * 2, 0);
            }
            __syncthreads();
            f32x4v acc[4];
            if (wid < 5) {
                const int eg = wid;
#pragma unroll
                for (int tt = 0; tt < 4; ++tt) {
                    acc[tt] = (f32x4v){0.f, 0.f, 0.f, 0.f};
#pragma unroll
                    for (int ks = 0; ks < 2; ++ks) {
                        const bf16x8 a = *(const LAS bf16x8*)(L + L_SC + ((16 * tt + l15) * TS + 32 * ks + 8 * q4) * 2);
                        const bf16x8 bb = *(const LAS bf16x8*)(L + L_VT + ((16 * eg + l15) * TS + 32 * ks + 8 * q4) * 2);
                        acc[tt] = __builtin_amdgcn_mfma_f32_16x16x32_bf16(a, bb, acc[tt], 0, 0, 0);
                    }
#pragma unroll
                    for (int kd = 0; kd < 4; ++kd) {
                        const bf16x8 a = *(const LAS bf16x8*)(L + L_QI + ((16 * tt + l15) * QS + 32 * kd + 8 * q4) * 2);
                        const bf16x8 bb = *(const LAS bf16x8*)(L + L_CT + ((16 * eg + l15) * QS + 32 * kd + 8 * q4) * 2);
                        acc[tt] = __builtin_amdgcn_mfma_f32_16x16x32_bf16(a, bb, acc[tt], 0, 0, 0);
                    }
                }
                asm volatile("s_waitcnt lgkmcnt(0)" ::: "memory");
#pragma unroll
                for (int db = 0; db < 8; ++db) {
                    Cacc[db] = Cacc[db] * cdec;
#pragma unroll
                    for (int ks = 0; ks < 2; ++ks) {
                        const bf16x8 a = *(const LAS bf16x8*)(L + L_KT + ((16 * db + l15) * TS + 32 * ks + 8 * q4) * 2);
                        const bf16x8 bb = *(const LAS bf16x8*)(L + L_WVT + ((16 * eg + l15) * TS + 32 * ks + 8 * q4) * 2);
                        Cacc[db] = __builtin_amdgcn_mfma_f32_16x16x32_bf16(a, bb, Cacc[db], 0, 0, 0);
                    }
                    *(LAS u32x2v*)(L + L_CT + ((16 * eg + l15) * QS + 16 * db + 4 * q4) * 2) = (u32x2v){pk2(Cacc[db][0], Cacc[db][1]), pk2(Cacc[db][2], Cacc[db][3])};
                }
                if (wid == 4 && l15 == 0) {
#pragma unroll
                    for (int tt = 0; tt < 4; ++tt) *(LAS f32x4v*)(L + L_DEN + (16 * tt + 4 * q4) * 4) = acc[tt];
                }
            }
            __syncthreads();
            if (wid < 4) {
#pragma unroll
                for (int tt = 0; tt < 4; ++tt) {
                    const f32x4v den = *(const LAS f32x4v*)(L + L_DEN + (16 * tt + 4 * q4) * 4);
#pragma unroll
                    for (int j = 0; j < 4; ++j) { const int t = 16 * tt + 4 * q4 + j; const float et = __shfl(emt, t);
                        const float hv = acc[tt][j] / fmaxf(fabsf(den[j]), et);
                        __builtin_amdgcn_raw_buffer_store_b16((unsigned short)f2bf(hv * bf2f(mog[tt * 4 + j])), rsO, lo_ao, (((int)row0 + 16 * tt + j) * D + 512 + h * 128 + vh * 64 + 16 * wid) * 2, 0); }
                }
            }
        }
#undef MLS_LOAD
    }
}

__global__ void __launch_bounds__(NTHR, 2) fwd_kernel(Args args) {
    extern __shared__ __attribute__((aligned(16))) unsigned char lds[];
    Frame F;
    F.lds = (LAS unsigned char*)lds;
    F.MISC = (volatile LAS unsigned*)(F.lds + MISC_OFF);
    F.tid = threadIdx.x; F.lane = F.tid & 63; F.wave = __builtin_amdgcn_readfirstlane(F.tid >> 6);
    F.G = gridDim.x;
    F.ws = args.ws; F.out = args.out;
#pragma unroll
    for (int i = 0; i < 18; ++i) F.in[i] = args.in[i];
    F.ctl = (gu32*)(F.ws + WS_CTL);
    for (int u = F.tid; u < (LDS_BYTES - LDSCTL_OFF) / 4; u += NTHR) ((LAS unsigned*)(F.lds + LDSCTL_OFF))[u] = 0u;
    __syncthreads();
    XcdBarrier bar = xcd_barrier_post((unsigned*)(F.ctl + CW_BAR), F.MISC + 8);
#define GRID_BAR() xcd_barrier(bar)

    const float* x = F.in[0];
    bf16* XN = (bf16*)(F.ws + WS_XN); bf16* AO = (bf16*)(F.ws + WS_AO); bf16* BIG = (bf16*)(F.ws + WS_BIG);
    float* SG = (float*)(F.ws + WS_SG); float* CUM = (float*)(F.ws + WS_CUM);
    float* out = F.out;

    const bf16* W1IN = (const bf16*)(F.ws + WS_W1IN); const bf16* W1OUT = (const bf16*)(F.ws + WS_W1OUT); const bf16* WIN = (const bf16*)(F.ws + WS_WIN);
    const bf16* WCAT = (const bf16*)(F.ws + WS_WCAT); const bf16* WOUT = (const bf16*)(F.ws + WS_WOUT); const bf16* W2IN = (const bf16*)(F.ws + WS_W2IN); const bf16* W2OUT = (const bf16*)(F.ws + WS_W2OUT);
#define FAST(b) ((FAST_MASK >> (b)) & 1)
#define GEMM_PHASE(EpiT, gobj, eobj) do { pg8::StaticOrder S_; S_.init((gobj).M, (gobj).N, F.G, (int)blockIdx.x); pg8::gemm_phase<EpiT, pg8::StaticOrder, true, true>(F.lds, gobj, S_, eobj); } while (0)

    if (FAST_MASK & 0x7f) phase_weights(F);
    phase_rmsnorm_bf16(F, x, F.in[1], XN);
    GRID_BAR();
    if (FAST(0)) { pg8::Gemm g{XN, W1IN, M, NFF, D, D, D}; pg8::EpiSwigluF E{BIG}; GEMM_PHASE(pg8::EpiSwigluF, g, E); }
    else { NGemm g1{XN, D, F.in[2], NFF, 0, D}, g2{XN, D, F.in[2], NFF, DFF, D}; EpiSwiglu E{BIG}; naive_gemm<true>(F, g1, g2, DFF, E); }
    GRID_BAR();
    if (FAST(1)) { pg8::Gemm g{BIG, W1OUT, M, D, DFF, DFF, DFF}; pg8::EpiResidF E{x, out, 0.5f}; GEMM_PHASE(pg8::EpiResidF, g, E); }
    else { NGemm g1{BIG, DFF, F.in[3], D, 0, DFF}; EpiResid E{x, out, 0.5f}; naive_gemm<false>(F, g1, g1, D, E); }
    GRID_BAR();
    phase_rmsnorm_bf16(F, out, F.in[4], XN);
    GRID_BAR();
    if (FAST(2)) { pg8::Gemm g{XN, WIN, M, NPJ, D, D, D}; pg8::EpiProjF E{BIG, SG, F.in[6], F.in[9], F.in[10]}; GEMM_PHASE(pg8::EpiProjF, g, E); }
    else { NGemm g1{XN, D, F.in[5], INC, 0, D}; EpiProj E{BIG, SG, F.in[6], F.in[9], F.in[10]}; naive_gemm<false>(F, g1, g1, INC, E); }
    GRID_BAR();
    phase_cumsum(F, SG, CUM);
    GRID_BAR();
    if (FAST(8)) phase_mlstm(F, BIG, SG, F.in[7], F.in[8], AO); else phase_mlstm_naive(F, BIG, SG, F.in[7], F.in[8], AO);
    if (FAST(7)) { const attn_body::AttnTensors AT{(const attn_body::bf16*)(BIG + PC_FQ), (const attn_body::bf16*)(BIG + PC_FK), (const attn_body::bf16*)(BIG + PC_FV), (attn_body::bf16*)AO, CUM};
                   const attn_body::StaticOrder SA((int)F.G, (int)blockIdx.x); attn_body::attn_phase<attn_body::StaticOrder>((char*)lds, AT, SA); }
    else phase_attn_naive(F, BIG, CUM, AO);
    GRID_BAR();
    if (FAST(3)) { pg8::Gemm ga{AO, WCAT, M, D, 512, D, D}; pg8::EpiGateF<false> Ea{BIG, XN}; GEMM_PHASE(pg8::EpiGateF<false>, ga, Ea);
                   pg8::Gemm gb{AO + 512, WCAT + 512, M, D, 512, D, D}; pg8::EpiGateF<true> Eb{BIG, XN}; GEMM_PHASE(pg8::EpiGateF<true>, gb, Eb); }
    else { NGemm g1{AO, D, F.in[11], D, 0, 512}, g2{AO + 512, D, F.in[12], D, 0, 512}; EpiMerge E{BIG, XN}; naive_gemm<true>(F, g1, g2, D, E); }
    GRID_BAR();
    if (FAST(4)) { pg8::Gemm g{XN, WOUT, M, D, D, D, D}; pg8::EpiResidF E{out, out, 1.0f}; GEMM_PHASE(pg8::EpiResidF, g, E); }
    else { NGemm g1{XN, D, F.in[13], D, 0, D}; EpiResid E{out, out, 1.0f}; naive_gemm<false>(F, g1, g1, D, E); }
    GRID_BAR();
    phase_rmsnorm_bf16(F, out, F.in[14], XN);
    GRID_BAR();
    if (FAST(5)) { pg8::Gemm g{XN, W2IN, M, NFF, D, D, D}; pg8::EpiSwigluF E{BIG}; GEMM_PHASE(pg8::EpiSwigluF, g, E); }
    else { NGemm g1{XN, D, F.in[15], NFF, 0, D}, g2{XN, D, F.in[15], NFF, DFF, D}; EpiSwiglu E{BIG}; naive_gemm<true>(F, g1, g2, DFF, E); }
    GRID_BAR();
    if (FAST(6)) { pg8::Gemm g{BIG, W2OUT, M, D, DFF, DFF, DFF}; pg8::EpiResidF E{out, out, 0.5f}; GEMM_PHASE(pg8::EpiResidF, g, E); }
    else { NGemm g1{BIG, DFF, F.in[16], D, 0, DFF}; EpiResid E{out, out, 0.5f}; naive_gemm<false>(F, g1, g1, D, E); }
    GRID_BAR();
    phase_rmsnorm_f32(F, out, F.in[17]);
}

extern "C" void kernel_launch(void* const* d_in, const int* in_sizes, int n_in, void* d_out, int out_size, void* d_ws, size_t ws_size, hipStream_t stream) {
    static int grid = 0;
    if (grid == 0) {
        if (n_in != 18 || in_sizes[0] != M * D || out_size != M * D || ws_size < WS_END) { fprintf(stderr, "kernel_launch: unexpected shapes (n_in %d, in0 %d, out %d, ws %zu)\n", n_in, n_in > 0 ? in_sizes[0] : -1, out_size, ws_size); grid = -1; return; }
        int dev = 0, cus = 0, per_cu = 0;
        if (hipGetDevice(&dev) != hipSuccess || hipDeviceGetAttribute(&cus, hipDeviceAttributeMultiprocessorCount, dev) != hipSuccess) { grid = -1; return; }
        if (hipFuncSetAttribute((const void*)fwd_kernel, hipFuncAttributeMaxDynamicSharedMemorySize, LDS_BYTES) != hipSuccess) { grid = -1; return; }
        if (hipOccupancyMaxActiveBlocksPerMultiprocessor(&per_cu, (const void*)fwd_kernel, NTHR, LDS_BYTES) != hipSuccess || per_cu < 1) { fprintf(stderr, "occupancy query says %d\n", per_cu); }
        (void)hipGetLastError();
        grid = cus;
    }
    if (grid < 0) return;
    if (hipMemsetAsync((char*)d_ws + WS_CTL, 0, CTL_ZERO_BYTES, stream) != hipSuccess) return;
    Args a{};
    for (int i = 0; i < 18; ++i) a.in[i] = (const float*)d_in[i];
    a.out = (float*)d_out; a.ws = (unsigned char*)d_ws;
    hipLaunchKernelGGL(fwd_kernel, dim3(grid), dim3(NTHR), LDS_BYTES, stream, a);
}
```

```cpp
#include <hip/hip_runtime.h>
#include <cstdio>
#include <cstdint>

#define GAS __attribute__((address_space(1)))
#define LAS __attribute__((address_space(3)))
typedef unsigned short bf16;
typedef unsigned v4u __attribute__((ext_vector_type(4)));
typedef float f32x4 __attribute__((ext_vector_type(4)));
typedef GAS unsigned gu32;
#define RLX_AGENT __ATOMIC_RELAXED, __HIP_MEMORY_SCOPE_AGENT

constexpr int BATCH = 32, SEQ = 2048, D = 1024, M = BATCH * SEQ;
constexpr int DFF = 2816, NFF = 2 * DFF;
constexpr int INC = 5648;
constexpr int PJA = 3072, PJB = 2560;
constexpr int FOXH = 8, FHD = 64, MLH = 4, MHD = 128;
constexpr int PC_FQ = 0, PC_FK = 512, PC_FV = 1024, PC_MQ = 1536, PC_MK = 2048, PC_MV = 2560;
constexpr int PB_MO = 0, PB_GA = 512, PB_GB = 1536;
constexpr float RMS_EPS = 1e-6f;
constexpr float LOG2E = 1.4426950408889634f;
constexpr float QSCALE2 = 0.125f * LOG2E;
constexpr int NWAVES = 8, NTHR = 512;
#ifndef REP_MASK
#define REP_MASK 0
#endif

constexpr size_t MiB = 1u << 20;
constexpr size_t WS_CTL = 0, CTL_ZERO_BYTES = 1 * MiB;
constexpr size_t WS_W1IN = 2 * MiB, WS_W1OUT = 13 * MiB, WS_WIN = 19 * MiB, WS_WCAT = 31 * MiB, WS_WOUT = 33 * MiB, WS_W2IN = 35 * MiB, WS_W2OUT = 46 * MiB;
constexpr int NPJ = 5888;
constexpr size_t WS_SG = 52 * MiB;
constexpr size_t WS_CUM = 56 * MiB;
constexpr size_t WS_SS = 58 * MiB;
constexpr size_t WS_XB = 64 * MiB;
constexpr size_t WS_AO = 192 * MiB;
constexpr size_t WS_PA = 320 * MiB;
constexpr size_t WS_PB = 704 * MiB;
constexpr size_t WS_END = 1024 * MiB;
constexpr int CW_BAR = 4096;

constexpr int LDS_BYTES = 147456;
constexpr int RING_BYTES = 131072, LDSCTL_OFF = RING_BYTES, MISC_OFF = LDSCTL_OFF + 320;

__device__ __forceinline__ float bf2f(bf16 v) { return __builtin_bit_cast(float, (unsigned)v << 16); }
__device__ __forceinline__ unsigned f2bf(float f) { unsigned u = __builtin_bit_cast(unsigned, f); return (u + 0x7fffu + ((u >> 16) & 1u)) >> 16; }
__device__ __forceinline__ unsigned pk2(float lo, float hi) { return f2bf(lo) | (f2bf(hi) << 16); }
__device__ __forceinline__ float sigmoidf_(float v) { return 1.f / (1.f + __expf(-v)); }
__device__ __forceinline__ float logsigmoidf_(float v) { return fminf(v, 0.f) - log1pf(__expf(-fabsf(v))); }
__device__ __forceinline__ float siluf_(float v) { return v / (1.f + __expf(-v)); }

#define XB_TMO      128
#define XB_XCNT(j)  (256  + 64 * (j))
#define XB_XSUB(j)  (1280 + 64 * (j))
#define XB_XGEN(j)  (2304 + 64 * (j))
#define XB_TOP      3328
#define XB_TOPGEN   3392
#define XCD_BAR_WORDS 3456
#define XB_SPIN_CAP (1u << 22)

__device__ __forceinline__ unsigned xb_ld(unsigned* p)              { return __hip_atomic_load(p, __ATOMIC_RELAXED, __HIP_MEMORY_SCOPE_AGENT); }
__device__ __forceinline__ unsigned xb_add(unsigned* p, unsigned v) { return __hip_atomic_fetch_add(p, v, __ATOMIC_RELAXED, __HIP_MEMORY_SCOPE_AGENT); }
__device__ __forceinline__ unsigned xb_xcc_id() { return (unsigned)__builtin_amdgcn_s_getreg((3 << 11) | 20) & 0xFu; }
#define XB_SPIN(cond, bar) do { unsigned _sp = 0; while (cond) { __builtin_amdgcn_s_sleep(1); \
    if ((++_sp & 255u) == 0u) { if (xb_ld(&(bar)[XB_TMO])) break; if (_sp > XB_SPIN_CAP) { atomicAdd(&(bar)[XB_TMO], 1u); break; } } } } while (0)

struct XcdBarrier { unsigned* bar; unsigned x; volatile LAS unsigned* st; };

__device__ __forceinline__ XcdBarrier xcd_barrier_post(unsigned* bar, volatile LAS unsigned* st) {
    XcdBarrier b; b.bar = bar; b.x = xb_xcc_id(); b.st = st;
    if (threadIdx.x == 0) (void)xb_add(&bar[XB_XCNT(b.x)], 1u);
    return b;
}
__device__ __forceinline__ void xcd_barrier_complete(unsigned* bar, unsigned x, unsigned& nloc, unsigned& nx) {
    const unsigned G = gridDim.x * gridDim.y * gridDim.z;
    unsigned sum, cnt, mine, sp = 0u;
    for (;;) {
        sum = 0u; cnt = 0u; mine = 0u;
#pragma unroll
        for (unsigned j = 0; j < 16; ++j) { const unsigned c = xb_ld(&bar[XB_XCNT(j)]); sum += c; cnt += (c > 0u) ? 1u : 0u; mine = (j == x) ? c : mine; }
        if (sum == G) break;
        __builtin_amdgcn_s_sleep(1);
        if ((++sp & 255u) == 0u) { if (xb_ld(&bar[XB_TMO])) break; if (sp > XB_SPIN_CAP) { atomicAdd(&bar[XB_TMO], 1u); break; } }
    }
    nloc = mine > 0u ? mine : 1u; nx = cnt > 0u ? cnt : 1u;
}
__device__ __forceinline__ void xcd_barrier(const XcdBarrier& b) {
    asm volatile("s_waitcnt vmcnt(0)" ::: "memory");
    __syncthreads();
    if (threadIdx.x == 0) {
        unsigned* bar = b.bar;
        __builtin_amdgcn_s_waitcnt(0);
        unsigned nloc = b.st[0], nx = b.st[1];
        if (nloc == 0u) { xcd_barrier_complete(bar, b.x, nloc, nx); b.st[0] = nloc; b.st[1] = nx; }
        const unsigned old = xb_add(&bar[XB_XSUB(b.x)], 1u);
        const unsigned gen = old / nloc;
        if (old + 1u == (gen + 1u) * nloc) {
            __builtin_amdgcn_fence(__ATOMIC_RELEASE, "agent");
            asm volatile("s_waitcnt vmcnt(0)" ::: "memory");
            const unsigned og = xb_add(&bar[XB_TOP], 1u);
            const unsigned tg = og / nx;
            if (og + 1u == (tg + 1u) * nx) xb_add(&bar[XB_TOPGEN], 1u);
            else XB_SPIN(xb_ld(&bar[XB_TOPGEN]) == tg, bar);
            __builtin_amdgcn_fence(__ATOMIC_ACQUIRE, "agent");
            xb_add(&bar[XB_XGEN(b.x)], 1u);
            asm volatile("s_waitcnt vmcnt(0)" ::: "memory");
        } else {
            XB_SPIN(xb_ld(&bar[XB_XGEN(b.x)]) == gen, bar);
            __builtin_amdgcn_fence(__ATOMIC_ACQUIRE, "agent");
            asm volatile("s_waitcnt vmcnt(0)" ::: "memory");
        }
    }
    __syncthreads();
}

struct Frame {
    LAS unsigned char* lds;
    volatile LAS unsigned* MISC;
    gu32* ctl;
    int wave, G;
    const float* in[18];
    float* out;
    unsigned char* ws;
};
struct Args { const float* in[18]; float* out; unsigned char* ws; };

__device__ __forceinline__ int lane_id() { return (int)__builtin_amdgcn_mbcnt_hi(~0u, __builtin_amdgcn_mbcnt_lo(~0u, 0u)); }
__device__ __forceinline__ int opaque_tid(int wv) { int t = wv * 64 + lane_id(); asm volatile("" : "+v"(t)); return t; }
__device__ __forceinline__ float wave_sum(float v) {
#pragma unroll
    for (int o = 1; o < 64; o <<= 1) v += __shfl_xor(v, o);
    return v;
}

__device__ __forceinline__ void phase_x_prep(Frame& F, const float* X, bf16* XB, float* SS) {
    const int ptid = opaque_tid(F.wave), plane = ptid & 63, pwave = __builtin_amdgcn_readfirstlane(ptid >> 6);
    const int gw = blockIdx.x * NWAVES + pwave, NGW = F.G * NWAVES;
    for (int m = gw; m < M; m += NGW) {
        const GAS f32x4* xr = (const GAS f32x4*)(X + (size_t)m * D) + plane;
        f32x4 v[4]; float s = 0.f;
#pragma unroll
        for (int j = 0; j < 4; ++j) { v[j] = xr[64 * j]; s += (v[j].x * v[j].x + v[j].y * v[j].y) + (v[j].z * v[j].z + v[j].w * v[j].w); }
        s = wave_sum(s);
        GAS unsigned long long* o8 = (GAS unsigned long long*)(XB + (size_t)m * D) + plane;
#pragma unroll
        for (int j = 0; j < 4; ++j) o8[64 * j] = (unsigned long long)pk2(v[j].x, v[j].y) | ((unsigned long long)pk2(v[j].z, v[j].w) << 32);
        if (plane < 16) SS[(size_t)m * 16 + plane] = (plane == 0) ? s : 0.f;
    }
}
__device__ __forceinline__ void phase_final_scale(Frame& F, float* X, const float* SS, const float* gain) {
    const int ptid = opaque_tid(F.wave), plane = ptid & 63, pwave = __builtin_amdgcn_readfirstlane(ptid >> 6);
    const int gw = blockIdx.x * NWAVES + pwave, NGW = F.G * NWAVES;
    f32x4 g[4];
#pragma unroll
    for (int j = 0; j < 4; ++j) g[j] = *((const GAS f32x4*)gain + plane + 64 * j);
    for (int m = gw; m < M; m += NGW) {
        GAS f32x4* xr = (GAS f32x4*)(X + (size_t)m * D) + plane;
        f32x4 v[4];
#pragma unroll
        for (int j = 0; j < 4; ++j) v[j] = xr[64 * j];
        float s = SS[(size_t)m * 16 + (plane & 15)];
#pragma unroll
        for (int o = 1; o < 16; o <<= 1) s += __shfl_xor(s, o);
        const float r = 1.0f / sqrtf(s * (1.f / D) + RMS_EPS);
#pragma unroll
        for (int j = 0; j < 4; ++j) xr[64 * j] = v[j] * r * g[j];
    }
}

__device__ __forceinline__ void phase_cumsum(Frame& F, const float* SG, float* CUM) {
    const int ptid = opaque_tid(F.wave), plane = ptid & 63, pwave = __builtin_amdgcn_readfirstlane(ptid >> 6); (void)plane; (void)pwave;
    const int gw = blockIdx.x * NWAVES + pwave, NGW = F.G * NWAVES;
    for (int it = gw; it < BATCH * FOXH; it += NGW) {
        const int b = it / FOXH, h = it % FOXH;
        float v[32]; float s = 0.f;
#pragma unroll
        for (int i = 0; i < 32; ++i) { s += SG[(size_t)(b * SEQ + plane * 32 + i) * 16 + h]; v[i] = s; }
        float incl = s;
#pragma unroll
        for (int o = 1; o < 64; o <<= 1) { const float t = __shfl_up(incl, o); if (plane >= o) incl += t; }
        const float excl = incl - s;
#pragma unroll
        for (int i = 0; i < 32; ++i) CUM[(size_t)it * SEQ + plane * 32 + i] = v[i] + excl;
    }
}


namespace pg8 {
#define PG8_LAS __attribute__((address_space(3)))
typedef unsigned short bf16_t;
typedef short bf16x8 __attribute__((ext_vector_type(8)));
typedef float f32x4 __attribute__((ext_vector_type(4)));
typedef unsigned u32x4 __attribute__((ext_vector_type(4)));
constexpr int BM = 256, BK = 64, HALF = 128, HTB = HALF * BK * 2  , STAGE_BYTES = 8 * HTB, NXCD = 8, WGM = 8;

__host__ __device__ __forceinline__ int lds_byte(int r, int c) { const int st = (r >> 4) * 2 + (c >> 5), rr = r & 15, cc = c & 31, ob = rr * 64 + cc * 2; return st * 1024 + (ob ^ (((ob >> 9) & 1) << 5)); }
__host__ __device__ __forceinline__ void stage_rc(int b, int& R, int& C) { const int st = b / 1024, sb = b % 1024, swz = sb ^ (((sb >> 9) & 1) << 5); R = (st >> 1) * 16 + swz / 64; C = (st & 1) * 32 + (swz % 64) / 2; }
__host__ __device__ __forceinline__ int perm32(int rho) { const int n = rho >> 4, i = rho & 15; return 8 * (i >> 2) + 4 * n + (i & 3); }

struct Unit { int pm, pn; };
struct Gemm { const bf16_t* A; const bf16_t* Bt; int M, N, K, lda, ldb; };

struct StaticOrder {
    int nM, nN, nwg, G, c;
    __host__ __device__ void init(int M, int N, int G_, int c_) { nM = M / BM; nN = N / BM; nwg = nM * nN; G = G_; c = c_; }
    __host__ __device__ bool next(int i, Unit& u) const {
        const long L = (long)i * G + c; if (L >= nwg) return false;
        int wgid = (int)L; { const int q = nwg / NXCD, r = nwg % NXCD, xcd = wgid % NXCD, off = wgid / NXCD; wgid = (xcd < r ? xcd * (q + 1) : r * (q + 1) + (xcd - r) * q) + off; }
        const int nig = WGM * nN, gid = wgid / nig, fm = gid * WGM, gsz = (nM - fm) < WGM ? (nM - fm) : WGM;
        u.pm = fm + ((wgid % nig) % gsz); u.pn = (wgid % nig) / gsz; return true;
    }
    __device__ __forceinline__ void a_ready(const Unit&) const {}
    __device__ __forceinline__ void done(const Unit&) const {}
};

__device__ __forceinline__ unsigned cvt_pk_bf16(float lo, float hi) { unsigned r; asm volatile("v_cvt_pk_bf16_f32 %0, %1, %2" : "=v"(r) : "v"(lo), "v"(hi)); return r; }
template <class Epi, class Sched, bool ALIGN_EPI = false, bool SP2 = false>
__device__ __forceinline__ void gemm_phase(PG8_LAS unsigned char* lds, const Gemm g, const Sched& S, const Epi& E, const int wv) {
    int tid_ = wv * 64 + (int)__builtin_amdgcn_mbcnt_hi(~0u, __builtin_amdgcn_mbcnt_lo(~0u, 0u)); asm volatile("" : "+v"(tid_));
    const int tid = tid_, wid = __builtin_amdgcn_readfirstlane(tid >> 6), lane = tid & 63, wr = wid >> 2, wc = wid & 3, fr = lane & 15, fq = lane >> 4;
    const int K = g.K, nt = K / BK;
    unsigned voffA[2], voffB[2];
#pragma unroll
    for (int i = 0; i < 2; ++i) { int R, C; stage_rc(tid * 16 + i * 8192, R, C); const int Rb = Epi::PERM ? ((R & ~31) + perm32(R & 31)) : R;
        voffA[i] = (unsigned)(R * g.lda + C) * 2u; voffB[i] = (unsigned)(Rb * g.ldb + C) * 2u; }
    const size_t kstep = (size_t)(BK * 2);
    const size_t hstepA = (size_t)HALF * g.lda * 2, hstepB = (size_t)HALF * g.ldb * 2;
    const size_t tstepA = 2 * hstepA, tstepB = 2 * hstepB;
    const unsigned ldsw = (unsigned)wid * 1024u;
    const int aoff = lds_byte(wr * 64 + fr, fq * 8), boff = lds_byte(wc * 32 + fr, fq * 8);
#define PG8_SA(b, h) (((b) * 2 + (h)) * HTB)
#define PG8_SB(b, h) ((4 + (b) * 2 + (h)) * HTB)
#define PG8_STAGE(bufoff, gbase, voff) do { _Pragma("unroll") for (int _i = 0; _i < 2; ++_i) \
        __builtin_amdgcn_global_load_lds((const unsigned*)((const char*)(gbase) + (voff)[_i]), (PG8_LAS unsigned*)(lds + (bufoff) + ldsw + _i * 8192), 16, 0, 0); } while (0)
#define PG8_LDA(dst, b, h) do { _Pragma("unroll") for (int m = 0; m < 4; ++m) _Pragma("unroll") for (int k = 0; k < 2; ++k) dst[m][k] = *(const PG8_LAS bf16x8*)(lds + PG8_SA(b, h) + aoff + m * 2048 + k * 1024); } while (0)
#define PG8_LDB(dst, b, h) do { _Pragma("unroll") for (int n = 0; n < 2; ++n) _Pragma("unroll") for (int k = 0; k < 2; ++k) dst[n][k] = *(const PG8_LAS bf16x8*)(lds + PG8_SB(b, h) + boff + n * 2048 + k * 1024); } while (0)
#define PG8_MMA(ai, bj, At, Bt) do { __builtin_amdgcn_s_setprio(1); _Pragma("unroll") for (int m = 0; m < 4; ++m) _Pragma("unroll") for (int n = 0; n < 2; ++n) _Pragma("unroll") for (int k = 0; k < 2; ++k) \
        acc[ai][bj][m][n] = __builtin_amdgcn_mfma_f32_16x16x32_bf16(Bt[n][k], At[m][k], acc[ai][bj][m][n], 0, 0, 0); __builtin_amdgcn_s_setprio(0); } while (0)
#define PG8_WAIT_V(n) asm volatile("s_waitcnt vmcnt(" #n ")" ::: "memory")
#define PG8_WAIT_L(n) asm volatile("s_waitcnt lgkmcnt(" #n ")" ::: "memory")
#define PG8_BAR __builtin_amdgcn_s_barrier()
#define PG8_SCHED __builtin_amdgcn_sched_barrier(0)
    Unit cur, nxt; int ui = 0;
    if (!S.next(0, cur)) return;
    f32x4 acc[2][2][4][2];
#pragma unroll
    for (int a = 0; a < 2; ++a)
#pragma unroll
        for (int b = 0; b < 2; ++b)
#pragma unroll
            for (int m = 0; m < 4; ++m)
#pragma unroll
                for (int n = 0; n < 2; ++n) acc[a][b][m][n] = (f32x4){0.f, 0.f, 0.f, 0.f};
    bf16x8 At[4][2], B0[2][2], B1[2][2];
    const char* cA = (const char*)g.A + (size_t)cur.pm * tstepA; const char* cB = (const char*)g.Bt + (size_t)cur.pn * tstepB;
    S.a_ready(cur);
    if constexpr (SP2) {
        PG8_STAGE(PG8_SB(0, 0), cB, voffB); PG8_STAGE(PG8_SB(0, 1), cB + hstepB, voffB); PG8_STAGE(PG8_SA(0, 0), cA, voffA); PG8_STAGE(PG8_SA(0, 1), cA + hstepA, voffA);
        if (wr == 1) PG8_BAR;
        PG8_WAIT_V(2); PG8_BAR;
        PG8_STAGE(PG8_SB(1, 0), cB + kstep, voffB); PG8_STAGE(PG8_SA(1, 0), cA + kstep, voffA); PG8_STAGE(PG8_SB(1, 1), cB + hstepB + kstep, voffB);
        PG8_WAIT_V(6); PG8_BAR;
    } else {
        PG8_STAGE(PG8_SB(0, 0), cB, voffB); PG8_STAGE(PG8_SA(0, 0), cA, voffA); PG8_STAGE(PG8_SB(0, 1), cB + hstepB, voffB); PG8_STAGE(PG8_SA(0, 1), cA + hstepA, voffA);
        if (wr == 1) PG8_BAR;
        PG8_WAIT_V(4); PG8_BAR;
        PG8_STAGE(PG8_SB(1, 0), cB + kstep, voffB); PG8_STAGE(PG8_SA(1, 0), cA + kstep, voffA); PG8_STAGE(PG8_SB(1, 1), cB + hstepB + kstep, voffB);
        PG8_WAIT_V(6); PG8_BAR;
    }
    for (;;) {
        const bool has_next = S.next(ui + 1, nxt);
        const char* nA = has_next ? (const char*)g.A + (size_t)nxt.pm * tstepA : cA; const char* nB = has_next ? (const char*)g.Bt + (size_t)nxt.pn * tstepB : cB;
        for (int t = 0; t < nt; t += 2) {
            const bool last = (t == nt - 2);
            const char* a1 = cA + (size_t)(t + 1) * kstep;
            const char* a2 = last ? nA : cA + (size_t)(t + 2) * kstep; const char* b2 = last ? nB : cB + (size_t)(t + 2) * kstep;
            const char* a3 = a2 + kstep; const char* b3 = b2 + kstep;
            if (last && has_next) S.a_ready(nxt);
            if constexpr (Epi::HOOK) { if (t == Epi::HOOK_T) E.mid(acc, cur, wr, wc, fr, fq); }
            if constexpr (SP2) {
            PG8_LDB(B0, 0, 0); PG8_LDB(B1, 0, 1); PG8_SCHED; PG8_LDA(At, 0, 0); PG8_STAGE(PG8_SA(1, 1), a1 + hstepA, voffA);
            PG8_WAIT_V(8); PG8_WAIT_L(0); PG8_BAR; PG8_MMA(0, 0, At, B0); PG8_MMA(0, 1, At, B1); PG8_BAR; PG8_SCHED;
            PG8_LDA(At, 0, 1); PG8_STAGE(PG8_SB(0, 0), b2, voffB); PG8_STAGE(PG8_SB(0, 1), b2 + hstepB, voffB); PG8_STAGE(PG8_SA(0, 0), a2, voffA);
            PG8_WAIT_V(8); PG8_WAIT_L(0); PG8_BAR; PG8_MMA(1, 0, At, B0); PG8_MMA(1, 1, At, B1); PG8_BAR; PG8_SCHED;
            PG8_LDB(B0, 1, 0); PG8_LDB(B1, 1, 1); PG8_SCHED; PG8_LDA(At, 1, 0); PG8_STAGE(PG8_SA(0, 1), a2 + hstepA, voffA);
            PG8_WAIT_V(8); PG8_WAIT_L(0); PG8_BAR; PG8_MMA(0, 0, At, B0); PG8_MMA(0, 1, At, B1); PG8_BAR; PG8_SCHED;
            PG8_LDA(At, 1, 1); PG8_STAGE(PG8_SB(1, 0), b3, voffB); PG8_STAGE(PG8_SB(1, 1), b3 + hstepB, voffB); PG8_STAGE(PG8_SA(1, 0), a3, voffA);
            PG8_WAIT_V(8); PG8_WAIT_L(0); PG8_BAR; PG8_MMA(1, 0, At, B0); PG8_MMA(1, 1, At, B1); PG8_BAR; PG8_SCHED;
            } else {
            PG8_LDB(B0, 0, 0); PG8_SCHED; PG8_LDA(At, 0, 0); PG8_STAGE(PG8_SA(1, 1), a1 + hstepA, voffA);
            PG8_WAIT_L(8); PG8_BAR; PG8_WAIT_L(0); PG8_MMA(0, 0, At, B0); PG8_BAR; PG8_SCHED;
            PG8_LDB(B1, 0, 1); PG8_STAGE(PG8_SB(0, 0), b2, voffB);
            PG8_BAR; PG8_WAIT_L(0); PG8_MMA(0, 1, At, B1); PG8_BAR;
            PG8_LDA(At, 0, 1); PG8_STAGE(PG8_SA(0, 0), a2, voffA);
            PG8_BAR; PG8_WAIT_L(0); PG8_MMA(1, 0, At, B0); PG8_BAR; PG8_SCHED;
            PG8_STAGE(PG8_SB(0, 1), b2 + hstepB, voffB);
            PG8_WAIT_V(6); PG8_BAR; PG8_MMA(1, 1, At, B1); PG8_BAR;
            PG8_LDB(B0, 1, 0); PG8_SCHED; PG8_LDA(At, 1, 0); PG8_STAGE(PG8_SA(0, 1), a2 + hstepA, voffA);
            PG8_WAIT_L(8); PG8_BAR; PG8_WAIT_L(0); PG8_MMA(0, 0, At, B0); PG8_BAR; PG8_SCHED;
            PG8_LDB(B1, 1, 1); PG8_STAGE(PG8_SB(1, 0), b3, voffB);
            PG8_BAR; PG8_WAIT_L(0); PG8_MMA(0, 1, At, B1); PG8_BAR;
            PG8_LDA(At, 1, 1); PG8_STAGE(PG8_SA(1, 0), a3, voffA);
            PG8_BAR; PG8_WAIT_L(0); PG8_MMA(1, 0, At, B0); PG8_BAR; PG8_SCHED;
            PG8_STAGE(PG8_SB(1, 1), b3 + hstepB, voffB);
            PG8_WAIT_V(6); PG8_BAR; PG8_MMA(1, 1, At, B1); PG8_BAR;
            }
        }
        if constexpr (ALIGN_EPI) { if (wr == 0) PG8_BAR; }
        if constexpr (!Epi::AFTER_DRAIN) { E(acc, cur, wr, wc, fr, fq); S.done(cur); }
        if (!has_next) break;
#pragma unroll
        for (int a = 0; a < 2; ++a)
#pragma unroll
            for (int b = 0; b < 2; ++b)
#pragma unroll
                for (int m = 0; m < 4; ++m)
#pragma unroll
                    for (int n = 0; n < 2; ++n) acc[a][b][m][n] = (f32x4){0.f, 0.f, 0.f, 0.f};
        cur = nxt; cA = nA; cB = nB; ++ui;
        if constexpr (ALIGN_EPI) { if (wr == 1) PG8_BAR; }
    }
    PG8_WAIT_V(0);
    if constexpr (!ALIGN_EPI) { if (wr == 0) PG8_BAR; }
    PG8_BAR;
    if constexpr (Epi::AFTER_DRAIN) { E.fused(acc, cur, wr, wc, fr, fq, lds, wid, lane); S.done(cur); }
#undef PG8_SA
#undef PG8_SB
#undef PG8_STAGE
#undef PG8_LDA
#undef PG8_LDB
#undef PG8_MMA
#undef PG8_WAIT_V
#undef PG8_WAIT_L
#undef PG8_BAR
#undef PG8_SCHED
}
}

namespace pg8 {
__device__ __forceinline__ float fsig(float v) { return __builtin_amdgcn_rcpf(1.f + __builtin_amdgcn_exp2f(-1.4426950408889634f * v)); }
__device__ __forceinline__ u32x4 pack8(const f32x4 a, const f32x4 b) { u32x4 w; w.x = cvt_pk_bf16(a[0], a[1]); w.y = cvt_pk_bf16(a[2], a[3]); w.z = cvt_pk_bf16(b[0], b[1]); w.w = cvt_pk_bf16(b[2], b[3]); return w; }
__device__ __forceinline__ void unpack8(const u32x4 w, f32x4& a, f32x4& b) {
    a[0] = __builtin_bit_cast(float, w.x << 16); a[1] = __builtin_bit_cast(float, w.x & 0xffff0000u); a[2] = __builtin_bit_cast(float, w.y << 16); a[3] = __builtin_bit_cast(float, w.y & 0xffff0000u);
    b[0] = __builtin_bit_cast(float, w.z << 16); b[1] = __builtin_bit_cast(float, w.z & 0xffff0000u); b[2] = __builtin_bit_cast(float, w.w << 16); b[3] = __builtin_bit_cast(float, w.w & 0xffff0000u); }
__device__ __forceinline__ float dot4(const f32x4 a) { return (a[0] * a[0] + a[1] * a[1]) + (a[2] * a[2] + a[3] * a[3]); }
__device__ __forceinline__ void row_rstd(const float* SS, const Unit& u, int wr, int fr, int fq, float (&rs)[2][4]) {
#pragma unroll
    for (int ai = 0; ai < 2; ++ai)
#pragma unroll
        for (int m = 0; m < 4; ++m) { const size_t row = (size_t)(u.pm * BM + ai * HALF + wr * 64 + m * 16 + fr); const f32x4 p = *(const f32x4*)(SS + row * 16 + 4 * fq);
            float s = (p[0] + p[1]) + (p[2] + p[3]); s += __shfl_xor(s, 16); s += __shfl_xor(s, 32); rs[ai][m] = 1.0f / sqrtf(s * (1.0f / D) + RMS_EPS); }
}
struct EpiSwigluF { static constexpr bool PERM = true, AFTER_DRAIN = false, HOOK = false; static constexpr int HOOK_T = 0; bf16_t* H; const float* SS;
    __device__ __forceinline__ void operator()(const f32x4 (&acc)[2][2][4][2], const Unit& u, int wr, int wc, int fr, int fq) const {
        const int row0 = u.pm * BM + wr * 64 + fr, col0 = u.pn * 128 + wc * 32 + 8 * fq;
        float rs[2][4]; row_rstd(SS, u, wr, fr, fq, rs);
#pragma unroll
        for (int ai = 0; ai < 2; ++ai)
#pragma unroll
            for (int m = 0; m < 4; ++m) { bf16_t* rowp = H + (size_t)(row0 + ai * HALF + m * 16) * DFF + col0; const float r = rs[ai][m];
                f32x4 h0, h1;
#pragma unroll
                for (int i = 0; i < 4; ++i) { const float g0 = acc[ai][0][m][0][i] * r, g1 = acc[ai][0][m][1][i] * r; h0[i] = g0 * fsig(g0) * (acc[ai][1][m][0][i] * r); h1[i] = g1 * fsig(g1) * (acc[ai][1][m][1][i] * r); }
                *(u32x4*)rowp = pack8(h0, h1); }
    } };
template <bool FINAL> struct EpiResidB { static constexpr bool PERM = true, AFTER_DRAIN = false, HOOK = false; static constexpr int HOOK_T = 0; bf16_t* XB; float* Of; float* SS; float coef;
    __device__ __forceinline__ void operator()(const f32x4 (&acc)[2][2][4][2], const Unit& u, int wr, int wc, int fr, int fq) const {
        const int row0 = u.pm * BM + wr * 64 + fr, col0 = u.pn * BM + wc * 32 + 8 * fq;
#pragma unroll
        for (int ai = 0; ai < 2; ++ai)
#pragma unroll
            for (int m = 0; m < 4; ++m) { const size_t row = (size_t)(row0 + ai * HALF + m * 16); float ssq = 0.f;
#pragma unroll
                for (int bj = 0; bj < 2; ++bj) { const int c = col0 + bj * HALF; f32x4 r0, r1; unpack8(*(const u32x4*)(XB + row * D + c), r0, r1);
                    f32x4 v0 = r0 + acc[ai][bj][m][0] * coef, v1 = r1 + acc[ai][bj][m][1] * coef;
                    if (FINAL) { *(f32x4*)(Of + row * D + c) = v0; *(f32x4*)(Of + row * D + c + 4) = v1; }
                    else { const u32x4 w = pack8(v0, v1); *(u32x4*)(XB + row * D + c) = w; unpack8(w, v0, v1); }
                    ssq += dot4(v0) + dot4(v1); }
                ssq += __shfl_xor(ssq, 16); ssq += __shfl_xor(ssq, 32);
                if (fq == 0) SS[row * 16 + 4 * u.pn + wc] = ssq; }
    } };
struct EpiProjF { static constexpr bool PERM = true, AFTER_DRAIN = false, HOOK = false; static constexpr int HOOK_T = 0; bf16_t* PA; bf16_t* PB; float* SG; const float* SS; const float* fb; const float* ib; const float* mfb;
    __device__ __forceinline__ void operator()(const f32x4 (&acc)[2][2][4][2], const Unit& u, int wr, int wc, int fr, int fq) const {
        const int row0 = u.pm * BM + wr * 64 + fr;
        float rs[2][4]; row_rstd(SS, u, wr, fr, fq, rs);
        if (u.pn < 22) {
            const int act = u.pn < 2 ? 0 : (u.pn < 12 ? 1 : 2); const int col0 = (u.pn < 12 ? u.pn : u.pn - 12) * BM + wc * 32 + 8 * fq;
            bf16_t* base = u.pn < 12 ? PA : PB; const int pitch = u.pn < 12 ? PJA : PJB;
#pragma unroll
            for (int ai = 0; ai < 2; ++ai)
#pragma unroll
                for (int m = 0; m < 4; ++m) { bf16_t* rowp = base + (size_t)(row0 + ai * HALF + m * 16) * pitch + col0; const float r = rs[ai][m] * (act == 0 ? QSCALE2 : 1.0f);
#pragma unroll
                    for (int bj = 0; bj < 2; ++bj) { f32x4 v0 = acc[ai][bj][m][0] * r, v1 = acc[ai][bj][m][1] * r;
                        if (act == 2) {
#pragma unroll
                            for (int i = 0; i < 4; ++i) { v0[i] = fsig(v0[i]); v1[i] = fsig(v1[i]); } }
                        *(u32x4*)(rowp + bj * HALF) = pack8(v0, v1); } }
        } else if (wc == 0 && fq < 2) {
            const f32x4 b0 = fq == 0 ? *(const f32x4*)fb : *(const f32x4*)ib, b1 = fq == 0 ? *(const f32x4*)(fb + 4) : *(const f32x4*)mfb;
#pragma unroll
            for (int ai = 0; ai < 2; ++ai)
#pragma unroll
                for (int m = 0; m < 4; ++m) { float* sp = SG + (size_t)(row0 + ai * HALF + m * 16) * 16 + 8 * fq; const float r = rs[ai][m];
                    f32x4 v0 = acc[ai][0][m][0] * r + b0, v1 = acc[ai][0][m][1] * r + b1;
#pragma unroll
                    for (int i = 0; i < 4; ++i) { if (fq == 0) v0[i] = logsigmoidf_(v0[i]); v1[i] = logsigmoidf_(v1[i]); }
                    *(f32x4*)sp = v0; *(f32x4*)(sp + 4) = v1; }
        }
    } };
struct EpiMergeF { static constexpr bool PERM = true, AFTER_DRAIN = false, HOOK = true; static constexpr int HOOK_T = 8; const bf16_t* PB; bf16_t* MG;
    __device__ __forceinline__ void mid(f32x4 (&acc)[2][2][4][2], const Unit& u, int wr, int wc, int fr, int fq) const {
        int row0 = u.pm * BM + wr * 64 + fr, col0 = u.pn * BM + wc * 32 + 8 * fq; asm volatile("" : "+v"(row0), "+v"(col0));
#pragma unroll
        for (int ai = 0; ai < 2; ++ai)
#pragma unroll
            for (int m = 0; m < 4; ++m) { const bf16_t* rowp = PB + (size_t)(row0 + ai * HALF + m * 16) * PJB + col0;
#pragma unroll
                for (int bj = 0; bj < 2; ++bj) { f32x4 a0, a1, b0, b1; unpack8(*(const u32x4*)(rowp + PB_GA + bj * HALF), a0, a1); unpack8(*(const u32x4*)(rowp + PB_GB + bj * HALF), b0, b1);
#pragma unroll
                    for (int i = 0; i < 4; ++i) { acc[ai][bj][m][0][i] *= a0[i] * __builtin_amdgcn_rcpf(fmaxf(b0[i], 1e-30f)); acc[ai][bj][m][1][i] *= a1[i] * __builtin_amdgcn_rcpf(fmaxf(b1[i], 1e-30f)); } } }
    }
    __device__ __forceinline__ void operator()(const f32x4 (&acc)[2][2][4][2], const Unit& u, int wr, int wc, int fr, int fq) const {
        const int row0 = u.pm * BM + wr * 64 + fr, col0 = u.pn * BM + wc * 32 + 8 * fq;
#pragma unroll
        for (int ai = 0; ai < 2; ++ai)
#pragma unroll
            for (int m = 0; m < 4; ++m) { const size_t row = (size_t)(row0 + ai * HALF + m * 16);
#pragma unroll
                for (int bj = 0; bj < 2; ++bj) { const int c = col0 + bj * HALF; f32x4 b0, b1; unpack8(*(const u32x4*)(PB + row * PJB + PB_GB + c), b0, b1);
                    *(u32x4*)(MG + row * D + c) = pack8(b0 * acc[ai][bj][m][0], b1 * acc[ai][bj][m][1]); } }
    } };
}

__device__ __forceinline__ void transpose_item(const float* W, int N, int scol0, bf16* WT, int ldt, int drow0, int k0, int kdst0, LAS float* scr, int lane, const float* gain) {
#pragma unroll 8
    for (int i = 0; i < 32; ++i) { const int kk = 2 * i + (lane >> 5); const float gk = gain ? gain[k0 + kk] : 1.0f; scr[kk * 33 + (lane & 31)] = W[(size_t)(k0 + kk) * N + scol0 + (lane & 31)] * gk; }
    asm volatile("s_waitcnt lgkmcnt(0)" ::: "memory");
    const int c = lane & 7;
#pragma unroll
    for (int j = 0; j < 4; ++j) { const int n = (lane >> 3) + 8 * j; const LAS float* s = scr + (8 * c) * 33 + n;
        v4u o; o.x = pk2(s[0 * 33], s[1 * 33]); o.y = pk2(s[2 * 33], s[3 * 33]); o.z = pk2(s[4 * 33], s[5 * 33]); o.w = pk2(s[6 * 33], s[7 * 33]);
        *(GAS v4u*)(WT + (size_t)(drow0 + n) * ldt + kdst0 + k0 + 8 * c) = o; }
    asm volatile("s_waitcnt lgkmcnt(0)" ::: "memory");
}
__device__ __forceinline__ void phase_weights(Frame& F) {
    const int ptid = opaque_tid(F.wave), plane = ptid & 63, pwave = __builtin_amdgcn_readfirstlane(ptid >> 6); (void)plane; (void)pwave;
    LAS float* scr = (LAS float*)(F.lds + pwave * 16384);
    const int gw = blockIdx.x * NWAVES + pwave, NGW = F.G * NWAVES;
    constexpr int PJ = PJA + PJB; constexpr int I_IN = (D / 64) * (NFF / 32), I_OUT = (DFF / 64) * (D / 32), I_PJ = (D / 64) * (PJ / 32), I_UP = (512 / 64) * (D / 32), I_WO = (D / 64) * (D / 32);
    constexpr int NITEMS = 2 * I_IN + 2 * I_OUT + I_PJ + 2 * I_UP + I_WO;
    for (int it = gw; it < NITEMS; it += NGW) {
        int r = it;
        if (r < 2 * I_IN) { const int which = r / I_IN; r -= which * I_IN; const int ndb = NFF / 32, kb = r / ndb, db = r % ndb, n = db * 32, pn = n >> 8, j = n & 255;
            const int sc = (j < 128) ? pn * 128 + j : DFF + pn * 128 + (j - 128);
            transpose_item(F.in[which ? 15 : 2], NFF, sc, (bf16*)(F.ws + (which ? WS_W2IN : WS_W1IN)), D, n, kb * 64, 0, scr, plane, F.in[which ? 14 : 1]); continue; }
        r -= 2 * I_IN;
        if (r < 2 * I_OUT) { const int which = r / I_OUT; r -= which * I_OUT; const int ndb = D / 32, kb = r / ndb, db = r % ndb;
            transpose_item(F.in[which ? 16 : 3], D, db * 32, (bf16*)(F.ws + (which ? WS_W2OUT : WS_W1OUT)), DFF, db * 32, kb * 64, 0, scr, plane, nullptr); continue; }
        r -= 2 * I_OUT;
        if (r < I_PJ) { const int ndb = PJ / 32, kb = r / ndb, db = r % ndb, n = db * 32; const int sc = n + (n < 1536 ? 0 : (n < 3072 ? 8 : 16));
            transpose_item(F.in[5], INC, sc, (bf16*)(F.ws + WS_WIN), D, n, kb * 64, 0, scr, plane, F.in[4]); continue; }
        r -= I_PJ;
        if (r < 2 * I_UP) { const int which = r / I_UP; r -= which * I_UP; const int ndb = D / 32, kb = r / ndb, db = r % ndb;
            transpose_item(F.in[which ? 12 : 11], D, db * 32, (bf16*)(F.ws + WS_WCAT), D, db * 32, kb * 64, which ? 512 : 0, scr, plane, nullptr); continue; }
        r -= 2 * I_UP;
        { const int ndb = D / 32, kb = r / ndb, db = r % ndb; transpose_item(F.in[13], D, db * 32, (bf16*)(F.ws + WS_WOUT), D, db * 32, kb * 64, 0, scr, plane, nullptr); }
    }
    { bf16* WT = (bf16*)(F.ws + WS_WIN); const float* W = F.in[5];
      for (int idx = blockIdx.x * NTHR + ptid; idx < 256 * 128; idx += F.G * NTHR) { const int row = idx >> 7, k8 = (idx & 127) * 8; v4u o = {0u, 0u, 0u, 0u};
          if (row < 16) { const int sc = row < 8 ? 1536 + row : (row < 12 ? 3080 + (row - 8) : 3084 + (row - 12)); float v[8];
#pragma unroll
              for (int i = 0; i < 8; ++i) v[i] = W[(size_t)(k8 + i) * INC + sc] * F.in[4][k8 + i];
              o.x = pk2(v[0], v[1]); o.y = pk2(v[2], v[3]); o.z = pk2(v[4], v[5]); o.w = pk2(v[6], v[7]); }
          *(GAS v4u*)(WT + (size_t)(PJ + row) * D + k8) = o; } }
}

#include <hip/hip_bf16.h>
#include <cmath>
namespace attn_body {
using bf16=__hip_bfloat16;
using bf16x8=__attribute__((ext_vector_type(8)))short;
using s16x4=__attribute__((ext_vector_type(4)))short;
using f32x16=__attribute__((ext_vector_type(16)))float;
using u32x4=__attribute__((ext_vector_type(4)))unsigned;
constexpr int BATCH=32,NHEAD=8,SEQ=2048,D=64,DM=3072,OP=1024;
constexpr int NW=8,QBLK=32,QB=QBLK*NW,KVBLK=64,NQB=SEQ/QB;
constexpr int ATTN_PITCH=DM, ATTN_UNIT_ROWS=QB;
__device__ __forceinline__ int crow(int r,int hi){return (r&3)+8*(r>>2)+4*hi;}
#define SBAR() __builtin_amdgcn_sched_barrier(0)
__device__ __forceinline__ void cmask(f32x16&p0,f32x16&p1,int jb,int qrel,int hi){
  const float NEG=-INFINITY; int kb=64*jb+4*hi;
  #pragma unroll
  for(int r=0;r<16;++r){int kv=kb+(r&3)+8*(r>>2); if(kv>qrel)p0[r]=NEG; if(kv+32>qrel)p1[r]=NEG;}
}

constexpr int NSLOT=3, SLOTB=8192;
constexpr int LDS_K=0, LDS_V=NSLOT*SLOTB, LDS_WS=2*NSLOT*SLOTB, LDS_OST=LDS_WS+NW*64*4, LDS_BIAS=LDS_OST+NW*4096, LDS_ROWB=LDS_BIAS+SEQ*8, LDS_BYTES=LDS_ROWB+QB*4;
constexpr float C2=0.125f*1.4426950408889634f;
__device__ __forceinline__ void glds16(const void*gsrc,unsigned lds_dst){unsigned keep;
  asm volatile("s_mov_b32 %0, m0\n\ts_mov_b32 m0, %2\n\ts_nop 0\n\tglobal_load_lds_dwordx4 %1, off\n\ts_mov_b32 m0, %0":"=&s"(keep):"v"(gsrc),"s"(lds_dst):"memory");}
__device__ __forceinline__ float max3f(float a,float b,float c){float r;asm("v_max3_f32 %0, %1, %2, %3":"=v"(r):"v"(a),"v"(b),"v"(c));return r;}
__device__ __forceinline__ float max2f(float a,float b){float r;asm("v_max_f32_e32 %0, %1, %2":"=v"(r):"v"(a),"v"(b));return r;}
__device__ __forceinline__ float fadd_s(float a,float b){float r;asm("v_add_f32_e32 %0, %1, %2":"=v"(r):"v"(a),"v"(b));return r;}
__device__ __forceinline__ float fsub_s(float a,float b){float r;asm("v_sub_f32_e32 %0, %1, %2":"=v"(r):"v"(a),"v"(b));return r;}
typedef float f32x2_t __attribute__((ext_vector_type(2))); typedef __bf16 bf16x2_t __attribute__((ext_vector_type(2)));
__device__ __forceinline__ unsigned cvtpk_s(float lo,float hi){f32x2_t v={lo,hi};bf16x2_t b=__builtin_convertvector(v,bf16x2_t);return __builtin_bit_cast(unsigned,b);}
#define WAIT_BAR(N) asm volatile("s_waitcnt vmcnt(" #N ") lgkmcnt(0)\n\ts_barrier":::"memory")

__device__ __forceinline__ void qkt(f32x16&p0,f32x16&p1,const char*Kslot,const bf16x8*qr,int r32,int hi,bf16x8 kx0,bf16x8 kx1,bf16x8 qx){
  const char*kb=Kslot+hi*1024+r32*16;
  #pragma unroll
  for(int d0=0;d0<4;++d0){
    const bf16x8 b0=*reinterpret_cast<const bf16x8*>(kb+d0*2048);
    const bf16x8 b1=*reinterpret_cast<const bf16x8*>(kb+d0*2048+512);
    if(d0==0){p0=__builtin_amdgcn_mfma_f32_32x32x16_bf16(b0,qr[0],f32x16{},0,0,0);p1=__builtin_amdgcn_mfma_f32_32x32x16_bf16(b1,qr[0],f32x16{},0,0,0);}
    else{p0=__builtin_amdgcn_mfma_f32_32x32x16_bf16(b0,qr[d0],p0,0,0,0);p1=__builtin_amdgcn_mfma_f32_32x32x16_bf16(b1,qr[d0],p1,0,0,0);}}
  p0=__builtin_amdgcn_mfma_f32_32x32x16_bf16(kx0,qx,p0,0,0,0);p1=__builtin_amdgcn_mfma_f32_32x32x16_bf16(kx1,qx,p1,0,0,0);
}
typedef __attribute__((address_space(3))) const char* lds_cptr;
typedef short v4i16_t __attribute__((ext_vector_type(4)));
__device__ __forceinline__ void kload8(bf16x8*kf,lds_cptr kp){
  kf[0]=*(const __attribute__((address_space(3))) bf16x8*)(kp);      kf[1]=*(const __attribute__((address_space(3))) bf16x8*)(kp+512);
  kf[2]=*(const __attribute__((address_space(3))) bf16x8*)(kp+2048); kf[3]=*(const __attribute__((address_space(3))) bf16x8*)(kp+2560);
  kf[4]=*(const __attribute__((address_space(3))) bf16x8*)(kp+4096); kf[5]=*(const __attribute__((address_space(3))) bf16x8*)(kp+4608);
  kf[6]=*(const __attribute__((address_space(3))) bf16x8*)(kp+6144); kf[7]=*(const __attribute__((address_space(3))) bf16x8*)(kp+6656);
}
__device__ __forceinline__ void kload2(bf16x8*kf,lds_cptr kp,int j){ kf[2*j]=*(const __attribute__((address_space(3))) bf16x8*)(kp+j*2048); kf[2*j+1]=*(const __attribute__((address_space(3))) bf16x8*)(kp+j*2048+512); }
typedef unsigned u32x2_t __attribute__((ext_vector_type(2)));
__device__ __forceinline__ bf16x8 kxfrag(lds_cptr tbl,int kv,int hi){ u32x2_t b=*(const __attribute__((address_space(3))) u32x2_t*)(tbl+kv*8); if(hi){b.x=0u;b.y=0u;} const u32x4 w={b.x,b.y,hi?0u:0x3F803F80u,0u}; return __builtin_bit_cast(bf16x8,w); }
__device__ __forceinline__ s16x4 vtr(lds_cptr p){ return __builtin_bit_cast(s16x4,__builtin_amdgcn_ds_read_tr16_b64_v4i16((__attribute__((address_space(3))) v4i16_t*)p)); }
__device__ __forceinline__ float rowmax(const f32x16&p0,const f32x16&p1){
  float a=max3f(p0[0],p0[1],p1[0]),b=max3f(p0[2],p0[3],p1[1]);a=max3f(a,p1[2],p1[3]);
  #pragma unroll
  for(int r=4;r<16;r+=4){a=max3f(a,p0[r],p0[r+1]);b=max3f(b,p0[r+2],p0[r+3]);a=max3f(a,p1[r],p1[r+1]);b=max3f(b,p1[r+2],p1[r+3]);}
  const float m=max2f(a,b);
  auto rr=__builtin_amdgcn_permlane32_swap(__float_as_uint(m),__float_as_uint(m),false,false);
  return max2f(__uint_as_float(rr[0]),__uint_as_float(rr[1]));
}
__device__ __forceinline__ void pv(f32x16*o,int vb,bf16x8 pa0,bf16x8 pa1,bf16x8 pa2,bf16x8 pa3){
  #pragma unroll
  for(int d0=0;d0<2;++d0){s16x4 lo[4],hi[4];
    #pragma unroll
    for(int ks=0;ks<4;++ks){
      asm volatile("ds_read_b64_tr_b16 %0,%1 offset:%c2":"=&v"(lo[ks]):"v"(vb),"i"(d0*4096+ks*1024):"memory");
      asm volatile("ds_read_b64_tr_b16 %0,%1 offset:%c2":"=&v"(hi[ks]):"v"(vb),"i"(d0*4096+ks*1024+512):"memory");}
    asm volatile("s_waitcnt lgkmcnt(0)":::"memory");SBAR();
    #define PK(k) (bf16x8){lo[k][0],lo[k][1],lo[k][2],lo[k][3],hi[k][0],hi[k][1],hi[k][2],hi[k][3]}
    o[d0]=__builtin_amdgcn_mfma_f32_32x32x16_bf16(pa0,PK(0),o[d0],0,0,0);
    o[d0]=__builtin_amdgcn_mfma_f32_32x32x16_bf16(pa1,PK(1),o[d0],0,0,0);
    o[d0]=__builtin_amdgcn_mfma_f32_32x32x16_bf16(pa2,PK(2),o[d0],0,0,0);
    o[d0]=__builtin_amdgcn_mfma_f32_32x32x16_bf16(pa3,PK(3),o[d0],0,0,0);
    #undef PK
  }
}

#ifndef ATTN_STORE16
#define ATTN_STORE16(p,v) (*(u32x4*)(p)=(v))
#endif
template<int THRL> __device__ __forceinline__ void attn_unit(int b,int h,int qb,const bf16*Q,const bf16*__restrict__ K,const bf16*__restrict__ V,bf16*O,const float*CUMh,char*shm,const int wv){
  int tid_=wv*64+(int)__builtin_amdgcn_mbcnt_hi(~0u,__builtin_amdgcn_mbcnt_lo(~0u,0u)); asm volatile("":"+v"(tid_)); const int tid=tid_,lane=tid&63,r32=lane&31,hi=lane>>5; const int wid=__builtin_amdgcn_readfirstlane(tid>>6);
  const long rowbase=(long)b*SEQ; const int q0=qb*QB;
  const bf16*Qw=Q+(rowbase+q0+wid*QBLK)*DM+h*D;
  const bf16*Kh=K+rowbase*DM+h*D,*Vh=V+rowbase*DM+h*D;
  const unsigned lds0=(unsigned)(uintptr_t)shm;
  float*wsf=(float*)(shm+LDS_WS)+wid*64;
  const bf16*ksrc=Kh+(long)lane*DM+wid*8;
  const bf16*vsrc=Vh+(long)(16*(wid&3)+(lane>>2))*DM+(wid>>2)*32+(lane&3)*8;
  const unsigned kdst=lds0+LDS_K+wid*1024, vdst=lds0+LDS_V+wid*1024;
  #define DMA_K(t,slot) glds16(ksrc+(long)(t)*KVBLK*DM,(unsigned)__builtin_amdgcn_readfirstlane(kdst+(slot)))
  #define DMA_V(t,slot) glds16(vsrc+(long)(t)*KVBLK*DM,(unsigned)__builtin_amdgcn_readfirstlane(vdst+(slot)))
  const int vb0=(int)(lds0+LDS_V)+((lane>>4)&1)*32+(lane&3)*8+(4*hi+((lane&15)>>2))*64;
  const char*Kbase=shm+LDS_K; bf16x8 kf[8];
  const lds_cptr shm3=(lds_cptr)shm; const lds_cptr kp0=shm3+LDS_K+hi*1024+r32*16; const lds_cptr vp0=shm3+LDS_V+((lane>>4)&1)*32+(lane&3)*8+(4*hi+((lane&15)>>2))*64;
  const int NT=(q0+QB)/KVBLK;
  DMA_K(0,0);DMA_V(0,0);DMA_K(1,SLOTB);
  bf16x8 qr[4];
  #pragma unroll
  for(int d0=0;d0<4;++d0)qr[d0]=*reinterpret_cast<const bf16x8*>(&Qw[(long)r32*DM+d0*16+hi*8]);
  const int qrel=wid*QBLK+r32;
  { const float cref=CUMh[q0]; __attribute__((address_space(3))) unsigned*bt=(__attribute__((address_space(3))) unsigned*)(shm3+LDS_BIAS); __attribute__((address_space(3))) float*rb=(__attribute__((address_space(3))) float*)(shm3+LDS_ROWB);
    for(int kv=tid;kv<q0+QB;kv+=NW*64){ const float bias=(cref-CUMh[kv])*1.4426950408889634f;
      const unsigned u1=__builtin_bit_cast(unsigned,bias); const unsigned h1=(u1+0x7fffu+((u1>>16)&1u))&0xffff0000u; const float r1=bias-__builtin_bit_cast(float,h1);
      const unsigned u2=__builtin_bit_cast(unsigned,r1);   const unsigned h2=(u2+0x7fffu+((u2>>16)&1u))&0xffff0000u; const float r2=r1-__builtin_bit_cast(float,h2);
      const unsigned u3=__builtin_bit_cast(unsigned,r2);   const unsigned h3=(u3+0x7fffu+((u3>>16)&1u))&0xffff0000u;
      bt[2*kv]=(h1>>16)|h2; bt[2*kv+1]=(h3>>16)|0x3F800000u; if(kv>=q0)rb[kv-q0]=bias; } }
  const lds_cptr btab=shm3+LDS_BIAS; u32x4 qxw={hi?0u:0x3F803F80u,0u,0u,0u};
  #define QX __builtin_bit_cast(bf16x8,qxw)
  #define RNEHI(u) (((u)+0x7fffu+(((u)>>16)&1u))&0xffff0000u)
  #define SETQX() do{ const float nm_=-mhat; const unsigned a1_=RNEHI(__builtin_bit_cast(unsigned,nm_)); const float s1_=nm_-__builtin_bit_cast(float,a1_); \
      const unsigned a2_=RNEHI(__builtin_bit_cast(unsigned,s1_)); const float s2_=s1_-__builtin_bit_cast(float,a2_); const unsigned a3_=RNEHI(__builtin_bit_cast(unsigned,s2_)); \
      qxw.y=hi?0u:(a1_|0x3F80u); qxw.z=hi?0u:((a2_>>16)|a3_); }while(0)
  float mhat=0.f,l_reg=0.f;f32x16 o[2];o[0]=f32x16{};o[1]=f32x16{};
  #define CMASK(P0,P1,t) do{int jb_=(t)-(NT-4); if(jb_>=0)cmask(P0,P1,jb_,qrel,hi);}while(0)
  bool resc=false;
  #define START(P0,P1) do{ const float rm=rowmax(P0,P1); resc=false; \
    { const float dl=max2f(rm,0.f); mhat=fadd_s(mhat,dl); \
      _Pragma("unroll") for(int r=0;r<16;++r){P0[r]=fsub_s(P0[r],dl);P1[r]=fsub_s(P1[r],dl);} \
      SETQX(); } \
    _Pragma("unroll") for(int r=0;r<16;++r)P0[r]=__builtin_amdgcn_exp2f(P0[r]); }while(0)
  #define RESC() do{ if(resc){ asm volatile("s_waitcnt lgkmcnt(0)":::"memory"); \
      _Pragma("unroll") for(int d_=0;d_<2;++d_) _Pragma("unroll") for(int r=0;r<16;++r)o[d_][r]*=wsf[crow(r,hi)]; } }while(0)
  f32x16 pA0,pA1,pB0,pB1;
  int sl_prev=0,sl_cur=0,sl_next=SLOTB;
  #define ROT() do{sl_prev=sl_cur;sl_cur=sl_next;sl_next=(sl_next==(NSLOT-1)*SLOTB)?0:sl_next+SLOTB;}while(0)
  DMA_K(2,2*SLOTB);
  WAIT_BAR(3);
  mhat=*(const __attribute__((address_space(3))) float*)(shm3+LDS_ROWB+qrel*4);
  SETQX();
  qkt(pA0,pA1,Kbase,qr,r32,hi,kxfrag(btab,r32,hi),kxfrag(btab,32+r32,hi),QX);asm volatile("s_nop 15\n\ts_nop 7":"+v"(pA0),"+v"(pA1));CMASK(pA0,pA1,0);
  START(pA0,pA1);
  _Pragma("unroll") for(int r=0;r<16;++r)pA1[r]=__builtin_amdgcn_exp2f(pA1[r]);
  WAIT_BAR(0);
  DMA_K(3,0);DMA_V(1,SLOTB);
  ROT();
  kload8(kf,kp0+sl_cur);
  WAIT_BAR(2);
  s16x4 vlo[8],vhi[8]; u32x4 pw0,pw1,pw2,pw3;
  #define PKW(P,B) cvtpk_s(P[B],P[B+1])
  #define PAF(k) __builtin_bit_cast(bf16x8,pw##k)
  #define VFR(i) (bf16x8){vlo[i][0],vlo[i][1],vlo[i][2],vlo[i][3],vhi[i][0],vhi[i][1],vhi[i][2],vhi[i][3]}
  #define PIN(x) asm volatile("":"+v"(x))
  #define MX3(a,b,c) __builtin_fmaxf(__builtin_fmaxf((a),(b)),(c))
  #define GAPA(MF,A0,A1,A2,A3,W0,W1,PW) do{ MF; sacc+=A0; sacc+=A1; sacc+=A2; sacc+=A3; PIN(sacc); W0; W1; PIN(PW); SBAR(); }while(0)
  #define EX(v) __builtin_amdgcn_exp2f(v)
  #define GAPB(MF,X,B) do{ MF; X[B]=EX(X[B]); X[B+1]=EX(X[B+1]); X[B+2]=EX(X[B+2]); X[B+3]=EX(X[B+3]); PIN(X); SBAR(); }while(0)
  #define VRD(i) do{ vlo[i]=vtr(vp_+(((i)>>2)*4096+((i)&3)*1024)); vhi[i]=vtr(vp_+(((i)>>2)*4096+((i)&3)*1024+512)); }while(0)
  #define KRD(G,j) do{ if(G){ kload2(kf,kp0+sl_next,j); SBAR(); } }while(0)
  #define STEP(C0,C1,P0,P1,t,GK,GV,GL) do{ SBAR(); \
    const lds_cptr vp_=vp0+sl_prev; \
    const bf16x8 kx0_=kxfrag(btab,64*(t)+r32,hi), kx1_=kxfrag(btab,64*(t)+32+r32,hi); \
    VRD(0); SBAR(); float sacc=(P0[0]+P0[1]); \
    GAPA(C0=__builtin_amdgcn_mfma_f32_32x32x16_bf16(kf[0],qr[0],f32x16{},0,0,0), P0[2],P0[3],P0[4],P0[5],     pw0[0]=PKW(P0,0), pw0[1]=PKW(P0,2), pw0); \
    VRD(4); SBAR(); GAPA(C1=__builtin_amdgcn_mfma_f32_32x32x16_bf16(kf[1],qr[0],f32x16{},0,0,0), P0[6],P0[7],P0[8],P0[9],     pw0[2]=PKW(P0,4), pw0[3]=PKW(P0,6), pw0); \
    VRD(1); SBAR(); GAPA(C0=__builtin_amdgcn_mfma_f32_32x32x16_bf16(kf[2],qr[1],C0,0,0,0),   P0[10],P0[11],P0[12],P0[13], pw1[0]=PKW(P0,8), pw1[1]=PKW(P0,10), pw1); \
    VRD(5); SBAR(); GAPA(C1=__builtin_amdgcn_mfma_f32_32x32x16_bf16(kf[3],qr[1],C1,0,0,0),   P0[14],P0[15],P1[0],P1[1],   pw1[2]=PKW(P0,12),pw1[3]=PKW(P0,14), pw1); \
    VRD(2); SBAR(); GAPA(C0=__builtin_amdgcn_mfma_f32_32x32x16_bf16(kf[4],qr[2],C0,0,0,0),   P1[2],P1[3],P1[4],P1[5],     pw2[0]=PKW(P1,0), pw2[1]=PKW(P1,2), pw2); \
    VRD(6); SBAR(); GAPA(C1=__builtin_amdgcn_mfma_f32_32x32x16_bf16(kf[5],qr[2],C1,0,0,0),   P1[6],P1[7],P1[8],P1[9],     pw2[2]=PKW(P1,4), pw2[3]=PKW(P1,6), pw2); \
    VRD(3); SBAR(); GAPA(C0=__builtin_amdgcn_mfma_f32_32x32x16_bf16(kf[6],qr[3],C0,0,0,0),   P1[10],P1[11],P1[12],P1[13], pw3[0]=PKW(P1,8), pw3[1]=PKW(P1,10), pw3); \
    VRD(7); SBAR(); GAPA(C1=__builtin_amdgcn_mfma_f32_32x32x16_bf16(kf[7],qr[3],C1,0,0,0),   P1[14],P1[15],0.f,0.f,       pw3[2]=PKW(P1,12),pw3[3]=PKW(P1,14), pw3); \
    C0=__builtin_amdgcn_mfma_f32_32x32x16_bf16(kx0_,QX,C0,0,0,0); C1=__builtin_amdgcn_mfma_f32_32x32x16_bf16(kx1_,QX,C1,0,0,0); SBAR(); \
    l_reg+=sacc; \
    if(GK){DMA_K((t)+3,sl_cur);} if(GV){DMA_V((t)+1,sl_next);} \
    CMASK(C0,C1,t); \
    { float a=MX3(C0[0],C0[1],C1[0]),b=MX3(C0[2],C0[3],C1[1]); a=MX3(a,C1[2],C1[3]); \
      _Pragma("unroll") for(int r=4;r<16;r+=4){a=MX3(a,C0[r],C0[r+1]);b=MX3(b,C0[r+2],C0[r+3]);a=MX3(a,C1[r],C1[r+1]);b=MX3(b,C1[r+2],C1[r+3]);} \
      float rm=__builtin_fmaxf(a,b); { auto rr=__builtin_amdgcn_permlane32_swap(__float_as_uint(rm),__float_as_uint(rm),false,false); rm=__builtin_fmaxf(__uint_as_float(rr[0]),__uint_as_float(rr[1])); } \
      resc=false; \
      if(__builtin_expect(__any(rm>(float)THRL),0)){ const float dl=__builtin_fmaxf(rm,0.f); mhat+=dl; \
        _Pragma("unroll") for(int r=0;r<16;++r){C0[r]-=dl;C1[r]-=dl;} \
        SETQX(); \
        const float f=__builtin_amdgcn_exp2f(-dl); l_reg*=f; if(hi==0)wsf[r32]=f; resc=true; } } \
    SBAR(); \
    GAPB(o[0]=__builtin_amdgcn_mfma_f32_32x32x16_bf16(PAF(0),VFR(0),o[0],0,0,0), C0,0); \
    GAPB(o[1]=__builtin_amdgcn_mfma_f32_32x32x16_bf16(PAF(0),VFR(4),o[1],0,0,0), C0,4); \
    KRD(GL,0); GAPB(o[0]=__builtin_amdgcn_mfma_f32_32x32x16_bf16(PAF(1),VFR(1),o[0],0,0,0), C0,8); \
    KRD(GL,1); GAPB(o[1]=__builtin_amdgcn_mfma_f32_32x32x16_bf16(PAF(1),VFR(5),o[1],0,0,0), C0,12); \
    KRD(GL,2); GAPB(o[0]=__builtin_amdgcn_mfma_f32_32x32x16_bf16(PAF(2),VFR(2),o[0],0,0,0), C1,0); \
    KRD(GL,3); GAPB(o[1]=__builtin_amdgcn_mfma_f32_32x32x16_bf16(PAF(2),VFR(6),o[1],0,0,0), C1,4); \
    GAPB(o[0]=__builtin_amdgcn_mfma_f32_32x32x16_bf16(PAF(3),VFR(3),o[0],0,0,0), C1,8); \
    GAPB(o[1]=__builtin_amdgcn_mfma_f32_32x32x16_bf16(PAF(3),VFR(7),o[1],0,0,0), C1,12); \
    }while(0)
  int t=1;
  #undef CMASK
  #define CMASK(P0,P1,t) do{}while(0)
  for(;t+5<NT;t+=2){
    STEP(pB0,pB1,pA0,pA1,t,true,true,true);     WAIT_BAR(2); RESC(); ROT();
    STEP(pA0,pA1,pB0,pB1,t+1,true,true,true);   WAIT_BAR(2); RESC(); ROT();
  }
  #undef CMASK
  #define CMASK(P0,P1,t) do{int jb_=(t)-(NT-4); if(jb_>=0)cmask(P0,P1,jb_,qrel,hi);}while(0)
  #define ENDW(tt) do{ if((tt)+3<NT){WAIT_BAR(2);} else if((tt)+2<NT){WAIT_BAR(1);} else {WAIT_BAR(0);} }while(0)
  for(;t+1<NT;t+=2){
    STEP(pB0,pB1,pA0,pA1,t,(t+3<NT),(t+1<NT),(t+1<NT));       ENDW(t);   RESC(); ROT();
    STEP(pA0,pA1,pB0,pB1,t+1,(t+4<NT),(t+2<NT),(t+2<NT));     ENDW(t+1); RESC(); ROT();
  }
  STEP(pB0,pB1,pA0,pA1,NT-1,false,false,false); RESC();
  { float sacc=pB0[0]+pB0[1]; _Pragma("unroll") for(int r=2;r<16;++r)sacc+=pB0[r]; _Pragma("unroll") for(int r=0;r<16;++r)sacc+=pB1[r]; l_reg+=sacc;
    pw0=(u32x4){PKW(pB0,0),PKW(pB0,2),PKW(pB0,4),PKW(pB0,6)};pw1=(u32x4){PKW(pB0,8),PKW(pB0,10),PKW(pB0,12),PKW(pB0,14)};pw2=(u32x4){PKW(pB1,0),PKW(pB1,2),PKW(pB1,4),PKW(pB1,6)};pw3=(u32x4){PKW(pB1,8),PKW(pB1,10),PKW(pB1,12),PKW(pB1,14)};
    SBAR(); pv(o,vb0+sl_cur,PAF(0),PAF(1),PAF(2),PAF(3)); }
  #undef PKW
  #undef PAF
  #undef VFR
  #undef PIN
  #undef MX3
  #undef GAPA
  #undef GAPB
  #undef EX
  #undef VRD
  #undef KRD
  #undef STEP
  #undef ENDW
  {auto rr=__builtin_amdgcn_permlane32_swap(__float_as_uint(l_reg),__float_as_uint(l_reg),false,false);l_reg=__uint_as_float(rr[0])+__uint_as_float(rr[1]);}
  if(hi==0)wsf[32+r32]=l_reg;asm volatile("s_waitcnt lgkmcnt(0)":::"memory");
  float rli[16];
  #pragma unroll
  for(int r=0;r<16;++r)rli[r]=__builtin_amdgcn_rcpf(wsf[32+crow(r,hi)]);
  bf16*Ow=O+(rowbase+q0+wid*QBLK)*OP+h*D;
  { bf16*stg=(bf16*)(shm+LDS_OST)+wid*2048;
    #pragma unroll
    for(int r=0;r<16;++r){const int orow=crow(r,hi);
      #pragma unroll
      for(int d0=0;d0<2;++d0)stg[orow*64+d0*32+r32]=__float2bfloat16(o[d0][r]*rli[r]);}
    asm volatile("s_waitcnt lgkmcnt(0)":::"memory");
    #pragma unroll
    for(int i=0;i<4;++i){const int row=i*8+(lane>>3),ch=lane&7; const u32x4 v=*(const u32x4*)(stg+row*64+ch*8); ATTN_STORE16(Ow+(long)row*OP+ch*8,v);} }
  asm volatile("s_waitcnt lgkmcnt(0)\n\ts_barrier":::"memory");
  #undef DMA_K
  #undef QX
  #undef RNEHI
  #undef SETQX
  #undef DMA_V
  #undef CMASK
  #undef START
  #undef RESC
  #undef ROT
}
constexpr int ATTN_LDS_BYTES=LDS_BYTES;
struct AttnTensors { const bf16* Q; const bf16* K; const bf16* V; bf16* O; const float* CUM; };
struct AttnUnit { int bh; int qb; };
struct StaticOrder {
  int c,G;
  __device__ __forceinline__ StaticOrder(int grid,int block):c(block),G(grid){}
  __device__ __forceinline__ bool next(int i,AttnUnit&u)const{ const int it=i*G+c; if(it>=BATCH*NHEAD*NQB)return false; u.bh=it%(BATCH*NHEAD); u.qb=NQB-1-it/(BATCH*NHEAD); return true; }
};
template<class Sched,int THRL=8> __device__ __forceinline__ void attn_phase(char*lds,const AttnTensors&T,const Sched&S,const int wv){
  AttnUnit u;
  for(int i=0;S.next(i,u);++i){ attn_unit<THRL>(u.bh/NHEAD,u.bh%NHEAD,u.qb,T.Q,T.K,T.V,T.O,T.CUM+(size_t)u.bh*SEQ,lds,wv); }
}
#undef SBAR
#undef WAIT_BAR
}

namespace mls {
typedef short bf16x8 __attribute__((ext_vector_type(8)));
typedef float f32x4v __attribute__((ext_vector_type(4)));
typedef unsigned u32x2v __attribute__((ext_vector_type(2)));
typedef unsigned u32x4v __attribute__((ext_vector_type(4)));
constexpr int QS = 136, TS = 72;
constexpr int L_Q = 0, L_QI = 17408, L_K = 34816, L_KT = 52224, L_VT = 70656, L_WVT = 82176, L_SC = 93696, L_CT = 102912, L_DEN = 124672, L_END = 124928;
constexpr float QK_SCALE = 0.08838834764831845f;
__device__ __forceinline__ float scan_add(float v, int lane) {
#pragma unroll
    for (int o = 1; o < 64; o <<= 1) { const float t = __shfl_up(v, o); if (lane >= o) v += t; }
    return v; }
__device__ __forceinline__ float scan_max(float v, int lane) {
#pragma unroll
    for (int o = 1; o < 64; o <<= 1) { const float t = __shfl_up(v, o); if (lane >= o) v = fmaxf(v, t); }
    return v; }
__device__ __forceinline__ float lo_bf(unsigned w) { return __builtin_bit_cast(float, w << 16); }
__device__ __forceinline__ float hi_bf(unsigned w) { return __builtin_bit_cast(float, w & 0xffff0000u); }
}
__device__ __forceinline__ void phase_mlstm(Frame& F, const bf16* P, const bf16* PBg, const float* SG, const float* convw, const float* convb, bf16* AO) {
    using namespace mls;
    const int tid = opaque_tid(F.wave), lane = tid & 63, wid = __builtin_amdgcn_readfirstlane(tid >> 6), l15 = lane & 15, q4 = lane >> 4;
    LAS unsigned char* L = F.lds;
    for (int it = blockIdx.x; it < BATCH * MLH * 2; it += F.G) {
        const int vh = it & 1, bh = it >> 1, b = bh / MLH, h = bh % MLH;
        const size_t row00 = (size_t)b * SEQ;
        const int ch2 = tid & 127, tq = __builtin_amdgcn_readfirstlane(tid >> 7); const bool isk = (wid & 1) != 0;
        const int cc = (ch2 & 63) * 2;
        const int pcol = (isk ? PC_MK : PC_MQ) + h * 128 + cc, cch = (isk ? 512 : 0) + h * 128 + cc;
        float w0[2], w1[2], w2[2], w3[2], cb[2];
#pragma unroll
        for (int i = 0; i < 2; ++i) { w0[i] = convw[cch + i]; w1[i] = convw[1024 + cch + i]; w2[i] = convw[2048 + cch + i]; w3[i] = convw[3072 + cch + i]; cb[i] = convb[cch + i]; }
        const int e2 = tid & 31, sg = tid >> 5;
        const int vcol = PC_MV + h * 128 + vh * 64 + 2 * e2;
        f32x4v Cacc[8];
#pragma unroll
        for (int i = 0; i < 8; ++i) Cacc[i] = (f32x4v){0.f, 0.f, 0.f, 0.f};
        float mcar = 0.f;
        __syncthreads();
        for (int i = tid; i < 80 * QS / 2; i += NTHR) ((LAS unsigned*)(L + L_CT))[i] = 0u;
        for (int i = tid; i < 16 * TS / 2; i += NTHR) { ((LAS unsigned*)(L + L_VT + 64 * TS * 2))[i] = (i < TS / 2) ? 0x3F803F80u : 0u; ((LAS unsigned*)(L + L_WVT + 64 * TS * 2))[i] = 0u; }
        unsigned raw[19], vraw[4]; float ig, lf;
        const unsigned lo_raw = (unsigned)pcol * 2u, lo_v = (unsigned)((4 * sg) * PJA + vcol) * 2u, lo_g = (unsigned)lane * 64u, lo_o = (unsigned)((4 * q4) * PJB + l15) * 2u, lo_ao = (unsigned)((4 * q4) * D + l15) * 2u;
        const __amdgpu_buffer_rsrc_t rsP = __builtin_amdgcn_make_buffer_rsrc((void*)P, 0, M * PJA * 2, 0x00020000), rsB = __builtin_amdgcn_make_buffer_rsrc((void*)PBg, 0, M * PJB * 2, 0x00020000), rsG = __builtin_amdgcn_make_buffer_rsrc((void*)SG, 0, M * 64, 0x00020000),
                                     rsO = __builtin_amdgcn_make_buffer_rsrc((void*)AO, 0, M * D * 2, 0x00020000);
        const int r00 = (int)row00;
#define MLS_LOAD(c) do { _Pragma("unroll") for (int i_ = 0; i_ < 19; ++i_) { const int tr_ = 64 * (c) + 16 * tq - 3 + i_; raw[i_] = (tr_ >= 0) ? __builtin_amdgcn_raw_buffer_load_b32(rsP, lo_raw, (r00 + tr_) * (PJA * 2), 0) : 0u; } \
        _Pragma("unroll") for (int i_ = 0; i_ < 4; ++i_) vraw[i_] = __builtin_amdgcn_raw_buffer_load_b32(rsP, lo_v, (r00 + 64 * (c) + i_) * (PJA * 2), 0); \
        ig = __builtin_bit_cast(float, __builtin_amdgcn_raw_buffer_load_b32(rsG, lo_g, (r00 + 64 * (c)) * 64 + (8 + h) * 4, 0)); lf = __builtin_bit_cast(float, __builtin_amdgcn_raw_buffer_load_b32(rsG, lo_g, (r00 + 64 * (c)) * 64 + (12 + h) * 4, 0)); } while (0)
        MLS_LOAD(0);
        for (int c = 0; c < SEQ / 64; ++c) {
            const size_t row0 = row00 + 64 * c;
            const float bcum = scan_add(lf, lane), aval = ig - bcum, pm = scan_max(aval, lane);
            const float pm63 = __shfl(pm, 63), gsum = __shfl(bcum, 63);
            const float Mx = fmaxf(mcar, pm63), mrow = fmaxf(pm, mcar);
            const float rowterm = -mrow, inter = __expf(mcar - mrow), emt = __expf(-(bcum + mrow)), wk = __expf(aval - Mx), cdec = __expf(mcar - Mx);
            mcar = gsum + Mx;
            {
                unsigned kt0[8], kt1[8];
#pragma unroll
                for (int i = 0; i < 16; i += 2) {
                    float y[2][2];
#pragma unroll
                    for (int u = 0; u < 2; ++u) {
                        float a0 = w0[0] * lo_bf(raw[i + u]) + w1[0] * lo_bf(raw[i + u + 1]) + w2[0] * lo_bf(raw[i + u + 2]) + w3[0] * lo_bf(raw[i + u + 3]) + cb[0];
                        float a1 = w0[1] * hi_bf(raw[i + u]) + w1[1] * hi_bf(raw[i + u + 1]) + w2[1] * hi_bf(raw[i + u + 2]) + w3[1] * hi_bf(raw[i + u + 3]) + cb[1];
                        y[u][0] = siluf_(a0); y[u][1] = siluf_(a1);
                        const int t = 16 * tq + i + u;
                        if (!isk) { const float q0 = y[u][0] * QK_SCALE, q1 = y[u][1] * QK_SCALE; const float itv = __shfl(inter, t);
                            *(LAS unsigned*)(L + L_Q + (t * QS + cc) * 2) = pk2(q0, q1); *(LAS unsigned*)(L + L_QI + (t * QS + cc) * 2) = pk2(q0 * itv, q1 * itv); }
                        else *(LAS unsigned*)(L + L_K + (t * QS + cc) * 2) = pk2(y[u][0], y[u][1]);
                    }
                    kt0[i >> 1] = pk2(y[0][0], y[1][0]); kt1[i >> 1] = pk2(y[0][1], y[1][1]);
                }
                if (isk) {
                    *(LAS u32x4v*)(L + L_KT + (cc * TS + 16 * tq) * 2) = (u32x4v){kt0[0], kt0[1], kt0[2], kt0[3]}; *(LAS u32x4v*)(L + L_KT + (cc * TS + 16 * tq + 8) * 2) = (u32x4v){kt0[4], kt0[5], kt0[6], kt0[7]};
                    *(LAS u32x4v*)(L + L_KT + ((cc + 1) * TS + 16 * tq) * 2) = (u32x4v){kt1[0], kt1[1], kt1[2], kt1[3]}; *(LAS u32x4v*)(L + L_KT + ((cc + 1) * TS + 16 * tq + 8) * 2) = (u32x4v){kt1[4], kt1[5], kt1[6], kt1[7]};
                }
            }
            {
                float v0[4], v1[4], wv[4];
#pragma unroll
                for (int i = 0; i < 4; ++i) { v0[i] = lo_bf(vraw[i]); v1[i] = hi_bf(vraw[i]); wv[i] = __shfl(wk, 4 * sg + i); }
                *(LAS u32x2v*)(L + L_VT + ((2 * e2) * TS + 4 * sg) * 2) = (u32x2v){pk2(v0[0], v0[1]), pk2(v0[2], v0[3])};
                *(LAS u32x2v*)(L + L_VT + ((2 * e2 + 1) * TS + 4 * sg) * 2) = (u32x2v){pk2(v1[0], v1[1]), pk2(v1[2], v1[3])};
                *(LAS u32x2v*)(L + L_WVT + ((2 * e2) * TS + 4 * sg) * 2) = (u32x2v){pk2(v0[0] * wv[0], v0[1] * wv[1]), pk2(v0[2] * wv[2], v0[3] * wv[3])};
                *(LAS u32x2v*)(L + L_WVT + ((2 * e2 + 1) * TS + 4 * sg) * 2) = (u32x2v){pk2(v1[0] * wv[0], v1[1] * wv[1]), pk2(v1[2] * wv[2], v1[3] * wv[3])};
                if (wid == 0) *(LAS unsigned short*)(L + L_WVT + (64 * TS + lane) * 2) = (unsigned short)f2bf(wk);
            }
            if (c + 1 < SEQ / 64) MLS_LOAD(c + 1);
            __syncthreads();
            {
                const int tt = wid >> 1;
#pragma unroll
                for (int si = 0; si < 2; ++si) {
                    const int ss = 2 * (wid & 1) + si;
                    f32x4v acc = (f32x4v){0.f, 0.f, 0.f, 0.f};
                    if (ss <= tt) {
#pragma unroll
                        for (int kd = 0; kd < 4; ++kd) {
                            const bf16x8 a = *(const LAS bf16x8*)(L + L_Q + ((16 * tt + l15) * QS + 32 * kd + 8 * q4) * 2);
                            const bf16x8 bb = *(const LAS bf16x8*)(L + L_K + ((16 * ss + l15) * QS + 32 * kd + 8 * q4) * 2);
                            acc = __builtin_amdgcn_mfma_f32_16x16x32_bf16(a, bb, acc, 0, 0, 0);
                        }
                    }
                    const int s = 16 * ss + l15; const float as_ = __shfl(aval, s);
#pragma unroll
                    for (int j = 0; j < 4; ++j) { const int t = 16 * tt + 4 * q4 + j; const float rt = __shfl(rowterm, t);
                        const float dv = (s <= t) ? acc[j] * __expf(rt + as_) : 0.f;
                        *(LAS unsigned short*)(L + L_SC + (t * TS + s) * 2) = (unsigned short)f2bf(dv); }
                }
            }
            unsigned short mog[16];
            if (wid < 4) {
#pragma unroll
                for (int tt = 0; tt < 4; ++tt)
#pragma unroll
                    for (int j = 0; j < 4; ++j) mog[tt * 4 + j] = __builtin_amdgcn_raw_buffer_load_b16(rsB, lo_o, (((int)row0 + 16 * tt + j) * PJB + PB_MO + h * 128 + vh * 64 + 16 * wid) * 2, 0);
            }
            __syncthreads();
            f32x4v acc[4];
            if (wid < 5) {
                const int eg = wid;
#pragma unroll
                for (int tt = 0; tt < 4; ++tt) {
                    acc[tt] = (f32x4v){0.f, 0.f, 0.f, 0.f};
#pragma unroll
                    for (int ks = 0; ks < 2; ++ks) {
                        const bf16x8 a = *(const LAS bf16x8*)(L + L_SC + ((16 * tt + l15) * TS + 32 * ks + 8 * q4) * 2);
                        const bf16x8 bb = *(const LAS bf16x8*)(L + L_VT + ((16 * eg + l15) * TS + 32 * ks + 8 * q4) * 2);
                        acc[tt] = __builtin_amdgcn_mfma_f32_16x16x32_bf16(a, bb, acc[tt], 0, 0, 0);
                    }
#pragma unroll
                    for (int kd = 0; kd < 4; ++kd) {
                        const bf16x8 a = *(const LAS bf16x8*)(L + L_QI + ((16 * tt + l15) * QS + 32 * kd + 8 * q4) * 2);
                        const bf16x8 bb = *(const LAS bf16x8*)(L + L_CT + ((16 * eg + l15) * QS + 32 * kd + 8 * q4) * 2);
                        acc[tt] = __builtin_amdgcn_mfma_f32_16x16x32_bf16(a, bb, acc[tt], 0, 0, 0);
                    }
                }
                asm volatile("s_waitcnt lgkmcnt(0)" ::: "memory");
#pragma unroll
                for (int db = 0; db < 8; ++db) {
                    Cacc[db] = Cacc[db] * cdec;
#pragma unroll
                    for (int ks = 0; ks < 2; ++ks) {
                        const bf16x8 a = *(const LAS bf16x8*)(L + L_KT + ((16 * db + l15) * TS + 32 * ks + 8 * q4) * 2);
                        const bf16x8 bb = *(const LAS bf16x8*)(L + L_WVT + ((16 * eg + l15) * TS + 32 * ks + 8 * q4) * 2);
                        Cacc[db] = __builtin_amdgcn_mfma_f32_16x16x32_bf16(a, bb, Cacc[db], 0, 0, 0);
                    }
                    *(LAS u32x2v*)(L + L_CT + ((16 * eg + l15) * QS + 16 * db + 4 * q4) * 2) = (u32x2v){pk2(Cacc[db][0], Cacc[db][1]), pk2(Cacc[db][2], Cacc[db][3])};
                }
                if (wid == 4 && l15 == 0) {
#pragma unroll
                    for (int tt = 0; tt < 4; ++tt) *(LAS f32x4v*)(L + L_DEN + (16 * tt + 4 * q4) * 4) = acc[tt];
                }
            }
            __syncthreads();
            if (wid < 4) {
#pragma unroll
                for (int tt = 0; tt < 4; ++tt) {
                    const f32x4v den = *(const LAS f32x4v*)(L + L_DEN + (16 * tt + 4 * q4) * 4);
#pragma unroll
                    for (int j = 0; j < 4; ++j) { const int t = 16 * tt + 4 * q4 + j; const float et = __shfl(emt, t);
                        const float hv = acc[tt][j] / fmaxf(fabsf(den[j]), et);
                        __builtin_amdgcn_raw_buffer_store_b16((unsigned short)f2bf(hv * bf2f(mog[tt * 4 + j])), rsO, lo_ao, (((int)row0 + 16 * tt + j) * D + 512 + h * 128 + vh * 64 + 16 * wid) * 2, 0); }
                }
            }
        }
#undef MLS_LOAD
    }
}

__global__ void __launch_bounds__(NTHR, 2) fwd_kernel(Args args) {
    extern __shared__ __attribute__((aligned(16))) unsigned char lds[];
    Frame F;
    F.lds = (LAS unsigned char*)lds;
    F.MISC = (volatile LAS unsigned*)(F.lds + MISC_OFF);
    F.wave = __builtin_amdgcn_readfirstlane((int)threadIdx.x >> 6);
    F.G = gridDim.x;
    F.ws = args.ws; F.out = args.out;
#pragma unroll
    for (int i = 0; i < 18; ++i) F.in[i] = args.in[i];
    F.ctl = (gu32*)(F.ws + WS_CTL);
    for (int u = threadIdx.x; u < (LDS_BYTES - LDSCTL_OFF) / 4; u += NTHR) ((LAS unsigned*)(F.lds + LDSCTL_OFF))[u] = 0u;
    __syncthreads();
    XcdBarrier bar = xcd_barrier_post((unsigned*)(F.ctl + CW_BAR), F.MISC + 8);
#define GRID_BAR() xcd_barrier(bar)

    const float* x = F.in[0];
    bf16* XB = (bf16*)(F.ws + WS_XB); bf16* AO = (bf16*)(F.ws + WS_AO); bf16* PA = (bf16*)(F.ws + WS_PA); bf16* PB = (bf16*)(F.ws + WS_PB);
    bf16* HB = PA; bf16* MG = PA;
    float* SG = (float*)(F.ws + WS_SG); float* CUM = (float*)(F.ws + WS_CUM); float* SS = (float*)(F.ws + WS_SS);
    float* out = F.out;
    const bf16* W1IN = (const bf16*)(F.ws + WS_W1IN); const bf16* W1OUT = (const bf16*)(F.ws + WS_W1OUT); const bf16* WIN = (const bf16*)(F.ws + WS_WIN);
    const bf16* WCAT = (const bf16*)(F.ws + WS_WCAT); const bf16* WOUT = (const bf16*)(F.ws + WS_WOUT); const bf16* W2IN = (const bf16*)(F.ws + WS_W2IN); const bf16* W2OUT = (const bf16*)(F.ws + WS_W2OUT);
#define GEMM_PHASE(EpiT, gobj, eobj) do { pg8::StaticOrder S_; S_.init((gobj).M, (gobj).N, F.G, (int)blockIdx.x); pg8::gemm_phase<EpiT, pg8::StaticOrder, true, true>(F.lds, gobj, S_, eobj, F.wave); } while (0)
#define REP(b) ((REP_MASK >> (b)) & 1)

    phase_weights(F);
    phase_x_prep(F, x, XB, SS);
    GRID_BAR();
    { pg8::Gemm g{XB, W1IN, M, NFF, D, D, D}; pg8::EpiSwigluF E{HB, SS}; GEMM_PHASE(pg8::EpiSwigluF, g, E); if (REP(0)) GEMM_PHASE(pg8::EpiSwigluF, g, E); }
    GRID_BAR();
    { pg8::Gemm g{HB, W1OUT, M, D, DFF, DFF, DFF}; pg8::EpiResidB<false> E{XB, nullptr, SS, 0.5f}; GEMM_PHASE(pg8::EpiResidB<false>, g, E); }
    GRID_BAR();
    { pg8::Gemm g{XB, WIN, M, NPJ, D, D, D}; pg8::EpiProjF E{PA, PB, SG, SS, F.in[6], F.in[9], F.in[10]}; GEMM_PHASE(pg8::EpiProjF, g, E); if (REP(2)) GEMM_PHASE(pg8::EpiProjF, g, E); }
    GRID_BAR();
    phase_cumsum(F, SG, CUM);
    GRID_BAR();
    phase_mlstm(F, PA, PB, SG, F.in[7], F.in[8], AO);
    if (REP(3)) phase_mlstm(F, PA, PB, SG, F.in[7], F.in[8], AO);
    { const attn_body::AttnTensors AT{(const attn_body::bf16*)(PA + PC_FQ), (const attn_body::bf16*)(PA + PC_FK), (const attn_body::bf16*)(PA + PC_FV), (attn_body::bf16*)AO, CUM};
      const attn_body::StaticOrder SA((int)F.G, (int)blockIdx.x); attn_body::attn_phase<attn_body::StaticOrder>((char*)lds, AT, SA, F.wave);
      if (REP(4)) attn_body::attn_phase<attn_body::StaticOrder>((char*)lds, AT, SA, F.wave); }
    GRID_BAR();
    { pg8::Gemm g{AO, WCAT, M, D, D, D, D}; pg8::EpiMergeF E{PB, MG}; GEMM_PHASE(pg8::EpiMergeF, g, E); if (REP(5)) GEMM_PHASE(pg8::EpiMergeF, g, E); }
    GRID_BAR();
    { pg8::Gemm g{MG, WOUT, M, D, D, D, D}; pg8::EpiResidB<false> E{XB, nullptr, SS, 1.0f}; GEMM_PHASE(pg8::EpiResidB<false>, g, E); }
    GRID_BAR();
    { pg8::Gemm g{XB, W2IN, M, NFF, D, D, D}; pg8::EpiSwigluF E{HB, SS}; GEMM_PHASE(pg8::EpiSwigluF, g, E); }
    GRID_BAR();
    { pg8::Gemm g{HB, W2OUT, M, D, DFF, DFF, DFF}; pg8::EpiResidB<true> E{XB, out, SS, 0.5f}; GEMM_PHASE(pg8::EpiResidB<true>, g, E); if (REP(1)) GEMM_PHASE(pg8::EpiResidB<true>, g, E); }
    GRID_BAR();
    phase_final_scale(F, out, SS, F.in[17]);
}

extern "C" void kernel_launch(void* const* d_in, const int* in_sizes, int n_in, void* d_out, int out_size, void* d_ws, size_t ws_size, hipStream_t stream) {
    static int grid = 0;
    if (grid == 0) {
        if (n_in != 18 || in_sizes[0] != M * D || out_size != M * D || ws_size < WS_END) { fprintf(stderr, "kernel_launch: unexpected shapes (n_in %d, in0 %d, out %d, ws %zu)\n", n_in, n_in > 0 ? in_sizes[0] : -1, out_size, ws_size); grid = -1; return; }
        int dev = 0, cus = 0, per_cu = 0;
        if (hipGetDevice(&dev) != hipSuccess || hipDeviceGetAttribute(&cus, hipDeviceAttributeMultiprocessorCount, dev) != hipSuccess) { grid = -1; return; }
        if (hipFuncSetAttribute((const void*)fwd_kernel, hipFuncAttributeMaxDynamicSharedMemorySize, LDS_BYTES) != hipSuccess) { grid = -1; return; }
        if (hipOccupancyMaxActiveBlocksPerMultiprocessor(&per_cu, (const void*)fwd_kernel, NTHR, LDS_BYTES) != hipSuccess || per_cu < 1) { fprintf(stderr, "occupancy query says %d\n", per_cu); }
        (void)hipGetLastError();
        grid = cus;
    }
    if (grid < 0) return;
    if (hipMemsetAsync((char*)d_ws + WS_CTL, 0, CTL_ZERO_BYTES, stream) != hipSuccess) return;
    Args a{};
    for (int i = 0; i < 18; ++i) a.in[i] = (const float*)d_in[i];
    a.out = (float*)d_out; a.ws = (unsigned char*)d_ws;
    hipLaunchKernelGGL(fwd_kernel, dim3(grid), dim3(NTHR), LDS_BYTES, stream, a);
}
```

```cpp
#include <hip/hip_runtime.h>
#include <cstdio>
#include <cstdint>

#define GAS __attribute__((address_space(1)))
#define LAS __attribute__((address_space(3)))
typedef unsigned short bf16;
typedef unsigned v4u __attribute__((ext_vector_type(4)));
typedef float f32x4 __attribute__((ext_vector_type(4)));
typedef GAS unsigned gu32;
#define RLX_AGENT __ATOMIC_RELAXED, __HIP_MEMORY_SCOPE_AGENT

constexpr int BATCH = 32, SEQ = 2048, D = 1024, M = BATCH * SEQ;
constexpr int DFF = 2816, NFF = 2 * DFF;
constexpr int INC = 5648;
constexpr int PJA = 3072, PJB = 2560;
constexpr int FOXH = 8, FHD = 64, MLH = 4, MHD = 128;
constexpr int PC_FQ = 0, PC_FK = 512, PC_FV = 1024, PC_MQ = 1536, PC_MK = 2048, PC_MV = 2560;
constexpr int PB_MO = 0, PB_GA = 512, PB_GB = 1536;
constexpr float RMS_EPS = 1e-6f;
constexpr float LOG2E = 1.4426950408889634f;
constexpr float QSCALE2 = 0.125f * LOG2E;
constexpr int NWAVES = 8, NTHR = 512;
#ifndef STAG_ON
#define STAG_ON 0
#endif
#ifndef REP_MASK
#define REP_MASK 0
#endif

constexpr size_t MiB = 1u << 20;
constexpr size_t WS_CTL = 0, CTL_ZERO_BYTES = 1 * MiB;
constexpr size_t WS_W1IN = 2 * MiB, WS_W1OUT = 13 * MiB, WS_WIN = 19 * MiB, WS_WCAT = 31 * MiB, WS_WOUT = 33 * MiB, WS_W2IN = 35 * MiB, WS_W2OUT = 46 * MiB;
constexpr int NPJ = 5888;
constexpr size_t WS_SG = 52 * MiB;
constexpr size_t WS_CUM = 56 * MiB;
constexpr size_t WS_SS = 58 * MiB;
constexpr size_t WS_XB = 64 * MiB;
constexpr size_t WS_AO = 192 * MiB;
constexpr size_t WS_PA = 320 * MiB;
constexpr size_t WS_PB = 704 * MiB;
constexpr size_t WS_END = 1024 * MiB;
constexpr int CW_BAR = 4096;

constexpr int LDS_BYTES = 147456;
constexpr int RING_BYTES = 131072, LDSCTL_OFF = RING_BYTES, MISC_OFF = LDSCTL_OFF + 320;

__device__ __forceinline__ float bf2f(bf16 v) { return __builtin_bit_cast(float, (unsigned)v << 16); }
__device__ __forceinline__ unsigned f2bf(float f) { unsigned u = __builtin_bit_cast(unsigned, f); return (u + 0x7fffu + ((u >> 16) & 1u)) >> 16; }
__device__ __forceinline__ unsigned pk2(float lo, float hi) { return f2bf(lo) | (f2bf(hi) << 16); }
__device__ __forceinline__ float sigmoidf_(float v) { return 1.f / (1.f + __expf(-v)); }
__device__ __forceinline__ float logsigmoidf_(float v) { return fminf(v, 0.f) - log1pf(__expf(-fabsf(v))); }
__device__ __forceinline__ float siluf_(float v) { return v / (1.f + __expf(-v)); }

#define XB_TMO      128
#define XB_XCNT(j)  (256  + 64 * (j))
#define XB_XSUB(j)  (1280 + 64 * (j))
#define XB_XGEN(j)  (2304 + 64 * (j))
#define XB_TOP      3328
#define XB_TOPGEN   3392
#define XCD_BAR_WORDS 3456
#define XB_SPIN_CAP (1u << 22)

__device__ __forceinline__ unsigned xb_ld(unsigned* p)              { return __hip_atomic_load(p, __ATOMIC_RELAXED, __HIP_MEMORY_SCOPE_AGENT); }
__device__ __forceinline__ unsigned xb_add(unsigned* p, unsigned v) { return __hip_atomic_fetch_add(p, v, __ATOMIC_RELAXED, __HIP_MEMORY_SCOPE_AGENT); }
__device__ __forceinline__ unsigned xb_xcc_id() { return (unsigned)__builtin_amdgcn_s_getreg((3 << 11) | 20) & 0xFu; }
#define XB_SPIN(cond, bar) do { unsigned _sp = 0; while (cond) { __builtin_amdgcn_s_sleep(1); \
    if ((++_sp & 255u) == 0u) { if (xb_ld(&(bar)[XB_TMO])) break; if (_sp > XB_SPIN_CAP) { atomicAdd(&(bar)[XB_TMO], 1u); break; } } } } while (0)

struct XcdBarrier { unsigned* bar; unsigned x; volatile LAS unsigned* st; int wv; };

__device__ __forceinline__ bool xb_leader(int wv) { int l = (int)__builtin_amdgcn_mbcnt_hi(~0u, __builtin_amdgcn_mbcnt_lo(~0u, 0u)); asm volatile("" : "+v"(l)); return wv == 0 && l == 0; }
__device__ __forceinline__ XcdBarrier xcd_barrier_post(unsigned* bar, volatile LAS unsigned* st, int wv) {
    XcdBarrier b; b.bar = bar; b.x = xb_xcc_id(); b.st = st; b.wv = wv;
    if (xb_leader(wv)) (void)xb_add(&bar[XB_XCNT(b.x)], 1u);
    return b;
}
__device__ __forceinline__ void xcd_barrier_complete(unsigned* bar, unsigned x, unsigned& nloc, unsigned& nx) {
    const unsigned G = gridDim.x * gridDim.y * gridDim.z;
    unsigned sum, cnt, mine, sp = 0u;
    for (;;) {
        sum = 0u; cnt = 0u; mine = 0u;
#pragma unroll
        for (unsigned j = 0; j < 16; ++j) { const unsigned c = xb_ld(&bar[XB_XCNT(j)]); sum += c; cnt += (c > 0u) ? 1u : 0u; mine = (j == x) ? c : mine; }
        if (sum == G) break;
        __builtin_amdgcn_s_sleep(1);
        if ((++sp & 255u) == 0u) { if (xb_ld(&bar[XB_TMO])) break; if (sp > XB_SPIN_CAP) { atomicAdd(&bar[XB_TMO], 1u); break; } }
    }
    nloc = mine > 0u ? mine : 1u; nx = cnt > 0u ? cnt : 1u;
}
__device__ __forceinline__ void xcd_barrier(const XcdBarrier& b) {
    asm volatile("s_waitcnt vmcnt(0)" ::: "memory");
    __syncthreads();
    if (xb_leader(b.wv)) {
        unsigned* bar = b.bar;
        __builtin_amdgcn_s_waitcnt(0);
        unsigned nloc = b.st[0], nx = b.st[1];
        if (nloc == 0u) { xcd_barrier_complete(bar, b.x, nloc, nx); b.st[0] = nloc; b.st[1] = nx; }
        const unsigned old = xb_add(&bar[XB_XSUB(b.x)], 1u);
        const unsigned gen = old / nloc;
        if (old + 1u == (gen + 1u) * nloc) {
            __builtin_amdgcn_fence(__ATOMIC_RELEASE, "agent");
            asm volatile("s_waitcnt vmcnt(0)" ::: "memory");
            const unsigned og = xb_add(&bar[XB_TOP], 1u);
            const unsigned tg = og / nx;
            if (og + 1u == (tg + 1u) * nx) xb_add(&bar[XB_TOPGEN], 1u);
            else XB_SPIN(xb_ld(&bar[XB_TOPGEN]) == tg, bar);
            __builtin_amdgcn_fence(__ATOMIC_ACQUIRE, "agent");
            xb_add(&bar[XB_XGEN(b.x)], 1u);
            asm volatile("s_waitcnt vmcnt(0)" ::: "memory");
        } else {
            XB_SPIN(xb_ld(&bar[XB_XGEN(b.x)]) == gen, bar);
            __builtin_amdgcn_fence(__ATOMIC_ACQUIRE, "agent");
            asm volatile("s_waitcnt vmcnt(0)" ::: "memory");
        }
    }
    __syncthreads();
}

struct Frame {
    LAS unsigned char* lds;
    volatile LAS unsigned* MISC;
    gu32* ctl;
    int wave, G;
    const float* in[18];
    float* out;
    unsigned char* ws;
};
struct Args { const float* in[18]; float* out; unsigned char* ws; };

__device__ __forceinline__ int lane_id() { return (int)__builtin_amdgcn_mbcnt_hi(~0u, __builtin_amdgcn_mbcnt_lo(~0u, 0u)); }
__device__ __forceinline__ int opaque_tid(int wv) { int t = wv * 64 + lane_id(); asm volatile("" : "+v"(t)); return t; }
__device__ __forceinline__ float bperm(float v, int idx) { return __builtin_bit_cast(float, __builtin_amdgcn_ds_bpermute(idx << 2, __builtin_bit_cast(int, v))); }
__device__ __forceinline__ float shx(float v, int lane, int mask) { return bperm(v, lane ^ mask); }
__device__ __forceinline__ float wave_sum(float v, int lane) {
#pragma unroll
    for (int o = 1; o < 64; o <<= 1) v += shx(v, lane, o);
    return v;
}

__device__ __forceinline__ void phase_x_prep(Frame& F, const float* X, bf16* XB, float* SS) {
    const int ptid = opaque_tid(F.wave), plane = ptid & 63, pwave = __builtin_amdgcn_readfirstlane(ptid >> 6);
    const int gw = blockIdx.x * NWAVES + pwave, NGW = F.G * NWAVES;
    for (int m = gw; m < M; m += NGW) {
        const GAS f32x4* xr = (const GAS f32x4*)(X + (size_t)m * D) + plane;
        f32x4 v[4]; float s = 0.f;
#pragma unroll
        for (int j = 0; j < 4; ++j) { v[j] = xr[64 * j]; s += (v[j].x * v[j].x + v[j].y * v[j].y) + (v[j].z * v[j].z + v[j].w * v[j].w); }
        s = wave_sum(s, plane);
        GAS unsigned long long* o8 = (GAS unsigned long long*)(XB + (size_t)m * D) + plane;
#pragma unroll
        for (int j = 0; j < 4; ++j) o8[64 * j] = (unsigned long long)pk2(v[j].x, v[j].y) | ((unsigned long long)pk2(v[j].z, v[j].w) << 32);
        if (plane < 16) SS[(size_t)m * 16 + plane] = (plane == 0) ? s : 0.f;
    }
}
__device__ __forceinline__ void phase_final_scale(Frame& F, float* X, const float* SS, const float* gain) {
    const int ptid = opaque_tid(F.wave), plane = ptid & 63, pwave = __builtin_amdgcn_readfirstlane(ptid >> 6);
    const int gw = blockIdx.x * NWAVES + pwave, NGW = F.G * NWAVES;
    f32x4 g[4];
#pragma unroll
    for (int j = 0; j < 4; ++j) g[j] = *((const GAS f32x4*)gain + plane + 64 * j);
    for (int m = gw; m < M; m += NGW) {
        GAS f32x4* xr = (GAS f32x4*)(X + (size_t)m * D) + plane;
        f32x4 v[4];
#pragma unroll
        for (int j = 0; j < 4; ++j) v[j] = xr[64 * j];
        float s = SS[(size_t)m * 16 + (plane & 15)];
#pragma unroll
        for (int o = 1; o < 16; o <<= 1) s += shx(s, plane, o);
        const float r = 1.0f / sqrtf(s * (1.f / D) + RMS_EPS);
#pragma unroll
        for (int j = 0; j < 4; ++j) xr[64 * j] = v[j] * r * g[j];
    }
}

__device__ __forceinline__ void phase_cumsum(Frame& F, const float* SG, float* CUM) {
    const int ptid = opaque_tid(F.wave), plane = ptid & 63, pwave = __builtin_amdgcn_readfirstlane(ptid >> 6); (void)plane; (void)pwave;
    const int gw = blockIdx.x * NWAVES + pwave, NGW = F.G * NWAVES;
    for (int it = gw; it < BATCH * FOXH; it += NGW) {
        const int b = it / FOXH, h = it % FOXH;
        float v[32]; float s = 0.f;
#pragma unroll
        for (int i = 0; i < 32; ++i) { s += SG[(size_t)(b * SEQ + plane * 32 + i) * 16 + h]; v[i] = s; }
        float incl = s;
#pragma unroll
        for (int o = 1; o < 64; o <<= 1) { const float t = bperm(incl, (plane - o) & 63); if (plane >= o) incl += t; }
        const float excl = incl - s;
#pragma unroll
        for (int i = 0; i < 32; ++i) CUM[(size_t)it * SEQ + plane * 32 + i] = v[i] + excl;
    }
}


namespace pg8 {
#define PG8_LAS __attribute__((address_space(3)))
typedef unsigned short bf16_t;
typedef short bf16x8 __attribute__((ext_vector_type(8)));
typedef float f32x4 __attribute__((ext_vector_type(4)));
typedef unsigned u32x4 __attribute__((ext_vector_type(4)));
constexpr int BM = 256, BK = 64, HALF = 128, HTB = HALF * BK * 2  , STAGE_BYTES = 8 * HTB, NXCD = 8, WGM = 8;

__host__ __device__ __forceinline__ int lds_byte(int r, int c) { const int st = (r >> 4) * 2 + (c >> 5), rr = r & 15, cc = c & 31, ob = rr * 64 + cc * 2; return st * 1024 + (ob ^ (((ob >> 9) & 1) << 5)); }
__host__ __device__ __forceinline__ void stage_rc(int b, int& R, int& C) { const int st = b / 1024, sb = b % 1024, swz = sb ^ (((sb >> 9) & 1) << 5); R = (st >> 1) * 16 + swz / 64; C = (st & 1) * 32 + (swz % 64) / 2; }
__host__ __device__ __forceinline__ int perm32(int rho) { const int n = rho >> 4, i = rho & 15; return 8 * (i >> 2) + 4 * n + (i & 3); }

struct Unit { int pm, pn; };
struct Gemm { const bf16_t* A; const bf16_t* Bt; int M, N, K, lda, ldb; };

struct StaticOrder {
    int nM, nN, nwg, G, c;
    __host__ __device__ void init(int M, int N, int G_, int c_) { nM = M / BM; nN = N / BM; nwg = nM * nN; G = G_; c = c_; }
    __host__ __device__ bool next(int i, Unit& u) const {
        const long L = (long)i * G + c; if (L >= nwg) return false;
        int wgid = (int)L; { const int q = nwg / NXCD, r = nwg % NXCD, xcd = wgid % NXCD, off = wgid / NXCD; wgid = (xcd < r ? xcd * (q + 1) : r * (q + 1) + (xcd - r) * q) + off; }
        const int nig = WGM * nN, gid = wgid / nig, fm = gid * WGM, gsz = (nM - fm) < WGM ? (nM - fm) : WGM;
        u.pm = fm + ((wgid % nig) % gsz); u.pn = (wgid % nig) / gsz; return true;
    }
    __device__ __forceinline__ void a_ready(const Unit&) const {}
    __device__ __forceinline__ void done(const Unit&) const {}
};

__device__ __forceinline__ unsigned cvt_pk_bf16(float lo, float hi) { unsigned r; asm volatile("v_cvt_pk_bf16_f32 %0, %1, %2" : "=v"(r) : "v"(lo), "v"(hi)); return r; }
template <class Epi, class Sched, bool ALIGN_EPI = false, bool SP2 = false>
__device__ __forceinline__ void gemm_phase(PG8_LAS unsigned char* lds, const Gemm g, const Sched& S, const Epi& E, const int wv) {
    int tid_ = wv * 64 + (int)__builtin_amdgcn_mbcnt_hi(~0u, __builtin_amdgcn_mbcnt_lo(~0u, 0u)); asm volatile("" : "+v"(tid_));
    const int tid = tid_, wid = __builtin_amdgcn_readfirstlane(tid >> 6), lane = tid & 63, wr = wid >> 2, wc = wid & 3, fr = lane & 15, fq = lane >> 4;
    const int K = g.K, nt = K / BK;
    unsigned voffA[2], voffB[2];
#pragma unroll
    for (int i = 0; i < 2; ++i) { int R, C; stage_rc(tid * 16 + i * 8192, R, C); const int Rb = Epi::PERM ? ((R & ~31) + perm32(R & 31)) : R;
        voffA[i] = (unsigned)(R * g.lda + C) * 2u; voffB[i] = (unsigned)(Rb * g.ldb + C) * 2u; }
    const size_t kstep = (size_t)(BK * 2);
    const size_t hstepA = (size_t)HALF * g.lda * 2, hstepB = (size_t)HALF * g.ldb * 2;
    const size_t tstepA = 2 * hstepA, tstepB = 2 * hstepB;
    const unsigned ldsw = (unsigned)wid * 1024u;
    const int aoff = lds_byte(wr * 64 + fr, fq * 8), boff = lds_byte(wc * 32 + fr, fq * 8);
#define PG8_SA(b, h) (((b) * 2 + (h)) * HTB)
#define PG8_SB(b, h) ((4 + (b) * 2 + (h)) * HTB)
#define PG8_STAGE(bufoff, gbase, voff) do { _Pragma("unroll") for (int _i = 0; _i < 2; ++_i) \
        __builtin_amdgcn_global_load_lds((const unsigned*)((const char*)(gbase) + (voff)[_i]), (PG8_LAS unsigned*)(lds + (bufoff) + ldsw + _i * 8192), 16, 0, 0); } while (0)
#define PG8_LDA(dst, b, h) do { _Pragma("unroll") for (int m = 0; m < 4; ++m) _Pragma("unroll") for (int k = 0; k < 2; ++k) dst[m][k] = *(const PG8_LAS bf16x8*)(lds + PG8_SA(b, h) + aoff + m * 2048 + k * 1024); } while (0)
#define PG8_LDB(dst, b, h) do { _Pragma("unroll") for (int n = 0; n < 2; ++n) _Pragma("unroll") for (int k = 0; k < 2; ++k) dst[n][k] = *(const PG8_LAS bf16x8*)(lds + PG8_SB(b, h) + boff + n * 2048 + k * 1024); } while (0)
#define PG8_MMA(ai, bj, At, Bt) do { __builtin_amdgcn_s_setprio(1); _Pragma("unroll") for (int m = 0; m < 4; ++m) _Pragma("unroll") for (int n = 0; n < 2; ++n) _Pragma("unroll") for (int k = 0; k < 2; ++k) \
        acc[ai][bj][m][n] = __builtin_amdgcn_mfma_f32_16x16x32_bf16(Bt[n][k], At[m][k], acc[ai][bj][m][n], 0, 0, 0); __builtin_amdgcn_s_setprio(0); } while (0)
#define PG8_WAIT_V(n) asm volatile("s_waitcnt vmcnt(" #n ")" ::: "memory")
#define PG8_WAIT_L(n) asm volatile("s_waitcnt lgkmcnt(" #n ")" ::: "memory")
#define PG8_BAR __builtin_amdgcn_s_barrier()
#define PG8_SCHED __builtin_amdgcn_sched_barrier(0)
    Unit cur, nxt; int ui = 0;
    if (!S.next(0, cur)) return;
    f32x4 acc[2][2][4][2];
#pragma unroll
    for (int a = 0; a < 2; ++a)
#pragma unroll
        for (int b = 0; b < 2; ++b)
#pragma unroll
            for (int m = 0; m < 4; ++m)
#pragma unroll
                for (int n = 0; n < 2; ++n) acc[a][b][m][n] = (f32x4){0.f, 0.f, 0.f, 0.f};
    bf16x8 At[4][2], B0[2][2], B1[2][2];
    const char* cA = (const char*)g.A + (size_t)cur.pm * tstepA; const char* cB = (const char*)g.Bt + (size_t)cur.pn * tstepB;
    S.a_ready(cur);
    if constexpr (SP2) {
        PG8_STAGE(PG8_SB(0, 0), cB, voffB); PG8_STAGE(PG8_SB(0, 1), cB + hstepB, voffB); PG8_STAGE(PG8_SA(0, 0), cA, voffA); PG8_STAGE(PG8_SA(0, 1), cA + hstepA, voffA);
        if (wr == 1) PG8_BAR;
        PG8_WAIT_V(2); PG8_BAR;
        PG8_STAGE(PG8_SB(1, 0), cB + kstep, voffB); PG8_STAGE(PG8_SA(1, 0), cA + kstep, voffA); PG8_STAGE(PG8_SB(1, 1), cB + hstepB + kstep, voffB);
        PG8_WAIT_V(6); PG8_BAR;
    } else {
        PG8_STAGE(PG8_SB(0, 0), cB, voffB); PG8_STAGE(PG8_SA(0, 0), cA, voffA); PG8_STAGE(PG8_SB(0, 1), cB + hstepB, voffB); PG8_STAGE(PG8_SA(0, 1), cA + hstepA, voffA);
        if (wr == 1) PG8_BAR;
        PG8_WAIT_V(4); PG8_BAR;
        PG8_STAGE(PG8_SB(1, 0), cB + kstep, voffB); PG8_STAGE(PG8_SA(1, 0), cA + kstep, voffA); PG8_STAGE(PG8_SB(1, 1), cB + hstepB + kstep, voffB);
        PG8_WAIT_V(6); PG8_BAR;
    }
    for (;;) {
        const bool has_next = S.next(ui + 1, nxt);
        const char* nA = has_next ? (const char*)g.A + (size_t)nxt.pm * tstepA : cA; const char* nB = has_next ? (const char*)g.Bt + (size_t)nxt.pn * tstepB : cB;
        for (int t = 0; t < nt; t += 2) {
            const bool last = (t == nt - 2);
            const char* a1 = cA + (size_t)(t + 1) * kstep;
            const char* a2 = last ? nA : cA + (size_t)(t + 2) * kstep; const char* b2 = last ? nB : cB + (size_t)(t + 2) * kstep;
            const char* a3 = a2 + kstep; const char* b3 = b2 + kstep;
            if (last && has_next) S.a_ready(nxt);
            if constexpr (Epi::HOOK) { if (t == Epi::HOOK_T) E.mid(acc, cur, wr, wc, fr, fq); }
            if constexpr (SP2) {
            PG8_LDB(B0, 0, 0); PG8_LDB(B1, 0, 1); PG8_SCHED; PG8_LDA(At, 0, 0); PG8_STAGE(PG8_SA(1, 1), a1 + hstepA, voffA);
            PG8_WAIT_V(8); PG8_WAIT_L(0); PG8_BAR; PG8_MMA(0, 0, At, B0); PG8_MMA(0, 1, At, B1); PG8_BAR; PG8_SCHED;
            PG8_LDA(At, 0, 1); PG8_STAGE(PG8_SB(0, 0), b2, voffB); PG8_STAGE(PG8_SB(0, 1), b2 + hstepB, voffB); PG8_STAGE(PG8_SA(0, 0), a2, voffA);
            PG8_WAIT_V(8); PG8_WAIT_L(0); PG8_BAR; PG8_MMA(1, 0, At, B0); PG8_MMA(1, 1, At, B1); PG8_BAR; PG8_SCHED;
            PG8_LDB(B0, 1, 0); PG8_LDB(B1, 1, 1); PG8_SCHED; PG8_LDA(At, 1, 0); PG8_STAGE(PG8_SA(0, 1), a2 + hstepA, voffA);
            PG8_WAIT_V(8); PG8_WAIT_L(0); PG8_BAR; PG8_MMA(0, 0, At, B0); PG8_MMA(0, 1, At, B1); PG8_BAR; PG8_SCHED;
            PG8_LDA(At, 1, 1); PG8_STAGE(PG8_SB(1, 0), b3, voffB); PG8_STAGE(PG8_SB(1, 1), b3 + hstepB, voffB); PG8_STAGE(PG8_SA(1, 0), a3, voffA);
            PG8_WAIT_V(8); PG8_WAIT_L(0); PG8_BAR; PG8_MMA(1, 0, At, B0); PG8_MMA(1, 1, At, B1); PG8_BAR; PG8_SCHED;
            } else {
            PG8_LDB(B0, 0, 0); PG8_SCHED; PG8_LDA(At, 0, 0); PG8_STAGE(PG8_SA(1, 1), a1 + hstepA, voffA);
            PG8_WAIT_L(8); PG8_BAR; PG8_WAIT_L(0); PG8_MMA(0, 0, At, B0); PG8_BAR; PG8_SCHED;
            PG8_LDB(B1, 0, 1); PG8_STAGE(PG8_SB(0, 0), b2, voffB);
            PG8_BAR; PG8_WAIT_L(0); PG8_MMA(0, 1, At, B1); PG8_BAR;
            PG8_LDA(At, 0, 1); PG8_STAGE(PG8_SA(0, 0), a2, voffA);
            PG8_BAR; PG8_WAIT_L(0); PG8_MMA(1, 0, At, B0); PG8_BAR; PG8_SCHED;
            PG8_STAGE(PG8_SB(0, 1), b2 + hstepB, voffB);
            PG8_WAIT_V(6); PG8_BAR; PG8_MMA(1, 1, At, B1); PG8_BAR;
            PG8_LDB(B0, 1, 0); PG8_SCHED; PG8_LDA(At, 1, 0); PG8_STAGE(PG8_SA(0, 1), a2 + hstepA, voffA);
            PG8_WAIT_L(8); PG8_BAR; PG8_WAIT_L(0); PG8_MMA(0, 0, At, B0); PG8_BAR; PG8_SCHED;
            PG8_LDB(B1, 1, 1); PG8_STAGE(PG8_SB(1, 0), b3, voffB);
            PG8_BAR; PG8_WAIT_L(0); PG8_MMA(0, 1, At, B1); PG8_BAR;
            PG8_LDA(At, 1, 1); PG8_STAGE(PG8_SA(1, 0), a3, voffA);
            PG8_BAR; PG8_WAIT_L(0); PG8_MMA(1, 0, At, B0); PG8_BAR; PG8_SCHED;
            PG8_STAGE(PG8_SB(1, 1), b3 + hstepB, voffB);
            PG8_WAIT_V(6); PG8_BAR; PG8_MMA(1, 1, At, B1); PG8_BAR;
            }
        }
        if constexpr (ALIGN_EPI) { if (wr == 0) PG8_BAR; }
        if constexpr (!Epi::AFTER_DRAIN) { E(acc, cur, wr, wc, fr, fq); S.done(cur); }
        if (!has_next) break;
#pragma unroll
        for (int a = 0; a < 2; ++a)
#pragma unroll
            for (int b = 0; b < 2; ++b)
#pragma unroll
                for (int m = 0; m < 4; ++m)
#pragma unroll
                    for (int n = 0; n < 2; ++n) acc[a][b][m][n] = (f32x4){0.f, 0.f, 0.f, 0.f};
        cur = nxt; cA = nA; cB = nB; ++ui;
        if constexpr (ALIGN_EPI) { if (wr == 1) PG8_BAR; }
    }
    PG8_WAIT_V(0);
    if constexpr (!ALIGN_EPI) { if (wr == 0) PG8_BAR; }
    PG8_BAR;
    if constexpr (Epi::AFTER_DRAIN) { E.fused(acc, cur, wr, wc, fr, fq, lds, wid, lane); S.done(cur); }
#undef PG8_SA
#undef PG8_SB
#undef PG8_STAGE
#undef PG8_LDA
#undef PG8_LDB
#undef PG8_MMA
#undef PG8_WAIT_V
#undef PG8_WAIT_L
#undef PG8_BAR
#undef PG8_SCHED
}
}

namespace pg8 {
__device__ __forceinline__ float fsig(float v) { return __builtin_amdgcn_rcpf(1.f + __builtin_amdgcn_exp2f(-1.4426950408889634f * v)); }
__device__ __forceinline__ u32x4 pack8(const f32x4 a, const f32x4 b) { u32x4 w; w.x = cvt_pk_bf16(a[0], a[1]); w.y = cvt_pk_bf16(a[2], a[3]); w.z = cvt_pk_bf16(b[0], b[1]); w.w = cvt_pk_bf16(b[2], b[3]); return w; }
__device__ __forceinline__ void unpack8(const u32x4 w, f32x4& a, f32x4& b) {
    a[0] = __builtin_bit_cast(float, w.x << 16); a[1] = __builtin_bit_cast(float, w.x & 0xffff0000u); a[2] = __builtin_bit_cast(float, w.y << 16); a[3] = __builtin_bit_cast(float, w.y & 0xffff0000u);
    b[0] = __builtin_bit_cast(float, w.z << 16); b[1] = __builtin_bit_cast(float, w.z & 0xffff0000u); b[2] = __builtin_bit_cast(float, w.w << 16); b[3] = __builtin_bit_cast(float, w.w & 0xffff0000u); }
#define PIN16(a) asm volatile("" : "+v"(a[0][0][0]), "+v"(a[0][0][1]), "+v"(a[0][1][0]), "+v"(a[0][1][1]), "+v"(a[0][2][0]), "+v"(a[0][2][1]), "+v"(a[0][3][0]), "+v"(a[0][3][1]), \
    "+v"(a[1][0][0]), "+v"(a[1][0][1]), "+v"(a[1][1][0]), "+v"(a[1][1][1]), "+v"(a[1][2][0]), "+v"(a[1][2][1]), "+v"(a[1][3][0]), "+v"(a[1][3][1]))
__device__ __forceinline__ float dot4(const f32x4 a) { return (a[0] * a[0] + a[1] * a[1]) + (a[2] * a[2] + a[3] * a[3]); }
__device__ __forceinline__ void row_rstd(const float* SS, const Unit& u, int wr, int fr, int fq, float (&rs)[2][4]) {
#pragma unroll
    for (int ai = 0; ai < 2; ++ai)
#pragma unroll
        for (int m = 0; m < 4; ++m) { const size_t row = (size_t)(u.pm * BM + ai * HALF + wr * 64 + m * 16 + fr); const f32x4 p = *(const f32x4*)(SS + row * 16 + 4 * fq);
            float s = (p[0] + p[1]) + (p[2] + p[3]); s += shx(s, fq * 16 + fr, 16); s += shx(s, fq * 16 + fr, 32); rs[ai][m] = 1.0f / sqrtf(s * (1.0f / D) + RMS_EPS); }
}
struct EpiSwigluF { static constexpr bool PERM = true, AFTER_DRAIN = false, HOOK = false; static constexpr int HOOK_T = 0; bf16_t* H; const float* SS;
    __device__ __forceinline__ void operator()(const f32x4 (&acc)[2][2][4][2], const Unit& u, int wr, int wc, int fr, int fq) const {
        const int row0 = u.pm * BM + wr * 64 + fr, col0 = u.pn * 128 + wc * 32 + 8 * fq;
        for (int rp_ = 0; rp_ < 1 + ((REP_MASK >> 6) & 1); ++rp_) {
        float rs[2][4]; row_rstd(SS, u, wr, fr, fq, rs);
#pragma unroll
        for (int ai = 0; ai < 2; ++ai)
#pragma unroll
            for (int m = 0; m < 4; ++m) { bf16_t* rowp = H + (size_t)(row0 + ai * HALF + m * 16) * DFF + col0; const float r = rs[ai][m];
                f32x4 h0, h1;
#pragma unroll
                for (int i = 0; i < 4; ++i) { const float g0 = acc[ai][0][m][0][i] * r, g1 = acc[ai][0][m][1][i] * r; h0[i] = g0 * fsig(g0) * (acc[ai][1][m][0][i] * r); h1[i] = g1 * fsig(g1) * (acc[ai][1][m][1][i] * r); }
                __builtin_nontemporal_store(pack8(h0, h1), (u32x4*)rowp); }
        }
    } };
template <bool FINAL> struct EpiResidB { static constexpr bool PERM = true, AFTER_DRAIN = false, HOOK = false; static constexpr int HOOK_T = 0; bf16_t* XB; float* Of; float* SS; float coef;
    __device__ __forceinline__ void operator()(const f32x4 (&acc)[2][2][4][2], const Unit& u, int wr, int wc, int fr, int fq) const {
        const int row0 = u.pm * BM + wr * 64 + fr, col0 = u.pn * BM + wc * 32 + 8 * fq;
        u32x4 rr[2][4][2];
#pragma unroll
        for (int ai = 0; ai < 2; ++ai)
#pragma unroll
            for (int m = 0; m < 4; ++m)
#pragma unroll
                for (int bj = 0; bj < 2; ++bj) rr[ai][m][bj] = *(const u32x4*)(XB + (size_t)(row0 + ai * HALF + m * 16) * D + col0 + bj * HALF);
        PIN16(rr);
#pragma unroll
        for (int ai = 0; ai < 2; ++ai)
#pragma unroll
            for (int m = 0; m < 4; ++m) { const size_t row = (size_t)(row0 + ai * HALF + m * 16); float ssq = 0.f;
#pragma unroll
                for (int bj = 0; bj < 2; ++bj) { const int c = col0 + bj * HALF; f32x4 r0, r1; unpack8(rr[ai][m][bj], r0, r1);
                    f32x4 v0 = r0 + acc[ai][bj][m][0] * coef, v1 = r1 + acc[ai][bj][m][1] * coef;
                    if (FINAL) { *(f32x4*)(Of + row * D + c) = v0; *(f32x4*)(Of + row * D + c + 4) = v1; }
                    else { const u32x4 w = pack8(v0, v1); *(u32x4*)(XB + row * D + c) = w; unpack8(w, v0, v1); }
                    ssq += dot4(v0) + dot4(v1); }
                ssq += shx(ssq, fq * 16 + fr, 16); ssq += shx(ssq, fq * 16 + fr, 32);
                if (fq == 0) SS[row * 16 + 4 * u.pn + wc] = ssq; }
    } };
struct EpiProjF { static constexpr bool PERM = true, AFTER_DRAIN = false, HOOK = false; static constexpr int HOOK_T = 0; bf16_t* PA; bf16_t* PB; float* SG; const float* SS; const float* fb; const float* ib; const float* mfb;
    __device__ __forceinline__ void operator()(const f32x4 (&acc)[2][2][4][2], const Unit& u, int wr, int wc, int fr, int fq) const {
        const int row0 = u.pm * BM + wr * 64 + fr;
        float rs[2][4]; row_rstd(SS, u, wr, fr, fq, rs);
        if (u.pn < 22) {
            const int act = u.pn < 2 ? 0 : (u.pn < 12 ? 1 : 2); const int col0 = (u.pn < 12 ? u.pn : u.pn - 12) * BM + wc * 32 + 8 * fq;
            bf16_t* base = u.pn < 12 ? PA : PB; const int pitch = u.pn < 12 ? PJA : PJB;
#pragma unroll
            for (int ai = 0; ai < 2; ++ai)
#pragma unroll
                for (int m = 0; m < 4; ++m) { bf16_t* rowp = base + (size_t)(row0 + ai * HALF + m * 16) * pitch + col0; const float r = rs[ai][m] * (act == 0 ? QSCALE2 : 1.0f);
#pragma unroll
                    for (int bj = 0; bj < 2; ++bj) { f32x4 v0 = acc[ai][bj][m][0] * r, v1 = acc[ai][bj][m][1] * r;
                        if (act == 2) {
#pragma unroll
                            for (int i = 0; i < 4; ++i) { v0[i] = fsig(v0[i]); v1[i] = fsig(v1[i]); } }
                        __builtin_nontemporal_store(pack8(v0, v1), (u32x4*)(rowp + bj * HALF)); } }
        } else if (wc == 0 && fq < 2) {
            const f32x4 b0 = fq == 0 ? *(const f32x4*)fb : *(const f32x4*)ib, b1 = fq == 0 ? *(const f32x4*)(fb + 4) : *(const f32x4*)mfb;
#pragma unroll
            for (int ai = 0; ai < 2; ++ai)
#pragma unroll
                for (int m = 0; m < 4; ++m) { float* sp = SG + (size_t)(row0 + ai * HALF + m * 16) * 16 + 8 * fq; const float r = rs[ai][m];
                    f32x4 v0 = acc[ai][0][m][0] * r + b0, v1 = acc[ai][0][m][1] * r + b1;
#pragma unroll
                    for (int i = 0; i < 4; ++i) { if (fq == 0) v0[i] = logsigmoidf_(v0[i]); v1[i] = logsigmoidf_(v1[i]); }
                    *(f32x4*)sp = v0; *(f32x4*)(sp + 4) = v1; }
        }
    } };
struct EpiMergeF { static constexpr bool PERM = true, AFTER_DRAIN = false, HOOK = true; static constexpr int HOOK_T = 8; const bf16_t* PB; bf16_t* MG;
    __device__ __forceinline__ void mid(f32x4 (&acc)[2][2][4][2], const Unit& u, int wr, int wc, int fr, int fq) const {
        int row0 = u.pm * BM + wr * 64 + fr, col0 = u.pn * BM + wc * 32 + 8 * fq; asm volatile("" : "+v"(row0), "+v"(col0));
#pragma unroll
        for (int ai = 0; ai < 2; ++ai) {
            u32x4 gg[2][4][2];
#pragma unroll
            for (int m = 0; m < 4; ++m)
#pragma unroll
                for (int bj = 0; bj < 2; ++bj) { const bf16_t* rowp = PB + (size_t)(row0 + ai * HALF + m * 16) * PJB + col0 + bj * HALF; gg[0][m][bj] = *(const u32x4*)(rowp + PB_GA); gg[1][m][bj] = *(const u32x4*)(rowp + PB_GB); }
            PIN16(gg);
#pragma unroll
            for (int m = 0; m < 4; ++m) {
#pragma unroll
                for (int bj = 0; bj < 2; ++bj) { f32x4 a0, a1, b0, b1; unpack8(gg[0][m][bj], a0, a1); unpack8(gg[1][m][bj], b0, b1);
#pragma unroll
                    for (int i = 0; i < 4; ++i) { acc[ai][bj][m][0][i] *= a0[i] * __builtin_amdgcn_rcpf(fmaxf(b0[i], 1e-30f)); acc[ai][bj][m][1][i] *= a1[i] * __builtin_amdgcn_rcpf(fmaxf(b1[i], 1e-30f)); } } } }
    }
    __device__ __forceinline__ void operator()(const f32x4 (&acc)[2][2][4][2], const Unit& u, int wr, int wc, int fr, int fq) const {
        const int row0 = u.pm * BM + wr * 64 + fr, col0 = u.pn * BM + wc * 32 + 8 * fq;
        u32x4 gb[2][4][2];
#pragma unroll
        for (int ai = 0; ai < 2; ++ai)
#pragma unroll
            for (int m = 0; m < 4; ++m)
#pragma unroll
                for (int bj = 0; bj < 2; ++bj) gb[ai][m][bj] = *(const u32x4*)(PB + (size_t)(row0 + ai * HALF + m * 16) * PJB + PB_GB + col0 + bj * HALF);
        PIN16(gb);
#pragma unroll
        for (int ai = 0; ai < 2; ++ai)
#pragma unroll
            for (int m = 0; m < 4; ++m) { const size_t row = (size_t)(row0 + ai * HALF + m * 16);
#pragma unroll
                for (int bj = 0; bj < 2; ++bj) { const int c = col0 + bj * HALF; f32x4 b0, b1; unpack8(gb[ai][m][bj], b0, b1);
                    *(u32x4*)(MG + row * D + c) = pack8(b0 * acc[ai][bj][m][0], b1 * acc[ai][bj][m][1]); } }
    } };
}

__device__ __forceinline__ void transpose_item(const float* W, int N, int scol0, bf16* WT, int ldt, int drow0, int k0, int kdst0, LAS float* scr, int lane, const float* gain) {
#pragma unroll 8
    for (int i = 0; i < 32; ++i) { const int kk = 2 * i + (lane >> 5); const float gk = gain ? gain[k0 + kk] : 1.0f; scr[kk * 33 + (lane & 31)] = W[(size_t)(k0 + kk) * N + scol0 + (lane & 31)] * gk; }
    asm volatile("s_waitcnt lgkmcnt(0)" ::: "memory");
    const int c = lane & 7;
#pragma unroll
    for (int j = 0; j < 4; ++j) { const int n = (lane >> 3) + 8 * j; const LAS float* s = scr + (8 * c) * 33 + n;
        v4u o; o.x = pk2(s[0 * 33], s[1 * 33]); o.y = pk2(s[2 * 33], s[3 * 33]); o.z = pk2(s[4 * 33], s[5 * 33]); o.w = pk2(s[6 * 33], s[7 * 33]);
        *(GAS v4u*)(WT + (size_t)(drow0 + n) * ldt + kdst0 + k0 + 8 * c) = o; }
    asm volatile("s_waitcnt lgkmcnt(0)" ::: "memory");
}
__device__ __forceinline__ void phase_weights(Frame& F) {
    const int ptid = opaque_tid(F.wave), plane = ptid & 63, pwave = __builtin_amdgcn_readfirstlane(ptid >> 6); (void)plane; (void)pwave;
    LAS float* scr = (LAS float*)(F.lds + pwave * 16384);
    const int gw = blockIdx.x * NWAVES + pwave, NGW = F.G * NWAVES;
    constexpr int PJ = PJA + PJB; constexpr int I_IN = (D / 64) * (NFF / 32), I_OUT = (DFF / 64) * (D / 32), I_PJ = (D / 64) * (PJ / 32), I_UP = (512 / 64) * (D / 32), I_WO = (D / 64) * (D / 32);
    constexpr int NITEMS = 2 * I_IN + 2 * I_OUT + I_PJ + 2 * I_UP + I_WO;
    for (int it = gw; it < NITEMS; it += NGW) {
        int r = it;
        if (r < 2 * I_IN) { const int which = r / I_IN; r -= which * I_IN; const int ndb = NFF / 32, kb = r / ndb, db = r % ndb, n = db * 32, pn = n >> 8, j = n & 255;
            const int sc = (j < 128) ? pn * 128 + j : DFF + pn * 128 + (j - 128);
            transpose_item(F.in[which ? 15 : 2], NFF, sc, (bf16*)(F.ws + (which ? WS_W2IN : WS_W1IN)), D, n, kb * 64, 0, scr, plane, F.in[which ? 14 : 1]); continue; }
        r -= 2 * I_IN;
        if (r < 2 * I_OUT) { const int which = r / I_OUT; r -= which * I_OUT; const int ndb = D / 32, kb = r / ndb, db = r % ndb;
            transpose_item(F.in[which ? 16 : 3], D, db * 32, (bf16*)(F.ws + (which ? WS_W2OUT : WS_W1OUT)), DFF, db * 32, kb * 64, 0, scr, plane, nullptr); continue; }
        r -= 2 * I_OUT;
        if (r < I_PJ) { const int ndb = PJ / 32, kb = r / ndb, db = r % ndb, n = db * 32; const int sc = n + (n < 1536 ? 0 : (n < 3072 ? 8 : 16));
            transpose_item(F.in[5], INC, sc, (bf16*)(F.ws + WS_WIN), D, n, kb * 64, 0, scr, plane, F.in[4]); continue; }
        r -= I_PJ;
        if (r < 2 * I_UP) { const int which = r / I_UP; r -= which * I_UP; const int ndb = D / 32, kb = r / ndb, db = r % ndb;
            transpose_item(F.in[which ? 12 : 11], D, db * 32, (bf16*)(F.ws + WS_WCAT), D, db * 32, kb * 64, which ? 512 : 0, scr, plane, nullptr); continue; }
        r -= 2 * I_UP;
        { const int ndb = D / 32, kb = r / ndb, db = r % ndb; transpose_item(F.in[13], D, db * 32, (bf16*)(F.ws + WS_WOUT), D, db * 32, kb * 64, 0, scr, plane, nullptr); }
    }
    { bf16* WT = (bf16*)(F.ws + WS_WIN); const float* W = F.in[5];
      for (int idx = blockIdx.x * NTHR + ptid; idx < 256 * 128; idx += F.G * NTHR) { const int row = idx >> 7, k8 = (idx & 127) * 8; v4u o = {0u, 0u, 0u, 0u};
          if (row < 16) { const int sc = row < 8 ? 1536 + row : (row < 12 ? 3080 + (row - 8) : 3084 + (row - 12)); float v[8];
#pragma unroll
              for (int i = 0; i < 8; ++i) v[i] = W[(size_t)(k8 + i) * INC + sc] * F.in[4][k8 + i];
              o.x = pk2(v[0], v[1]); o.y = pk2(v[2], v[3]); o.z = pk2(v[4], v[5]); o.w = pk2(v[6], v[7]); }
          *(GAS v4u*)(WT + (size_t)(PJ + row) * D + k8) = o; } }
}

#include <hip/hip_bf16.h>
#include <cmath>
namespace attn_body {
using bf16=__hip_bfloat16;
using bf16x8=__attribute__((ext_vector_type(8)))short;
using s16x4=__attribute__((ext_vector_type(4)))short;
using f32x16=__attribute__((ext_vector_type(16)))float;
using u32x4=__attribute__((ext_vector_type(4)))unsigned;
constexpr int BATCH=32,NHEAD=8,SEQ=2048,D=64,DM=3072,OP=1024;
constexpr int NW=8,QBLK=32,QB=QBLK*NW,KVBLK=64,NQB=SEQ/QB;
constexpr int ATTN_PITCH=DM, ATTN_UNIT_ROWS=QB;
__device__ __forceinline__ int crow(int r,int hi){return (r&3)+8*(r>>2)+4*hi;}
#define SBAR() __builtin_amdgcn_sched_barrier(0)
__device__ __forceinline__ void cmask(f32x16&p0,f32x16&p1,int jb,int qrel,int hi){
  const float NEG=-INFINITY; int kb=64*jb+4*hi;
  #pragma unroll
  for(int r=0;r<16;++r){int kv=kb+(r&3)+8*(r>>2); if(kv>qrel)p0[r]=NEG; if(kv+32>qrel)p1[r]=NEG;}
}

constexpr int NSLOT=3, SLOTB=8192;
constexpr int LDS_K=0, LDS_V=NSLOT*SLOTB, LDS_WS=2*NSLOT*SLOTB, LDS_OST=LDS_WS+NW*64*4, LDS_BIAS=LDS_OST+NW*4096, LDS_ROWB=LDS_BIAS+SEQ*8, LDS_BYTES=LDS_ROWB+QB*4;
constexpr float C2=0.125f*1.4426950408889634f;
__device__ __forceinline__ void glds16(const void*gsrc,unsigned lds_dst){unsigned keep;
  asm volatile("s_mov_b32 %0, m0\n\ts_mov_b32 m0, %2\n\ts_nop 0\n\tglobal_load_lds_dwordx4 %1, off\n\ts_mov_b32 m0, %0":"=&s"(keep):"v"(gsrc),"s"(lds_dst):"memory");}
__device__ __forceinline__ float max3f(float a,float b,float c){float r;asm("v_max3_f32 %0, %1, %2, %3":"=v"(r):"v"(a),"v"(b),"v"(c));return r;}
__device__ __forceinline__ float max2f(float a,float b){float r;asm("v_max_f32_e32 %0, %1, %2":"=v"(r):"v"(a),"v"(b));return r;}
__device__ __forceinline__ float fadd_s(float a,float b){float r;asm("v_add_f32_e32 %0, %1, %2":"=v"(r):"v"(a),"v"(b));return r;}
__device__ __forceinline__ float fsub_s(float a,float b){float r;asm("v_sub_f32_e32 %0, %1, %2":"=v"(r):"v"(a),"v"(b));return r;}
typedef float f32x2_t __attribute__((ext_vector_type(2))); typedef __bf16 bf16x2_t __attribute__((ext_vector_type(2)));
__device__ __forceinline__ unsigned cvtpk_s(float lo,float hi){f32x2_t v={lo,hi};bf16x2_t b=__builtin_convertvector(v,bf16x2_t);return __builtin_bit_cast(unsigned,b);}
#define WAIT_BAR(N) asm volatile("s_waitcnt vmcnt(" #N ") lgkmcnt(0)\n\ts_barrier":::"memory")

__device__ __forceinline__ void qkt(f32x16&p0,f32x16&p1,const char*Kslot,const bf16x8*qr,int r32,int hi,bf16x8 kx0,bf16x8 kx1,bf16x8 qx){
  const char*kb=Kslot+hi*1024+r32*16;
  #pragma unroll
  for(int d0=0;d0<4;++d0){
    const bf16x8 b0=*reinterpret_cast<const bf16x8*>(kb+d0*2048);
    const bf16x8 b1=*reinterpret_cast<const bf16x8*>(kb+d0*2048+512);
    if(d0==0){p0=__builtin_amdgcn_mfma_f32_32x32x16_bf16(b0,qr[0],f32x16{},0,0,0);p1=__builtin_amdgcn_mfma_f32_32x32x16_bf16(b1,qr[0],f32x16{},0,0,0);}
    else{p0=__builtin_amdgcn_mfma_f32_32x32x16_bf16(b0,qr[d0],p0,0,0,0);p1=__builtin_amdgcn_mfma_f32_32x32x16_bf16(b1,qr[d0],p1,0,0,0);}}
  p0=__builtin_amdgcn_mfma_f32_32x32x16_bf16(kx0,qx,p0,0,0,0);p1=__builtin_amdgcn_mfma_f32_32x32x16_bf16(kx1,qx,p1,0,0,0);
}
typedef __attribute__((address_space(3))) const char* lds_cptr;
typedef short v4i16_t __attribute__((ext_vector_type(4)));
__device__ __forceinline__ void kload8(bf16x8*kf,lds_cptr kp){
  kf[0]=*(const __attribute__((address_space(3))) bf16x8*)(kp);      kf[1]=*(const __attribute__((address_space(3))) bf16x8*)(kp+512);
  kf[2]=*(const __attribute__((address_space(3))) bf16x8*)(kp+2048); kf[3]=*(const __attribute__((address_space(3))) bf16x8*)(kp+2560);
  kf[4]=*(const __attribute__((address_space(3))) bf16x8*)(kp+4096); kf[5]=*(const __attribute__((address_space(3))) bf16x8*)(kp+4608);
  kf[6]=*(const __attribute__((address_space(3))) bf16x8*)(kp+6144); kf[7]=*(const __attribute__((address_space(3))) bf16x8*)(kp+6656);
}
__device__ __forceinline__ void kload2(bf16x8*kf,lds_cptr kp,int j){ kf[2*j]=*(const __attribute__((address_space(3))) bf16x8*)(kp+j*2048); kf[2*j+1]=*(const __attribute__((address_space(3))) bf16x8*)(kp+j*2048+512); }
typedef unsigned u32x2_t __attribute__((ext_vector_type(2)));
__device__ __forceinline__ bf16x8 kxfrag(lds_cptr tbl,int kv,int hi){ u32x2_t b=*(const __attribute__((address_space(3))) u32x2_t*)(tbl+kv*8); if(hi){b.x=0u;b.y=0u;} const u32x4 w={b.x,b.y,hi?0u:0x3F803F80u,0u}; return __builtin_bit_cast(bf16x8,w); }
__device__ __forceinline__ s16x4 vtr(lds_cptr p){ return __builtin_bit_cast(s16x4,__builtin_amdgcn_ds_read_tr16_b64_v4i16((__attribute__((address_space(3))) v4i16_t*)p)); }
__device__ __forceinline__ float rowmax(const f32x16&p0,const f32x16&p1){
  float a=max3f(p0[0],p0[1],p1[0]),b=max3f(p0[2],p0[3],p1[1]);a=max3f(a,p1[2],p1[3]);
  #pragma unroll
  for(int r=4;r<16;r+=4){a=max3f(a,p0[r],p0[r+1]);b=max3f(b,p0[r+2],p0[r+3]);a=max3f(a,p1[r],p1[r+1]);b=max3f(b,p1[r+2],p1[r+3]);}
  const float m=max2f(a,b);
  auto rr=__builtin_amdgcn_permlane32_swap(__float_as_uint(m),__float_as_uint(m),false,false);
  return max2f(__uint_as_float(rr[0]),__uint_as_float(rr[1]));
}
__device__ __forceinline__ void pv(f32x16*o,int vb,bf16x8 pa0,bf16x8 pa1,bf16x8 pa2,bf16x8 pa3){
  #pragma unroll
  for(int d0=0;d0<2;++d0){s16x4 lo[4],hi[4];
    #pragma unroll
    for(int ks=0;ks<4;++ks){
      asm volatile("ds_read_b64_tr_b16 %0,%1 offset:%c2":"=&v"(lo[ks]):"v"(vb),"i"(d0*4096+ks*1024):"memory");
      asm volatile("ds_read_b64_tr_b16 %0,%1 offset:%c2":"=&v"(hi[ks]):"v"(vb),"i"(d0*4096+ks*1024+512):"memory");}
    asm volatile("s_waitcnt lgkmcnt(0)":::"memory");SBAR();
    #define PK(k) (bf16x8){lo[k][0],lo[k][1],lo[k][2],lo[k][3],hi[k][0],hi[k][1],hi[k][2],hi[k][3]}
    o[d0]=__builtin_amdgcn_mfma_f32_32x32x16_bf16(pa0,PK(0),o[d0],0,0,0);
    o[d0]=__builtin_amdgcn_mfma_f32_32x32x16_bf16(pa1,PK(1),o[d0],0,0,0);
    o[d0]=__builtin_amdgcn_mfma_f32_32x32x16_bf16(pa2,PK(2),o[d0],0,0,0);
    o[d0]=__builtin_amdgcn_mfma_f32_32x32x16_bf16(pa3,PK(3),o[d0],0,0,0);
    #undef PK
  }
}

#ifndef ATTN_STORE16
#define ATTN_STORE16(p,v) (*(u32x4*)(p)=(v))
#endif
template<int THRL> __device__ __forceinline__ void attn_unit(int b,int h,int qb,const bf16*Q,const bf16*__restrict__ K,const bf16*__restrict__ V,bf16*O,const float*CUMh,char*shm,const int wv){
  int tid_=wv*64+(int)__builtin_amdgcn_mbcnt_hi(~0u,__builtin_amdgcn_mbcnt_lo(~0u,0u)); asm volatile("":"+v"(tid_)); const int tid=tid_,lane=tid&63,r32=lane&31,hi=lane>>5; const int wid=__builtin_amdgcn_readfirstlane(tid>>6);
  const long rowbase=(long)b*SEQ; const int q0=qb*QB;
  const bf16*Qw=Q+(rowbase+q0+wid*QBLK)*DM+h*D;
  const bf16*Kh=K+rowbase*DM+h*D,*Vh=V+rowbase*DM+h*D;
  const unsigned lds0=(unsigned)(uintptr_t)shm;
  float*wsf=(float*)(shm+LDS_WS)+wid*64;
  const bf16*ksrc=Kh+(long)lane*DM+wid*8;
  const bf16*vsrc=Vh+(long)(16*(wid&3)+(lane>>2))*DM+(wid>>2)*32+(lane&3)*8;
  const unsigned kdst=lds0+LDS_K+wid*1024, vdst=lds0+LDS_V+wid*1024;
  #define DMA_K(t,slot) glds16(ksrc+(long)(t)*KVBLK*DM,(unsigned)__builtin_amdgcn_readfirstlane(kdst+(slot)))
  #define DMA_V(t,slot) glds16(vsrc+(long)(t)*KVBLK*DM,(unsigned)__builtin_amdgcn_readfirstlane(vdst+(slot)))
  const int vb0=(int)(lds0+LDS_V)+((lane>>4)&1)*32+(lane&3)*8+(4*hi+((lane&15)>>2))*64;
  const char*Kbase=shm+LDS_K; bf16x8 kf[8];
  const lds_cptr shm3=(lds_cptr)shm; const lds_cptr kp0=shm3+LDS_K+hi*1024+r32*16; const lds_cptr vp0=shm3+LDS_V+((lane>>4)&1)*32+(lane&3)*8+(4*hi+((lane&15)>>2))*64;
  const int NT=(q0+QB)/KVBLK;
  DMA_K(0,0);DMA_V(0,0);DMA_K(1,SLOTB);
  bf16x8 qr[4];
  #pragma unroll
  for(int d0=0;d0<4;++d0)qr[d0]=*reinterpret_cast<const bf16x8*>(&Qw[(long)r32*DM+d0*16+hi*8]);
  const int qrel=wid*QBLK+r32;
  { const float cref=CUMh[q0]; __attribute__((address_space(3))) unsigned*bt=(__attribute__((address_space(3))) unsigned*)(shm3+LDS_BIAS); __attribute__((address_space(3))) float*rb=(__attribute__((address_space(3))) float*)(shm3+LDS_ROWB);
    for(int kv=tid;kv<q0+QB;kv+=NW*64){ const float bias=(cref-CUMh[kv])*1.4426950408889634f;
      const unsigned u1=__builtin_bit_cast(unsigned,bias); const unsigned h1=(u1+0x7fffu+((u1>>16)&1u))&0xffff0000u; const float r1=bias-__builtin_bit_cast(float,h1);
      const unsigned u2=__builtin_bit_cast(unsigned,r1);   const unsigned h2=(u2+0x7fffu+((u2>>16)&1u))&0xffff0000u; const float r2=r1-__builtin_bit_cast(float,h2);
      const unsigned u3=__builtin_bit_cast(unsigned,r2);   const unsigned h3=(u3+0x7fffu+((u3>>16)&1u))&0xffff0000u;
      bt[2*kv]=(h1>>16)|h2; bt[2*kv+1]=(h3>>16)|0x3F800000u; if(kv>=q0)rb[kv-q0]=bias; } }
  const lds_cptr btab=shm3+LDS_BIAS; u32x4 qxw={hi?0u:0x3F803F80u,0u,0u,0u};
  #define QX __builtin_bit_cast(bf16x8,qxw)
  #define RNEHI(u) (((u)+0x7fffu+(((u)>>16)&1u))&0xffff0000u)
  #define SETQX() do{ const float nm_=-mhat; const unsigned a1_=RNEHI(__builtin_bit_cast(unsigned,nm_)); const float s1_=nm_-__builtin_bit_cast(float,a1_); \
      const unsigned a2_=RNEHI(__builtin_bit_cast(unsigned,s1_)); const float s2_=s1_-__builtin_bit_cast(float,a2_); const unsigned a3_=RNEHI(__builtin_bit_cast(unsigned,s2_)); \
      qxw.y=hi?0u:(a1_|0x3F80u); qxw.z=hi?0u:((a2_>>16)|a3_); }while(0)
  float mhat=0.f,l_reg=0.f;f32x16 o[2];o[0]=f32x16{};o[1]=f32x16{};
  #define CMASK(P0,P1,t) do{int jb_=(t)-(NT-4); if(jb_>=0)cmask(P0,P1,jb_,qrel,hi);}while(0)
  bool resc=false;
  #define START(P0,P1) do{ const float rm=rowmax(P0,P1); resc=false; \
    { const float dl=max2f(rm,0.f); mhat=fadd_s(mhat,dl); \
      _Pragma("unroll") for(int r=0;r<16;++r){P0[r]=fsub_s(P0[r],dl);P1[r]=fsub_s(P1[r],dl);} \
      SETQX(); } \
    _Pragma("unroll") for(int r=0;r<16;++r)P0[r]=__builtin_amdgcn_exp2f(P0[r]); }while(0)
  #define RESC() do{ if(resc){ asm volatile("s_waitcnt lgkmcnt(0)":::"memory"); \
      _Pragma("unroll") for(int d_=0;d_<2;++d_) _Pragma("unroll") for(int r=0;r<16;++r)o[d_][r]*=wsf[crow(r,hi)]; } }while(0)
  f32x16 pA0,pA1,pB0,pB1;
  int sl_prev=0,sl_cur=0,sl_next=SLOTB;
  #define ROT() do{sl_prev=sl_cur;sl_cur=sl_next;sl_next=(sl_next==(NSLOT-1)*SLOTB)?0:sl_next+SLOTB;}while(0)
  DMA_K(2,2*SLOTB);
  WAIT_BAR(3);
  mhat=*(const __attribute__((address_space(3))) float*)(shm3+LDS_ROWB+qrel*4);
  SETQX();
  qkt(pA0,pA1,Kbase,qr,r32,hi,kxfrag(btab,r32,hi),kxfrag(btab,32+r32,hi),QX);asm volatile("s_nop 15\n\ts_nop 7":"+v"(pA0),"+v"(pA1));CMASK(pA0,pA1,0);
  START(pA0,pA1);
  _Pragma("unroll") for(int r=0;r<16;++r)pA1[r]=__builtin_amdgcn_exp2f(pA1[r]);
  WAIT_BAR(0);
  DMA_K(3,0);DMA_V(1,SLOTB);
  ROT();
  kload8(kf,kp0+sl_cur);
  WAIT_BAR(2);
  s16x4 vlo[8],vhi[8]; u32x4 pw0,pw1,pw2,pw3;
  #define PKW(P,B) cvtpk_s(P[B],P[B+1])
  #define PAF(k) __builtin_bit_cast(bf16x8,pw##k)
  #define VFR(i) (bf16x8){vlo[i][0],vlo[i][1],vlo[i][2],vlo[i][3],vhi[i][0],vhi[i][1],vhi[i][2],vhi[i][3]}
  #define PIN(x) asm volatile("":"+v"(x))
  #define MX3(a,b,c) __builtin_fmaxf(__builtin_fmaxf((a),(b)),(c))
  #define GAPA(MF,A0,A1,A2,A3,W0,W1,PW) do{ MF; sacc+=A0; sacc+=A1; sacc+=A2; sacc+=A3; PIN(sacc); W0; W1; PIN(PW); SBAR(); }while(0)
  #define EX(v) __builtin_amdgcn_exp2f(v)
  #define GAPB(MF,X,B) do{ MF; X[B]=EX(X[B]); X[B+1]=EX(X[B+1]); X[B+2]=EX(X[B+2]); X[B+3]=EX(X[B+3]); PIN(X); SBAR(); }while(0)
  #define VRD(i) do{ vlo[i]=vtr(vp_+(((i)>>2)*4096+((i)&3)*1024)); vhi[i]=vtr(vp_+(((i)>>2)*4096+((i)&3)*1024+512)); }while(0)
  #define KRD(G,j) do{ if(G){ kload2(kf,kp0+sl_next,j); SBAR(); } }while(0)
  #define STEP(C0,C1,P0,P1,t,GK,GV,GL) do{ SBAR(); \
    const lds_cptr vp_=vp0+sl_prev; \
    const bf16x8 kx0_=kxfrag(btab,64*(t)+r32,hi), kx1_=kxfrag(btab,64*(t)+32+r32,hi); \
    VRD(0); SBAR(); float sacc=(P0[0]+P0[1]); \
    GAPA(C0=__builtin_amdgcn_mfma_f32_32x32x16_bf16(kf[0],qr[0],f32x16{},0,0,0), P0[2],P0[3],P0[4],P0[5],     pw0[0]=PKW(P0,0), pw0[1]=PKW(P0,2), pw0); \
    VRD(4); SBAR(); GAPA(C1=__builtin_amdgcn_mfma_f32_32x32x16_bf16(kf[1],qr[0],f32x16{},0,0,0), P0[6],P0[7],P0[8],P0[9],     pw0[2]=PKW(P0,4), pw0[3]=PKW(P0,6), pw0); \
    VRD(1); SBAR(); GAPA(C0=__builtin_amdgcn_mfma_f32_32x32x16_bf16(kf[2],qr[1],C0,0,0,0),   P0[10],P0[11],P0[12],P0[13], pw1[0]=PKW(P0,8), pw1[1]=PKW(P0,10), pw1); \
    VRD(5); SBAR(); GAPA(C1=__builtin_amdgcn_mfma_f32_32x32x16_bf16(kf[3],qr[1],C1,0,0,0),   P0[14],P0[15],P1[0],P1[1],   pw1[2]=PKW(P0,12),pw1[3]=PKW(P0,14), pw1); \
    VRD(2); SBAR(); GAPA(C0=__builtin_amdgcn_mfma_f32_32x32x16_bf16(kf[4],qr[2],C0,0,0,0),   P1[2],P1[3],P1[4],P1[5],     pw2[0]=PKW(P1,0), pw2[1]=PKW(P1,2), pw2); \
    VRD(6); SBAR(); GAPA(C1=__builtin_amdgcn_mfma_f32_32x32x16_bf16(kf[5],qr[2],C1,0,0,0),   P1[6],P1[7],P1[8],P1[9],     pw2[2]=PKW(P1,4), pw2[3]=PKW(P1,6), pw2); \
    VRD(3); SBAR(); GAPA(C0=__builtin_amdgcn_mfma_f32_32x32x16_bf16(kf[6],qr[3],C0,0,0,0),   P1[10],P1[11],P1[12],P1[13], pw3[0]=PKW(P1,8), pw3[1]=PKW(P1,10), pw3); \
    VRD(7); SBAR(); GAPA(C1=__builtin_amdgcn_mfma_f32_32x32x16_bf16(kf[7],qr[3],C1,0,0,0),   P1[14],P1[15],0.f,0.f,       pw3[2]=PKW(P1,12),pw3[3]=PKW(P1,14), pw3); \
    C0=__builtin_amdgcn_mfma_f32_32x32x16_bf16(kx0_,QX,C0,0,0,0); C1=__builtin_amdgcn_mfma_f32_32x32x16_bf16(kx1_,QX,C1,0,0,0); SBAR(); \
    l_reg+=sacc; \
    if(GK){DMA_K((t)+3,sl_cur);} if(GV){DMA_V((t)+1,sl_next);} \
    CMASK(C0,C1,t); \
    { float a=MX3(C0[0],C0[1],C1[0]),b=MX3(C0[2],C0[3],C1[1]); a=MX3(a,C1[2],C1[3]); \
      _Pragma("unroll") for(int r=4;r<16;r+=4){a=MX3(a,C0[r],C0[r+1]);b=MX3(b,C0[r+2],C0[r+3]);a=MX3(a,C1[r],C1[r+1]);b=MX3(b,C1[r+2],C1[r+3]);} \
      float rm=__builtin_fmaxf(a,b); { auto rr=__builtin_amdgcn_permlane32_swap(__float_as_uint(rm),__float_as_uint(rm),false,false); rm=__builtin_fmaxf(__uint_as_float(rr[0]),__uint_as_float(rr[1])); } \
      resc=false; \
      if(__builtin_expect(__any(rm>(float)THRL),0)){ const float dl=__builtin_fmaxf(rm,0.f); mhat+=dl; \
        _Pragma("unroll") for(int r=0;r<16;++r){C0[r]-=dl;C1[r]-=dl;} \
        SETQX(); \
        const float f=__builtin_amdgcn_exp2f(-dl); l_reg*=f; if(hi==0)wsf[r32]=f; resc=true; } } \
    SBAR(); \
    GAPB(o[0]=__builtin_amdgcn_mfma_f32_32x32x16_bf16(PAF(0),VFR(0),o[0],0,0,0), C0,0); \
    GAPB(o[1]=__builtin_amdgcn_mfma_f32_32x32x16_bf16(PAF(0),VFR(4),o[1],0,0,0), C0,4); \
    KRD(GL,0); GAPB(o[0]=__builtin_amdgcn_mfma_f32_32x32x16_bf16(PAF(1),VFR(1),o[0],0,0,0), C0,8); \
    KRD(GL,1); GAPB(o[1]=__builtin_amdgcn_mfma_f32_32x32x16_bf16(PAF(1),VFR(5),o[1],0,0,0), C0,12); \
    KRD(GL,2); GAPB(o[0]=__builtin_amdgcn_mfma_f32_32x32x16_bf16(PAF(2),VFR(2),o[0],0,0,0), C1,0); \
    KRD(GL,3); GAPB(o[1]=__builtin_amdgcn_mfma_f32_32x32x16_bf16(PAF(2),VFR(6),o[1],0,0,0), C1,4); \
    GAPB(o[0]=__builtin_amdgcn_mfma_f32_32x32x16_bf16(PAF(3),VFR(3),o[0],0,0,0), C1,8); \
    GAPB(o[1]=__builtin_amdgcn_mfma_f32_32x32x16_bf16(PAF(3),VFR(7),o[1],0,0,0), C1,12); \
    }while(0)
  int t=1;
  #undef CMASK
  #define CMASK(P0,P1,t) do{}while(0)
  for(;t+5<NT;t+=2){
    STEP(pB0,pB1,pA0,pA1,t,true,true,true);     WAIT_BAR(2); RESC(); ROT();
    STEP(pA0,pA1,pB0,pB1,t+1,true,true,true);   WAIT_BAR(2); RESC(); ROT();
  }
  #undef CMASK
  #define CMASK(P0,P1,t) do{int jb_=(t)-(NT-4); if(jb_>=0)cmask(P0,P1,jb_,qrel,hi);}while(0)
  #define ENDW(tt) do{ if((tt)+3<NT){WAIT_BAR(2);} else if((tt)+2<NT){WAIT_BAR(1);} else {WAIT_BAR(0);} }while(0)
  for(;t+1<NT;t+=2){
    STEP(pB0,pB1,pA0,pA1,t,(t+3<NT),(t+1<NT),(t+1<NT));       ENDW(t);   RESC(); ROT();
    STEP(pA0,pA1,pB0,pB1,t+1,(t+4<NT),(t+2<NT),(t+2<NT));     ENDW(t+1); RESC(); ROT();
  }
  STEP(pB0,pB1,pA0,pA1,NT-1,false,false,false); RESC();
  { float sacc=pB0[0]+pB0[1]; _Pragma("unroll") for(int r=2;r<16;++r)sacc+=pB0[r]; _Pragma("unroll") for(int r=0;r<16;++r)sacc+=pB1[r]; l_reg+=sacc;
    pw0=(u32x4){PKW(pB0,0),PKW(pB0,2),PKW(pB0,4),PKW(pB0,6)};pw1=(u32x4){PKW(pB0,8),PKW(pB0,10),PKW(pB0,12),PKW(pB0,14)};pw2=(u32x4){PKW(pB1,0),PKW(pB1,2),PKW(pB1,4),PKW(pB1,6)};pw3=(u32x4){PKW(pB1,8),PKW(pB1,10),PKW(pB1,12),PKW(pB1,14)};
    SBAR(); pv(o,vb0+sl_cur,PAF(0),PAF(1),PAF(2),PAF(3)); }
  #undef PKW
  #undef PAF
  #undef VFR
  #undef PIN
  #undef MX3
  #undef GAPA
  #undef GAPB
  #undef EX
  #undef VRD
  #undef KRD
  #undef STEP
  #undef ENDW
  {auto rr=__builtin_amdgcn_permlane32_swap(__float_as_uint(l_reg),__float_as_uint(l_reg),false,false);l_reg=__uint_as_float(rr[0])+__uint_as_float(rr[1]);}
  if(hi==0)wsf[32+r32]=l_reg;asm volatile("s_waitcnt lgkmcnt(0)":::"memory");
  float rli[16];
  #pragma unroll
  for(int r=0;r<16;++r)rli[r]=__builtin_amdgcn_rcpf(wsf[32+crow(r,hi)]);
  bf16*Ow=O+(rowbase+q0+wid*QBLK)*OP+h*D;
  { bf16*stg=(bf16*)(shm+LDS_OST)+wid*2048;
    #pragma unroll
    for(int r=0;r<16;++r){const int orow=crow(r,hi);
      #pragma unroll
      for(int d0=0;d0<2;++d0)stg[orow*64+d0*32+r32]=__float2bfloat16(o[d0][r]*rli[r]);}
    asm volatile("s_waitcnt lgkmcnt(0)":::"memory");
    #pragma unroll
    for(int i=0;i<4;++i){const int row=i*8+(lane>>3),ch=lane&7; const u32x4 v=*(const u32x4*)(stg+row*64+ch*8); ATTN_STORE16(Ow+(long)row*OP+ch*8,v);} }
  asm volatile("s_waitcnt lgkmcnt(0)\n\ts_barrier":::"memory");
  #undef DMA_K
  #undef QX
  #undef RNEHI
  #undef SETQX
  #undef DMA_V
  #undef CMASK
  #undef START
  #undef RESC
  #undef ROT
}
constexpr int ATTN_LDS_BYTES=LDS_BYTES;
struct AttnTensors { const bf16* Q; const bf16* K; const bf16* V; bf16* O; const float* CUM; };
struct AttnUnit { int bh; int qb; };
struct StaticOrder {
  int c,G;
  __device__ __forceinline__ StaticOrder(int grid,int block):c(block),G(grid){}
  __device__ __forceinline__ bool next(int i,AttnUnit&u)const{ const int it=i*G+c; if(it>=BATCH*NHEAD*NQB)return false; u.bh=it%(BATCH*NHEAD); u.qb=NQB-1-it/(BATCH*NHEAD); return true; }
};
template<class Sched,int THRL=8> __device__ __forceinline__ void attn_phase(char*lds,const AttnTensors&T,const Sched&S,const int wv){
  AttnUnit u;
  for(int i=0;S.next(i,u);++i){ attn_unit<THRL>(u.bh/NHEAD,u.bh%NHEAD,u.qb,T.Q,T.K,T.V,T.O,T.CUM+(size_t)u.bh*SEQ,lds,wv); }
}
#undef SBAR
#undef WAIT_BAR
}

namespace mls {
typedef short bf16x8 __attribute__((ext_vector_type(8)));
typedef float f32x4v __attribute__((ext_vector_type(4)));
typedef unsigned u32x2v __attribute__((ext_vector_type(2)));
typedef unsigned u32x4v __attribute__((ext_vector_type(4)));
constexpr int QS = 136, TS = 72;
constexpr int L_Q = 0, L_QI = 17408, L_K = 34816, L_KT = 52224, L_VT = 70656, L_WVT = 82176, L_SC = 93696, L_CT = 102912, L_DEN = 124672, L_END = 124928;
constexpr float QK_SCALE = 0.08838834764831845f;
__device__ __forceinline__ float scan_add(float v, int lane) {
#pragma unroll
    for (int o = 1; o < 64; o <<= 1) { const float t = bperm(v, (lane - o) & 63); if (lane >= o) v += t; }
    return v; }
__device__ __forceinline__ float scan_max(float v, int lane) {
#pragma unroll
    for (int o = 1; o < 64; o <<= 1) { const float t = bperm(v, (lane - o) & 63); if (lane >= o) v = fmaxf(v, t); }
    return v; }
__device__ __forceinline__ float lo_bf(unsigned w) { return __builtin_bit_cast(float, w << 16); }
__device__ __forceinline__ float hi_bf(unsigned w) { return __builtin_bit_cast(float, w & 0xffff0000u); }
}
__device__ __forceinline__ void phase_mlstm(Frame& F, const bf16* P, const bf16* PBg, const float* SG, const float* convw, const float* convb, bf16* AO) {
    using namespace mls;
    const int tid = opaque_tid(F.wave), lane = tid & 63, wid = __builtin_amdgcn_readfirstlane(tid >> 6), l15 = lane & 15, q4 = lane >> 4;
    LAS unsigned char* L = F.lds;
    for (int it = blockIdx.x; it < BATCH * MLH * 2; it += F.G) {
        const int vh = it & 1, bh = it >> 1, b = bh / MLH, h = bh % MLH;
        const size_t row00 = (size_t)b * SEQ;
        const int ch2 = tid & 127, tq = __builtin_amdgcn_readfirstlane(tid >> 7); const bool isk = (wid & 1) != 0;
        const int cc = (ch2 & 63) * 2;
        const int pcol = (isk ? PC_MK : PC_MQ) + h * 128 + cc, cch = (isk ? 512 : 0) + h * 128 + cc;
        float w0[2], w1[2], w2[2], w3[2], cb[2];
#pragma unroll
        for (int i = 0; i < 2; ++i) { w0[i] = convw[cch + i]; w1[i] = convw[1024 + cch + i]; w2[i] = convw[2048 + cch + i]; w3[i] = convw[3072 + cch + i]; cb[i] = convb[cch + i]; }
        const int e2 = tid & 31, sg = tid >> 5;
        const int vcol = PC_MV + h * 128 + vh * 64 + 2 * e2;
        f32x4v Cacc[8];
#pragma unroll
        for (int i = 0; i < 8; ++i) Cacc[i] = (f32x4v){0.f, 0.f, 0.f, 0.f};
        float mcar = 0.f;
        __syncthreads();
        for (int i = tid; i < 80 * QS / 2; i += NTHR) ((LAS unsigned*)(L + L_CT))[i] = 0u;
        for (int i = tid; i < 16 * TS / 2; i += NTHR) { ((LAS unsigned*)(L + L_VT + 64 * TS * 2))[i] = (i < TS / 2) ? 0x3F803F80u : 0u; ((LAS unsigned*)(L + L_WVT + 64 * TS * 2))[i] = 0u; }
        unsigned raw[19], vraw[4]; float ig, lf;
        const unsigned lo_raw = (unsigned)pcol * 2u, lo_v = (unsigned)((4 * sg) * PJA + vcol) * 2u, lo_g = (unsigned)lane * 64u, lo_o = (unsigned)((4 * q4) * PJB + l15) * 2u, lo_ao = (unsigned)((4 * q4) * D + l15) * 2u;
        const __amdgpu_buffer_rsrc_t rsP = __builtin_amdgcn_make_buffer_rsrc((void*)P, 0, M * PJA * 2, 0x00020000), rsB = __builtin_amdgcn_make_buffer_rsrc((void*)PBg, 0, M * PJB * 2, 0x00020000), rsG = __builtin_amdgcn_make_buffer_rsrc((void*)SG, 0, M * 64, 0x00020000),
                                     rsO = __builtin_amdgcn_make_buffer_rsrc((void*)AO, 0, M * D * 2, 0x00020000);
        const int r00 = (int)row00;
#define MLS_LOAD(c) do { _Pragma("unroll") for (int i_ = 0; i_ < 19; ++i_) { const int tr_ = 64 * (c) + 16 * tq - 3 + i_; raw[i_] = (tr_ >= 0) ? __builtin_amdgcn_raw_buffer_load_b32(rsP, lo_raw, (r00 + tr_) * (PJA * 2), 0) : 0u; } \
        _Pragma("unroll") for (int i_ = 0; i_ < 4; ++i_) vraw[i_] = __builtin_amdgcn_raw_buffer_load_b32(rsP, lo_v, (r00 + 64 * (c) + i_) * (PJA * 2), 0); \
        ig = __builtin_bit_cast(float, __builtin_amdgcn_raw_buffer_load_b32(rsG, lo_g, (r00 + 64 * (c)) * 64 + (8 + h) * 4, 0)); lf = __builtin_bit_cast(float, __builtin_amdgcn_raw_buffer_load_b32(rsG, lo_g, (r00 + 64 * (c)) * 64 + (12 + h) * 4, 0)); } while (0)
        MLS_LOAD(0);
        for (int c = 0; c < SEQ / 64; ++c) {
            const size_t row0 = row00 + 64 * c;
            const float bcum = scan_add(lf, lane), aval = ig - bcum, pm = scan_max(aval, lane);
            const float pm63 = bperm(pm, 63), gsum = bperm(bcum, 63);
            const float Mx = fmaxf(mcar, pm63), mrow = fmaxf(pm, mcar);
            const float rowterm = -mrow, inter = __expf(mcar - mrow), emt = __expf(-(bcum + mrow)), wk = __expf(aval - Mx), cdec = __expf(mcar - Mx);
            mcar = gsum + Mx;
            {
                unsigned kt0[8], kt1[8];
#pragma unroll
                for (int i = 0; i < 16; i += 2) {
                    float y[2][2];
#pragma unroll
                    for (int u = 0; u < 2; ++u) {
                        float a0 = w0[0] * lo_bf(raw[i + u]) + w1[0] * lo_bf(raw[i + u + 1]) + w2[0] * lo_bf(raw[i + u + 2]) + w3[0] * lo_bf(raw[i + u + 3]) + cb[0];
                        float a1 = w0[1] * hi_bf(raw[i + u]) + w1[1] * hi_bf(raw[i + u + 1]) + w2[1] * hi_bf(raw[i + u + 2]) + w3[1] * hi_bf(raw[i + u + 3]) + cb[1];
                        y[u][0] = siluf_(a0); y[u][1] = siluf_(a1);
                        const int t = 16 * tq + i + u;
                        if (!isk) { const float q0 = y[u][0] * QK_SCALE, q1 = y[u][1] * QK_SCALE; const float itv = bperm(inter, t);
                            *(LAS unsigned*)(L + L_Q + (t * QS + cc) * 2) = pk2(q0, q1); *(LAS unsigned*)(L + L_QI + (t * QS + cc) * 2) = pk2(q0 * itv, q1 * itv); }
                        else *(LAS unsigned*)(L + L_K + (t * QS + cc) * 2) = pk2(y[u][0], y[u][1]);
                    }
                    kt0[i >> 1] = pk2(y[0][0], y[1][0]); kt1[i >> 1] = pk2(y[0][1], y[1][1]);
                }
                if (isk) {
                    *(LAS u32x4v*)(L + L_KT + (cc * TS + 16 * tq) * 2) = (u32x4v){kt0[0], kt0[1], kt0[2], kt0[3]}; *(LAS u32x4v*)(L + L_KT + (cc * TS + 16 * tq + 8) * 2) = (u32x4v){kt0[4], kt0[5], kt0[6], kt0[7]};
                    *(LAS u32x4v*)(L + L_KT + ((cc + 1) * TS + 16 * tq) * 2) = (u32x4v){kt1[0], kt1[1], kt1[2], kt1[3]}; *(LAS u32x4v*)(L + L_KT + ((cc + 1) * TS + 16 * tq + 8) * 2) = (u32x4v){kt1[4], kt1[5], kt1[6], kt1[7]};
                }
            }
            {
                float v0[4], v1[4], wv[4];
#pragma unroll
                for (int i = 0; i < 4; ++i) { v0[i] = lo_bf(vraw[i]); v1[i] = hi_bf(vraw[i]); wv[i] = bperm(wk, 4 * sg + i); }
                *(LAS u32x2v*)(L + L_VT + ((2 * e2) * TS + 4 * sg) * 2) = (u32x2v){pk2(v0[0], v0[1]), pk2(v0[2], v0[3])};
                *(LAS u32x2v*)(L + L_VT + ((2 * e2 + 1) * TS + 4 * sg) * 2) = (u32x2v){pk2(v1[0], v1[1]), pk2(v1[2], v1[3])};
                *(LAS u32x2v*)(L + L_WVT + ((2 * e2) * TS + 4 * sg) * 2) = (u32x2v){pk2(v0[0] * wv[0], v0[1] * wv[1]), pk2(v0[2] * wv[2], v0[3] * wv[3])};
                *(LAS u32x2v*)(L + L_WVT + ((2 * e2 + 1) * TS + 4 * sg) * 2) = (u32x2v){pk2(v1[0] * wv[0], v1[1] * wv[1]), pk2(v1[2] * wv[2], v1[3] * wv[3])};
                if (wid == 0) *(LAS unsigned short*)(L + L_WVT + (64 * TS + lane) * 2) = (unsigned short)f2bf(wk);
            }
            if (c + 1 < SEQ / 64) MLS_LOAD(c + 1);
            __syncthreads();
            {
                const int tt = wid >> 1;
#pragma unroll
                for (int si = 0; si < 2; ++si) {
                    const int ss = 2 * (wid & 1) + si;
                    f32x4v acc = (f32x4v){0.f, 0.f, 0.f, 0.f};
                    if (ss <= tt) {
#pragma unroll
                        for (int kd = 0; kd < 4; ++kd) {
                            const bf16x8 a = *(const LAS bf16x8*)(L + L_Q + ((16 * tt + l15) * QS + 32 * kd + 8 * q4) * 2);
                            const bf16x8 bb = *(const LAS bf16x8*)(L + L_K + ((16 * ss + l15) * QS + 32 * kd + 8 * q4) * 2);
                            acc = __builtin_amdgcn_mfma_f32_16x16x32_bf16(a, bb, acc, 0, 0, 0);
                        }
                    }
                    const int s = 16 * ss + l15; const float as_ = bperm(aval, s);
#pragma unroll
                    for (int j = 0; j < 4; ++j) { const int t = 16 * tt + 4 * q4 + j; const float rt = bperm(rowterm, t);
                        const float dv = (s <= t) ? acc[j] * __expf(rt + as_) : 0.f;
                        *(LAS unsigned short*)(L + L_SC + (t * TS + s) * 2) = (unsigned short)f2bf(dv); }
                }
            }
            unsigned short mog[16];
            if (wid < 4) {
#pragma unroll
                for (int tt = 0; tt < 4; ++tt)
#pragma unroll
                    for (int j = 0; j < 4; ++j) mog[tt * 4 + j] = __builtin_amdgcn_raw_buffer_load_b16(rsB, lo_o, (((int)row0 + 16 * tt + j) * PJB + PB_MO + h * 128 + vh * 64 + 16 * wid) * 2, 0);
            }
            __syncthreads();
            f32x4v acc[4];
            if (wid < 5) {
                const int eg = wid;
#pragma unroll
                for (int tt = 0; tt < 4; ++tt) {
                    acc[tt] = (f32x4v){0.f, 0.f, 0.f, 0.f};
#pragma unroll
                    for (int ks = 0; ks < 2; ++ks) {
                        const bf16x8 a = *(const LAS bf16x8*)(L + L_SC + ((16 * tt + l15) * TS + 32 * ks + 8 * q4) * 2);
                        const bf16x8 bb = *(const LAS bf16x8*)(L + L_VT + ((16 * eg + l15) * TS + 32 * ks + 8 * q4) * 2);
                        acc[tt] = __builtin_amdgcn_mfma_f32_16x16x32_bf16(a, bb, acc[tt], 0, 0, 0);
                    }
#pragma unroll
                    for (int kd = 0; kd < 4; ++kd) {
                        const bf16x8 a = *(const LAS bf16x8*)(L + L_QI + ((16 * tt + l15) * QS + 32 * kd + 8 * q4) * 2);
                        const bf16x8 bb = *(const LAS bf16x8*)(L + L_CT + ((16 * eg + l15) * QS + 32 * kd + 8 * q4) * 2);
                        acc[tt] = __builtin_amdgcn_mfma_f32_16x16x32_bf16(a, bb, acc[tt], 0, 0, 0);
                    }
                }
                asm volatile("s_waitcnt lgkmcnt(0)" ::: "memory");
#pragma unroll
                for (int db = 0; db < 8; ++db) {
                    Cacc[db] = Cacc[db] * cdec;
#pragma unroll
                    for (int ks = 0; ks < 2; ++ks) {
                        const bf16x8 a = *(const LAS bf16x8*)(L + L_KT + ((16 * db + l15) * TS + 32 * ks + 8 * q4) * 2);
                        const bf16x8 bb = *(const LAS bf16x8*)(L + L_WVT + ((16 * eg + l15) * TS + 32 * ks + 8 * q4) * 2);
                        Cacc[db] = __builtin_amdgcn_mfma_f32_16x16x32_bf16(a, bb, Cacc[db], 0, 0, 0);
                    }
                    *(LAS u32x2v*)(L + L_CT + ((16 * eg + l15) * QS + 16 * db + 4 * q4) * 2) = (u32x2v){pk2(Cacc[db][0], Cacc[db][1]), pk2(Cacc[db][2], Cacc[db][3])};
                }
                if (wid == 4 && l15 == 0) {
#pragma unroll
                    for (int tt = 0; tt < 4; ++tt) *(LAS f32x4v*)(L + L_DEN + (16 * tt + 4 * q4) * 4) = acc[tt];
                }
            }
            __syncthreads();
            if (wid < 4) {
#pragma unroll
                for (int tt = 0; tt < 4; ++tt) {
                    const f32x4v den = *(const LAS f32x4v*)(L + L_DEN + (16 * tt + 4 * q4) * 4);
#pragma unroll
                    for (int j = 0; j < 4; ++j) { const int t = 16 * tt + 4 * q4 + j; const float et = bperm(emt, t);
                        const float hv = acc[tt][j] / fmaxf(fabsf(den[j]), et);
                        __builtin_amdgcn_raw_buffer_store_b16((unsigned short)f2bf(hv * bf2f(mog[tt * 4 + j])), rsO, lo_ao, (((int)row0 + 16 * tt + j) * D + 512 + h * 128 + vh * 64 + 16 * wid) * 2, 0); }
                }
            }
        }
#undef MLS_LOAD
    }
}

__global__ void __launch_bounds__(NTHR, 2) fwd_kernel(Args args) {
    extern __shared__ __attribute__((aligned(16))) unsigned char lds[];
    Frame F;
    F.lds = (LAS unsigned char*)lds;
    F.MISC = (volatile LAS unsigned*)(F.lds + MISC_OFF);
    F.wave = __builtin_amdgcn_readfirstlane((int)threadIdx.x >> 6);
    F.G = gridDim.x;
    F.ws = args.ws; F.out = args.out;
#pragma unroll
    for (int i = 0; i < 18; ++i) F.in[i] = args.in[i];
    F.ctl = (gu32*)(F.ws + WS_CTL);
    for (int u = threadIdx.x; u < (LDS_BYTES - LDSCTL_OFF) / 4; u += NTHR) ((LAS unsigned*)(F.lds + LDSCTL_OFF))[u] = 0u;
    __syncthreads();
    XcdBarrier bar = xcd_barrier_post((unsigned*)(F.ctl + CW_BAR), F.MISC + 8, F.wave);
#define GRID_BAR() xcd_barrier(bar)

    const float* x = F.in[0];
    bf16* XB = (bf16*)(F.ws + WS_XB); bf16* AO = (bf16*)(F.ws + WS_AO); bf16* PA = (bf16*)(F.ws + WS_PA); bf16* PB = (bf16*)(F.ws + WS_PB);
    bf16* HB = PA; bf16* MG = PA;
    float* SG = (float*)(F.ws + WS_SG); float* CUM = (float*)(F.ws + WS_CUM); float* SS = (float*)(F.ws + WS_SS);
    float* out = F.out;
    const bf16* W1IN = (const bf16*)(F.ws + WS_W1IN); const bf16* W1OUT = (const bf16*)(F.ws + WS_W1OUT); const bf16* WIN = (const bf16*)(F.ws + WS_WIN);
    const bf16* WCAT = (const bf16*)(F.ws + WS_WCAT); const bf16* WOUT = (const bf16*)(F.ws + WS_WOUT); const bf16* W2IN = (const bf16*)(F.ws + WS_W2IN); const bf16* W2OUT = (const bf16*)(F.ws + WS_W2OUT);
#define STAGGER(step) do { if (STAG_ON) { const unsigned long long t0_ = __builtin_amdgcn_s_memrealtime(); const unsigned long long w_ = (unsigned long long)((blockIdx.x & 7u) * (unsigned)(step)); while (__builtin_amdgcn_s_memrealtime() - t0_ < w_) __builtin_amdgcn_s_sleep(8); } } while (0)
#define GEMM_PHASE(EpiT, gobj, eobj) do { pg8::StaticOrder S_; S_.init((gobj).M, (gobj).N, F.G, (int)blockIdx.x); pg8::gemm_phase<EpiT, pg8::StaticOrder, true, true>(F.lds, gobj, S_, eobj, F.wave); } while (0)
#define REP(b) ((REP_MASK >> (b)) & 1)

    phase_weights(F);
    phase_x_prep(F, x, XB, SS);
    GRID_BAR();
    STAGGER(430);
    { pg8::Gemm g{XB, W1IN, M, NFF, D, D, D}; pg8::EpiSwigluF E{HB, SS}; GEMM_PHASE(pg8::EpiSwigluF, g, E); if (REP(0)) GEMM_PHASE(pg8::EpiSwigluF, g, E); }
    GRID_BAR();
    { pg8::Gemm g{HB, W1OUT, M, D, DFF, DFF, DFF}; pg8::EpiResidB<false> E{XB, nullptr, SS, 0.5f}; GEMM_PHASE(pg8::EpiResidB<false>, g, E); }
    GRID_BAR();
    STAGGER(460);
    { pg8::Gemm g{XB, WIN, M, NPJ, D, D, D}; pg8::EpiProjF E{PA, PB, SG, SS, F.in[6], F.in[9], F.in[10]}; GEMM_PHASE(pg8::EpiProjF, g, E); if (REP(2)) GEMM_PHASE(pg8::EpiProjF, g, E); }
    GRID_BAR();
    phase_cumsum(F, SG, CUM);
    GRID_BAR();
    phase_mlstm(F, PA, PB, SG, F.in[7], F.in[8], AO);
    if (REP(3)) phase_mlstm(F, PA, PB, SG, F.in[7], F.in[8], AO);
    { const attn_body::AttnTensors AT{(const attn_body::bf16*)(PA + PC_FQ), (const attn_body::bf16*)(PA + PC_FK), (const attn_body::bf16*)(PA + PC_FV), (attn_body::bf16*)AO, CUM};
      const attn_body::StaticOrder SA((int)F.G, (int)blockIdx.x); attn_body::attn_phase<attn_body::StaticOrder>((char*)lds, AT, SA, F.wave);
      if (REP(4)) attn_body::attn_phase<attn_body::StaticOrder>((char*)lds, AT, SA, F.wave); }
    GRID_BAR();
    { pg8::Gemm g{AO, WCAT, M, D, D, D, D}; pg8::EpiMergeF E{PB, MG}; GEMM_PHASE(pg8::EpiMergeF, g, E); if (REP(5)) GEMM_PHASE(pg8::EpiMergeF, g, E); }
    GRID_BAR();
    { pg8::Gemm g{MG, WOUT, M, D, D, D, D}; pg8::EpiResidB<false> E{XB, nullptr, SS, 1.0f}; GEMM_PHASE(pg8::EpiResidB<false>, g, E); }
    GRID_BAR();
    STAGGER(430);
    { pg8::Gemm g{XB, W2IN, M, NFF, D, D, D}; pg8::EpiSwigluF E{HB, SS}; GEMM_PHASE(pg8::EpiSwigluF, g, E); }
    GRID_BAR();
    { pg8::Gemm g{HB, W2OUT, M, D, DFF, DFF, DFF}; pg8::EpiResidB<true> E{XB, out, SS, 0.5f}; GEMM_PHASE(pg8::EpiResidB<true>, g, E); if (REP(1)) GEMM_PHASE(pg8::EpiResidB<true>, g, E); }
    GRID_BAR();
    phase_final_scale(F, out, SS, F.in[17]);
}

extern "C" void kernel_launch(void* const* d_in, const int* in_sizes, int n_in, void* d_out, int out_size, void* d_ws, size_t ws_size, hipStream_t stream) {
    static int grid = 0;
    if (grid == 0) {
        if (n_in != 18 || in_sizes[0] != M * D || out_size != M * D || ws_size < WS_END) { fprintf(stderr, "kernel_launch: unexpected shapes (n_in %d, in0 %d, out %d, ws %zu)\n", n_in, n_in > 0 ? in_sizes[0] : -1, out_size, ws_size); grid = -1; return; }
        int dev = 0, cus = 0, per_cu = 0;
        if (hipGetDevice(&dev) != hipSuccess || hipDeviceGetAttribute(&cus, hipDeviceAttributeMultiprocessorCount, dev) != hipSuccess) { grid = -1; return; }
        if (hipFuncSetAttribute((const void*)fwd_kernel, hipFuncAttributeMaxDynamicSharedMemorySize, LDS_BYTES) != hipSuccess) { grid = -1; return; }
        if (hipOccupancyMaxActiveBlocksPerMultiprocessor(&per_cu, (const void*)fwd_kernel, NTHR, LDS_BYTES) != hipSuccess || per_cu < 1) { fprintf(stderr, "occupancy query says %d\n", per_cu); }
        (void)hipGetLastError();
        grid = cus;
    }
    if (grid < 0) return;
    if (hipMemsetAsync((char*)d_ws + WS_CTL, 0, CTL_ZERO_BYTES, stream) != hipSuccess) return;
    Args a{};
    for (int i = 0; i < 18; ++i) a.in[i] = (const float*)d_in[i];
    a.out = (float*)d_out; a.ws = (unsigned char*)d_ws;
    hipLaunchKernelGGL(fwd_kernel, dim3(grid), dim3(NTHR), LDS_BYTES, stream, a);
}
```

```cpp
#include <hip/hip_runtime.h>
#include <cstdio>
#include <cstdint>

#define GAS __attribute__((address_space(1)))
#define LAS __attribute__((address_space(3)))
typedef unsigned short bf16;
typedef unsigned v4u __attribute__((ext_vector_type(4)));
typedef float f32x4 __attribute__((ext_vector_type(4)));
typedef GAS unsigned gu32;
#define RLX_AGENT __ATOMIC_RELAXED, __HIP_MEMORY_SCOPE_AGENT

constexpr int BATCH = 32, SEQ = 2048, D = 1024, M = BATCH * SEQ;
constexpr int DFF = 2816, NFF = 2 * DFF;
constexpr int INC = 5648;
constexpr int PJA = 3072, PJB = 2560;
constexpr int FOXH = 8, FHD = 64, MLH = 4, MHD = 128;
constexpr int PC_FQ = 0, PC_FK = 512, PC_FV = 1024, PC_MQ = 1536, PC_MK = 2048, PC_MV = 2560;
constexpr int PB_MO = 0, PB_GA = 512, PB_GB = 1536;
constexpr float RMS_EPS = 1e-6f;
constexpr float LOG2E = 1.4426950408889634f;
constexpr float QSCALE2 = 0.125f * LOG2E;
constexpr int NWAVES = 8, NTHR = 512;
#ifndef STAG_ON
#define STAG_ON 0
#endif
#ifndef MLSTM_FUSED
#define MLSTM_FUSED 1
#endif
#ifndef REP_MASK
#define REP_MASK 0
#endif

constexpr size_t MiB = 1u << 20;
constexpr size_t WS_CTL = 0, CTL_ZERO_BYTES = 1 * MiB;
constexpr size_t WS_W1IN = 2 * MiB, WS_W1OUT = 13 * MiB, WS_WIN = 19 * MiB, WS_WCAT = 31 * MiB, WS_WOUT = 33 * MiB, WS_W2IN = 35 * MiB, WS_W2OUT = 46 * MiB;
constexpr int NPJ = 5888;
constexpr size_t WS_SG = 52 * MiB;
constexpr size_t WS_CUM = 56 * MiB;
constexpr size_t WS_SS = 58 * MiB;
constexpr size_t WS_XB = 64 * MiB;
constexpr size_t WS_AO = 192 * MiB;
constexpr size_t WS_PA = 320 * MiB;
constexpr size_t WS_PB = 704 * MiB;
constexpr size_t WS_END = 1024 * MiB;
constexpr int CW_BAR = 4096;

constexpr int LDS_BYTES = 147456;
constexpr int RING_BYTES = 131072, LDSCTL_OFF = RING_BYTES, MISC_OFF = LDSCTL_OFF + 320;

__device__ __forceinline__ float bf2f(bf16 v) { return __builtin_bit_cast(float, (unsigned)v << 16); }
__device__ __forceinline__ unsigned f2bf(float f) { unsigned u = __builtin_bit_cast(unsigned, f); return (u + 0x7fffu + ((u >> 16) & 1u)) >> 16; }
__device__ __forceinline__ unsigned pk2(float lo, float hi) { return f2bf(lo) | (f2bf(hi) << 16); }
__device__ __forceinline__ float sigmoidf_(float v) { return 1.f / (1.f + __expf(-v)); }
__device__ __forceinline__ float logsigmoidf_(float v) { return fminf(v, 0.f) - log1pf(__expf(-fabsf(v))); }
__device__ __forceinline__ float siluf_(float v) { return v / (1.f + __expf(-v)); }

#define XB_TMO      128
#define XB_XCNT(j)  (256  + 64 * (j))
#define XB_XSUB(j)  (1280 + 64 * (j))
#define XB_XGEN(j)  (2304 + 64 * (j))
#define XB_TOP      3328
#define XB_TOPGEN   3392
#define XCD_BAR_WORDS 3456
#define XB_SPIN_CAP (1u << 22)

__device__ __forceinline__ unsigned xb_ld(unsigned* p)              { return __hip_atomic_load(p, __ATOMIC_RELAXED, __HIP_MEMORY_SCOPE_AGENT); }
__device__ __forceinline__ unsigned xb_add(unsigned* p, unsigned v) { return __hip_atomic_fetch_add(p, v, __ATOMIC_RELAXED, __HIP_MEMORY_SCOPE_AGENT); }
__device__ __forceinline__ unsigned xb_xcc_id() { return (unsigned)__builtin_amdgcn_s_getreg((3 << 11) | 20) & 0xFu; }
#define XB_SPIN(cond, bar) do { unsigned _sp = 0; while (cond) { __builtin_amdgcn_s_sleep(1); \
    if ((++_sp & 255u) == 0u) { if (xb_ld(&(bar)[XB_TMO])) break; if (_sp > XB_SPIN_CAP) { atomicAdd(&(bar)[XB_TMO], 1u); break; } } } } while (0)

struct XcdBarrier { unsigned* bar; unsigned x; volatile LAS unsigned* st; int wv; };

__device__ __forceinline__ bool xb_leader(int wv) { int l = (int)__builtin_amdgcn_mbcnt_hi(~0u, __builtin_amdgcn_mbcnt_lo(~0u, 0u)); asm volatile("" : "+v"(l)); return wv == 0 && l == 0; }
__device__ __forceinline__ XcdBarrier xcd_barrier_post(unsigned* bar, volatile LAS unsigned* st, int wv) {
    XcdBarrier b; b.bar = bar; b.x = xb_xcc_id(); b.st = st; b.wv = wv;
    if (xb_leader(wv)) (void)xb_add(&bar[XB_XCNT(b.x)], 1u);
    return b;
}
__device__ __forceinline__ void xcd_barrier_complete(unsigned* bar, unsigned x, unsigned& nloc, unsigned& nx) {
    const unsigned G = gridDim.x * gridDim.y * gridDim.z;
    unsigned sum, cnt, mine, sp = 0u;
    for (;;) {
        sum = 0u; cnt = 0u; mine = 0u;
#pragma unroll
        for (unsigned j = 0; j < 16; ++j) { const unsigned c = xb_ld(&bar[XB_XCNT(j)]); sum += c; cnt += (c > 0u) ? 1u : 0u; mine = (j == x) ? c : mine; }
        if (sum == G) break;
        __builtin_amdgcn_s_sleep(1);
        if ((++sp & 255u) == 0u) { if (xb_ld(&bar[XB_TMO])) break; if (sp > XB_SPIN_CAP) { atomicAdd(&bar[XB_TMO], 1u); break; } }
    }
    nloc = mine > 0u ? mine : 1u; nx = cnt > 0u ? cnt : 1u;
}
__device__ __forceinline__ void xcd_barrier(const XcdBarrier& b) {
    asm volatile("s_waitcnt vmcnt(0)" ::: "memory");
    __syncthreads();
    if (xb_leader(b.wv)) {
        unsigned* bar = b.bar;
        __builtin_amdgcn_s_waitcnt(0);
        unsigned nloc = b.st[0], nx = b.st[1];
        if (nloc == 0u) { xcd_barrier_complete(bar, b.x, nloc, nx); b.st[0] = nloc; b.st[1] = nx; }
        const unsigned old = xb_add(&bar[XB_XSUB(b.x)], 1u);
        const unsigned gen = old / nloc;
        if (old + 1u == (gen + 1u) * nloc) {
            __builtin_amdgcn_fence(__ATOMIC_RELEASE, "agent");
            asm volatile("s_waitcnt vmcnt(0)" ::: "memory");
            const unsigned og = xb_add(&bar[XB_TOP], 1u);
            const unsigned tg = og / nx;
            if (og + 1u == (tg + 1u) * nx) xb_add(&bar[XB_TOPGEN], 1u);
            else XB_SPIN(xb_ld(&bar[XB_TOPGEN]) == tg, bar);
            __builtin_amdgcn_fence(__ATOMIC_ACQUIRE, "agent");
            xb_add(&bar[XB_XGEN(b.x)], 1u);
            asm volatile("s_waitcnt vmcnt(0)" ::: "memory");
        } else {
            XB_SPIN(xb_ld(&bar[XB_XGEN(b.x)]) == gen, bar);
            __builtin_amdgcn_fence(__ATOMIC_ACQUIRE, "agent");
            asm volatile("s_waitcnt vmcnt(0)" ::: "memory");
        }
    }
    __syncthreads();
}

struct Frame {
    LAS unsigned char* lds;
    volatile LAS unsigned* MISC;
    gu32* ctl;
    int wave, G;
    const float* in[18];
    float* out;
    unsigned char* ws;
};
struct Args { const float* in[18]; float* out; unsigned char* ws; };

__device__ __forceinline__ int lane_id() { return (int)__builtin_amdgcn_mbcnt_hi(~0u, __builtin_amdgcn_mbcnt_lo(~0u, 0u)); }
__device__ __forceinline__ int opaque_tid(int wv) { int t = wv * 64 + lane_id(); asm volatile("" : "+v"(t)); return t; }
__device__ __forceinline__ float bperm(float v, int idx) { return __builtin_bit_cast(float, __builtin_amdgcn_ds_bpermute(idx << 2, __builtin_bit_cast(int, v))); }
__device__ __forceinline__ float rdl(float v, int idx) { return __builtin_bit_cast(float, __builtin_amdgcn_readlane(__builtin_bit_cast(int, v), idx)); }
__device__ __forceinline__ float shx(float v, int lane, int mask) { return bperm(v, lane ^ mask); }
__device__ __forceinline__ float wave_sum(float v, int lane) {
#pragma unroll
    for (int o = 1; o < 64; o <<= 1) v += shx(v, lane, o);
    return v;
}

__device__ __forceinline__ void phase_x_prep(Frame& F, const float* X, bf16* XB, float* SS) {
    const int ptid = opaque_tid(F.wave), plane = ptid & 63, pwave = __builtin_amdgcn_readfirstlane(ptid >> 6);
    const int gw = blockIdx.x * NWAVES + pwave, NGW = F.G * NWAVES;
    for (int m = gw; m < M; m += NGW) {
        const GAS f32x4* xr = (const GAS f32x4*)(X + (size_t)m * D) + plane;
        f32x4 v[4]; float s = 0.f;
#pragma unroll
        for (int j = 0; j < 4; ++j) { v[j] = xr[64 * j]; s += (v[j].x * v[j].x + v[j].y * v[j].y) + (v[j].z * v[j].z + v[j].w * v[j].w); }
        s = wave_sum(s, plane);
        GAS unsigned long long* o8 = (GAS unsigned long long*)(XB + (size_t)m * D) + plane;
#pragma unroll
        for (int j = 0; j < 4; ++j) o8[64 * j] = (unsigned long long)pk2(v[j].x, v[j].y) | ((unsigned long long)pk2(v[j].z, v[j].w) << 32);
        if (plane < 16) SS[(size_t)m * 16 + plane] = (plane == 0) ? s : 0.f;
    }
}
__device__ __forceinline__ void phase_final_scale(Frame& F, float* X, const float* SS, const float* gain) {
    const int ptid = opaque_tid(F.wave), plane = ptid & 63, pwave = __builtin_amdgcn_readfirstlane(ptid >> 6);
    const int gw = blockIdx.x * NWAVES + pwave, NGW = F.G * NWAVES;
    f32x4 g[4];
#pragma unroll
    for (int j = 0; j < 4; ++j) g[j] = *((const GAS f32x4*)gain + plane + 64 * j);
    for (int m = gw; m < M; m += NGW) {
        GAS f32x4* xr = (GAS f32x4*)(X + (size_t)m * D) + plane;
        f32x4 v[4];
#pragma unroll
        for (int j = 0; j < 4; ++j) v[j] = xr[64 * j];
        float s = SS[(size_t)m * 16 + (plane & 15)];
#pragma unroll
        for (int o = 1; o < 16; o <<= 1) s += shx(s, plane, o);
        const float r = 1.0f / sqrtf(s * (1.f / D) + RMS_EPS);
#pragma unroll
        for (int j = 0; j < 4; ++j) xr[64 * j] = v[j] * r * g[j];
    }
}

__device__ __forceinline__ void phase_cumsum(Frame& F, const float* SG, float* CUM) {
    const int ptid = opaque_tid(F.wave), plane = ptid & 63, pwave = __builtin_amdgcn_readfirstlane(ptid >> 6); (void)plane; (void)pwave;
    const int gw = blockIdx.x * NWAVES + pwave, NGW = F.G * NWAVES;
    for (int it = gw; it < BATCH * FOXH; it += NGW) {
        const int b = it / FOXH, h = it % FOXH;
        float v[32]; float s = 0.f;
#pragma unroll
        for (int i = 0; i < 32; ++i) { s += SG[(size_t)(b * SEQ + plane * 32 + i) * 16 + h]; v[i] = s; }
        float incl = s;
#pragma unroll
        for (int o = 1; o < 64; o <<= 1) { const float t = bperm(incl, (plane - o) & 63); if (plane >= o) incl += t; }
        const float excl = incl - s;
#pragma unroll
        for (int i = 0; i < 32; ++i) CUM[(size_t)it * SEQ + plane * 32 + i] = v[i] + excl;
    }
}


namespace pg8 {
#define PG8_LAS __attribute__((address_space(3)))
typedef unsigned short bf16_t;
typedef short bf16x8 __attribute__((ext_vector_type(8)));
typedef float f32x4 __attribute__((ext_vector_type(4)));
typedef unsigned u32x4 __attribute__((ext_vector_type(4)));
constexpr int BM = 256, BK = 64, HALF = 128, HTB = HALF * BK * 2  , STAGE_BYTES = 8 * HTB, NXCD = 8, WGM = 8;

__host__ __device__ __forceinline__ int lds_byte(int r, int c) { const int st = (r >> 4) * 2 + (c >> 5), rr = r & 15, cc = c & 31, ob = rr * 64 + cc * 2; return st * 1024 + (ob ^ (((ob >> 9) & 1) << 5)); }
__host__ __device__ __forceinline__ void stage_rc(int b, int& R, int& C) { const int st = b / 1024, sb = b % 1024, swz = sb ^ (((sb >> 9) & 1) << 5); R = (st >> 1) * 16 + swz / 64; C = (st & 1) * 32 + (swz % 64) / 2; }
__host__ __device__ __forceinline__ int perm32(int rho) { const int n = rho >> 4, i = rho & 15; return 8 * (i >> 2) + 4 * n + (i & 3); }

struct Unit { int pm, pn; };
struct Gemm { const bf16_t* A; const bf16_t* Bt; int M, N, K, lda, ldb; };

struct StaticOrder {
    int nM, nN, nwg, G, c;
    __host__ __device__ void init(int M, int N, int G_, int c_) { nM = M / BM; nN = N / BM; nwg = nM * nN; G = G_; c = c_; }
    __host__ __device__ bool next(int i, Unit& u) const {
        const long L = (long)i * G + c; if (L >= nwg) return false;
        int wgid = (int)L; { const int q = nwg / NXCD, r = nwg % NXCD, xcd = wgid % NXCD, off = wgid / NXCD; wgid = (xcd < r ? xcd * (q + 1) : r * (q + 1) + (xcd - r) * q) + off; }
        const int nig = WGM * nN, gid = wgid / nig, fm = gid * WGM, gsz = (nM - fm) < WGM ? (nM - fm) : WGM;
        u.pm = fm + ((wgid % nig) % gsz); u.pn = (wgid % nig) / gsz; return true;
    }
    __device__ __forceinline__ void a_ready(const Unit&) const {}
    __device__ __forceinline__ void done(const Unit&) const {}
};

__device__ __forceinline__ unsigned cvt_pk_bf16(float lo, float hi) { unsigned r; asm volatile("v_cvt_pk_bf16_f32 %0, %1, %2" : "=v"(r) : "v"(lo), "v"(hi)); return r; }
template <class Epi, class Sched, bool ALIGN_EPI = false, bool SP2 = false>
__device__ __forceinline__ void gemm_phase(PG8_LAS unsigned char* lds, const Gemm g, const Sched& S, const Epi& E, const int wv) {
    int tid_ = wv * 64 + (int)__builtin_amdgcn_mbcnt_hi(~0u, __builtin_amdgcn_mbcnt_lo(~0u, 0u)); asm volatile("" : "+v"(tid_));
    const int tid = tid_, wid = __builtin_amdgcn_readfirstlane(tid >> 6), lane = tid & 63, wr = wid >> 2, wc = wid & 3, fr = lane & 15, fq = lane >> 4;
    const int K = g.K, nt = K / BK;
    unsigned voffA[2], voffB[2];
#pragma unroll
    for (int i = 0; i < 2; ++i) { int R, C; stage_rc(tid * 16 + i * 8192, R, C); const int Rb = Epi::PERM ? ((R & ~31) + perm32(R & 31)) : R;
        voffA[i] = (unsigned)(R * g.lda + C) * 2u; voffB[i] = (unsigned)(Rb * g.ldb + C) * 2u; }
    const size_t kstep = (size_t)(BK * 2);
    const size_t hstepA = (size_t)HALF * g.lda * 2, hstepB = (size_t)HALF * g.ldb * 2;
    const size_t tstepA = 2 * hstepA, tstepB = 2 * hstepB;
    const unsigned ldsw = (unsigned)wid * 1024u;
    const int aoff = lds_byte(wr * 64 + fr, fq * 8), boff = lds_byte(wc * 32 + fr, fq * 8);
#define PG8_SA(b, h) (((b) * 2 + (h)) * HTB)
#define PG8_SB(b, h) ((4 + (b) * 2 + (h)) * HTB)
#define PG8_STAGE(bufoff, gbase, voff) do { _Pragma("unroll") for (int _i = 0; _i < 2; ++_i) \
        __builtin_amdgcn_global_load_lds((const unsigned*)((const char*)(gbase) + (voff)[_i]), (PG8_LAS unsigned*)(lds + (bufoff) + ldsw + _i * 8192), 16, 0, 0); } while (0)
#define PG8_LDA(dst, b, h) do { _Pragma("unroll") for (int m = 0; m < 4; ++m) _Pragma("unroll") for (int k = 0; k < 2; ++k) dst[m][k] = *(const PG8_LAS bf16x8*)(lds + PG8_SA(b, h) + aoff + m * 2048 + k * 1024); } while (0)
#define PG8_LDB(dst, b, h) do { _Pragma("unroll") for (int n = 0; n < 2; ++n) _Pragma("unroll") for (int k = 0; k < 2; ++k) dst[n][k] = *(const PG8_LAS bf16x8*)(lds + PG8_SB(b, h) + boff + n * 2048 + k * 1024); } while (0)
#define PG8_MMA(ai, bj, At, Bt) do { __builtin_amdgcn_s_setprio(1); _Pragma("unroll") for (int m = 0; m < 4; ++m) _Pragma("unroll") for (int n = 0; n < 2; ++n) _Pragma("unroll") for (int k = 0; k < 2; ++k) \
        acc[ai][bj][m][n] = __builtin_amdgcn_mfma_f32_16x16x32_bf16(Bt[n][k], At[m][k], acc[ai][bj][m][n], 0, 0, 0); __builtin_amdgcn_s_setprio(0); } while (0)
#define PG8_WAIT_V(n) asm volatile("s_waitcnt vmcnt(" #n ")" ::: "memory")
#define PG8_WAIT_L(n) asm volatile("s_waitcnt lgkmcnt(" #n ")" ::: "memory")
#define PG8_BAR __builtin_amdgcn_s_barrier()
#define PG8_SCHED __builtin_amdgcn_sched_barrier(0)
    Unit cur, nxt; int ui = 0;
    if (!S.next(0, cur)) return;
    f32x4 acc[2][2][4][2];
#pragma unroll
    for (int a = 0; a < 2; ++a)
#pragma unroll
        for (int b = 0; b < 2; ++b)
#pragma unroll
            for (int m = 0; m < 4; ++m)
#pragma unroll
                for (int n = 0; n < 2; ++n) acc[a][b][m][n] = (f32x4){0.f, 0.f, 0.f, 0.f};
    bf16x8 At[4][2], B0[2][2], B1[2][2];
    const char* cA = (const char*)g.A + (size_t)cur.pm * tstepA; const char* cB = (const char*)g.Bt + (size_t)cur.pn * tstepB;
    S.a_ready(cur);
    if constexpr (SP2) {
        PG8_STAGE(PG8_SB(0, 0), cB, voffB); PG8_STAGE(PG8_SB(0, 1), cB + hstepB, voffB); PG8_STAGE(PG8_SA(0, 0), cA, voffA); PG8_STAGE(PG8_SA(0, 1), cA + hstepA, voffA);
        if (wr == 1) PG8_BAR;
        PG8_WAIT_V(2); PG8_BAR;
        PG8_STAGE(PG8_SB(1, 0), cB + kstep, voffB); PG8_STAGE(PG8_SA(1, 0), cA + kstep, voffA); PG8_STAGE(PG8_SB(1, 1), cB + hstepB + kstep, voffB);
        PG8_WAIT_V(6); PG8_BAR;
    } else {
        PG8_STAGE(PG8_SB(0, 0), cB, voffB); PG8_STAGE(PG8_SA(0, 0), cA, voffA); PG8_STAGE(PG8_SB(0, 1), cB + hstepB, voffB); PG8_STAGE(PG8_SA(0, 1), cA + hstepA, voffA);
        if (wr == 1) PG8_BAR;
        PG8_WAIT_V(4); PG8_BAR;
        PG8_STAGE(PG8_SB(1, 0), cB + kstep, voffB); PG8_STAGE(PG8_SA(1, 0), cA + kstep, voffA); PG8_STAGE(PG8_SB(1, 1), cB + hstepB + kstep, voffB);
        PG8_WAIT_V(6); PG8_BAR;
    }
    for (;;) {
        const bool has_next = S.next(ui + 1, nxt);
        const char* nA = has_next ? (const char*)g.A + (size_t)nxt.pm * tstepA : cA; const char* nB = has_next ? (const char*)g.Bt + (size_t)nxt.pn * tstepB : cB;
        for (int t = 0; t < nt; t += 2) {
            const bool last = (t == nt - 2);
            const char* a1 = cA + (size_t)(t + 1) * kstep;
            const char* a2 = last ? nA : cA + (size_t)(t + 2) * kstep; const char* b2 = last ? nB : cB + (size_t)(t + 2) * kstep;
            const char* a3 = a2 + kstep; const char* b3 = b2 + kstep;
            if (last && has_next) S.a_ready(nxt);
            if constexpr (Epi::HOOK) { if (t == Epi::HOOK_T) E.mid(acc, cur, wr, wc, fr, fq); }
            if constexpr (SP2) {
            PG8_LDB(B0, 0, 0); PG8_LDB(B1, 0, 1); PG8_SCHED; PG8_LDA(At, 0, 0); PG8_STAGE(PG8_SA(1, 1), a1 + hstepA, voffA);
            PG8_WAIT_V(8); PG8_WAIT_L(0); PG8_BAR; PG8_MMA(0, 0, At, B0); PG8_MMA(0, 1, At, B1); PG8_BAR; PG8_SCHED;
            PG8_LDA(At, 0, 1); PG8_STAGE(PG8_SB(0, 0), b2, voffB); PG8_STAGE(PG8_SB(0, 1), b2 + hstepB, voffB); PG8_STAGE(PG8_SA(0, 0), a2, voffA);
            PG8_WAIT_V(8); PG8_WAIT_L(0); PG8_BAR; PG8_MMA(1, 0, At, B0); PG8_MMA(1, 1, At, B1); PG8_BAR; PG8_SCHED;
            PG8_LDB(B0, 1, 0); PG8_LDB(B1, 1, 1); PG8_SCHED; PG8_LDA(At, 1, 0); PG8_STAGE(PG8_SA(0, 1), a2 + hstepA, voffA);
            PG8_WAIT_V(8); PG8_WAIT_L(0); PG8_BAR; PG8_MMA(0, 0, At, B0); PG8_MMA(0, 1, At, B1); PG8_BAR; PG8_SCHED;
            PG8_LDA(At, 1, 1); PG8_STAGE(PG8_SB(1, 0), b3, voffB); PG8_STAGE(PG8_SB(1, 1), b3 + hstepB, voffB); PG8_STAGE(PG8_SA(1, 0), a3, voffA);
            PG8_WAIT_V(8); PG8_WAIT_L(0); PG8_BAR; PG8_MMA(1, 0, At, B0); PG8_MMA(1, 1, At, B1); PG8_BAR; PG8_SCHED;
            } else {
            PG8_LDB(B0, 0, 0); PG8_SCHED; PG8_LDA(At, 0, 0); PG8_STAGE(PG8_SA(1, 1), a1 + hstepA, voffA);
            PG8_WAIT_L(8); PG8_BAR; PG8_WAIT_L(0); PG8_MMA(0, 0, At, B0); PG8_BAR; PG8_SCHED;
            PG8_LDB(B1, 0, 1); PG8_STAGE(PG8_SB(0, 0), b2, voffB);
            PG8_BAR; PG8_WAIT_L(0); PG8_MMA(0, 1, At, B1); PG8_BAR;
            PG8_LDA(At, 0, 1); PG8_STAGE(PG8_SA(0, 0), a2, voffA);
            PG8_BAR; PG8_WAIT_L(0); PG8_MMA(1, 0, At, B0); PG8_BAR; PG8_SCHED;
            PG8_STAGE(PG8_SB(0, 1), b2 + hstepB, voffB);
            PG8_WAIT_V(6); PG8_BAR; PG8_MMA(1, 1, At, B1); PG8_BAR;
            PG8_LDB(B0, 1, 0); PG8_SCHED; PG8_LDA(At, 1, 0); PG8_STAGE(PG8_SA(0, 1), a2 + hstepA, voffA);
            PG8_WAIT_L(8); PG8_BAR; PG8_WAIT_L(0); PG8_MMA(0, 0, At, B0); PG8_BAR; PG8_SCHED;
            PG8_LDB(B1, 1, 1); PG8_STAGE(PG8_SB(1, 0), b3, voffB);
            PG8_BAR; PG8_WAIT_L(0); PG8_MMA(0, 1, At, B1); PG8_BAR;
            PG8_LDA(At, 1, 1); PG8_STAGE(PG8_SA(1, 0), a3, voffA);
            PG8_BAR; PG8_WAIT_L(0); PG8_MMA(1, 0, At, B0); PG8_BAR; PG8_SCHED;
            PG8_STAGE(PG8_SB(1, 1), b3 + hstepB, voffB);
            PG8_WAIT_V(6); PG8_BAR; PG8_MMA(1, 1, At, B1); PG8_BAR;
            }
        }
        if constexpr (ALIGN_EPI) { if (wr == 0) PG8_BAR; }
        if constexpr (!Epi::AFTER_DRAIN) { E(acc, cur, wr, wc, fr, fq); S.done(cur); }
        if (!has_next) break;
#pragma unroll
        for (int a = 0; a < 2; ++a)
#pragma unroll
            for (int b = 0; b < 2; ++b)
#pragma unroll
                for (int m = 0; m < 4; ++m)
#pragma unroll
                    for (int n = 0; n < 2; ++n) acc[a][b][m][n] = (f32x4){0.f, 0.f, 0.f, 0.f};
        cur = nxt; cA = nA; cB = nB; ++ui;
        if constexpr (ALIGN_EPI) { if (wr == 1) PG8_BAR; }
    }
    PG8_WAIT_V(0);
    if constexpr (!ALIGN_EPI) { if (wr == 0) PG8_BAR; }
    PG8_BAR;
    if constexpr (Epi::AFTER_DRAIN) { E.fused(acc, cur, wr, wc, fr, fq, lds, wid, lane); S.done(cur); }
#undef PG8_SA
#undef PG8_SB
#undef PG8_STAGE
#undef PG8_LDA
#undef PG8_LDB
#undef PG8_MMA
#undef PG8_WAIT_V
#undef PG8_WAIT_L
#undef PG8_BAR
#undef PG8_SCHED
}
}

namespace pg8 {
__device__ __forceinline__ float fsig(float v) { return __builtin_amdgcn_rcpf(1.f + __builtin_amdgcn_exp2f(-1.4426950408889634f * v)); }
__device__ __forceinline__ u32x4 pack8(const f32x4 a, const f32x4 b) { u32x4 w; w.x = cvt_pk_bf16(a[0], a[1]); w.y = cvt_pk_bf16(a[2], a[3]); w.z = cvt_pk_bf16(b[0], b[1]); w.w = cvt_pk_bf16(b[2], b[3]); return w; }
__device__ __forceinline__ void unpack8(const u32x4 w, f32x4& a, f32x4& b) {
    a[0] = __builtin_bit_cast(float, w.x << 16); a[1] = __builtin_bit_cast(float, w.x & 0xffff0000u); a[2] = __builtin_bit_cast(float, w.y << 16); a[3] = __builtin_bit_cast(float, w.y & 0xffff0000u);
    b[0] = __builtin_bit_cast(float, w.z << 16); b[1] = __builtin_bit_cast(float, w.z & 0xffff0000u); b[2] = __builtin_bit_cast(float, w.w << 16); b[3] = __builtin_bit_cast(float, w.w & 0xffff0000u); }
#define PIN16(a) asm volatile("" : "+v"(a[0][0][0]), "+v"(a[0][0][1]), "+v"(a[0][1][0]), "+v"(a[0][1][1]), "+v"(a[0][2][0]), "+v"(a[0][2][1]), "+v"(a[0][3][0]), "+v"(a[0][3][1]), \
    "+v"(a[1][0][0]), "+v"(a[1][0][1]), "+v"(a[1][1][0]), "+v"(a[1][1][1]), "+v"(a[1][2][0]), "+v"(a[1][2][1]), "+v"(a[1][3][0]), "+v"(a[1][3][1]))
__device__ __forceinline__ float dot4(const f32x4 a) { return (a[0] * a[0] + a[1] * a[1]) + (a[2] * a[2] + a[3] * a[3]); }
__device__ __forceinline__ void row_rstd(const float* SS, const Unit& u, int wr, int fr, int fq, float (&rs)[2][4]) {
#pragma unroll
    for (int ai = 0; ai < 2; ++ai)
#pragma unroll
        for (int m = 0; m < 4; ++m) { const size_t row = (size_t)(u.pm * BM + ai * HALF + wr * 64 + m * 16 + fr); const f32x4 p = *(const f32x4*)(SS + row * 16 + 4 * fq);
            float s = (p[0] + p[1]) + (p[2] + p[3]); s += shx(s, fq * 16 + fr, 16); s += shx(s, fq * 16 + fr, 32); rs[ai][m] = 1.0f / sqrtf(s * (1.0f / D) + RMS_EPS); }
}
struct EpiSwigluF { static constexpr bool PERM = true, AFTER_DRAIN = false, HOOK = false; static constexpr int HOOK_T = 0; bf16_t* H; const float* SS;
    __device__ __forceinline__ void operator()(const f32x4 (&acc)[2][2][4][2], const Unit& u, int wr, int wc, int fr, int fq) const {
        const int row0 = u.pm * BM + wr * 64 + fr, col0 = u.pn * 128 + wc * 32 + 8 * fq;
        for (int rp_ = 0; rp_ < 1 + ((REP_MASK >> 6) & 1); ++rp_) {
        float rs[2][4]; row_rstd(SS, u, wr, fr, fq, rs);
#pragma unroll
        for (int ai = 0; ai < 2; ++ai)
#pragma unroll
            for (int m = 0; m < 4; ++m) { bf16_t* rowp = H + (size_t)(row0 + ai * HALF + m * 16) * DFF + col0; const float r = rs[ai][m];
                f32x4 h0, h1;
#pragma unroll
                for (int i = 0; i < 4; ++i) { const float g0 = acc[ai][0][m][0][i] * r, g1 = acc[ai][0][m][1][i] * r; h0[i] = g0 * fsig(g0) * (acc[ai][1][m][0][i] * r); h1[i] = g1 * fsig(g1) * (acc[ai][1][m][1][i] * r); }
                __builtin_nontemporal_store(pack8(h0, h1), (u32x4*)rowp); }
        }
    } };
template <bool FINAL> struct EpiResidB { static constexpr bool PERM = true, AFTER_DRAIN = false, HOOK = false; static constexpr int HOOK_T = 0; bf16_t* XB; float* Of; float* SS; float coef;
    __device__ __forceinline__ void operator()(const f32x4 (&acc)[2][2][4][2], const Unit& u, int wr, int wc, int fr, int fq) const {
        const int row0 = u.pm * BM + wr * 64 + fr, col0 = u.pn * BM + wc * 32 + 8 * fq;
        u32x4 rr[2][4][2];
#pragma unroll
        for (int ai = 0; ai < 2; ++ai)
#pragma unroll
            for (int m = 0; m < 4; ++m)
#pragma unroll
                for (int bj = 0; bj < 2; ++bj) rr[ai][m][bj] = *(const u32x4*)(XB + (size_t)(row0 + ai * HALF + m * 16) * D + col0 + bj * HALF);
        PIN16(rr);
#pragma unroll
        for (int ai = 0; ai < 2; ++ai)
#pragma unroll
            for (int m = 0; m < 4; ++m) { const size_t row = (size_t)(row0 + ai * HALF + m * 16); float ssq = 0.f;
#pragma unroll
                for (int bj = 0; bj < 2; ++bj) { const int c = col0 + bj * HALF; f32x4 r0, r1; unpack8(rr[ai][m][bj], r0, r1);
                    f32x4 v0 = r0 + acc[ai][bj][m][0] * coef, v1 = r1 + acc[ai][bj][m][1] * coef;
                    if (FINAL) { *(f32x4*)(Of + row * D + c) = v0; *(f32x4*)(Of + row * D + c + 4) = v1; }
                    else { const u32x4 w = pack8(v0, v1); *(u32x4*)(XB + row * D + c) = w; unpack8(w, v0, v1); }
                    ssq += dot4(v0) + dot4(v1); }
                ssq += shx(ssq, fq * 16 + fr, 16); ssq += shx(ssq, fq * 16 + fr, 32);
                if (fq == 0) SS[row * 16 + 4 * u.pn + wc] = ssq; }
    } };
struct EpiProjF { static constexpr bool PERM = true, AFTER_DRAIN = false, HOOK = false; static constexpr int HOOK_T = 0; bf16_t* PA; bf16_t* PB; float* SG; const float* SS; const float* fb; const float* ib; const float* mfb;
    __device__ __forceinline__ void operator()(const f32x4 (&acc)[2][2][4][2], const Unit& u, int wr, int wc, int fr, int fq) const {
        const int row0 = u.pm * BM + wr * 64 + fr;
        float rs[2][4]; row_rstd(SS, u, wr, fr, fq, rs);
        if (u.pn < 22) {
            const int act = u.pn < 2 ? 0 : (u.pn < 12 ? 1 : 2); const int col0 = (u.pn < 12 ? u.pn : u.pn - 12) * BM + wc * 32 + 8 * fq;
            bf16_t* base = u.pn < 12 ? PA : PB; const int pitch = u.pn < 12 ? PJA : PJB;
#pragma unroll
            for (int ai = 0; ai < 2; ++ai)
#pragma unroll
                for (int m = 0; m < 4; ++m) { bf16_t* rowp = base + (size_t)(row0 + ai * HALF + m * 16) * pitch + col0; const float r = rs[ai][m] * (act == 0 ? QSCALE2 : 1.0f);
#pragma unroll
                    for (int bj = 0; bj < 2; ++bj) { f32x4 v0 = acc[ai][bj][m][0] * r, v1 = acc[ai][bj][m][1] * r;
                        if (act == 2) {
#pragma unroll
                            for (int i = 0; i < 4; ++i) { v0[i] = fsig(v0[i]); v1[i] = fsig(v1[i]); } }
                        __builtin_nontemporal_store(pack8(v0, v1), (u32x4*)(rowp + bj * HALF)); } }
        } else if (wc == 0 && fq < 2) {
            const f32x4 b0 = fq == 0 ? *(const f32x4*)fb : *(const f32x4*)ib, b1 = fq == 0 ? *(const f32x4*)(fb + 4) : *(const f32x4*)mfb;
#pragma unroll
            for (int ai = 0; ai < 2; ++ai)
#pragma unroll
                for (int m = 0; m < 4; ++m) { float* sp = SG + (size_t)(row0 + ai * HALF + m * 16) * 16 + 8 * fq; const float r = rs[ai][m];
                    f32x4 v0 = acc[ai][0][m][0] * r + b0, v1 = acc[ai][0][m][1] * r + b1;
#pragma unroll
                    for (int i = 0; i < 4; ++i) { if (fq == 0) v0[i] = logsigmoidf_(v0[i]); v1[i] = logsigmoidf_(v1[i]); }
                    *(f32x4*)sp = v0; *(f32x4*)(sp + 4) = v1; }
        }
    } };
struct EpiMergeF { static constexpr bool PERM = true, AFTER_DRAIN = false, HOOK = true; static constexpr int HOOK_T = 8; const bf16_t* PB; bf16_t* MG;
    __device__ __forceinline__ void mid(f32x4 (&acc)[2][2][4][2], const Unit& u, int wr, int wc, int fr, int fq) const {
        int row0 = u.pm * BM + wr * 64 + fr, col0 = u.pn * BM + wc * 32 + 8 * fq; asm volatile("" : "+v"(row0), "+v"(col0));
#pragma unroll
        for (int ai = 0; ai < 2; ++ai) {
            u32x4 gg[2][4][2];
#pragma unroll
            for (int m = 0; m < 4; ++m)
#pragma unroll
                for (int bj = 0; bj < 2; ++bj) { const bf16_t* rowp = PB + (size_t)(row0 + ai * HALF + m * 16) * PJB + col0 + bj * HALF; gg[0][m][bj] = *(const u32x4*)(rowp + PB_GA); gg[1][m][bj] = *(const u32x4*)(rowp + PB_GB); }
            PIN16(gg);
#pragma unroll
            for (int m = 0; m < 4; ++m) {
#pragma unroll
                for (int bj = 0; bj < 2; ++bj) { f32x4 a0, a1, b0, b1; unpack8(gg[0][m][bj], a0, a1); unpack8(gg[1][m][bj], b0, b1);
#pragma unroll
                    for (int i = 0; i < 4; ++i) { acc[ai][bj][m][0][i] *= a0[i] * __builtin_amdgcn_rcpf(fmaxf(b0[i], 1e-30f)); acc[ai][bj][m][1][i] *= a1[i] * __builtin_amdgcn_rcpf(fmaxf(b1[i], 1e-30f)); } } } }
    }
    __device__ __forceinline__ void operator()(const f32x4 (&acc)[2][2][4][2], const Unit& u, int wr, int wc, int fr, int fq) const {
        const int row0 = u.pm * BM + wr * 64 + fr, col0 = u.pn * BM + wc * 32 + 8 * fq;
        u32x4 gb[2][4][2];
#pragma unroll
        for (int ai = 0; ai < 2; ++ai)
#pragma unroll
            for (int m = 0; m < 4; ++m)
#pragma unroll
                for (int bj = 0; bj < 2; ++bj) gb[ai][m][bj] = *(const u32x4*)(PB + (size_t)(row0 + ai * HALF + m * 16) * PJB + PB_GB + col0 + bj * HALF);
        PIN16(gb);
#pragma unroll
        for (int ai = 0; ai < 2; ++ai)
#pragma unroll
            for (int m = 0; m < 4; ++m) { const size_t row = (size_t)(row0 + ai * HALF + m * 16);
#pragma unroll
                for (int bj = 0; bj < 2; ++bj) { const int c = col0 + bj * HALF; f32x4 b0, b1; unpack8(gb[ai][m][bj], b0, b1);
                    *(u32x4*)(MG + row * D + c) = pack8(b0 * acc[ai][bj][m][0], b1 * acc[ai][bj][m][1]); } }
    } };
}

__device__ __forceinline__ void transpose_item(const float* W, int N, int scol0, bf16* WT, int ldt, int drow0, int k0, int kdst0, LAS float* scr, int lane, const float* gain) {
#pragma unroll 8
    for (int i = 0; i < 32; ++i) { const int kk = 2 * i + (lane >> 5); const float gk = gain ? gain[k0 + kk] : 1.0f; scr[kk * 33 + (lane & 31)] = W[(size_t)(k0 + kk) * N + scol0 + (lane & 31)] * gk; }
    asm volatile("s_waitcnt lgkmcnt(0)" ::: "memory");
    const int c = lane & 7;
#pragma unroll
    for (int j = 0; j < 4; ++j) { const int n = (lane >> 3) + 8 * j; const LAS float* s = scr + (8 * c) * 33 + n;
        v4u o; o.x = pk2(s[0 * 33], s[1 * 33]); o.y = pk2(s[2 * 33], s[3 * 33]); o.z = pk2(s[4 * 33], s[5 * 33]); o.w = pk2(s[6 * 33], s[7 * 33]);
        *(GAS v4u*)(WT + (size_t)(drow0 + n) * ldt + kdst0 + k0 + 8 * c) = o; }
    asm volatile("s_waitcnt lgkmcnt(0)" ::: "memory");
}
__device__ __forceinline__ void phase_weights(Frame& F) {
    const int ptid = opaque_tid(F.wave), plane = ptid & 63, pwave = __builtin_amdgcn_readfirstlane(ptid >> 6); (void)plane; (void)pwave;
    LAS float* scr = (LAS float*)(F.lds + pwave * 16384);
    const int gw = blockIdx.x * NWAVES + pwave, NGW = F.G * NWAVES;
    constexpr int PJ = PJA + PJB; constexpr int I_IN = (D / 64) * (NFF / 32), I_OUT = (DFF / 64) * (D / 32), I_PJ = (D / 64) * (PJ / 32), I_UP = (512 / 64) * (D / 32), I_WO = (D / 64) * (D / 32);
    constexpr int NITEMS = 2 * I_IN + 2 * I_OUT + I_PJ + 2 * I_UP + I_WO;
    for (int it = gw; it < NITEMS; it += NGW) {
        int r = it;
        if (r < 2 * I_IN) { const int which = r / I_IN; r -= which * I_IN; const int ndb = NFF / 32, kb = r / ndb, db = r % ndb, n = db * 32, pn = n >> 8, j = n & 255;
            const int sc = (j < 128) ? pn * 128 + j : DFF + pn * 128 + (j - 128);
            transpose_item(F.in[which ? 15 : 2], NFF, sc, (bf16*)(F.ws + (which ? WS_W2IN : WS_W1IN)), D, n, kb * 64, 0, scr, plane, F.in[which ? 14 : 1]); continue; }
        r -= 2 * I_IN;
        if (r < 2 * I_OUT) { const int which = r / I_OUT; r -= which * I_OUT; const int ndb = D / 32, kb = r / ndb, db = r % ndb;
            transpose_item(F.in[which ? 16 : 3], D, db * 32, (bf16*)(F.ws + (which ? WS_W2OUT : WS_W1OUT)), DFF, db * 32, kb * 64, 0, scr, plane, nullptr); continue; }
        r -= 2 * I_OUT;
        if (r < I_PJ) { const int ndb = PJ / 32, kb = r / ndb, db = r % ndb, n = db * 32; const int sc = n + (n < 1536 ? 0 : (n < 3072 ? 8 : 16));
            transpose_item(F.in[5], INC, sc, (bf16*)(F.ws + WS_WIN), D, n, kb * 64, 0, scr, plane, F.in[4]); continue; }
        r -= I_PJ;
        if (r < 2 * I_UP) { const int which = r / I_UP; r -= which * I_UP; const int ndb = D / 32, kb = r / ndb, db = r % ndb;
            transpose_item(F.in[which ? 12 : 11], D, db * 32, (bf16*)(F.ws + WS_WCAT), D, db * 32, kb * 64, which ? 512 : 0, scr, plane, nullptr); continue; }
        r -= 2 * I_UP;
        { const int ndb = D / 32, kb = r / ndb, db = r % ndb; transpose_item(F.in[13], D, db * 32, (bf16*)(F.ws + WS_WOUT), D, db * 32, kb * 64, 0, scr, plane, nullptr); }
    }
    { bf16* WT = (bf16*)(F.ws + WS_WIN); const float* W = F.in[5];
      for (int idx = blockIdx.x * NTHR + ptid; idx < 256 * 128; idx += F.G * NTHR) { const int row = idx >> 7, k8 = (idx & 127) * 8; v4u o = {0u, 0u, 0u, 0u};
          if (row < 16) { const int sc = row < 8 ? 1536 + row : (row < 12 ? 3080 + (row - 8) : 3084 + (row - 12)); float v[8];
#pragma unroll
              for (int i = 0; i < 8; ++i) v[i] = W[(size_t)(k8 + i) * INC + sc] * F.in[4][k8 + i];
              o.x = pk2(v[0], v[1]); o.y = pk2(v[2], v[3]); o.z = pk2(v[4], v[5]); o.w = pk2(v[6], v[7]); }
          *(GAS v4u*)(WT + (size_t)(PJ + row) * D + k8) = o; } }
}

#include <hip/hip_bf16.h>
#include <cmath>
namespace attn_body {
using bf16=__hip_bfloat16;
using bf16x8=__attribute__((ext_vector_type(8)))short;
using s16x4=__attribute__((ext_vector_type(4)))short;
using f32x16=__attribute__((ext_vector_type(16)))float;
using u32x4=__attribute__((ext_vector_type(4)))unsigned;
constexpr int BATCH=32,NHEAD=8,SEQ=2048,D=64,DM=3072,OP=1024;
constexpr int NW=8,QBLK=32,QB=QBLK*NW,KVBLK=64,NQB=SEQ/QB;
constexpr int ATTN_PITCH=DM, ATTN_UNIT_ROWS=QB;
__device__ __forceinline__ int crow(int r,int hi){return (r&3)+8*(r>>2)+4*hi;}
#define SBAR() __builtin_amdgcn_sched_barrier(0)
__device__ __forceinline__ void cmask(f32x16&p0,f32x16&p1,int jb,int qrel,int hi){
  const float NEG=-INFINITY; int kb=64*jb+4*hi;
  #pragma unroll
  for(int r=0;r<16;++r){int kv=kb+(r&3)+8*(r>>2); if(kv>qrel)p0[r]=NEG; if(kv+32>qrel)p1[r]=NEG;}
}

constexpr int NSLOT=3, SLOTB=8192;
constexpr int LDS_K=0, LDS_V=NSLOT*SLOTB, LDS_WS=2*NSLOT*SLOTB, LDS_OST=LDS_WS+NW*64*4, LDS_BIAS=LDS_OST+NW*4096, LDS_ROWB=LDS_BIAS+SEQ*8, LDS_BYTES=LDS_ROWB+QB*4;
constexpr float C2=0.125f*1.4426950408889634f;
__device__ __forceinline__ void glds16(const void*gsrc,unsigned lds_dst){unsigned keep;
  asm volatile("s_mov_b32 %0, m0\n\ts_mov_b32 m0, %2\n\ts_nop 0\n\tglobal_load_lds_dwordx4 %1, off\n\ts_mov_b32 m0, %0":"=&s"(keep):"v"(gsrc),"s"(lds_dst):"memory");}
__device__ __forceinline__ float max3f(float a,float b,float c){float r;asm("v_max3_f32 %0, %1, %2, %3":"=v"(r):"v"(a),"v"(b),"v"(c));return r;}
__device__ __forceinline__ float max2f(float a,float b){float r;asm("v_max_f32_e32 %0, %1, %2":"=v"(r):"v"(a),"v"(b));return r;}
__device__ __forceinline__ float fadd_s(float a,float b){float r;asm("v_add_f32_e32 %0, %1, %2":"=v"(r):"v"(a),"v"(b));return r;}
__device__ __forceinline__ float fsub_s(float a,float b){float r;asm("v_sub_f32_e32 %0, %1, %2":"=v"(r):"v"(a),"v"(b));return r;}
typedef float f32x2_t __attribute__((ext_vector_type(2))); typedef __bf16 bf16x2_t __attribute__((ext_vector_type(2)));
__device__ __forceinline__ unsigned cvtpk_s(float lo,float hi){f32x2_t v={lo,hi};bf16x2_t b=__builtin_convertvector(v,bf16x2_t);return __builtin_bit_cast(unsigned,b);}
#define WAIT_BAR(N) asm volatile("s_waitcnt vmcnt(" #N ") lgkmcnt(0)\n\ts_barrier":::"memory")

__device__ __forceinline__ void qkt(f32x16&p0,f32x16&p1,const char*Kslot,const bf16x8*qr,int r32,int hi,bf16x8 kx0,bf16x8 kx1,bf16x8 qx){
  const char*kb=Kslot+hi*1024+r32*16;
  #pragma unroll
  for(int d0=0;d0<4;++d0){
    const bf16x8 b0=*reinterpret_cast<const bf16x8*>(kb+d0*2048);
    const bf16x8 b1=*reinterpret_cast<const bf16x8*>(kb+d0*2048+512);
    if(d0==0){p0=__builtin_amdgcn_mfma_f32_32x32x16_bf16(b0,qr[0],f32x16{},0,0,0);p1=__builtin_amdgcn_mfma_f32_32x32x16_bf16(b1,qr[0],f32x16{},0,0,0);}
    else{p0=__builtin_amdgcn_mfma_f32_32x32x16_bf16(b0,qr[d0],p0,0,0,0);p1=__builtin_amdgcn_mfma_f32_32x32x16_bf16(b1,qr[d0],p1,0,0,0);}}
  p0=__builtin_amdgcn_mfma_f32_32x32x16_bf16(kx0,qx,p0,0,0,0);p1=__builtin_amdgcn_mfma_f32_32x32x16_bf16(kx1,qx,p1,0,0,0);
}
typedef __attribute__((address_space(3))) const char* lds_cptr;
typedef short v4i16_t __attribute__((ext_vector_type(4)));
__device__ __forceinline__ void kload8(bf16x8*kf,lds_cptr kp){
  kf[0]=*(const __attribute__((address_space(3))) bf16x8*)(kp);      kf[1]=*(const __attribute__((address_space(3))) bf16x8*)(kp+512);
  kf[2]=*(const __attribute__((address_space(3))) bf16x8*)(kp+2048); kf[3]=*(const __attribute__((address_space(3))) bf16x8*)(kp+2560);
  kf[4]=*(const __attribute__((address_space(3))) bf16x8*)(kp+4096); kf[5]=*(const __attribute__((address_space(3))) bf16x8*)(kp+4608);
  kf[6]=*(const __attribute__((address_space(3))) bf16x8*)(kp+6144); kf[7]=*(const __attribute__((address_space(3))) bf16x8*)(kp+6656);
}
__device__ __forceinline__ void kload2(bf16x8*kf,lds_cptr kp,int j){ kf[2*j]=*(const __attribute__((address_space(3))) bf16x8*)(kp+j*2048); kf[2*j+1]=*(const __attribute__((address_space(3))) bf16x8*)(kp+j*2048+512); }
typedef unsigned u32x2_t __attribute__((ext_vector_type(2)));
__device__ __forceinline__ bf16x8 kxfrag(lds_cptr tbl,int kv,int hi){ u32x2_t b=*(const __attribute__((address_space(3))) u32x2_t*)(tbl+kv*8); if(hi){b.x=0u;b.y=0u;} const u32x4 w={b.x,b.y,hi?0u:0x3F803F80u,0u}; return __builtin_bit_cast(bf16x8,w); }
__device__ __forceinline__ s16x4 vtr(lds_cptr p){ return __builtin_bit_cast(s16x4,__builtin_amdgcn_ds_read_tr16_b64_v4i16((__attribute__((address_space(3))) v4i16_t*)p)); }
__device__ __forceinline__ float rowmax(const f32x16&p0,const f32x16&p1){
  float a=max3f(p0[0],p0[1],p1[0]),b=max3f(p0[2],p0[3],p1[1]);a=max3f(a,p1[2],p1[3]);
  #pragma unroll
  for(int r=4;r<16;r+=4){a=max3f(a,p0[r],p0[r+1]);b=max3f(b,p0[r+2],p0[r+3]);a=max3f(a,p1[r],p1[r+1]);b=max3f(b,p1[r+2],p1[r+3]);}
  const float m=max2f(a,b);
  auto rr=__builtin_amdgcn_permlane32_swap(__float_as_uint(m),__float_as_uint(m),false,false);
  return max2f(__uint_as_float(rr[0]),__uint_as_float(rr[1]));
}
__device__ __forceinline__ void pv(f32x16*o,int vb,bf16x8 pa0,bf16x8 pa1,bf16x8 pa2,bf16x8 pa3){
  #pragma unroll
  for(int d0=0;d0<2;++d0){s16x4 lo[4],hi[4];
    #pragma unroll
    for(int ks=0;ks<4;++ks){
      asm volatile("ds_read_b64_tr_b16 %0,%1 offset:%c2":"=&v"(lo[ks]):"v"(vb),"i"(d0*4096+ks*1024):"memory");
      asm volatile("ds_read_b64_tr_b16 %0,%1 offset:%c2":"=&v"(hi[ks]):"v"(vb),"i"(d0*4096+ks*1024+512):"memory");}
    asm volatile("s_waitcnt lgkmcnt(0)":::"memory");SBAR();
    #define PK(k) (bf16x8){lo[k][0],lo[k][1],lo[k][2],lo[k][3],hi[k][0],hi[k][1],hi[k][2],hi[k][3]}
    o[d0]=__builtin_amdgcn_mfma_f32_32x32x16_bf16(pa0,PK(0),o[d0],0,0,0);
    o[d0]=__builtin_amdgcn_mfma_f32_32x32x16_bf16(pa1,PK(1),o[d0],0,0,0);
    o[d0]=__builtin_amdgcn_mfma_f32_32x32x16_bf16(pa2,PK(2),o[d0],0,0,0);
    o[d0]=__builtin_amdgcn_mfma_f32_32x32x16_bf16(pa3,PK(3),o[d0],0,0,0);
    #undef PK
  }
}

#ifndef ATTN_STORE16
#define ATTN_STORE16(p,v) (*(u32x4*)(p)=(v))
#endif
template<int THRL> __device__ __forceinline__ void attn_unit(int b,int h,int qb,const bf16*Q,const bf16*__restrict__ K,const bf16*__restrict__ V,bf16*O,const float*CUMh,char*shm,const int wv){
  int tid_=wv*64+(int)__builtin_amdgcn_mbcnt_hi(~0u,__builtin_amdgcn_mbcnt_lo(~0u,0u)); asm volatile("":"+v"(tid_)); const int tid=tid_,lane=tid&63,r32=lane&31,hi=lane>>5; const int wid=__builtin_amdgcn_readfirstlane(tid>>6);
  const long rowbase=(long)b*SEQ; const int q0=qb*QB;
  const bf16*Qw=Q+(rowbase+q0+wid*QBLK)*DM+h*D;
  const bf16*Kh=K+rowbase*DM+h*D,*Vh=V+rowbase*DM+h*D;
  const unsigned lds0=(unsigned)(uintptr_t)shm;
  float*wsf=(float*)(shm+LDS_WS)+wid*64;
  const bf16*ksrc=Kh+(long)lane*DM+wid*8;
  const bf16*vsrc=Vh+(long)(16*(wid&3)+(lane>>2))*DM+(wid>>2)*32+(lane&3)*8;
  const unsigned kdst=lds0+LDS_K+wid*1024, vdst=lds0+LDS_V+wid*1024;
  #define DMA_K(t,slot) glds16(ksrc+(long)(t)*KVBLK*DM,(unsigned)__builtin_amdgcn_readfirstlane(kdst+(slot)))
  #define DMA_V(t,slot) glds16(vsrc+(long)(t)*KVBLK*DM,(unsigned)__builtin_amdgcn_readfirstlane(vdst+(slot)))
  const int vb0=(int)(lds0+LDS_V)+((lane>>4)&1)*32+(lane&3)*8+(4*hi+((lane&15)>>2))*64;
  const char*Kbase=shm+LDS_K; bf16x8 kf[8];
  const lds_cptr shm3=(lds_cptr)shm; const lds_cptr kp0=shm3+LDS_K+hi*1024+r32*16; const lds_cptr vp0=shm3+LDS_V+((lane>>4)&1)*32+(lane&3)*8+(4*hi+((lane&15)>>2))*64;
  const int NT=(q0+QB)/KVBLK;
  DMA_K(0,0);DMA_V(0,0);DMA_K(1,SLOTB);
  bf16x8 qr[4];
  #pragma unroll
  for(int d0=0;d0<4;++d0)qr[d0]=*reinterpret_cast<const bf16x8*>(&Qw[(long)r32*DM+d0*16+hi*8]);
  const int qrel=wid*QBLK+r32;
  { const float cref=CUMh[q0]; __attribute__((address_space(3))) unsigned*bt=(__attribute__((address_space(3))) unsigned*)(shm3+LDS_BIAS); __attribute__((address_space(3))) float*rb=(__attribute__((address_space(3))) float*)(shm3+LDS_ROWB);
    for(int kv=tid;kv<q0+QB;kv+=NW*64){ const float bias=(cref-CUMh[kv])*1.4426950408889634f;
      const unsigned u1=__builtin_bit_cast(unsigned,bias); const unsigned h1=(u1+0x7fffu+((u1>>16)&1u))&0xffff0000u; const float r1=bias-__builtin_bit_cast(float,h1);
      const unsigned u2=__builtin_bit_cast(unsigned,r1);   const unsigned h2=(u2+0x7fffu+((u2>>16)&1u))&0xffff0000u; const float r2=r1-__builtin_bit_cast(float,h2);
      const unsigned u3=__builtin_bit_cast(unsigned,r2);   const unsigned h3=(u3+0x7fffu+((u3>>16)&1u))&0xffff0000u;
      bt[2*kv]=(h1>>16)|h2; bt[2*kv+1]=(h3>>16)|0x3F800000u; if(kv>=q0)rb[kv-q0]=bias; } }
  const lds_cptr btab=shm3+LDS_BIAS; u32x4 qxw={hi?0u:0x3F803F80u,0u,0u,0u};
  #define QX __builtin_bit_cast(bf16x8,qxw)
  #define RNEHI(u) (((u)+0x7fffu+(((u)>>16)&1u))&0xffff0000u)
  #define SETQX() do{ const float nm_=-mhat; const unsigned a1_=RNEHI(__builtin_bit_cast(unsigned,nm_)); const float s1_=nm_-__builtin_bit_cast(float,a1_); \
      const unsigned a2_=RNEHI(__builtin_bit_cast(unsigned,s1_)); const float s2_=s1_-__builtin_bit_cast(float,a2_); const unsigned a3_=RNEHI(__builtin_bit_cast(unsigned,s2_)); \
      qxw.y=hi?0u:(a1_|0x3F80u); qxw.z=hi?0u:((a2_>>16)|a3_); }while(0)
  float mhat=0.f,l_reg=0.f;f32x16 o[2];o[0]=f32x16{};o[1]=f32x16{};
  #define CMASK(P0,P1,t) do{int jb_=(t)-(NT-4); if(jb_>=0)cmask(P0,P1,jb_,qrel,hi);}while(0)
  bool resc=false;
  #define START(P0,P1) do{ const float rm=rowmax(P0,P1); resc=false; \
    { const float dl=max2f(rm,0.f); mhat=fadd_s(mhat,dl); \
      _Pragma("unroll") for(int r=0;r<16;++r){P0[r]=fsub_s(P0[r],dl);P1[r]=fsub_s(P1[r],dl);} \
      SETQX(); } \
    _Pragma("unroll") for(int r=0;r<16;++r)P0[r]=__builtin_amdgcn_exp2f(P0[r]); }while(0)
  #define RESC() do{ if(resc){ asm volatile("s_waitcnt lgkmcnt(0)":::"memory"); \
      _Pragma("unroll") for(int d_=0;d_<2;++d_) _Pragma("unroll") for(int r=0;r<16;++r)o[d_][r]*=wsf[crow(r,hi)]; } }while(0)
  f32x16 pA0,pA1,pB0,pB1;
  int sl_prev=0,sl_cur=0,sl_next=SLOTB;
  #define ROT() do{sl_prev=sl_cur;sl_cur=sl_next;sl_next=(sl_next==(NSLOT-1)*SLOTB)?0:sl_next+SLOTB;}while(0)
  DMA_K(2,2*SLOTB);
  WAIT_BAR(3);
  mhat=*(const __attribute__((address_space(3))) float*)(shm3+LDS_ROWB+qrel*4);
  SETQX();
  qkt(pA0,pA1,Kbase,qr,r32,hi,kxfrag(btab,r32,hi),kxfrag(btab,32+r32,hi),QX);asm volatile("s_nop 15\n\ts_nop 7":"+v"(pA0),"+v"(pA1));CMASK(pA0,pA1,0);
  START(pA0,pA1);
  _Pragma("unroll") for(int r=0;r<16;++r)pA1[r]=__builtin_amdgcn_exp2f(pA1[r]);
  WAIT_BAR(0);
  DMA_K(3,0);DMA_V(1,SLOTB);
  ROT();
  kload8(kf,kp0+sl_cur);
  WAIT_BAR(2);
  s16x4 vlo[8],vhi[8]; u32x4 pw0,pw1,pw2,pw3;
  #define PKW(P,B) cvtpk_s(P[B],P[B+1])
  #define PAF(k) __builtin_bit_cast(bf16x8,pw##k)
  #define VFR(i) (bf16x8){vlo[i][0],vlo[i][1],vlo[i][2],vlo[i][3],vhi[i][0],vhi[i][1],vhi[i][2],vhi[i][3]}
  #define PIN(x) asm volatile("":"+v"(x))
  #define MX3(a,b,c) __builtin_fmaxf(__builtin_fmaxf((a),(b)),(c))
  #define GAPA(MF,A0,A1,A2,A3,W0,W1,PW) do{ MF; sacc+=A0; sacc+=A1; sacc+=A2; sacc+=A3; PIN(sacc); W0; W1; PIN(PW); SBAR(); }while(0)
  #define EX(v) __builtin_amdgcn_exp2f(v)
  #define GAPB(MF,X,B) do{ MF; X[B]=EX(X[B]); X[B+1]=EX(X[B+1]); X[B+2]=EX(X[B+2]); X[B+3]=EX(X[B+3]); PIN(X); SBAR(); }while(0)
  #define VRD(i) do{ vlo[i]=vtr(vp_+(((i)>>2)*4096+((i)&3)*1024)); vhi[i]=vtr(vp_+(((i)>>2)*4096+((i)&3)*1024+512)); }while(0)
  #define KRD(G,j) do{ if(G){ kload2(kf,kp0+sl_next,j); SBAR(); } }while(0)
  #define STEP(C0,C1,P0,P1,t,GK,GV,GL) do{ SBAR(); \
    const lds_cptr vp_=vp0+sl_prev; \
    const bf16x8 kx0_=kxfrag(btab,64*(t)+r32,hi), kx1_=kxfrag(btab,64*(t)+32+r32,hi); \
    VRD(0); SBAR(); float sacc=(P0[0]+P0[1]); \
    GAPA(C0=__builtin_amdgcn_mfma_f32_32x32x16_bf16(kf[0],qr[0],f32x16{},0,0,0), P0[2],P0[3],P0[4],P0[5],     pw0[0]=PKW(P0,0), pw0[1]=PKW(P0,2), pw0); \
    VRD(4); SBAR(); GAPA(C1=__builtin_amdgcn_mfma_f32_32x32x16_bf16(kf[1],qr[0],f32x16{},0,0,0), P0[6],P0[7],P0[8],P0[9],     pw0[2]=PKW(P0,4), pw0[3]=PKW(P0,6), pw0); \
    VRD(1); SBAR(); GAPA(C0=__builtin_amdgcn_mfma_f32_32x32x16_bf16(kf[2],qr[1],C0,0,0,0),   P0[10],P0[11],P0[12],P0[13], pw1[0]=PKW(P0,8), pw1[1]=PKW(P0,10), pw1); \
    VRD(5); SBAR(); GAPA(C1=__builtin_amdgcn_mfma_f32_32x32x16_bf16(kf[3],qr[1],C1,0,0,0),   P0[14],P0[15],P1[0],P1[1],   pw1[2]=PKW(P0,12),pw1[3]=PKW(P0,14), pw1); \
    VRD(2); SBAR(); GAPA(C0=__builtin_amdgcn_mfma_f32_32x32x16_bf16(kf[4],qr[2],C0,0,0,0),   P1[2],P1[3],P1[4],P1[5],     pw2[0]=PKW(P1,0), pw2[1]=PKW(P1,2), pw2); \
    VRD(6); SBAR(); GAPA(C1=__builtin_amdgcn_mfma_f32_32x32x16_bf16(kf[5],qr[2],C1,0,0,0),   P1[6],P1[7],P1[8],P1[9],     pw2[2]=PKW(P1,4), pw2[3]=PKW(P1,6), pw2); \
    VRD(3); SBAR(); GAPA(C0=__builtin_amdgcn_mfma_f32_32x32x16_bf16(kf[6],qr[3],C0,0,0,0),   P1[10],P1[11],P1[12],P1[13], pw3[0]=PKW(P1,8), pw3[1]=PKW(P1,10), pw3); \
    VRD(7); SBAR(); GAPA(C1=__builtin_amdgcn_mfma_f32_32x32x16_bf16(kf[7],qr[3],C1,0,0,0),   P1[14],P1[15],0.f,0.f,       pw3[2]=PKW(P1,12),pw3[3]=PKW(P1,14), pw3); \
    C0=__builtin_amdgcn_mfma_f32_32x32x16_bf16(kx0_,QX,C0,0,0,0); C1=__builtin_amdgcn_mfma_f32_32x32x16_bf16(kx1_,QX,C1,0,0,0); SBAR(); \
    l_reg+=sacc; \
    if(GK){DMA_K((t)+3,sl_cur);} if(GV){DMA_V((t)+1,sl_next);} \
    CMASK(C0,C1,t); \
    { float a=MX3(C0[0],C0[1],C1[0]),b=MX3(C0[2],C0[3],C1[1]); a=MX3(a,C1[2],C1[3]); \
      _Pragma("unroll") for(int r=4;r<16;r+=4){a=MX3(a,C0[r],C0[r+1]);b=MX3(b,C0[r+2],C0[r+3]);a=MX3(a,C1[r],C1[r+1]);b=MX3(b,C1[r+2],C1[r+3]);} \
      float rm=__builtin_fmaxf(a,b); { auto rr=__builtin_amdgcn_permlane32_swap(__float_as_uint(rm),__float_as_uint(rm),false,false); rm=__builtin_fmaxf(__uint_as_float(rr[0]),__uint_as_float(rr[1])); } \
      resc=false; \
      if(__builtin_expect(__any(rm>(float)THRL),0)){ const float dl=__builtin_fmaxf(rm,0.f); mhat+=dl; \
        _Pragma("unroll") for(int r=0;r<16;++r){C0[r]-=dl;C1[r]-=dl;} \
        SETQX(); \
        const float f=__builtin_amdgcn_exp2f(-dl); l_reg*=f; if(hi==0)wsf[r32]=f; resc=true; } } \
    SBAR(); \
    GAPB(o[0]=__builtin_amdgcn_mfma_f32_32x32x16_bf16(PAF(0),VFR(0),o[0],0,0,0), C0,0); \
    GAPB(o[1]=__builtin_amdgcn_mfma_f32_32x32x16_bf16(PAF(0),VFR(4),o[1],0,0,0), C0,4); \
    KRD(GL,0); GAPB(o[0]=__builtin_amdgcn_mfma_f32_32x32x16_bf16(PAF(1),VFR(1),o[0],0,0,0), C0,8); \
    KRD(GL,1); GAPB(o[1]=__builtin_amdgcn_mfma_f32_32x32x16_bf16(PAF(1),VFR(5),o[1],0,0,0), C0,12); \
    KRD(GL,2); GAPB(o[0]=__builtin_amdgcn_mfma_f32_32x32x16_bf16(PAF(2),VFR(2),o[0],0,0,0), C1,0); \
    KRD(GL,3); GAPB(o[1]=__builtin_amdgcn_mfma_f32_32x32x16_bf16(PAF(2),VFR(6),o[1],0,0,0), C1,4); \
    GAPB(o[0]=__builtin_amdgcn_mfma_f32_32x32x16_bf16(PAF(3),VFR(3),o[0],0,0,0), C1,8); \
    GAPB(o[1]=__builtin_amdgcn_mfma_f32_32x32x16_bf16(PAF(3),VFR(7),o[1],0,0,0), C1,12); \
    }while(0)
  int t=1;
  #undef CMASK
  #define CMASK(P0,P1,t) do{}while(0)
  for(;t+5<NT;t+=2){
    STEP(pB0,pB1,pA0,pA1,t,true,true,true);     WAIT_BAR(2); RESC(); ROT();
    STEP(pA0,pA1,pB0,pB1,t+1,true,true,true);   WAIT_BAR(2); RESC(); ROT();
  }
  #undef CMASK
  #define CMASK(P0,P1,t) do{int jb_=(t)-(NT-4); if(jb_>=0)cmask(P0,P1,jb_,qrel,hi);}while(0)
  #define ENDW(tt) do{ if((tt)+3<NT){WAIT_BAR(2);} else if((tt)+2<NT){WAIT_BAR(1);} else {WAIT_BAR(0);} }while(0)
  for(;t+1<NT;t+=2){
    STEP(pB0,pB1,pA0,pA1,t,(t+3<NT),(t+1<NT),(t+1<NT));       ENDW(t);   RESC(); ROT();
    STEP(pA0,pA1,pB0,pB1,t+1,(t+4<NT),(t+2<NT),(t+2<NT));     ENDW(t+1); RESC(); ROT();
  }
  STEP(pB0,pB1,pA0,pA1,NT-1,false,false,false); RESC();
  { float sacc=pB0[0]+pB0[1]; _Pragma("unroll") for(int r=2;r<16;++r)sacc+=pB0[r]; _Pragma("unroll") for(int r=0;r<16;++r)sacc+=pB1[r]; l_reg+=sacc;
    pw0=(u32x4){PKW(pB0,0),PKW(pB0,2),PKW(pB0,4),PKW(pB0,6)};pw1=(u32x4){PKW(pB0,8),PKW(pB0,10),PKW(pB0,12),PKW(pB0,14)};pw2=(u32x4){PKW(pB1,0),PKW(pB1,2),PKW(pB1,4),PKW(pB1,6)};pw3=(u32x4){PKW(pB1,8),PKW(pB1,10),PKW(pB1,12),PKW(pB1,14)};
    SBAR(); pv(o,vb0+sl_cur,PAF(0),PAF(1),PAF(2),PAF(3)); }
  #undef PKW
  #undef PAF
  #undef VFR
  #undef PIN
  #undef MX3
  #undef GAPA
  #undef GAPB
  #undef EX
  #undef VRD
  #undef KRD
  #undef STEP
  #undef ENDW
  {auto rr=__builtin_amdgcn_permlane32_swap(__float_as_uint(l_reg),__float_as_uint(l_reg),false,false);l_reg=__uint_as_float(rr[0])+__uint_as_float(rr[1]);}
  if(hi==0)wsf[32+r32]=l_reg;asm volatile("s_waitcnt lgkmcnt(0)":::"memory");
  float rli[16];
  #pragma unroll
  for(int r=0;r<16;++r)rli[r]=__builtin_amdgcn_rcpf(wsf[32+crow(r,hi)]);
  bf16*Ow=O+(rowbase+q0+wid*QBLK)*OP+h*D;
  { bf16*stg=(bf16*)(shm+LDS_OST)+wid*2048;
    #pragma unroll
    for(int r=0;r<16;++r){const int orow=crow(r,hi);
      #pragma unroll
      for(int d0=0;d0<2;++d0)stg[orow*64+d0*32+r32]=__float2bfloat16(o[d0][r]*rli[r]);}
    asm volatile("s_waitcnt lgkmcnt(0)":::"memory");
    #pragma unroll
    for(int i=0;i<4;++i){const int row=i*8+(lane>>3),ch=lane&7; const u32x4 v=*(const u32x4*)(stg+row*64+ch*8); ATTN_STORE16(Ow+(long)row*OP+ch*8,v);} }
  asm volatile("s_waitcnt lgkmcnt(0)\n\ts_barrier":::"memory");
  #undef DMA_K
  #undef QX
  #undef RNEHI
  #undef SETQX
  #undef DMA_V
  #undef CMASK
  #undef START
  #undef RESC
  #undef ROT
}
constexpr int ATTN_LDS_BYTES=LDS_BYTES;
struct AttnTensors { const bf16* Q; const bf16* K; const bf16* V; bf16* O; const float* CUM; };
struct AttnUnit { int bh; int qb; };
struct StaticOrder {
  int c,G;
  __device__ __forceinline__ StaticOrder(int grid,int block):c(block),G(grid){}
  __device__ __forceinline__ bool next(int i,AttnUnit&u)const{ const int it=i*G+c; if(it>=BATCH*NHEAD*NQB)return false; u.bh=it%(BATCH*NHEAD); u.qb=NQB-1-it/(BATCH*NHEAD); return true; }
};
template<class Sched,int THRL=8> __device__ __forceinline__ void attn_phase(char*lds,const AttnTensors&T,const Sched&S,const int wv){
  AttnUnit u;
  for(int i=0;S.next(i,u);++i){ attn_unit<THRL>(u.bh/NHEAD,u.bh%NHEAD,u.qb,T.Q,T.K,T.V,T.O,T.CUM+(size_t)u.bh*SEQ,lds,wv); }
}
#undef SBAR
#undef WAIT_BAR
}

namespace mls {
typedef short bf16x8 __attribute__((ext_vector_type(8)));
typedef float f32x4v __attribute__((ext_vector_type(4)));
typedef unsigned u32x2v __attribute__((ext_vector_type(2)));
typedef unsigned u32x4v __attribute__((ext_vector_type(4)));
constexpr int QS = 136, TS = 72;
constexpr int L_Q = 0, L_K = 17408, L_KT = 34816, L_VT = 53248, L_WVT = 73984, L_SC = 94720, L_END = 103936;
constexpr float QK_SCALE = 0.08838834764831845f;
constexpr size_t G_A = 2 * MiB, G_RT = 3 * MiB, G_IT = 4 * MiB, G_EM = 5 * MiB, G_WK = 6 * MiB, G_CD = 7 * MiB, G_DL = 8 * MiB, G_UN = 9 * MiB, G_HALO = 11 * MiB;
__device__ __forceinline__ float scan_add(float v, int lane) {
#pragma unroll
    for (int o = 1; o < 64; o <<= 1) { const float t = bperm(v, (lane - o) & 63); if (lane >= o) v += t; }
    return v; }
__device__ __forceinline__ float scan_max(float v, int lane) {
#pragma unroll
    for (int o = 1; o < 64; o <<= 1) { const float t = bperm(v, (lane - o) & 63); if (lane >= o) v = fmaxf(v, t); }
    return v; }
__device__ __forceinline__ float lo_bf(unsigned w) { return __builtin_bit_cast(float, w << 16); }
__device__ __forceinline__ float hi_bf(unsigned w) { return __builtin_bit_cast(float, w & 0xffff0000u); }
typedef float f32x2_t __attribute__((ext_vector_type(2))); typedef __bf16 bf16x2_t __attribute__((ext_vector_type(2)));
__device__ __forceinline__ unsigned cvtpk(float lo, float hi) { f32x2_t v = {lo, hi}; bf16x2_t b = __builtin_convertvector(v, bf16x2_t); return __builtin_bit_cast(unsigned, b); }
__device__ __forceinline__ float fsilu(float v) { return v * __builtin_amdgcn_rcpf(1.f + __builtin_amdgcn_exp2f(-1.4426950408889634f * v)); }
}
__device__ __forceinline__ void phase_mgates(Frame& F, const float* SG) {
    using namespace mls;
    const int ptid = opaque_tid(F.wave), plane = ptid & 63, pwave = __builtin_amdgcn_readfirstlane(ptid >> 6);
    const int gw = blockIdx.x * NWAVES + pwave, NGW = F.G * NWAVES;
    float* GA = (float*)(F.ws + G_A); float* GPM = (float*)(F.ws + G_RT); float* GB = (float*)(F.ws + G_IT); float* GP63 = (float*)(F.ws + G_WK); float* GG = GP63 + BATCH * MLH * 32;
    for (int task = gw; task < BATCH * MLH * 32; task += NGW) {
        const int bh = task >> 5, c = task & 31, b = bh >> 2, h = bh & 3;
        const size_t row = (size_t)b * SEQ + 64 * c + plane;
        const float ig = SG[row * 16 + 8 + h], lf = SG[row * 16 + 12 + h];
        const float bcum = scan_add(lf, plane), aval = ig - bcum, pm = scan_max(aval, plane);
        const size_t idx = (size_t)bh * SEQ + 64 * c + plane;
        GA[idx] = aval; GPM[idx] = pm; GB[idx] = bcum;
        if (plane == 63) { GP63[task] = pm; GG[task] = bcum; }
    }
}
__device__ __forceinline__ void phase_mprep(Frame& F, const bf16* PA, const float* convw, const float* convb, bf16* SCR) {
    using namespace mls;
    const int tid = opaque_tid(F.wave), lane = tid & 63, wid = __builtin_amdgcn_readfirstlane(tid >> 6), l15 = lane & 15, q4 = lane >> 4;
    LAS unsigned char* L = F.lds;
    const float* GA = (const float*)(F.ws + G_A); const float* GPM = (const float*)(F.ws + G_RT); const float* GB = (const float*)(F.ws + G_IT); const float* GP63 = (const float*)(F.ws + G_WK); const float* GG = GP63 + BATCH * MLH * 32;
    float* GEM = (float*)(F.ws + G_EM); float* GCD = (float*)(F.ws + G_CD);
    float* DL = (float*)(F.ws + G_DL); float* UN = (float*)(F.ws + G_UN);
    const int ch2 = tid & 127, tq = __builtin_amdgcn_readfirstlane(tid >> 7); const bool isk = (wid & 1) != 0;
    const int cc = (ch2 & 63) * 2;
    const int e2 = tid & 63, sg = __builtin_amdgcn_readfirstlane(tid >> 6);
    const __amdgpu_buffer_rsrc_t rsP = __builtin_amdgcn_make_buffer_rsrc((void*)PA, 0, M * PJA * 2, 0x00020000), rsS = __builtin_amdgcn_make_buffer_rsrc((void*)SCR, 0, M * D * 4, 0x00020000);
    constexpr int S_QI = 0, S_UT = M * 512 * 2, S_NL = M * 1536 * 2;
    __syncthreads();
    for (int i = tid; i < 16 * TS / 2; i += NTHR) { ((LAS unsigned*)(L + L_VT + 128 * TS * 2))[i] = (i < TS / 2) ? 0x3F803F80u : 0u; ((LAS unsigned*)(L + L_WVT + 128 * TS * 2))[i] = 0u; }
    unsigned raw[19], vraw[8]; float g_pm, g_b, g_a, g_p63, g_g;
#define MP_BAR() asm volatile("s_waitcnt lgkmcnt(0)\n\ts_barrier" ::: "memory")
#define MP_LOAD(item) do { const int bh_ = (item) >> 5, c_ = (item) & 31, b_ = bh_ >> 2, h_ = bh_ & 3; const int r0_ = b_ * SEQ + 64 * c_; \
        const unsigned lo_raw_ = (unsigned)((isk ? PC_MK : PC_MQ) + h_ * 128 + cc) * 2u, lo_v_ = (unsigned)(PC_MV + h_ * 128 + 2 * e2) * 2u; \
        _Pragma("unroll") for (int i_ = 0; i_ < 19; ++i_) { const int tr_ = 16 * tq - 3 + i_; raw[i_] = (64 * c_ + tr_ >= 0) ? __builtin_amdgcn_raw_buffer_load_b32(rsP, lo_raw_, (r0_ + tr_) * (PJA * 2), 0) : 0u; } \
        _Pragma("unroll") for (int i_ = 0; i_ < 8; ++i_) vraw[i_] = __builtin_amdgcn_raw_buffer_load_b32(rsP, lo_v_, (r0_ + 8 * sg + i_) * (PJA * 2), 0); \
        const size_t gi_ = (size_t)bh_ * SEQ + 64 * c_ + lane; g_pm = GPM[gi_]; g_b = GB[gi_]; g_a = GA[gi_]; g_p63 = GP63[bh_ * 32 + (lane & 31)]; g_g = GG[bh_ * 32 + (lane & 31)]; } while (0)
    int it = blockIdx.x;
    if (it < BATCH * MLH * 32) MP_LOAD(it);
    for (; it < BATCH * MLH * 32; it += F.G) {
        const int bh = it >> 5, c = it & 31, b = bh >> 2, h = bh & 3; const int row0 = b * SEQ + 64 * c;
        const int cch = (isk ? 512 : 0) + h * 128 + cc;
        float w0[2], w1[2], w2[2], w3[2], cb[2];
#pragma unroll
        for (int i = 0; i < 2; ++i) { w0[i] = convw[cch + i]; w1[i] = convw[1024 + cch + i]; w2[i] = convw[2048 + cch + i]; w3[i] = convw[3072 + cch + i]; cb[i] = convb[cch + i]; }
        float mcar = 0.f;
        for (int cp = 0; cp < c; ++cp) mcar = rdl(g_g, cp) + fmaxf(mcar, rdl(g_p63, cp));
        const float Mx = fmaxf(mcar, rdl(g_p63, c)), mrow = fmaxf(g_pm, mcar);
        const float rowterm = -mrow, inter = __expf(mcar - mrow), aval = g_a, wk = __expf(g_a - Mx);
        if (wid == 0) { GEM[(size_t)bh * SEQ + 64 * c + lane] = __expf(-(g_b + mrow)); if (lane == 0) GCD[bh * 32 + c] = __expf(mcar - Mx); }
        {
            unsigned kt0[8], kt1[8];
#pragma unroll
            for (int i = 0; i < 16; i += 2) {
                float y[2][2];
#pragma unroll
                for (int u = 0; u < 2; ++u) {
                    const float a0 = w0[0] * lo_bf(raw[i + u]) + w1[0] * lo_bf(raw[i + u + 1]) + w2[0] * lo_bf(raw[i + u + 2]) + w3[0] * lo_bf(raw[i + u + 3]) + cb[0];
                    const float a1 = w0[1] * hi_bf(raw[i + u]) + w1[1] * hi_bf(raw[i + u + 1]) + w2[1] * hi_bf(raw[i + u + 2]) + w3[1] * hi_bf(raw[i + u + 3]) + cb[1];
                    y[u][0] = fsilu(a0); y[u][1] = fsilu(a1);
                    const int t = 16 * tq + i + u;
                    if (!isk) { const float q0 = y[u][0] * QK_SCALE, q1 = y[u][1] * QK_SCALE; const float itv = rdl(inter, t);
                        *(LAS unsigned*)(L + L_Q + (t * QS + cc) * 2) = cvtpk(q0, q1);
                        __builtin_amdgcn_raw_buffer_store_b32(cvtpk(q0 * itv, q1 * itv), rsS, (unsigned)((cc >> 5) * 1024 + ((cc >> 3) & 3) * 256 + (cc & 7) * 2), S_QI + (it * 4 + (t >> 4)) * 4096 + (t & 15) * 16, 0); }
                    else *(LAS unsigned*)(L + L_K + (t * QS + cc) * 2) = cvtpk(y[u][0], y[u][1]);
                }
                kt0[i >> 1] = cvtpk(y[0][0], y[1][0]); kt1[i >> 1] = cvtpk(y[0][1], y[1][1]);
            }
            if (isk) {
                *(LAS u32x4v*)(L + L_KT + (cc * TS + 16 * tq) * 2) = (u32x4v){kt0[0], kt0[1], kt0[2], kt0[3]}; *(LAS u32x4v*)(L + L_KT + (cc * TS + 16 * tq + 8) * 2) = (u32x4v){kt0[4], kt0[5], kt0[6], kt0[7]};
                *(LAS u32x4v*)(L + L_KT + ((cc + 1) * TS + 16 * tq) * 2) = (u32x4v){kt1[0], kt1[1], kt1[2], kt1[3]}; *(LAS u32x4v*)(L + L_KT + ((cc + 1) * TS + 16 * tq + 8) * 2) = (u32x4v){kt1[4], kt1[5], kt1[6], kt1[7]};
            }
            float v0[8], v1[8], wv[8];
#pragma unroll
            for (int i = 0; i < 8; ++i) { v0[i] = lo_bf(vraw[i]); v1[i] = hi_bf(vraw[i]); wv[i] = rdl(wk, 8 * sg + i); }
            *(LAS u32x4v*)(L + L_VT + ((2 * e2) * TS + 8 * sg) * 2) = (u32x4v){cvtpk(v0[0], v0[1]), cvtpk(v0[2], v0[3]), cvtpk(v0[4], v0[5]), cvtpk(v0[6], v0[7])};
            *(LAS u32x4v*)(L + L_VT + ((2 * e2 + 1) * TS + 8 * sg) * 2) = (u32x4v){cvtpk(v1[0], v1[1]), cvtpk(v1[2], v1[3]), cvtpk(v1[4], v1[5]), cvtpk(v1[6], v1[7])};
            *(LAS u32x4v*)(L + L_WVT + ((2 * e2) * TS + 8 * sg) * 2) = (u32x4v){cvtpk(v0[0] * wv[0], v0[1] * wv[1]), cvtpk(v0[2] * wv[2], v0[3] * wv[3]), cvtpk(v0[4] * wv[4], v0[5] * wv[5]), cvtpk(v0[6] * wv[6], v0[7] * wv[7])};
            *(LAS u32x4v*)(L + L_WVT + ((2 * e2 + 1) * TS + 8 * sg) * 2) = (u32x4v){cvtpk(v1[0] * wv[0], v1[1] * wv[1]), cvtpk(v1[2] * wv[2], v1[3] * wv[3]), cvtpk(v1[4] * wv[4], v1[5] * wv[5]), cvtpk(v1[6] * wv[6], v1[7] * wv[7])};
            if (wid == 0) *(LAS unsigned short*)(L + L_WVT + (128 * TS + lane) * 2) = (unsigned short)f2bf(wk);
        }
        if (it + F.G < BATCH * MLH * 32) MP_LOAD(it + F.G);
        MP_BAR();
        {
            const int tt = wid >> 1;
#pragma unroll
            for (int si = 0; si < 2; ++si) {
                const int ss = 2 * (wid & 1) + si;
                f32x4v acc = (f32x4v){0.f, 0.f, 0.f, 0.f};
                if (ss <= tt) {
#pragma unroll
                    for (int kd = 0; kd < 4; ++kd) {
                        const bf16x8 a = *(const LAS bf16x8*)(L + L_Q + ((16 * tt + l15) * QS + 32 * kd + 8 * q4) * 2);
                        const bf16x8 bb = *(const LAS bf16x8*)(L + L_K + ((16 * ss + l15) * QS + 32 * kd + 8 * q4) * 2);
                        acc = __builtin_amdgcn_mfma_f32_16x16x32_bf16(a, bb, acc, 0, 0, 0);
                    }
                }
                const int s = 16 * ss + l15; const float as_ = bperm(aval, s);
#pragma unroll
                for (int j = 0; j < 4; ++j) { const int t = 16 * tt + 4 * q4 + j; const float rt = bperm(rowterm, t);
                    const float dv = (s <= t) ? acc[j] * __expf(rt + as_) : 0.f;
                    *(LAS unsigned short*)(L + L_SC + (t * TS + s) * 2) = (unsigned short)f2bf(dv); }
            }
        }
        {
            const int db = wid;
#pragma unroll
            for (int eg = 0; eg < 9; ++eg) {
                f32x4v acc = (f32x4v){0.f, 0.f, 0.f, 0.f};
#pragma unroll
                for (int ks = 0; ks < 2; ++ks) {
                    const bf16x8 a = *(const LAS bf16x8*)(L + L_KT + ((16 * db + l15) * TS + 32 * ks + 8 * q4) * 2);
                    const bf16x8 bb = *(const LAS bf16x8*)(L + L_WVT + ((16 * eg + l15) * TS + 32 * ks + 8 * q4) * 2);
                    acc = __builtin_amdgcn_mfma_f32_16x16x32_bf16(a, bb, acc, 0, 0, 0);
                }
                if (eg < 8) { const int e = 16 * eg + l15;
                    __builtin_amdgcn_raw_buffer_store_b64((u32x2v){cvtpk(acc[0], acc[1]), cvtpk(acc[2], acc[3])}, rsS, (unsigned)((((q4 >> 1) * 16 + l15) * 16) + 8 * (q4 & 1)), S_UT + ((it * 8 + eg) * 4 + (db >> 1)) * 1024 + ((2 * db) & 3) * 256, 0); (void)e; }
                else if (l15 == 0) *(u32x2v*)((char*)UN + ((size_t)(it * 4 + (db >> 1)) * 4 + (((2 * db) & 3) + (q4 >> 1))) * 16 + 8 * (q4 & 1)) = (u32x2v){cvtpk(acc[0], acc[1]), cvtpk(acc[2], acc[3])};
            }
        }
        MP_BAR();
        for (int p = wid; p < 36; p += NWAVES) {
            const int tt = p & 3, eg = p >> 2;
            f32x4v acc = (f32x4v){0.f, 0.f, 0.f, 0.f};
#pragma unroll
            for (int ks = 0; ks < 2; ++ks) {
                const bf16x8 a = *(const LAS bf16x8*)(L + L_VT + ((16 * eg + l15) * TS + 32 * ks + 8 * q4) * 2);
                const bf16x8 bb = *(const LAS bf16x8*)(L + L_SC + ((16 * tt + l15) * TS + 32 * ks + 8 * q4) * 2);
                acc = __builtin_amdgcn_mfma_f32_16x16x32_bf16(a, bb, acc, 0, 0, 0);
            }
            if (eg < 8) __builtin_amdgcn_raw_buffer_store_b64((u32x2v){cvtpk(acc[0], acc[1]), cvtpk(acc[2], acc[3])}, rsS, (unsigned)lane * 8u, S_NL + ((it * 8 + eg) * 4 + tt) * 512, 0);
            else if (q4 == 0) DL[(size_t)(row0 + 16 * tt + l15) * 4 + h] = acc[0];
        }
        MP_BAR();
    }
#undef MP_LOAD
#undef MP_BAR
}
__device__ __forceinline__ void phase_mchain(Frame& F, const bf16* SCR, const bf16* PB, bf16* AO) {
    using namespace mls;
    const int tid = opaque_tid(F.wave), lane = tid & 63, wid = __builtin_amdgcn_readfirstlane(tid >> 6), l15 = lane & 15, q4 = lane >> 4;
    const float* GEM = (const float*)(F.ws + G_EM); const float* GCD = (const float*)(F.ws + G_CD); const float* DL = (const float*)(F.ws + G_DL); const float* UN = (const float*)(F.ws + G_UN);
    constexpr int S_QI = 0, S_UT = M * 512 * 2, S_NL = M * 1536 * 2;
    const __amdgpu_buffer_rsrc_t rsP = __builtin_amdgcn_make_buffer_rsrc((void*)SCR, 0, M * D * 4, 0x00020000), rsB = __builtin_amdgcn_make_buffer_rsrc((void*)PB, 0, M * PJB * 2, 0x00020000),
                                 rsO = __builtin_amdgcn_make_buffer_rsrc((void*)AO, 0, M * D * 2, 0x00020000), rsE = __builtin_amdgcn_make_buffer_rsrc((void*)GEM, 0, BATCH * MLH * SEQ * 4, 0x00020000),
                                 rsD = __builtin_amdgcn_make_buffer_rsrc((void*)DL, 0, M * 16, 0x00020000), rsU = __builtin_amdgcn_make_buffer_rsrc((void*)UN, 0, BATCH * MLH * 32 * 128 * 2, 0x00020000);
    const unsigned lo_o = (unsigned)(l15 * D + 4 * q4) * 2u, lo_m = (unsigned)(l15 * PJB + 4 * q4) * 2u, lo_d = (unsigned)l15 * 16u, lo_e = (unsigned)l15 * 4u;
    const int th = wid >> 2;
    for (int id = blockIdx.x * 4 + (wid & 3); id < BATCH * MLH * 8; id += F.G * 4) {
        const int bh = id >> 3, eg = id & 7, b = bh >> 2, h = bh & 3;
        const int r00 = b * SEQ;
        float Cst[4][8], nst[4][8];
#pragma unroll
        for (int kd = 0; kd < 4; ++kd)
#pragma unroll
            for (int j = 0; j < 8; ++j) { Cst[kd][j] = 0.f; nst[kd][j] = 0.f; }
        u32x4v qfA[2][4], qfB[2][4], ut[4], un[4]; u32x2v nlA[2], moA[2], nlB[2], moB[2]; float dlA[2], emA[2], dlB[2], emB[2], cd;
#define MC_LOADQ(c, qf) do { const int it_ = bh * 32 + (c); \
            _Pragma("unroll") for (int t2_ = 0; t2_ < 2; ++t2_) \
                _Pragma("unroll") for (int kd_ = 0; kd_ < 4; ++kd_) qf[t2_][kd_] = __builtin_amdgcn_raw_buffer_load_b128(rsP, (unsigned)lane * 16u, S_QI + ((it_ * 4 + 2 * th + t2_) * 4 + kd_) * 1024, 0); } while (0)
#define MC_LOADS(c, nl, mo, dl, em) do { const int r0_ = r00 + 64 * (c), it_ = bh * 32 + (c); \
            _Pragma("unroll") for (int t2_ = 0; t2_ < 2; ++t2_) { const int rt_ = r0_ + 16 * (2 * th + t2_); \
                nl[t2_] = __builtin_amdgcn_raw_buffer_load_b64(rsP, (unsigned)lane * 8u, S_NL + ((it_ * 8 + eg) * 4 + 2 * th + t2_) * 512, 0); mo[t2_] = __builtin_amdgcn_raw_buffer_load_b64(rsB, lo_m, (rt_ * PJB + PB_MO + h * 128 + 16 * eg) * 2, 0); \
                dl[t2_] = __builtin_bit_cast(float, __builtin_amdgcn_raw_buffer_load_b32(rsD, lo_d, (rt_ * 4 + h) * 4, 0)); em[t2_] = __builtin_bit_cast(float, __builtin_amdgcn_raw_buffer_load_b32(rsE, lo_e, (bh * SEQ + 64 * (c) + 16 * (2 * th + t2_)) * 4, 0)); } } while (0)
#define MC_LOADU(c) do { const int it_ = bh * 32 + (c); \
            _Pragma("unroll") for (int kd_ = 0; kd_ < 4; ++kd_) { ut[kd_] = __builtin_amdgcn_raw_buffer_load_b128(rsP, (unsigned)lane * 16u, S_UT + ((it_ * 8 + eg) * 4 + kd_) * 1024, 0); \
                un[kd_] = __builtin_amdgcn_raw_buffer_load_b128(rsU, (unsigned)q4 * 16u, (it_ * 4 + kd_) * 64, 0); } \
            cd = GCD[it_]; } while (0)
#define MC_STEP(c, qf, nl, mo, dl, em, qfN, nlN, moN, dlN, emN) do { const int r0_ = r00 + 64 * (c); \
            if ((c) + 1 < SEQ / 64) { MC_LOADQ((c) + 1, qfN); MC_LOADS((c) + 1, nlN, moN, dlN, emN); } \
            f32x4v acc_[2], accd_[2]; \
            _Pragma("unroll") for (int t2_ = 0; t2_ < 2; ++t2_) { acc_[t2_] = (f32x4v){lo_bf(nl[t2_].x), hi_bf(nl[t2_].x), lo_bf(nl[t2_].y), hi_bf(nl[t2_].y)}; accd_[t2_] = (f32x4v){q4 == 0 ? dl[t2_] : 0.f, 0.f, 0.f, 0.f}; } \
            _Pragma("unroll") for (int kd_ = 0; kd_ < 4; ++kd_) { \
                const bf16x8 af_ = __builtin_bit_cast(bf16x8, (u32x4v){cvtpk(Cst[kd_][0], Cst[kd_][1]), cvtpk(Cst[kd_][2], Cst[kd_][3]), cvtpk(Cst[kd_][4], Cst[kd_][5]), cvtpk(Cst[kd_][6], Cst[kd_][7])}); \
                const bf16x8 nf_ = __builtin_bit_cast(bf16x8, (u32x4v){cvtpk(nst[kd_][0], nst[kd_][1]), cvtpk(nst[kd_][2], nst[kd_][3]), cvtpk(nst[kd_][4], nst[kd_][5]), cvtpk(nst[kd_][6], nst[kd_][7])}); \
                _Pragma("unroll") for (int t2_ = 0; t2_ < 2; ++t2_) { acc_[t2_] = __builtin_amdgcn_mfma_f32_16x16x32_bf16(af_, __builtin_bit_cast(bf16x8, qf[t2_][kd_]), acc_[t2_], 0, 0, 0); \
                    accd_[t2_] = __builtin_amdgcn_mfma_f32_16x16x32_bf16(nf_, __builtin_bit_cast(bf16x8, qf[t2_][kd_]), accd_[t2_], 0, 0, 0); } } \
            _Pragma("unroll") for (int t2_ = 0; t2_ < 2; ++t2_) { \
                const float den_ = bperm(accd_[t2_][0], l15); const float rd_ = 1.0f / fmaxf(fabsf(den_), em[t2_]); \
                const float o0_ = acc_[t2_][0] * rd_ * lo_bf(mo[t2_].x), o1_ = acc_[t2_][1] * rd_ * hi_bf(mo[t2_].x), o2_ = acc_[t2_][2] * rd_ * lo_bf(mo[t2_].y), o3_ = acc_[t2_][3] * rd_ * hi_bf(mo[t2_].y); \
                __builtin_amdgcn_raw_buffer_store_b64((u32x2v){cvtpk(o0_, o1_), cvtpk(o2_, o3_)}, rsO, lo_o, ((r0_ + 16 * (2 * th + t2_)) * D + 512 + h * 128 + 16 * eg) * 2, 0); } \
            _Pragma("unroll") for (int kd_ = 0; kd_ < 4; ++kd_) { const unsigned uw_[4] = {ut[kd_].x, ut[kd_].y, ut[kd_].z, ut[kd_].w}; const unsigned nw_[4] = {un[kd_].x, un[kd_].y, un[kd_].z, un[kd_].w}; \
                _Pragma("unroll") for (int j_ = 0; j_ < 4; ++j_) { Cst[kd_][2 * j_] = cd * Cst[kd_][2 * j_] + lo_bf(uw_[j_]); Cst[kd_][2 * j_ + 1] = cd * Cst[kd_][2 * j_ + 1] + hi_bf(uw_[j_]); \
                    nst[kd_][2 * j_] = (l15 == 0) ? cd * nst[kd_][2 * j_] + lo_bf(nw_[j_]) : 0.f; nst[kd_][2 * j_ + 1] = (l15 == 0) ? cd * nst[kd_][2 * j_ + 1] + hi_bf(nw_[j_]) : 0.f; } } \
            if ((c) + 1 < SEQ / 64) MC_LOADU((c) + 1); } while (0)
        MC_LOADQ(0, qfA); MC_LOADS(0, nlA, moA, dlA, emA); MC_LOADU(0);
        for (int c = 0; c < SEQ / 64; c += 2) {
            MC_STEP(c, qfA, nlA, moA, dlA, emA, qfB, nlB, moB, dlB, emB);
            MC_STEP(c + 1, qfB, nlB, moB, dlB, emB, qfA, nlA, moA, dlA, emA);
        }
#undef MC_LOADQ
#undef MC_LOADS
#undef MC_LOADU
#undef MC_STEP
    }
}

__device__ __forceinline__ void phase_mlstm_fused(Frame& F, const bf16* P, const bf16* PBg, const float* SG, const float* convw, const float* convb, bf16* AO) {
    using namespace mls;
    constexpr int L_Q = 0, L_QI = 17408, L_K = 34816, L_KT = 52224, L_VT = 70656, L_WVT = 82176, L_SC = 93696, L_CT = 102912, L_DEN = 124672;
    const float* GA = (const float*)(F.ws + G_A); const float* GPM = (const float*)(F.ws + G_RT); const float* GB = (const float*)(F.ws + G_IT); const float* GP63 = (const float*)(F.ws + G_WK); const float* GG = GP63 + BATCH * MLH * 32;
#define ML_BAR() asm volatile("s_waitcnt lgkmcnt(0)\n\ts_barrier" ::: "memory")
    const int tid = opaque_tid(F.wave), lane = tid & 63, wid = __builtin_amdgcn_readfirstlane(tid >> 6), l15 = lane & 15, q4 = lane >> 4;
    LAS unsigned char* L = F.lds;
    for (int it = blockIdx.x; it < BATCH * MLH * 2; it += F.G) {
        const int vh = it & 1, bh = it >> 1, b = bh / MLH, h = bh % MLH;
        const size_t row00 = (size_t)b * SEQ;
        const int ch2 = tid & 127, tq = __builtin_amdgcn_readfirstlane(tid >> 7); const bool isk = (wid & 1) != 0;
        const int cc = (ch2 & 63) * 2;
        const int pcol = (isk ? PC_MK : PC_MQ) + h * 128 + cc, cch = (isk ? 512 : 0) + h * 128 + cc;
        float w0[2], w1[2], w2[2], w3[2], cb[2];
#pragma unroll
        for (int i = 0; i < 2; ++i) { w0[i] = convw[cch + i]; w1[i] = convw[1024 + cch + i]; w2[i] = convw[2048 + cch + i]; w3[i] = convw[3072 + cch + i]; cb[i] = convb[cch + i]; }
        const int e2 = tid & 31, sg = tid >> 5;
        const int vcol = PC_MV + h * 128 + vh * 64 + 2 * e2;
        f32x4v Cacc[8];
#pragma unroll
        for (int i = 0; i < 8; ++i) Cacc[i] = (f32x4v){0.f, 0.f, 0.f, 0.f};
        float mcar = 0.f;
        __syncthreads();
        for (int i = tid; i < 80 * QS / 2; i += NTHR) ((LAS unsigned*)(L + L_CT))[i] = 0u;
        for (int i = tid; i < 16 * TS / 2; i += NTHR) { ((LAS unsigned*)(L + L_VT + 64 * TS * 2))[i] = (i < TS / 2) ? 0x3F803F80u : 0u; ((LAS unsigned*)(L + L_WVT + 64 * TS * 2))[i] = 0u; }
        unsigned raw[19], vraw[4]; float g_a, g_pm, g_b, g_p63, g_g;
        const unsigned lo_raw = (unsigned)pcol * 2u, lo_v = (unsigned)((4 * sg) * PJA + vcol) * 2u, lo_o = (unsigned)((4 * q4) * PJB + l15) * 2u, lo_ao = (unsigned)((4 * q4) * D + l15) * 2u;
        const __amdgpu_buffer_rsrc_t rsP = __builtin_amdgcn_make_buffer_rsrc((void*)P, 0, M * PJA * 2, 0x00020000), rsB = __builtin_amdgcn_make_buffer_rsrc((void*)PBg, 0, M * PJB * 2, 0x00020000),
                                     rsO = __builtin_amdgcn_make_buffer_rsrc((void*)AO, 0, M * D * 2, 0x00020000);
        const int r00 = (int)row00;
#define MLS_LOAD(c) do { _Pragma("unroll") for (int i_ = 0; i_ < 19; ++i_) { const int tr_ = 64 * (c) + 16 * tq - 3 + i_; raw[i_] = (tr_ >= 0) ? __builtin_amdgcn_raw_buffer_load_b32(rsP, lo_raw, (r00 + tr_) * (PJA * 2), 0) : 0u; } \
        _Pragma("unroll") for (int i_ = 0; i_ < 4; ++i_) vraw[i_] = __builtin_amdgcn_raw_buffer_load_b32(rsP, lo_v, (r00 + 64 * (c) + i_) * (PJA * 2), 0); \
        { const size_t gi_ = (size_t)bh * SEQ + 64 * (c) + lane; g_a = GA[gi_]; g_pm = GPM[gi_]; g_b = GB[gi_]; g_p63 = GP63[bh * 32 + (c)]; g_g = GG[bh * 32 + (c)]; } } while (0)
        MLS_LOAD(0);
        for (int c = 0; c < SEQ / 64; ++c) {
            const size_t row0 = row00 + 64 * c;
            const float bcum = g_b, aval = g_a, pm = g_pm, pm63 = g_p63, gsum = g_g;
            const float Mx = fmaxf(mcar, pm63), mrow = fmaxf(pm, mcar);
            const float rowterm = -mrow, inter = __expf(mcar - mrow), emt = __expf(-(bcum + mrow)), wk = __expf(aval - Mx), cdec = __expf(mcar - Mx);
            mcar = gsum + Mx;
            {
                unsigned kt0[8], kt1[8];
#pragma unroll
                for (int i = 0; i < 16; i += 2) {
                    float y[2][2];
#pragma unroll
                    for (int u = 0; u < 2; ++u) {
                        float a0 = w0[0] * lo_bf(raw[i + u]) + w1[0] * lo_bf(raw[i + u + 1]) + w2[0] * lo_bf(raw[i + u + 2]) + w3[0] * lo_bf(raw[i + u + 3]) + cb[0];
                        float a1 = w0[1] * hi_bf(raw[i + u]) + w1[1] * hi_bf(raw[i + u + 1]) + w2[1] * hi_bf(raw[i + u + 2]) + w3[1] * hi_bf(raw[i + u + 3]) + cb[1];
                        y[u][0] = fsilu(a0); y[u][1] = fsilu(a1);
                        const int t = 16 * tq + i + u;
                        if (!isk) { const float q0 = y[u][0] * QK_SCALE, q1 = y[u][1] * QK_SCALE; const float itv = rdl(inter, t);
                            *(LAS unsigned*)(L + L_Q + (t * QS + cc) * 2) = cvtpk(q0, q1); *(LAS unsigned*)(L + L_QI + (t * QS + cc) * 2) = cvtpk(q0 * itv, q1 * itv); }
                        else *(LAS unsigned*)(L + L_K + (t * QS + cc) * 2) = cvtpk(y[u][0], y[u][1]);
                    }
                    kt0[i >> 1] = cvtpk(y[0][0], y[1][0]); kt1[i >> 1] = cvtpk(y[0][1], y[1][1]);
                }
                if (isk) {
                    *(LAS u32x4v*)(L + L_KT + (cc * TS + 16 * tq) * 2) = (u32x4v){kt0[0], kt0[1], kt0[2], kt0[3]}; *(LAS u32x4v*)(L + L_KT + (cc * TS + 16 * tq + 8) * 2) = (u32x4v){kt0[4], kt0[5], kt0[6], kt0[7]};
                    *(LAS u32x4v*)(L + L_KT + ((cc + 1) * TS + 16 * tq) * 2) = (u32x4v){kt1[0], kt1[1], kt1[2], kt1[3]}; *(LAS u32x4v*)(L + L_KT + ((cc + 1) * TS + 16 * tq + 8) * 2) = (u32x4v){kt1[4], kt1[5], kt1[6], kt1[7]};
                }
            }
            {
                float v0[4], v1[4], wv[4];
#pragma unroll
                for (int i = 0; i < 4; ++i) { v0[i] = lo_bf(vraw[i]); v1[i] = hi_bf(vraw[i]); wv[i] = bperm(wk, 4 * sg + i); }
                *(LAS u32x2v*)(L + L_VT + ((2 * e2) * TS + 4 * sg) * 2) = (u32x2v){cvtpk(v0[0], v0[1]), cvtpk(v0[2], v0[3])};
                *(LAS u32x2v*)(L + L_VT + ((2 * e2 + 1) * TS + 4 * sg) * 2) = (u32x2v){cvtpk(v1[0], v1[1]), cvtpk(v1[2], v1[3])};
                *(LAS u32x2v*)(L + L_WVT + ((2 * e2) * TS + 4 * sg) * 2) = (u32x2v){cvtpk(v0[0] * wv[0], v0[1] * wv[1]), cvtpk(v0[2] * wv[2], v0[3] * wv[3])};
                *(LAS u32x2v*)(L + L_WVT + ((2 * e2 + 1) * TS + 4 * sg) * 2) = (u32x2v){cvtpk(v1[0] * wv[0], v1[1] * wv[1]), cvtpk(v1[2] * wv[2], v1[3] * wv[3])};
                if (wid == 0) *(LAS unsigned short*)(L + L_WVT + (64 * TS + lane) * 2) = (unsigned short)f2bf(wk);
            }
            if (c + 1 < SEQ / 64) MLS_LOAD(c + 1);
            ML_BAR();
            {
                const int tt = wid >> 1;
#pragma unroll
                for (int si = 0; si < 2; ++si) {
                    const int ss = 2 * (wid & 1) + si;
                    f32x4v acc = (f32x4v){0.f, 0.f, 0.f, 0.f};
                    if (ss <= tt) {
#pragma unroll
                        for (int kd = 0; kd < 4; ++kd) {
                            const bf16x8 a = *(const LAS bf16x8*)(L + L_Q + ((16 * tt + l15) * QS + 32 * kd + 8 * q4) * 2);
                            const bf16x8 bb = *(const LAS bf16x8*)(L + L_K + ((16 * ss + l15) * QS + 32 * kd + 8 * q4) * 2);
                            acc = __builtin_amdgcn_mfma_f32_16x16x32_bf16(a, bb, acc, 0, 0, 0);
                        }
                    }
                    const int s = 16 * ss + l15; const float as_ = bperm(aval, s);
#pragma unroll
                    for (int j = 0; j < 4; ++j) { const int t = 16 * tt + 4 * q4 + j; const float rt = bperm(rowterm, t);
                        const float dv = (s <= t) ? acc[j] * __expf(rt + as_) : 0.f;
                        *(LAS unsigned short*)(L + L_SC + (t * TS + s) * 2) = (unsigned short)f2bf(dv); }
                }
            }
            unsigned short mog[16];
            if (wid < 4) {
#pragma unroll
                for (int tt = 0; tt < 4; ++tt)
#pragma unroll
                    for (int j = 0; j < 4; ++j) mog[tt * 4 + j] = __builtin_amdgcn_raw_buffer_load_b16(rsB, lo_o, (((int)row0 + 16 * tt + j) * PJB + PB_MO + h * 128 + vh * 64 + 16 * wid) * 2, 0);
            }
            ML_BAR();
            f32x4v acc[4];
            if (wid < 5) {
                const int eg = wid;
#pragma unroll
                for (int tt = 0; tt < 4; ++tt) {
                    acc[tt] = (f32x4v){0.f, 0.f, 0.f, 0.f};
#pragma unroll
                    for (int ks = 0; ks < 2; ++ks) {
                        const bf16x8 a = *(const LAS bf16x8*)(L + L_SC + ((16 * tt + l15) * TS + 32 * ks + 8 * q4) * 2);
                        const bf16x8 bb = *(const LAS bf16x8*)(L + L_VT + ((16 * eg + l15) * TS + 32 * ks + 8 * q4) * 2);
                        acc[tt] = __builtin_amdgcn_mfma_f32_16x16x32_bf16(a, bb, acc[tt], 0, 0, 0);
                    }
#pragma unroll
                    for (int kd = 0; kd < 4; ++kd) {
                        const bf16x8 a = *(const LAS bf16x8*)(L + L_QI + ((16 * tt + l15) * QS + 32 * kd + 8 * q4) * 2);
                        const bf16x8 bb = *(const LAS bf16x8*)(L + L_CT + ((16 * eg + l15) * QS + 32 * kd + 8 * q4) * 2);
                        acc[tt] = __builtin_amdgcn_mfma_f32_16x16x32_bf16(a, bb, acc[tt], 0, 0, 0);
                    }
                }
                asm volatile("s_waitcnt lgkmcnt(0)" ::: "memory");
#pragma unroll
                for (int db = 0; db < 8; ++db) {
                    Cacc[db] = Cacc[db] * cdec;
#pragma unroll
                    for (int ks = 0; ks < 2; ++ks) {
                        const bf16x8 a = *(const LAS bf16x8*)(L + L_KT + ((16 * db + l15) * TS + 32 * ks + 8 * q4) * 2);
                        const bf16x8 bb = *(const LAS bf16x8*)(L + L_WVT + ((16 * eg + l15) * TS + 32 * ks + 8 * q4) * 2);
                        Cacc[db] = __builtin_amdgcn_mfma_f32_16x16x32_bf16(a, bb, Cacc[db], 0, 0, 0);
                    }
                    *(LAS u32x2v*)(L + L_CT + ((16 * eg + l15) * QS + 16 * db + 4 * q4) * 2) = (u32x2v){cvtpk(Cacc[db][0], Cacc[db][1]), cvtpk(Cacc[db][2], Cacc[db][3])};
                }
                if (wid == 4 && l15 == 0) {
#pragma unroll
                    for (int tt = 0; tt < 4; ++tt) *(LAS f32x4v*)(L + L_DEN + (16 * tt + 4 * q4) * 4) = acc[tt];
                }
            }
            ML_BAR();
            if (wid < 4) {
#pragma unroll
                for (int tt = 0; tt < 4; ++tt) {
                    const f32x4v den = *(const LAS f32x4v*)(L + L_DEN + (16 * tt + 4 * q4) * 4);
#pragma unroll
                    for (int j = 0; j < 4; ++j) { const int t = 16 * tt + 4 * q4 + j; const float et = bperm(emt, t);
                        const float hv = acc[tt][j] / fmaxf(fabsf(den[j]), et);
                        __builtin_amdgcn_raw_buffer_store_b16((unsigned short)f2bf(hv * bf2f(mog[tt * 4 + j])), rsO, lo_ao, (((int)row0 + 16 * tt + j) * D + 512 + h * 128 + vh * 64 + 16 * wid) * 2, 0); }
                }
            }
        }
#undef MLS_LOAD
#undef ML_BAR
    }
}


__global__ void __launch_bounds__(NTHR, 2) fwd_kernel(Args args) {
    extern __shared__ __attribute__((aligned(16))) unsigned char lds[];
    Frame F;
    F.lds = (LAS unsigned char*)lds;
    F.MISC = (volatile LAS unsigned*)(F.lds + MISC_OFF);
    F.wave = __builtin_amdgcn_readfirstlane((int)threadIdx.x >> 6);
    F.G = gridDim.x;
    F.ws = args.ws; F.out = args.out;
#pragma unroll
    for (int i = 0; i < 18; ++i) F.in[i] = args.in[i];
    F.ctl = (gu32*)(F.ws + WS_CTL);
    for (int u = threadIdx.x; u < (LDS_BYTES - LDSCTL_OFF) / 4; u += NTHR) ((LAS unsigned*)(F.lds + LDSCTL_OFF))[u] = 0u;
    __syncthreads();
    XcdBarrier bar = xcd_barrier_post((unsigned*)(F.ctl + CW_BAR), F.MISC + 8, F.wave);
#define GRID_BAR() xcd_barrier(bar)

    const float* x = F.in[0];
    bf16* XB = (bf16*)(F.ws + WS_XB); bf16* AO = (bf16*)(F.ws + WS_AO); bf16* PA = (bf16*)(F.ws + WS_PA); bf16* PB = (bf16*)(F.ws + WS_PB);
    bf16* HB = PA; bf16* MG = PA;
    float* SG = (float*)(F.ws + WS_SG); float* CUM = (float*)(F.ws + WS_CUM); float* SS = (float*)(F.ws + WS_SS);
    float* out = F.out;
    const bf16* W1IN = (const bf16*)(F.ws + WS_W1IN); const bf16* W1OUT = (const bf16*)(F.ws + WS_W1OUT); const bf16* WIN = (const bf16*)(F.ws + WS_WIN);
    const bf16* WCAT = (const bf16*)(F.ws + WS_WCAT); const bf16* WOUT = (const bf16*)(F.ws + WS_WOUT); const bf16* W2IN = (const bf16*)(F.ws + WS_W2IN); const bf16* W2OUT = (const bf16*)(F.ws + WS_W2OUT);
#define STAGGER(step) do { if (STAG_ON) { const unsigned long long t0_ = __builtin_amdgcn_s_memrealtime(); const unsigned long long w_ = (unsigned long long)((blockIdx.x & 7u) * (unsigned)(step)); while (__builtin_amdgcn_s_memrealtime() - t0_ < w_) __builtin_amdgcn_s_sleep(8); } } while (0)
#define GEMM_PHASE(EpiT, gobj, eobj) do { pg8::StaticOrder S_; S_.init((gobj).M, (gobj).N, F.G, (int)blockIdx.x); pg8::gemm_phase<EpiT, pg8::StaticOrder, true, true>(F.lds, gobj, S_, eobj, F.wave); } while (0)
#define REP(b) ((REP_MASK >> (b)) & 1)

    phase_weights(F);
    phase_x_prep(F, x, XB, SS);
    GRID_BAR();
    STAGGER(430);
    { pg8::Gemm g{XB, W1IN, M, NFF, D, D, D}; pg8::EpiSwigluF E{HB, SS}; GEMM_PHASE(pg8::EpiSwigluF, g, E); if (REP(0)) GEMM_PHASE(pg8::EpiSwigluF, g, E); }
    GRID_BAR();
    { pg8::Gemm g{HB, W1OUT, M, D, DFF, DFF, DFF}; pg8::EpiResidB<false> E{XB, nullptr, SS, 0.5f}; GEMM_PHASE(pg8::EpiResidB<false>, g, E); }
    GRID_BAR();
    STAGGER(460);
    { pg8::Gemm g{XB, WIN, M, NPJ, D, D, D}; pg8::EpiProjF E{PA, PB, SG, SS, F.in[6], F.in[9], F.in[10]}; GEMM_PHASE(pg8::EpiProjF, g, E); if (REP(2)) GEMM_PHASE(pg8::EpiProjF, g, E); }
    GRID_BAR();
    phase_cumsum(F, SG, CUM);
    phase_mgates(F, SG);
    GRID_BAR();
    if (MLSTM_FUSED) { phase_mlstm_fused(F, PA, PB, SG, F.in[7], F.in[8], AO); if (REP(3)) phase_mlstm_fused(F, PA, PB, SG, F.in[7], F.in[8], AO); }
    else {
    phase_mprep(F, PA, F.in[7], F.in[8], (bf16*)out);
    if (REP(3)) phase_mprep(F, PA, F.in[7], F.in[8], (bf16*)out);
    GRID_BAR();
    phase_mchain(F, (const bf16*)out, PB, AO);
    if (REP(7)) phase_mchain(F, (const bf16*)out, PB, AO);
    }
    { const attn_body::AttnTensors AT{(const attn_body::bf16*)(PA + PC_FQ), (const attn_body::bf16*)(PA + PC_FK), (const attn_body::bf16*)(PA + PC_FV), (attn_body::bf16*)AO, CUM};
      const attn_body::StaticOrder SA((int)F.G, (int)blockIdx.x); attn_body::attn_phase<attn_body::StaticOrder>((char*)lds, AT, SA, F.wave);
      if (REP(4)) attn_body::attn_phase<attn_body::StaticOrder>((char*)lds, AT, SA, F.wave); }
    GRID_BAR();
    { pg8::Gemm g{AO, WCAT, M, D, D, D, D}; pg8::EpiMergeF E{PB, MG}; GEMM_PHASE(pg8::EpiMergeF, g, E); if (REP(5)) GEMM_PHASE(pg8::EpiMergeF, g, E); }
    GRID_BAR();
    { pg8::Gemm g{MG, WOUT, M, D, D, D, D}; pg8::EpiResidB<false> E{XB, nullptr, SS, 1.0f}; GEMM_PHASE(pg8::EpiResidB<false>, g, E); }
    GRID_BAR();
    STAGGER(430);
    { pg8::Gemm g{XB, W2IN, M, NFF, D, D, D}; pg8::EpiSwigluF E{HB, SS}; GEMM_PHASE(pg8::EpiSwigluF, g, E); }
    GRID_BAR();
    { pg8::Gemm g{HB, W2OUT, M, D, DFF, DFF, DFF}; pg8::EpiResidB<true> E{XB, out, SS, 0.5f}; GEMM_PHASE(pg8::EpiResidB<true>, g, E); if (REP(1)) GEMM_PHASE(pg8::EpiResidB<true>, g, E); }
    GRID_BAR();
    phase_final_scale(F, out, SS, F.in[17]);
}

extern "C" void kernel_launch(void* const* d_in, const int* in_sizes, int n_in, void* d_out, int out_size, void* d_ws, size_t ws_size, hipStream_t stream) {
    static int grid = 0;
    if (grid == 0) {
        if (n_in != 18 || in_sizes[0] != M * D || out_size != M * D || ws_size < WS_END) { fprintf(stderr, "kernel_launch: unexpected shapes (n_in %d, in0 %d, out %d, ws %zu)\n", n_in, n_in > 0 ? in_sizes[0] : -1, out_size, ws_size); grid = -1; return; }
        int dev = 0, cus = 0, per_cu = 0;
        if (hipGetDevice(&dev) != hipSuccess || hipDeviceGetAttribute(&cus, hipDeviceAttributeMultiprocessorCount, dev) != hipSuccess) { grid = -1; return; }
        if (hipFuncSetAttribute((const void*)fwd_kernel, hipFuncAttributeMaxDynamicSharedMemorySize, LDS_BYTES) != hipSuccess) { grid = -1; return; }
        if (hipOccupancyMaxActiveBlocksPerMultiprocessor(&per_cu, (const void*)fwd_kernel, NTHR, LDS_BYTES) != hipSuccess || per_cu < 1) { fprintf(stderr, "occupancy query says %d\n", per_cu); }
        (void)hipGetLastError();
        grid = cus;
    }
    if (grid < 0) return;
    if (hipMemsetAsync((char*)d_ws + WS_CTL, 0, CTL_ZERO_BYTES, stream) != hipSuccess) return;
    Args a{};
    for (int i = 0; i < 18; ++i) a.in[i] = (const float*)d_in[i];
    a.out = (float*)d_out; a.ws = (unsigned char*)d_ws;
    hipLaunchKernelGGL(fwd_kernel, dim3(grid), dim3(NTHR), LDS_BYTES, stream, a);
}
```

```cpp
#include <hip/hip_runtime.h>
#include <cstdio>
#include <cstdint>

#define GAS __attribute__((address_space(1)))
#define LAS __attribute__((address_space(3)))
typedef unsigned short bf16;
typedef unsigned v4u __attribute__((ext_vector_type(4)));
typedef float f32x4 __attribute__((ext_vector_type(4)));
typedef GAS unsigned gu32;
#define RLX_AGENT __ATOMIC_RELAXED, __HIP_MEMORY_SCOPE_AGENT

constexpr int BATCH = 32, SEQ = 2048, D = 1024, M = BATCH * SEQ;
constexpr int DFF = 2816, NFF = 2 * DFF;
constexpr int INC = 5648;
constexpr int PJA = 3072, PJB = 2560;
constexpr int FOXH = 8, FHD = 64, MLH = 4, MHD = 128;
constexpr int PC_FQ = 0, PC_FK = 512, PC_FV = 1024, PC_MQ = 1536, PC_MK = 2048, PC_MV = 2560;
constexpr int PB_MO = 0, PB_GA = 512, PB_GB = 1536;
constexpr float RMS_EPS = 1e-6f;
constexpr float LOG2E = 1.4426950408889634f;
constexpr float QSCALE2 = 0.125f * LOG2E;
constexpr int NWAVES = 8, NTHR = 512;
#ifndef STAG_ON
#define STAG_ON 0
#endif
#ifndef MLSTM_FUSED
#define MLSTM_FUSED 1
#endif
#ifndef REP_MASK
#define REP_MASK 0
#endif

constexpr size_t MiB = 1u << 20;
constexpr size_t WS_CTL = 0, CTL_ZERO_BYTES = 1 * MiB;
constexpr size_t WS_W1IN = 2 * MiB, WS_W1OUT = 13 * MiB, WS_WIN = 19 * MiB, WS_WCAT = 31 * MiB, WS_WOUT = 33 * MiB, WS_W2IN = 35 * MiB, WS_W2OUT = 46 * MiB;
constexpr int NPJ = 5888;
constexpr size_t WS_SG = 52 * MiB;
constexpr size_t WS_CUM = 56 * MiB;
constexpr size_t WS_SS = 58 * MiB;
constexpr size_t WS_XB = 64 * MiB;
constexpr size_t WS_AO = 192 * MiB;
constexpr size_t WS_PA = 320 * MiB;
constexpr size_t WS_PB = 704 * MiB;
constexpr size_t WS_END = 1024 * MiB;
constexpr int CW_BAR = 4096;

constexpr int LDS_BYTES = 147456;
constexpr int RING_BYTES = 131072, LDSCTL_OFF = RING_BYTES, MISC_OFF = LDSCTL_OFF + 320;

__device__ __forceinline__ float bf2f(bf16 v) { return __builtin_bit_cast(float, (unsigned)v << 16); }
__device__ __forceinline__ unsigned f2bf(float f) { unsigned u = __builtin_bit_cast(unsigned, f); return (u + 0x7fffu + ((u >> 16) & 1u)) >> 16; }
__device__ __forceinline__ unsigned pk2(float lo, float hi) { return f2bf(lo) | (f2bf(hi) << 16); }
__device__ __forceinline__ float sigmoidf_(float v) { return 1.f / (1.f + __expf(-v)); }
__device__ __forceinline__ float logsigmoidf_(float v) { return fminf(v, 0.f) - log1pf(__expf(-fabsf(v))); }
__device__ __forceinline__ float siluf_(float v) { return v / (1.f + __expf(-v)); }

#define XB_TMO      128
#define XB_XCNT(j)  (256  + 64 * (j))
#define XB_XSUB(j)  (1280 + 64 * (j))
#define XB_XGEN(j)  (2304 + 64 * (j))
#define XB_TOP      3328
#define XB_TOPGEN   3392
#define XCD_BAR_WORDS 3456
#define XB_SPIN_CAP (1u << 22)

__device__ __forceinline__ unsigned xb_ld(unsigned* p)              { return __hip_atomic_load(p, __ATOMIC_RELAXED, __HIP_MEMORY_SCOPE_AGENT); }
__device__ __forceinline__ unsigned xb_add(unsigned* p, unsigned v) { return __hip_atomic_fetch_add(p, v, __ATOMIC_RELAXED, __HIP_MEMORY_SCOPE_AGENT); }
__device__ __forceinline__ unsigned xb_xcc_id() { return (unsigned)__builtin_amdgcn_s_getreg((3 << 11) | 20) & 0xFu; }
#define XB_SPIN(cond, bar) do { unsigned _sp = 0; while (cond) { __builtin_amdgcn_s_sleep(1); \
    if ((++_sp & 255u) == 0u) { if (xb_ld(&(bar)[XB_TMO])) break; if (_sp > XB_SPIN_CAP) { atomicAdd(&(bar)[XB_TMO], 1u); break; } } } } while (0)

struct XcdBarrier { unsigned* bar; unsigned x; volatile LAS unsigned* st; int wv; };

__device__ __forceinline__ bool xb_leader(int wv) { int l = (int)__builtin_amdgcn_mbcnt_hi(~0u, __builtin_amdgcn_mbcnt_lo(~0u, 0u)); asm volatile("" : "+v"(l)); return wv == 0 && l == 0; }
__device__ __forceinline__ XcdBarrier xcd_barrier_post(unsigned* bar, volatile LAS unsigned* st, int wv) {
    XcdBarrier b; b.bar = bar; b.x = xb_xcc_id(); b.st = st; b.wv = wv;
    if (xb_leader(wv)) (void)xb_add(&bar[XB_XCNT(b.x)], 1u);
    return b;
}
__device__ __forceinline__ void xcd_barrier_complete(unsigned* bar, unsigned x, unsigned& nloc, unsigned& nx) {
    const unsigned G = gridDim.x * gridDim.y * gridDim.z;
    unsigned sum, cnt, mine, sp = 0u;
    for (;;) {
        sum = 0u; cnt = 0u; mine = 0u;
#pragma unroll
        for (unsigned j = 0; j < 16; ++j) { const unsigned c = xb_ld(&bar[XB_XCNT(j)]); sum += c; cnt += (c > 0u) ? 1u : 0u; mine = (j == x) ? c : mine; }
        if (sum == G) break;
        __builtin_amdgcn_s_sleep(1);
        if ((++sp & 255u) == 0u) { if (xb_ld(&bar[XB_TMO])) break; if (sp > XB_SPIN_CAP) { atomicAdd(&bar[XB_TMO], 1u); break; } }
    }
    nloc = mine > 0u ? mine : 1u; nx = cnt > 0u ? cnt : 1u;
}
__device__ __forceinline__ void xcd_barrier(const XcdBarrier& b) {
    asm volatile("s_waitcnt vmcnt(0)" ::: "memory");
    __syncthreads();
    if (xb_leader(b.wv)) {
        unsigned* bar = b.bar;
        __builtin_amdgcn_s_waitcnt(0);
        unsigned nloc = b.st[0], nx = b.st[1];
        if (nloc == 0u) { xcd_barrier_complete(bar, b.x, nloc, nx); b.st[0] = nloc; b.st[1] = nx; }
        const unsigned old = xb_add(&bar[XB_XSUB(b.x)], 1u);
        const unsigned gen = old / nloc;
        if (old + 1u == (gen + 1u) * nloc) {
            __builtin_amdgcn_fence(__ATOMIC_RELEASE, "agent");
            asm volatile("s_waitcnt vmcnt(0)" ::: "memory");
            const unsigned og = xb_add(&bar[XB_TOP], 1u);
            const unsigned tg = og / nx;
            if (og + 1u == (tg + 1u) * nx) xb_add(&bar[XB_TOPGEN], 1u);
            else XB_SPIN(xb_ld(&bar[XB_TOPGEN]) == tg, bar);
            __builtin_amdgcn_fence(__ATOMIC_ACQUIRE, "agent");
            xb_add(&bar[XB_XGEN(b.x)], 1u);
            asm volatile("s_waitcnt vmcnt(0)" ::: "memory");
        } else {
            XB_SPIN(xb_ld(&bar[XB_XGEN(b.x)]) == gen, bar);
            __builtin_amdgcn_fence(__ATOMIC_ACQUIRE, "agent");
            asm volatile("s_waitcnt vmcnt(0)" ::: "memory");
        }
    }
    __syncthreads();
}

struct Frame {
    LAS unsigned char* lds;
    volatile LAS unsigned* MISC;
    gu32* ctl;
    int wave, G;
    const float* in[18];
    float* out;
    unsigned char* ws;
};
struct Args { const float* in[18]; float* out; unsigned char* ws; };

__device__ __forceinline__ int lane_id() { return (int)__builtin_amdgcn_mbcnt_hi(~0u, __builtin_amdgcn_mbcnt_lo(~0u, 0u)); }
__device__ __forceinline__ int opaque_tid(int wv) { int t = wv * 64 + lane_id(); asm volatile("" : "+v"(t)); return t; }
__device__ __forceinline__ float bperm(float v, int idx) { return __builtin_bit_cast(float, __builtin_amdgcn_ds_bpermute(idx << 2, __builtin_bit_cast(int, v))); }
__device__ __forceinline__ float rdl(float v, int idx) { return __builtin_bit_cast(float, __builtin_amdgcn_readlane(__builtin_bit_cast(int, v), idx)); }
__device__ __forceinline__ float shx(float v, int lane, int mask) { return bperm(v, lane ^ mask); }
__device__ __forceinline__ float wave_sum(float v, int lane) {
#pragma unroll
    for (int o = 1; o < 64; o <<= 1) v += shx(v, lane, o);
    return v;
}

__device__ __forceinline__ void phase_x_prep(Frame& F, const float* X, bf16* XB, float* SS) {
    const int ptid = opaque_tid(F.wave), plane = ptid & 63, pwave = __builtin_amdgcn_readfirstlane(ptid >> 6);
    const int gw = blockIdx.x * NWAVES + pwave, NGW = F.G * NWAVES;
    for (int m = gw; m < M; m += NGW) {
        const GAS f32x4* xr = (const GAS f32x4*)(X + (size_t)m * D) + plane;
        f32x4 v[4]; float s = 0.f;
#pragma unroll
        for (int j = 0; j < 4; ++j) { v[j] = xr[64 * j]; s += (v[j].x * v[j].x + v[j].y * v[j].y) + (v[j].z * v[j].z + v[j].w * v[j].w); }
        s = wave_sum(s, plane);
        GAS unsigned long long* o8 = (GAS unsigned long long*)(XB + (size_t)m * D) + plane;
#pragma unroll
        for (int j = 0; j < 4; ++j) o8[64 * j] = (unsigned long long)pk2(v[j].x, v[j].y) | ((unsigned long long)pk2(v[j].z, v[j].w) << 32);
        if (plane < 16) SS[(size_t)m * 16 + plane] = (plane == 0) ? s : 0.f;
    }
}
__device__ __forceinline__ void phase_final_scale(Frame& F, float* X, const float* SS, const float* gain) {
    const int ptid = opaque_tid(F.wave), plane = ptid & 63, pwave = __builtin_amdgcn_readfirstlane(ptid >> 6);
    const int gw = blockIdx.x * NWAVES + pwave, NGW = F.G * NWAVES;
    f32x4 g[4];
#pragma unroll
    for (int j = 0; j < 4; ++j) g[j] = *((const GAS f32x4*)gain + plane + 64 * j);
    for (int m = gw; m < M; m += NGW) {
        GAS f32x4* xr = (GAS f32x4*)(X + (size_t)m * D) + plane;
        f32x4 v[4];
#pragma unroll
        for (int j = 0; j < 4; ++j) v[j] = xr[64 * j];
        float s = SS[(size_t)m * 16 + (plane & 15)];
#pragma unroll
        for (int o = 1; o < 16; o <<= 1) s += shx(s, plane, o);
        const float r = 1.0f / sqrtf(s * (1.f / D) + RMS_EPS);
#pragma unroll
        for (int j = 0; j < 4; ++j) xr[64 * j] = v[j] * r * g[j];
    }
}

__device__ __forceinline__ void phase_cumsum(Frame& F, const float* SG, float* CUM) {
    const int ptid = opaque_tid(F.wave), plane = ptid & 63, pwave = __builtin_amdgcn_readfirstlane(ptid >> 6); (void)plane; (void)pwave;
    const int gw = blockIdx.x * NWAVES + pwave, NGW = F.G * NWAVES;
    for (int it = gw; it < BATCH * FOXH; it += NGW) {
        const int b = it / FOXH, h = it % FOXH;
        float v[32]; float s = 0.f;
#pragma unroll
        for (int i = 0; i < 32; ++i) { s += SG[(size_t)(b * SEQ + plane * 32 + i) * 16 + h]; v[i] = s; }
        float incl = s;
#pragma unroll
        for (int o = 1; o < 64; o <<= 1) { const float t = bperm(incl, (plane - o) & 63); if (plane >= o) incl += t; }
        const float excl = incl - s;
#pragma unroll
        for (int i = 0; i < 32; ++i) CUM[(size_t)it * SEQ + plane * 32 + i] = v[i] + excl;
    }
}


namespace pg8 {
#define PG8_LAS __attribute__((address_space(3)))
typedef unsigned short bf16_t;
typedef short bf16x8 __attribute__((ext_vector_type(8)));
typedef float f32x4 __attribute__((ext_vector_type(4)));
typedef unsigned u32x4 __attribute__((ext_vector_type(4)));
constexpr int RSTD_LDS_OFF = 131072 + 1024;
constexpr int BM = 256, BK = 64, HALF = 128, HTB = HALF * BK * 2  , STAGE_BYTES = 8 * HTB, NXCD = 8, WGM = 8;

__host__ __device__ __forceinline__ int lds_byte(int r, int c) { const int st = (r >> 4) * 2 + (c >> 5), rr = r & 15, cc = c & 31, ob = rr * 64 + cc * 2; return st * 1024 + (ob ^ (((ob >> 9) & 1) << 5)); }
__host__ __device__ __forceinline__ void stage_rc(int b, int& R, int& C) { const int st = b / 1024, sb = b % 1024, swz = sb ^ (((sb >> 9) & 1) << 5); R = (st >> 1) * 16 + swz / 64; C = (st & 1) * 32 + (swz % 64) / 2; }
__host__ __device__ __forceinline__ int perm32(int rho) { const int n = rho >> 4, i = rho & 15; return 8 * (i >> 2) + 4 * n + (i & 3); }

struct Unit { int pm, pn; };
struct Gemm { const bf16_t* A; const bf16_t* Bt; int M, N, K, lda, ldb; };

struct StaticOrder {
    int nM, nN, nwg, G, c;
    __host__ __device__ void init(int M, int N, int G_, int c_) { nM = M / BM; nN = N / BM; nwg = nM * nN; G = G_; c = c_; }
    __host__ __device__ bool next(int i, Unit& u) const {
        const long L = (long)i * G + c; if (L >= nwg) return false;
        int wgid = (int)L; { const int q = nwg / NXCD, r = nwg % NXCD, xcd = wgid % NXCD, off = wgid / NXCD; wgid = (xcd < r ? xcd * (q + 1) : r * (q + 1) + (xcd - r) * q) + off; }
        const int nig = WGM * nN, gid = wgid / nig, fm = gid * WGM, gsz = (nM - fm) < WGM ? (nM - fm) : WGM;
        u.pm = fm + ((wgid % nig) % gsz); u.pn = (wgid % nig) / gsz; return true;
    }
    __device__ __forceinline__ void a_ready(const Unit&) const {}
    __device__ __forceinline__ void done(const Unit&) const {}
};

__device__ __forceinline__ unsigned cvt_pk_bf16(float lo, float hi) { unsigned r; asm volatile("v_cvt_pk_bf16_f32 %0, %1, %2" : "=v"(r) : "v"(lo), "v"(hi)); return r; }
template <class Epi, class Sched, bool ALIGN_EPI = false, bool SP2 = false>
__device__ __forceinline__ void gemm_phase(PG8_LAS unsigned char* lds, const Gemm g, const Sched& S, const Epi& E, const int wv) {
    int tid_ = wv * 64 + (int)__builtin_amdgcn_mbcnt_hi(~0u, __builtin_amdgcn_mbcnt_lo(~0u, 0u)); asm volatile("" : "+v"(tid_));
    const int tid = tid_, wid = __builtin_amdgcn_readfirstlane(tid >> 6), lane = tid & 63, wr = wid >> 2, wc = wid & 3, fr = lane & 15, fq = lane >> 4;
    const int K = g.K, nt = K / BK;
    unsigned voffA[2], voffB[2];
#pragma unroll
    for (int i = 0; i < 2; ++i) { int R, C; stage_rc(tid * 16 + i * 8192, R, C); const int Rb = Epi::PERM ? ((R & ~31) + perm32(R & 31)) : R;
        voffA[i] = (unsigned)(R * g.lda + C) * 2u; voffB[i] = (unsigned)(Rb * g.ldb + C) * 2u; }
    const size_t kstep = (size_t)(BK * 2);
    const size_t hstepA = (size_t)HALF * g.lda * 2, hstepB = (size_t)HALF * g.ldb * 2;
    const size_t tstepA = 2 * hstepA, tstepB = 2 * hstepB;
    const unsigned ldsw = (unsigned)wid * 1024u;
    const int aoff = lds_byte(wr * 64 + fr, fq * 8), boff = lds_byte(wc * 32 + fr, fq * 8);
#define PG8_SA(b, h) (((b) * 2 + (h)) * HTB)
#define PG8_SB(b, h) ((4 + (b) * 2 + (h)) * HTB)
#define PG8_STAGE(bufoff, gbase, voff) do { _Pragma("unroll") for (int _i = 0; _i < 2; ++_i) \
        __builtin_amdgcn_global_load_lds((const unsigned*)((const char*)(gbase) + (voff)[_i]), (PG8_LAS unsigned*)(lds + (bufoff) + ldsw + _i * 8192), 16, 0, 0); } while (0)
#define PG8_LDA(dst, b, h) do { _Pragma("unroll") for (int m = 0; m < 4; ++m) _Pragma("unroll") for (int k = 0; k < 2; ++k) dst[m][k] = *(const PG8_LAS bf16x8*)(lds + PG8_SA(b, h) + aoff + m * 2048 + k * 1024); } while (0)
#define PG8_LDB(dst, b, h) do { _Pragma("unroll") for (int n = 0; n < 2; ++n) _Pragma("unroll") for (int k = 0; k < 2; ++k) dst[n][k] = *(const PG8_LAS bf16x8*)(lds + PG8_SB(b, h) + boff + n * 2048 + k * 1024); } while (0)
#define PG8_MMA(ai, bj, At, Bt) do { __builtin_amdgcn_s_setprio(1); _Pragma("unroll") for (int m = 0; m < 4; ++m) _Pragma("unroll") for (int n = 0; n < 2; ++n) _Pragma("unroll") for (int k = 0; k < 2; ++k) \
        acc[ai][bj][m][n] = __builtin_amdgcn_mfma_f32_16x16x32_bf16(Bt[n][k], At[m][k], acc[ai][bj][m][n], 0, 0, 0); __builtin_amdgcn_s_setprio(0); } while (0)
#define PG8_WAIT_V(n) asm volatile("s_waitcnt vmcnt(" #n ")" ::: "memory")
#define PG8_WAIT_L(n) asm volatile("s_waitcnt lgkmcnt(" #n ")" ::: "memory")
#define PG8_BAR __builtin_amdgcn_s_barrier()
#define PG8_SCHED __builtin_amdgcn_sched_barrier(0)
    Unit cur, nxt; int ui = 0; int rs_pm = -1; (void)rs_pm;
    if (!S.next(0, cur)) return;
    f32x4 acc[2][2][4][2];
#pragma unroll
    for (int a = 0; a < 2; ++a)
#pragma unroll
        for (int b = 0; b < 2; ++b)
#pragma unroll
            for (int m = 0; m < 4; ++m)
#pragma unroll
                for (int n = 0; n < 2; ++n) acc[a][b][m][n] = (f32x4){0.f, 0.f, 0.f, 0.f};
    bf16x8 At[4][2], B0[2][2], B1[2][2];
    const char* cA = (const char*)g.A + (size_t)cur.pm * tstepA; const char* cB = (const char*)g.Bt + (size_t)cur.pn * tstepB;
    S.a_ready(cur);
    if constexpr (SP2) {
        PG8_STAGE(PG8_SB(0, 0), cB, voffB); PG8_STAGE(PG8_SB(0, 1), cB + hstepB, voffB); PG8_STAGE(PG8_SA(0, 0), cA, voffA); PG8_STAGE(PG8_SA(0, 1), cA + hstepA, voffA);
        if (wr == 1) PG8_BAR;
        PG8_WAIT_V(2); PG8_BAR;
        PG8_STAGE(PG8_SB(1, 0), cB + kstep, voffB); PG8_STAGE(PG8_SA(1, 0), cA + kstep, voffA); PG8_STAGE(PG8_SB(1, 1), cB + hstepB + kstep, voffB);
        PG8_WAIT_V(6); PG8_BAR;
    } else {
        PG8_STAGE(PG8_SB(0, 0), cB, voffB); PG8_STAGE(PG8_SA(0, 0), cA, voffA); PG8_STAGE(PG8_SB(0, 1), cB + hstepB, voffB); PG8_STAGE(PG8_SA(0, 1), cA + hstepA, voffA);
        if (wr == 1) PG8_BAR;
        PG8_WAIT_V(4); PG8_BAR;
        PG8_STAGE(PG8_SB(1, 0), cB + kstep, voffB); PG8_STAGE(PG8_SA(1, 0), cA + kstep, voffA); PG8_STAGE(PG8_SB(1, 1), cB + hstepB + kstep, voffB);
        PG8_WAIT_V(6); PG8_BAR;
    }
    for (;;) {
        const bool has_next = S.next(ui + 1, nxt);
        const char* nA = has_next ? (const char*)g.A + (size_t)nxt.pm * tstepA : cA; const char* nB = has_next ? (const char*)g.Bt + (size_t)nxt.pn * tstepB : cB;
        for (int t = 0; t < nt; t += 2) {
            const bool last = (t == nt - 2);
            const char* a1 = cA + (size_t)(t + 1) * kstep;
            const char* a2 = last ? nA : cA + (size_t)(t + 2) * kstep; const char* b2 = last ? nB : cB + (size_t)(t + 2) * kstep;
            const char* a3 = a2 + kstep; const char* b3 = b2 + kstep;
            if (last && has_next) S.a_ready(nxt);
            if constexpr (Epi::HOOK) { if (t == Epi::HOOK_T) E.mid(acc, cur, wr, wc, fr, fq); }
            if constexpr (SP2) {
            PG8_LDB(B0, 0, 0); PG8_LDB(B1, 0, 1); PG8_SCHED; PG8_LDA(At, 0, 0); PG8_STAGE(PG8_SA(1, 1), a1 + hstepA, voffA);
            PG8_WAIT_V(8); PG8_WAIT_L(0); PG8_BAR; PG8_MMA(0, 0, At, B0); PG8_MMA(0, 1, At, B1); PG8_BAR; PG8_SCHED;
            PG8_LDA(At, 0, 1); PG8_STAGE(PG8_SB(0, 0), b2, voffB); PG8_STAGE(PG8_SB(0, 1), b2 + hstepB, voffB); PG8_STAGE(PG8_SA(0, 0), a2, voffA);
            PG8_WAIT_V(8); PG8_WAIT_L(0); PG8_BAR; PG8_MMA(1, 0, At, B0); PG8_MMA(1, 1, At, B1); PG8_BAR; PG8_SCHED;
            PG8_LDB(B0, 1, 0); PG8_LDB(B1, 1, 1); PG8_SCHED; PG8_LDA(At, 1, 0); PG8_STAGE(PG8_SA(0, 1), a2 + hstepA, voffA);
            PG8_WAIT_V(8); PG8_WAIT_L(0); PG8_BAR; PG8_MMA(0, 0, At, B0); PG8_MMA(0, 1, At, B1); PG8_BAR; PG8_SCHED;
            PG8_LDA(At, 1, 1); PG8_STAGE(PG8_SB(1, 0), b3, voffB); PG8_STAGE(PG8_SB(1, 1), b3 + hstepB, voffB); PG8_STAGE(PG8_SA(1, 0), a3, voffA);
            PG8_WAIT_V(8); PG8_WAIT_L(0); PG8_BAR; PG8_MMA(1, 0, At, B0); PG8_MMA(1, 1, At, B1); PG8_BAR; PG8_SCHED;
            } else {
            PG8_LDB(B0, 0, 0); PG8_SCHED; PG8_LDA(At, 0, 0); PG8_STAGE(PG8_SA(1, 1), a1 + hstepA, voffA);
            PG8_WAIT_L(8); PG8_BAR; PG8_WAIT_L(0); PG8_MMA(0, 0, At, B0); PG8_BAR; PG8_SCHED;
            PG8_LDB(B1, 0, 1); PG8_STAGE(PG8_SB(0, 0), b2, voffB);
            PG8_BAR; PG8_WAIT_L(0); PG8_MMA(0, 1, At, B1); PG8_BAR;
            PG8_LDA(At, 0, 1); PG8_STAGE(PG8_SA(0, 0), a2, voffA);
            PG8_BAR; PG8_WAIT_L(0); PG8_MMA(1, 0, At, B0); PG8_BAR; PG8_SCHED;
            PG8_STAGE(PG8_SB(0, 1), b2 + hstepB, voffB);
            PG8_WAIT_V(6); PG8_BAR; PG8_MMA(1, 1, At, B1); PG8_BAR;
            PG8_LDB(B0, 1, 0); PG8_SCHED; PG8_LDA(At, 1, 0); PG8_STAGE(PG8_SA(0, 1), a2 + hstepA, voffA);
            PG8_WAIT_L(8); PG8_BAR; PG8_WAIT_L(0); PG8_MMA(0, 0, At, B0); PG8_BAR; PG8_SCHED;
            PG8_LDB(B1, 1, 1); PG8_STAGE(PG8_SB(1, 0), b3, voffB);
            PG8_BAR; PG8_WAIT_L(0); PG8_MMA(0, 1, At, B1); PG8_BAR;
            PG8_LDA(At, 1, 1); PG8_STAGE(PG8_SA(1, 0), a3, voffA);
            PG8_BAR; PG8_WAIT_L(0); PG8_MMA(1, 0, At, B0); PG8_BAR; PG8_SCHED;
            PG8_STAGE(PG8_SB(1, 1), b3 + hstepB, voffB);
            PG8_WAIT_V(6); PG8_BAR; PG8_MMA(1, 1, At, B1); PG8_BAR;
            }
        }
        if constexpr (ALIGN_EPI) { if (wr == 0) PG8_BAR; }
        if constexpr (Epi::RSTD) { if (cur.pm != rs_pm) {
                const int row_ = tid >> 1, hf_ = tid & 1; const float* sp_ = E.SS + ((size_t)cur.pm * BM + row_) * 16 + hf_ * 8; const f32x4 p0_ = *(const f32x4*)sp_, p1_ = *(const f32x4*)(sp_ + 4);
                float s_ = ((p0_[0] + p0_[1]) + (p0_[2] + p0_[3])) + ((p1_[0] + p1_[1]) + (p1_[2] + p1_[3])); s_ += shx(s_, lane, 1);
                if (hf_ == 0) *(PG8_LAS float*)(lds + RSTD_LDS_OFF + row_ * 4) = 1.0f / sqrtf(s_ * (1.0f / D) + RMS_EPS);
                asm volatile("s_waitcnt lgkmcnt(0)\n\ts_barrier" ::: "memory"); rs_pm = cur.pm; } }
        if constexpr (!Epi::AFTER_DRAIN) { E(acc, cur, wr, wc, fr, fq, lds); S.done(cur); }
        if (!has_next) break;
#pragma unroll
        for (int a = 0; a < 2; ++a)
#pragma unroll
            for (int b = 0; b < 2; ++b)
#pragma unroll
                for (int m = 0; m < 4; ++m)
#pragma unroll
                    for (int n = 0; n < 2; ++n) acc[a][b][m][n] = (f32x4){0.f, 0.f, 0.f, 0.f};
        cur = nxt; cA = nA; cB = nB; ++ui;
        if constexpr (ALIGN_EPI) { if (wr == 1) PG8_BAR; }
    }
    PG8_WAIT_V(0);
    if constexpr (!ALIGN_EPI) { if (wr == 0) PG8_BAR; }
    PG8_BAR;
    if constexpr (Epi::AFTER_DRAIN) { E.fused(acc, cur, wr, wc, fr, fq, lds, wid, lane); S.done(cur); }
#undef PG8_SA
#undef PG8_SB
#undef PG8_STAGE
#undef PG8_LDA
#undef PG8_LDB
#undef PG8_MMA
#undef PG8_WAIT_V
#undef PG8_WAIT_L
#undef PG8_BAR
#undef PG8_SCHED
}
}

namespace pg8 {
__device__ __forceinline__ float fsig(float v) { return __builtin_amdgcn_rcpf(1.f + __builtin_amdgcn_exp2f(-1.4426950408889634f * v)); }
__device__ __forceinline__ u32x4 pack8(const f32x4 a, const f32x4 b) { u32x4 w; w.x = cvt_pk_bf16(a[0], a[1]); w.y = cvt_pk_bf16(a[2], a[3]); w.z = cvt_pk_bf16(b[0], b[1]); w.w = cvt_pk_bf16(b[2], b[3]); return w; }
__device__ __forceinline__ void unpack8(const u32x4 w, f32x4& a, f32x4& b) {
    a[0] = __builtin_bit_cast(float, w.x << 16); a[1] = __builtin_bit_cast(float, w.x & 0xffff0000u); a[2] = __builtin_bit_cast(float, w.y << 16); a[3] = __builtin_bit_cast(float, w.y & 0xffff0000u);
    b[0] = __builtin_bit_cast(float, w.z << 16); b[1] = __builtin_bit_cast(float, w.z & 0xffff0000u); b[2] = __builtin_bit_cast(float, w.w << 16); b[3] = __builtin_bit_cast(float, w.w & 0xffff0000u); }
#define PIN16(a) asm volatile("" : "+v"(a[0][0][0]), "+v"(a[0][0][1]), "+v"(a[0][1][0]), "+v"(a[0][1][1]), "+v"(a[0][2][0]), "+v"(a[0][2][1]), "+v"(a[0][3][0]), "+v"(a[0][3][1]), \
    "+v"(a[1][0][0]), "+v"(a[1][0][1]), "+v"(a[1][1][0]), "+v"(a[1][1][1]), "+v"(a[1][2][0]), "+v"(a[1][2][1]), "+v"(a[1][3][0]), "+v"(a[1][3][1]))
__device__ __forceinline__ float dot4(const f32x4 a) { return (a[0] * a[0] + a[1] * a[1]) + (a[2] * a[2] + a[3] * a[3]); }
__device__ __forceinline__ void row_rstd(PG8_LAS unsigned char* lds, int wr, int fr, float (&rs)[2][4]) {
#pragma unroll
    for (int ai = 0; ai < 2; ++ai)
#pragma unroll
        for (int m = 0; m < 4; ++m) rs[ai][m] = *(const PG8_LAS float*)(lds + RSTD_LDS_OFF + (ai * HALF + wr * 64 + m * 16 + fr) * 4);
}
struct EpiSwigluF { static constexpr bool PERM = true, AFTER_DRAIN = false, HOOK = false, RSTD = true; static constexpr int HOOK_T = 0; bf16_t* H; const float* SS;
    __device__ __forceinline__ void operator()(const f32x4 (&acc)[2][2][4][2], const Unit& u, int wr, int wc, int fr, int fq, PG8_LAS unsigned char* lds) const {
        const int row0 = u.pm * BM + wr * 64 + fr, col0 = u.pn * 128 + wc * 32 + 8 * fq;
        for (int rp_ = 0; rp_ < 1 + ((REP_MASK >> 6) & 1); ++rp_) {
        float rs[2][4]; row_rstd(lds, wr, fr, rs);
#pragma unroll
        for (int ai = 0; ai < 2; ++ai)
#pragma unroll
            for (int m = 0; m < 4; ++m) { bf16_t* rowp = H + (size_t)(row0 + ai * HALF + m * 16) * DFF + col0; const float r = rs[ai][m];
                f32x4 h0, h1;
#pragma unroll
                for (int i = 0; i < 4; ++i) { const float g0 = acc[ai][0][m][0][i] * r, g1 = acc[ai][0][m][1][i] * r; h0[i] = g0 * fsig(g0) * (acc[ai][1][m][0][i] * r); h1[i] = g1 * fsig(g1) * (acc[ai][1][m][1][i] * r); }
                __builtin_nontemporal_store(pack8(h0, h1), (u32x4*)rowp); }
        }
    } };
template <bool FINAL> struct EpiResidB { static constexpr bool PERM = true, AFTER_DRAIN = false, HOOK = false, RSTD = false; static constexpr int HOOK_T = 0; bf16_t* XB; float* Of; float* SS; float coef;
    __device__ __forceinline__ void operator()(const f32x4 (&acc)[2][2][4][2], const Unit& u, int wr, int wc, int fr, int fq, PG8_LAS unsigned char* lds) const {
        const int row0 = u.pm * BM + wr * 64 + fr, col0 = u.pn * BM + wc * 32 + 8 * fq;
        u32x4 rr[2][4][2];
#pragma unroll
        for (int ai = 0; ai < 2; ++ai)
#pragma unroll
            for (int m = 0; m < 4; ++m)
#pragma unroll
                for (int bj = 0; bj < 2; ++bj) rr[ai][m][bj] = *(const u32x4*)(XB + (size_t)(row0 + ai * HALF + m * 16) * D + col0 + bj * HALF);
        PIN16(rr);
#pragma unroll
        for (int ai = 0; ai < 2; ++ai)
#pragma unroll
            for (int m = 0; m < 4; ++m) { const size_t row = (size_t)(row0 + ai * HALF + m * 16); float ssq = 0.f;
#pragma unroll
                for (int bj = 0; bj < 2; ++bj) { const int c = col0 + bj * HALF; f32x4 r0, r1; unpack8(rr[ai][m][bj], r0, r1);
                    f32x4 v0 = r0 + acc[ai][bj][m][0] * coef, v1 = r1 + acc[ai][bj][m][1] * coef;
                    if (FINAL) { *(f32x4*)(Of + row * D + c) = v0; *(f32x4*)(Of + row * D + c + 4) = v1; }
                    else { const u32x4 w = pack8(v0, v1); *(u32x4*)(XB + row * D + c) = w; unpack8(w, v0, v1); }
                    ssq += dot4(v0) + dot4(v1); }
                ssq += shx(ssq, fq * 16 + fr, 16); ssq += shx(ssq, fq * 16 + fr, 32);
                if (fq == 0) SS[row * 16 + 4 * u.pn + wc] = ssq; }
    } };
struct EpiProjF { static constexpr bool PERM = true, AFTER_DRAIN = false, HOOK = false, RSTD = true; static constexpr int HOOK_T = 0; bf16_t* PA; bf16_t* PB; float* SG; const float* SS; const float* fb; const float* ib; const float* mfb;
    __device__ __forceinline__ void operator()(const f32x4 (&acc)[2][2][4][2], const Unit& u, int wr, int wc, int fr, int fq, PG8_LAS unsigned char* lds) const {
        const int row0 = u.pm * BM + wr * 64 + fr;
        float rs[2][4]; row_rstd(lds, wr, fr, rs);
        if (u.pn < 22) {
            const int act = u.pn < 2 ? 0 : (u.pn < 12 ? 1 : 2); const int col0 = (u.pn < 12 ? u.pn : u.pn - 12) * BM + wc * 32 + 8 * fq;
            bf16_t* base = u.pn < 12 ? PA : PB; const int pitch = u.pn < 12 ? PJA : PJB;
#pragma unroll
            for (int ai = 0; ai < 2; ++ai)
#pragma unroll
                for (int m = 0; m < 4; ++m) { bf16_t* rowp = base + (size_t)(row0 + ai * HALF + m * 16) * pitch + col0; const float r = rs[ai][m] * (act == 0 ? QSCALE2 : 1.0f);
#pragma unroll
                    for (int bj = 0; bj < 2; ++bj) { f32x4 v0 = acc[ai][bj][m][0] * r, v1 = acc[ai][bj][m][1] * r;
                        if (act == 2) {
#pragma unroll
                            for (int i = 0; i < 4; ++i) { v0[i] = fsig(v0[i]); v1[i] = fsig(v1[i]); } }
                        __builtin_nontemporal_store(pack8(v0, v1), (u32x4*)(rowp + bj * HALF)); } }
        } else if (wc == 0 && fq < 2) {
            const f32x4 b0 = fq == 0 ? *(const f32x4*)fb : *(const f32x4*)ib, b1 = fq == 0 ? *(const f32x4*)(fb + 4) : *(const f32x4*)mfb;
#pragma unroll
            for (int ai = 0; ai < 2; ++ai)
#pragma unroll
                for (int m = 0; m < 4; ++m) { float* sp = SG + (size_t)(row0 + ai * HALF + m * 16) * 16 + 8 * fq; const float r = rs[ai][m];
                    f32x4 v0 = acc[ai][0][m][0] * r + b0, v1 = acc[ai][0][m][1] * r + b1;
#pragma unroll
                    for (int i = 0; i < 4; ++i) { if (fq == 0) v0[i] = logsigmoidf_(v0[i]); v1[i] = logsigmoidf_(v1[i]); }
                    *(f32x4*)sp = v0; *(f32x4*)(sp + 4) = v1; }
        }
    } };
struct EpiMergeF { static constexpr bool PERM = true, AFTER_DRAIN = false, HOOK = true, RSTD = false; static constexpr int HOOK_T = 8; const bf16_t* PB; bf16_t* MG;
    __device__ __forceinline__ void mid(f32x4 (&acc)[2][2][4][2], const Unit& u, int wr, int wc, int fr, int fq) const {
        int row0 = u.pm * BM + wr * 64 + fr, col0 = u.pn * BM + wc * 32 + 8 * fq; asm volatile("" : "+v"(row0), "+v"(col0));
#pragma unroll
        for (int ai = 0; ai < 2; ++ai) {
            u32x4 gg[2][4][2];
#pragma unroll
            for (int m = 0; m < 4; ++m)
#pragma unroll
                for (int bj = 0; bj < 2; ++bj) { const bf16_t* rowp = PB + (size_t)(row0 + ai * HALF + m * 16) * PJB + col0 + bj * HALF; gg[0][m][bj] = *(const u32x4*)(rowp + PB_GA); gg[1][m][bj] = *(const u32x4*)(rowp + PB_GB); }
            PIN16(gg);
#pragma unroll
            for (int m = 0; m < 4; ++m) {
#pragma unroll
                for (int bj = 0; bj < 2; ++bj) { f32x4 a0, a1, b0, b1; unpack8(gg[0][m][bj], a0, a1); unpack8(gg[1][m][bj], b0, b1);
#pragma unroll
                    for (int i = 0; i < 4; ++i) { acc[ai][bj][m][0][i] *= a0[i] * __builtin_amdgcn_rcpf(fmaxf(b0[i], 1e-30f)); acc[ai][bj][m][1][i] *= a1[i] * __builtin_amdgcn_rcpf(fmaxf(b1[i], 1e-30f)); } } } }
    }
    __device__ __forceinline__ void operator()(const f32x4 (&acc)[2][2][4][2], const Unit& u, int wr, int wc, int fr, int fq, PG8_LAS unsigned char* lds) const {
        const int row0 = u.pm * BM + wr * 64 + fr, col0 = u.pn * BM + wc * 32 + 8 * fq;
        u32x4 gb[2][4][2];
#pragma unroll
        for (int ai = 0; ai < 2; ++ai)
#pragma unroll
            for (int m = 0; m < 4; ++m)
#pragma unroll
                for (int bj = 0; bj < 2; ++bj) gb[ai][m][bj] = *(const u32x4*)(PB + (size_t)(row0 + ai * HALF + m * 16) * PJB + PB_GB + col0 + bj * HALF);
        PIN16(gb);
#pragma unroll
        for (int ai = 0; ai < 2; ++ai)
#pragma unroll
            for (int m = 0; m < 4; ++m) { const size_t row = (size_t)(row0 + ai * HALF + m * 16);
#pragma unroll
                for (int bj = 0; bj < 2; ++bj) { const int c = col0 + bj * HALF; f32x4 b0, b1; unpack8(gb[ai][m][bj], b0, b1);
                    *(u32x4*)(MG + row * D + c) = pack8(b0 * acc[ai][bj][m][0], b1 * acc[ai][bj][m][1]); } }
    } };
}

__device__ __forceinline__ void transpose_item(const float* W, int N, int scol0, bf16* WT, int ldt, int drow0, int k0, int kdst0, LAS float* scr, int lane, const float* gain) {
#pragma unroll 8
    for (int i = 0; i < 32; ++i) { const int kk = 2 * i + (lane >> 5); const float gk = gain ? gain[k0 + kk] : 1.0f; scr[kk * 33 + (lane & 31)] = W[(size_t)(k0 + kk) * N + scol0 + (lane & 31)] * gk; }
    asm volatile("s_waitcnt lgkmcnt(0)" ::: "memory");
    const int c = lane & 7;
#pragma unroll
    for (int j = 0; j < 4; ++j) { const int n = (lane >> 3) + 8 * j; const LAS float* s = scr + (8 * c) * 33 + n;
        v4u o; o.x = pk2(s[0 * 33], s[1 * 33]); o.y = pk2(s[2 * 33], s[3 * 33]); o.z = pk2(s[4 * 33], s[5 * 33]); o.w = pk2(s[6 * 33], s[7 * 33]);
        *(GAS v4u*)(WT + (size_t)(drow0 + n) * ldt + kdst0 + k0 + 8 * c) = o; }
    asm volatile("s_waitcnt lgkmcnt(0)" ::: "memory");
}
__device__ __forceinline__ void phase_weights(Frame& F) {
    const int ptid = opaque_tid(F.wave), plane = ptid & 63, pwave = __builtin_amdgcn_readfirstlane(ptid >> 6); (void)plane; (void)pwave;
    LAS float* scr = (LAS float*)(F.lds + pwave * 16384);
    const int gw = blockIdx.x * NWAVES + pwave, NGW = F.G * NWAVES;
    constexpr int PJ = PJA + PJB; constexpr int I_IN = (D / 64) * (NFF / 32), I_OUT = (DFF / 64) * (D / 32), I_PJ = (D / 64) * (PJ / 32), I_UP = (512 / 64) * (D / 32), I_WO = (D / 64) * (D / 32);
    constexpr int NITEMS = 2 * I_IN + 2 * I_OUT + I_PJ + 2 * I_UP + I_WO;
    for (int it = gw; it < NITEMS; it += NGW) {
        int r = it;
        if (r < 2 * I_IN) { const int which = r / I_IN; r -= which * I_IN; const int ndb = NFF / 32, kb = r / ndb, db = r % ndb, n = db * 32, pn = n >> 8, j = n & 255;
            const int sc = (j < 128) ? pn * 128 + j : DFF + pn * 128 + (j - 128);
            transpose_item(F.in[which ? 15 : 2], NFF, sc, (bf16*)(F.ws + (which ? WS_W2IN : WS_W1IN)), D, n, kb * 64, 0, scr, plane, F.in[which ? 14 : 1]); continue; }
        r -= 2 * I_IN;
        if (r < 2 * I_OUT) { const int which = r / I_OUT; r -= which * I_OUT; const int ndb = D / 32, kb = r / ndb, db = r % ndb;
            transpose_item(F.in[which ? 16 : 3], D, db * 32, (bf16*)(F.ws + (which ? WS_W2OUT : WS_W1OUT)), DFF, db * 32, kb * 64, 0, scr, plane, nullptr); continue; }
        r -= 2 * I_OUT;
        if (r < I_PJ) { const int ndb = PJ / 32, kb = r / ndb, db = r % ndb, n = db * 32; const int sc = n + (n < 1536 ? 0 : (n < 3072 ? 8 : 16));
            transpose_item(F.in[5], INC, sc, (bf16*)(F.ws + WS_WIN), D, n, kb * 64, 0, scr, plane, F.in[4]); continue; }
        r -= I_PJ;
        if (r < 2 * I_UP) { const int which = r / I_UP; r -= which * I_UP; const int ndb = D / 32, kb = r / ndb, db = r % ndb;
            transpose_item(F.in[which ? 12 : 11], D, db * 32, (bf16*)(F.ws + WS_WCAT), D, db * 32, kb * 64, which ? 512 : 0, scr, plane, nullptr); continue; }
        r -= 2 * I_UP;
        { const int ndb = D / 32, kb = r / ndb, db = r % ndb; transpose_item(F.in[13], D, db * 32, (bf16*)(F.ws + WS_WOUT), D, db * 32, kb * 64, 0, scr, plane, nullptr); }
    }
    { bf16* WT = (bf16*)(F.ws + WS_WIN); const float* W = F.in[5];
      for (int idx = blockIdx.x * NTHR + ptid; idx < 256 * 128; idx += F.G * NTHR) { const int row = idx >> 7, k8 = (idx & 127) * 8; v4u o = {0u, 0u, 0u, 0u};
          if (row < 16) { const int sc = row < 8 ? 1536 + row : (row < 12 ? 3080 + (row - 8) : 3084 + (row - 12)); float v[8];
#pragma unroll
              for (int i = 0; i < 8; ++i) v[i] = W[(size_t)(k8 + i) * INC + sc] * F.in[4][k8 + i];
              o.x = pk2(v[0], v[1]); o.y = pk2(v[2], v[3]); o.z = pk2(v[4], v[5]); o.w = pk2(v[6], v[7]); }
          *(GAS v4u*)(WT + (size_t)(PJ + row) * D + k8) = o; } }
}

#include <hip/hip_bf16.h>
#include <cmath>
namespace attn_body {
using bf16=__hip_bfloat16;
using bf16x8=__attribute__((ext_vector_type(8)))short;
using s16x4=__attribute__((ext_vector_type(4)))short;
using f32x16=__attribute__((ext_vector_type(16)))float;
using u32x4=__attribute__((ext_vector_type(4)))unsigned;
constexpr int BATCH=32,NHEAD=8,SEQ=2048,D=64,DM=3072,OP=1024;
constexpr int NW=8,QBLK=32,QB=QBLK*NW,KVBLK=64,NQB=SEQ/QB;
constexpr int ATTN_PITCH=DM, ATTN_UNIT_ROWS=QB;
__device__ __forceinline__ int crow(int r,int hi){return (r&3)+8*(r>>2)+4*hi;}
#define SBAR() __builtin_amdgcn_sched_barrier(0)
__device__ __forceinline__ void cmask(f32x16&p0,f32x16&p1,int jb,int qrel,int hi){
  const float NEG=-INFINITY; int kb=64*jb+4*hi;
  #pragma unroll
  for(int r=0;r<16;++r){int kv=kb+(r&3)+8*(r>>2); if(kv>qrel)p0[r]=NEG; if(kv+32>qrel)p1[r]=NEG;}
}

constexpr int NSLOT=3, SLOTB=8192;
constexpr int LDS_K=0, LDS_V=NSLOT*SLOTB, LDS_WS=2*NSLOT*SLOTB, LDS_OST=LDS_WS+NW*64*4, LDS_BIAS=LDS_OST+NW*4096, LDS_ROWB=LDS_BIAS+SEQ*8, LDS_BYTES=LDS_ROWB+QB*4;
constexpr float C2=0.125f*1.4426950408889634f;
__device__ __forceinline__ void glds16(const void*gsrc,unsigned lds_dst){unsigned keep;
  asm volatile("s_mov_b32 %0, m0\n\ts_mov_b32 m0, %2\n\ts_nop 0\n\tglobal_load_lds_dwordx4 %1, off\n\ts_mov_b32 m0, %0":"=&s"(keep):"v"(gsrc),"s"(lds_dst):"memory");}
__device__ __forceinline__ float max3f(float a,float b,float c){float r;asm("v_max3_f32 %0, %1, %2, %3":"=v"(r):"v"(a),"v"(b),"v"(c));return r;}
__device__ __forceinline__ float max2f(float a,float b){float r;asm("v_max_f32_e32 %0, %1, %2":"=v"(r):"v"(a),"v"(b));return r;}
__device__ __forceinline__ float fadd_s(float a,float b){float r;asm("v_add_f32_e32 %0, %1, %2":"=v"(r):"v"(a),"v"(b));return r;}
__device__ __forceinline__ float fsub_s(float a,float b){float r;asm("v_sub_f32_e32 %0, %1, %2":"=v"(r):"v"(a),"v"(b));return r;}
typedef float f32x2_t __attribute__((ext_vector_type(2))); typedef __bf16 bf16x2_t __attribute__((ext_vector_type(2)));
__device__ __forceinline__ unsigned cvtpk_s(float lo,float hi){f32x2_t v={lo,hi};bf16x2_t b=__builtin_convertvector(v,bf16x2_t);return __builtin_bit_cast(unsigned,b);}
#define WAIT_BAR(N) asm volatile("s_waitcnt vmcnt(" #N ") lgkmcnt(0)\n\ts_barrier":::"memory")

__device__ __forceinline__ void qkt(f32x16&p0,f32x16&p1,const char*Kslot,const bf16x8*qr,int r32,int hi,bf16x8 kx0,bf16x8 kx1,bf16x8 qx){
  const char*kb=Kslot+hi*1024+r32*16;
  #pragma unroll
  for(int d0=0;d0<4;++d0){
    const bf16x8 b0=*reinterpret_cast<const bf16x8*>(kb+d0*2048);
    const bf16x8 b1=*reinterpret_cast<const bf16x8*>(kb+d0*2048+512);
    if(d0==0){p0=__builtin_amdgcn_mfma_f32_32x32x16_bf16(b0,qr[0],f32x16{},0,0,0);p1=__builtin_amdgcn_mfma_f32_32x32x16_bf16(b1,qr[0],f32x16{},0,0,0);}
    else{p0=__builtin_amdgcn_mfma_f32_32x32x16_bf16(b0,qr[d0],p0,0,0,0);p1=__builtin_amdgcn_mfma_f32_32x32x16_bf16(b1,qr[d0],p1,0,0,0);}}
  p0=__builtin_amdgcn_mfma_f32_32x32x16_bf16(kx0,qx,p0,0,0,0);p1=__builtin_amdgcn_mfma_f32_32x32x16_bf16(kx1,qx,p1,0,0,0);
}
typedef __attribute__((address_space(3))) const char* lds_cptr;
typedef short v4i16_t __attribute__((ext_vector_type(4)));
__device__ __forceinline__ void kload8(bf16x8*kf,lds_cptr kp){
  kf[0]=*(const __attribute__((address_space(3))) bf16x8*)(kp);      kf[1]=*(const __attribute__((address_space(3))) bf16x8*)(kp+512);
  kf[2]=*(const __attribute__((address_space(3))) bf16x8*)(kp+2048); kf[3]=*(const __attribute__((address_space(3))) bf16x8*)(kp+2560);
  kf[4]=*(const __attribute__((address_space(3))) bf16x8*)(kp+4096); kf[5]=*(const __attribute__((address_space(3))) bf16x8*)(kp+4608);
  kf[6]=*(const __attribute__((address_space(3))) bf16x8*)(kp+6144); kf[7]=*(const __attribute__((address_space(3))) bf16x8*)(kp+6656);
}
__device__ __forceinline__ void kload2(bf16x8*kf,lds_cptr kp,int j){ kf[2*j]=*(const __attribute__((address_space(3))) bf16x8*)(kp+j*2048); kf[2*j+1]=*(const __attribute__((address_space(3))) bf16x8*)(kp+j*2048+512); }
typedef unsigned u32x2_t __attribute__((ext_vector_type(2)));
__device__ __forceinline__ bf16x8 kxfrag(lds_cptr tbl,int kv,int hi){ u32x2_t b=*(const __attribute__((address_space(3))) u32x2_t*)(tbl+kv*8); if(hi){b.x=0u;b.y=0u;} const u32x4 w={b.x,b.y,hi?0u:0x3F803F80u,0u}; return __builtin_bit_cast(bf16x8,w); }
__device__ __forceinline__ s16x4 vtr(lds_cptr p){ return __builtin_bit_cast(s16x4,__builtin_amdgcn_ds_read_tr16_b64_v4i16((__attribute__((address_space(3))) v4i16_t*)p)); }
__device__ __forceinline__ float rowmax(const f32x16&p0,const f32x16&p1){
  float a=max3f(p0[0],p0[1],p1[0]),b=max3f(p0[2],p0[3],p1[1]);a=max3f(a,p1[2],p1[3]);
  #pragma unroll
  for(int r=4;r<16;r+=4){a=max3f(a,p0[r],p0[r+1]);b=max3f(b,p0[r+2],p0[r+3]);a=max3f(a,p1[r],p1[r+1]);b=max3f(b,p1[r+2],p1[r+3]);}
  const float m=max2f(a,b);
  auto rr=__builtin_amdgcn_permlane32_swap(__float_as_uint(m),__float_as_uint(m),false,false);
  return max2f(__uint_as_float(rr[0]),__uint_as_float(rr[1]));
}
__device__ __forceinline__ void pv(f32x16*o,int vb,bf16x8 pa0,bf16x8 pa1,bf16x8 pa2,bf16x8 pa3){
  #pragma unroll
  for(int d0=0;d0<2;++d0){s16x4 lo[4],hi[4];
    #pragma unroll
    for(int ks=0;ks<4;++ks){
      asm volatile("ds_read_b64_tr_b16 %0,%1 offset:%c2":"=&v"(lo[ks]):"v"(vb),"i"(d0*4096+ks*1024):"memory");
      asm volatile("ds_read_b64_tr_b16 %0,%1 offset:%c2":"=&v"(hi[ks]):"v"(vb),"i"(d0*4096+ks*1024+512):"memory");}
    asm volatile("s_waitcnt lgkmcnt(0)":::"memory");SBAR();
    #define PK(k) (bf16x8){lo[k][0],lo[k][1],lo[k][2],lo[k][3],hi[k][0],hi[k][1],hi[k][2],hi[k][3]}
    o[d0]=__builtin_amdgcn_mfma_f32_32x32x16_bf16(pa0,PK(0),o[d0],0,0,0);
    o[d0]=__builtin_amdgcn_mfma_f32_32x32x16_bf16(pa1,PK(1),o[d0],0,0,0);
    o[d0]=__builtin_amdgcn_mfma_f32_32x32x16_bf16(pa2,PK(2),o[d0],0,0,0);
    o[d0]=__builtin_amdgcn_mfma_f32_32x32x16_bf16(pa3,PK(3),o[d0],0,0,0);
    #undef PK
  }
}

#ifndef ATTN_STORE16
#define ATTN_STORE16(p,v) (*(u32x4*)(p)=(v))
#endif
template<int THRL> __device__ __forceinline__ void attn_unit(int b,int h,int qb,const bf16*Q,const bf16*__restrict__ K,const bf16*__restrict__ V,bf16*O,const float*CUMh,char*shm,const int wv){
  int tid_=wv*64+(int)__builtin_amdgcn_mbcnt_hi(~0u,__builtin_amdgcn_mbcnt_lo(~0u,0u)); asm volatile("":"+v"(tid_)); const int tid=tid_,lane=tid&63,r32=lane&31,hi=lane>>5; const int wid=__builtin_amdgcn_readfirstlane(tid>>6);
  const long rowbase=(long)b*SEQ; const int q0=qb*QB;
  const bf16*Qw=Q+(rowbase+q0+wid*QBLK)*DM+h*D;
  const bf16*Kh=K+rowbase*DM+h*D,*Vh=V+rowbase*DM+h*D;
  const unsigned lds0=(unsigned)(uintptr_t)shm;
  float*wsf=(float*)(shm+LDS_WS)+wid*64;
  const bf16*ksrc=Kh+(long)lane*DM+wid*8;
  const bf16*vsrc=Vh+(long)(16*(wid&3)+(lane>>2))*DM+(wid>>2)*32+(lane&3)*8;
  const unsigned kdst=lds0+LDS_K+wid*1024, vdst=lds0+LDS_V+wid*1024;
  #define DMA_K(t,slot) glds16(ksrc+(long)(t)*KVBLK*DM,(unsigned)__builtin_amdgcn_readfirstlane(kdst+(slot)))
  #define DMA_V(t,slot) glds16(vsrc+(long)(t)*KVBLK*DM,(unsigned)__builtin_amdgcn_readfirstlane(vdst+(slot)))
  const int vb0=(int)(lds0+LDS_V)+((lane>>4)&1)*32+(lane&3)*8+(4*hi+((lane&15)>>2))*64;
  const char*Kbase=shm+LDS_K; bf16x8 kf[8];
  const lds_cptr shm3=(lds_cptr)shm; const lds_cptr kp0=shm3+LDS_K+hi*1024+r32*16; const lds_cptr vp0=shm3+LDS_V+((lane>>4)&1)*32+(lane&3)*8+(4*hi+((lane&15)>>2))*64;
  const int NT=(q0+QB)/KVBLK;
  DMA_K(0,0);DMA_V(0,0);DMA_K(1,SLOTB);
  bf16x8 qr[4];
  #pragma unroll
  for(int d0=0;d0<4;++d0)qr[d0]=*reinterpret_cast<const bf16x8*>(&Qw[(long)r32*DM+d0*16+hi*8]);
  const int qrel=wid*QBLK+r32;
  { const float cref=CUMh[q0]; __attribute__((address_space(3))) unsigned*bt=(__attribute__((address_space(3))) unsigned*)(shm3+LDS_BIAS); __attribute__((address_space(3))) float*rb=(__attribute__((address_space(3))) float*)(shm3+LDS_ROWB);
    for(int kv=tid;kv<q0+QB;kv+=NW*64){ const float bias=(cref-CUMh[kv])*1.4426950408889634f;
      const unsigned u1=__builtin_bit_cast(unsigned,bias); const unsigned h1=(u1+0x7fffu+((u1>>16)&1u))&0xffff0000u; const float r1=bias-__builtin_bit_cast(float,h1);
      const unsigned u2=__builtin_bit_cast(unsigned,r1);   const unsigned h2=(u2+0x7fffu+((u2>>16)&1u))&0xffff0000u; const float r2=r1-__builtin_bit_cast(float,h2);
      const unsigned u3=__builtin_bit_cast(unsigned,r2);   const unsigned h3=(u3+0x7fffu+((u3>>16)&1u))&0xffff0000u;
      bt[2*kv]=(h1>>16)|h2; bt[2*kv+1]=(h3>>16)|0x3F800000u; if(kv>=q0)rb[kv-q0]=bias; } }
  const lds_cptr btab=shm3+LDS_BIAS; u32x4 qxw={hi?0u:0x3F803F80u,0u,0u,0u};
  #define QX __builtin_bit_cast(bf16x8,qxw)
  #define RNEHI(u) (((u)+0x7fffu+(((u)>>16)&1u))&0xffff0000u)
  #define SETQX() do{ const float nm_=-mhat; const unsigned a1_=RNEHI(__builtin_bit_cast(unsigned,nm_)); const float s1_=nm_-__builtin_bit_cast(float,a1_); \
      const unsigned a2_=RNEHI(__builtin_bit_cast(unsigned,s1_)); const float s2_=s1_-__builtin_bit_cast(float,a2_); const unsigned a3_=RNEHI(__builtin_bit_cast(unsigned,s2_)); \
      qxw.y=hi?0u:(a1_|0x3F80u); qxw.z=hi?0u:((a2_>>16)|a3_); }while(0)
  float mhat=0.f,l_reg=0.f;f32x16 o[2];o[0]=f32x16{};o[1]=f32x16{};
  #define CMASK(P0,P1,t) do{int jb_=(t)-(NT-4); if(jb_>=0)cmask(P0,P1,jb_,qrel,hi);}while(0)
  bool resc=false;
  #define START(P0,P1) do{ const float rm=rowmax(P0,P1); resc=false; \
    { const float dl=max2f(rm,0.f); mhat=fadd_s(mhat,dl); \
      _Pragma("unroll") for(int r=0;r<16;++r){P0[r]=fsub_s(P0[r],dl);P1[r]=fsub_s(P1[r],dl);} \
      SETQX(); } \
    _Pragma("unroll") for(int r=0;r<16;++r)P0[r]=__builtin_amdgcn_exp2f(P0[r]); }while(0)
  #define RESC() do{ if(resc){ asm volatile("s_waitcnt lgkmcnt(0)":::"memory"); \
      _Pragma("unroll") for(int d_=0;d_<2;++d_) _Pragma("unroll") for(int r=0;r<16;++r)o[d_][r]*=wsf[crow(r,hi)]; } }while(0)
  f32x16 pA0,pA1,pB0,pB1;
  int sl_prev=0,sl_cur=0,sl_next=SLOTB;
  #define ROT() do{sl_prev=sl_cur;sl_cur=sl_next;sl_next=(sl_next==(NSLOT-1)*SLOTB)?0:sl_next+SLOTB;}while(0)
  DMA_K(2,2*SLOTB);
  WAIT_BAR(3);
  mhat=*(const __attribute__((address_space(3))) float*)(shm3+LDS_ROWB+qrel*4);
  SETQX();
  qkt(pA0,pA1,Kbase,qr,r32,hi,kxfrag(btab,r32,hi),kxfrag(btab,32+r32,hi),QX);asm volatile("s_nop 15\n\ts_nop 7":"+v"(pA0),"+v"(pA1));CMASK(pA0,pA1,0);
  START(pA0,pA1);
  _Pragma("unroll") for(int r=0;r<16;++r)pA1[r]=__builtin_amdgcn_exp2f(pA1[r]);
  WAIT_BAR(0);
  DMA_K(3,0);DMA_V(1,SLOTB);
  ROT();
  kload8(kf,kp0+sl_cur);
  WAIT_BAR(2);
  s16x4 vlo[8],vhi[8]; u32x4 pw0,pw1,pw2,pw3;
  #define PKW(P,B) cvtpk_s(P[B],P[B+1])
  #define PAF(k) __builtin_bit_cast(bf16x8,pw##k)
  #define VFR(i) (bf16x8){vlo[i][0],vlo[i][1],vlo[i][2],vlo[i][3],vhi[i][0],vhi[i][1],vhi[i][2],vhi[i][3]}
  #define PIN(x) asm volatile("":"+v"(x))
  #define MX3(a,b,c) __builtin_fmaxf(__builtin_fmaxf((a),(b)),(c))
  #define GAPA(MF,A0,A1,A2,A3,W0,W1,PW) do{ MF; sacc+=A0; sacc+=A1; sacc+=A2; sacc+=A3; PIN(sacc); W0; W1; PIN(PW); SBAR(); }while(0)
  #define EX(v) __builtin_amdgcn_exp2f(v)
  #define GAPB(MF,X,B) do{ MF; X[B]=EX(X[B]); X[B+1]=EX(X[B+1]); X[B+2]=EX(X[B+2]); X[B+3]=EX(X[B+3]); PIN(X); SBAR(); }while(0)
  #define VRD(i) do{ vlo[i]=vtr(vp_+(((i)>>2)*4096+((i)&3)*1024)); vhi[i]=vtr(vp_+(((i)>>2)*4096+((i)&3)*1024+512)); }while(0)
  #define KRD(G,j) do{ if(G){ kload2(kf,kp0+sl_next,j); SBAR(); } }while(0)
  #define STEP(C0,C1,P0,P1,t,GK,GV,GL) do{ SBAR(); \
    const lds_cptr vp_=vp0+sl_prev; \
    const bf16x8 kx0_=kxfrag(btab,64*(t)+r32,hi), kx1_=kxfrag(btab,64*(t)+32+r32,hi); \
    VRD(0); SBAR(); float sacc=(P0[0]+P0[1]); \
    GAPA(C0=__builtin_amdgcn_mfma_f32_32x32x16_bf16(kf[0],qr[0],f32x16{},0,0,0), P0[2],P0[3],P0[4],P0[5],     pw0[0]=PKW(P0,0), pw0[1]=PKW(P0,2), pw0); \
    VRD(4); SBAR(); GAPA(C1=__builtin_amdgcn_mfma_f32_32x32x16_bf16(kf[1],qr[0],f32x16{},0,0,0), P0[6],P0[7],P0[8],P0[9],     pw0[2]=PKW(P0,4), pw0[3]=PKW(P0,6), pw0); \
    VRD(1); SBAR(); GAPA(C0=__builtin_amdgcn_mfma_f32_32x32x16_bf16(kf[2],qr[1],C0,0,0,0),   P0[10],P0[11],P0[12],P0[13], pw1[0]=PKW(P0,8), pw1[1]=PKW(P0,10), pw1); \
    VRD(5); SBAR(); GAPA(C1=__builtin_amdgcn_mfma_f32_32x32x16_bf16(kf[3],qr[1],C1,0,0,0),   P0[14],P0[15],P1[0],P1[1],   pw1[2]=PKW(P0,12),pw1[3]=PKW(P0,14), pw1); \
    VRD(2); SBAR(); GAPA(C0=__builtin_amdgcn_mfma_f32_32x32x16_bf16(kf[4],qr[2],C0,0,0,0),   P1[2],P1[3],P1[4],P1[5],     pw2[0]=PKW(P1,0), pw2[1]=PKW(P1,2), pw2); \
    VRD(6); SBAR(); GAPA(C1=__builtin_amdgcn_mfma_f32_32x32x16_bf16(kf[5],qr[2],C1,0,0,0),   P1[6],P1[7],P1[8],P1[9],     pw2[2]=PKW(P1,4), pw2[3]=PKW(P1,6), pw2); \
    VRD(3); SBAR(); GAPA(C0=__builtin_amdgcn_mfma_f32_32x32x16_bf16(kf[6],qr[3],C0,0,0,0),   P1[10],P1[11],P1[12],P1[13], pw3[0]=PKW(P1,8), pw3[1]=PKW(P1,10), pw3); \
    VRD(7); SBAR(); GAPA(C1=__builtin_amdgcn_mfma_f32_32x32x16_bf16(kf[7],qr[3],C1,0,0,0),   P1[14],P1[15],0.f,0.f,       pw3[2]=PKW(P1,12),pw3[3]=PKW(P1,14), pw3); \
    C0=__builtin_amdgcn_mfma_f32_32x32x16_bf16(kx0_,QX,C0,0,0,0); C1=__builtin_amdgcn_mfma_f32_32x32x16_bf16(kx1_,QX,C1,0,0,0); SBAR(); \
    l_reg+=sacc; \
    if(GK){DMA_K((t)+3,sl_cur);} if(GV){DMA_V((t)+1,sl_next);} \
    CMASK(C0,C1,t); \
    { float a=MX3(C0[0],C0[1],C1[0]),b=MX3(C0[2],C0[3],C1[1]); a=MX3(a,C1[2],C1[3]); \
      _Pragma("unroll") for(int r=4;r<16;r+=4){a=MX3(a,C0[r],C0[r+1]);b=MX3(b,C0[r+2],C0[r+3]);a=MX3(a,C1[r],C1[r+1]);b=MX3(b,C1[r+2],C1[r+3]);} \
      float rm=__builtin_fmaxf(a,b); { auto rr=__builtin_amdgcn_permlane32_swap(__float_as_uint(rm),__float_as_uint(rm),false,false); rm=__builtin_fmaxf(__uint_as_float(rr[0]),__uint_as_float(rr[1])); } \
      resc=false; \
      if(__builtin_expect(__any(rm>(float)THRL),0)){ const float dl=__builtin_fmaxf(rm,0.f); mhat+=dl; \
        _Pragma("unroll") for(int r=0;r<16;++r){C0[r]-=dl;C1[r]-=dl;} \
        SETQX(); \
        const float f=__builtin_amdgcn_exp2f(-dl); l_reg*=f; if(hi==0)wsf[r32]=f; resc=true; } } \
    SBAR(); \
    GAPB(o[0]=__builtin_amdgcn_mfma_f32_32x32x16_bf16(PAF(0),VFR(0),o[0],0,0,0), C0,0); \
    GAPB(o[1]=__builtin_amdgcn_mfma_f32_32x32x16_bf16(PAF(0),VFR(4),o[1],0,0,0), C0,4); \
    KRD(GL,0); GAPB(o[0]=__builtin_amdgcn_mfma_f32_32x32x16_bf16(PAF(1),VFR(1),o[0],0,0,0), C0,8); \
    KRD(GL,1); GAPB(o[1]=__builtin_amdgcn_mfma_f32_32x32x16_bf16(PAF(1),VFR(5),o[1],0,0,0), C0,12); \
    KRD(GL,2); GAPB(o[0]=__builtin_amdgcn_mfma_f32_32x32x16_bf16(PAF(2),VFR(2),o[0],0,0,0), C1,0); \
    KRD(GL,3); GAPB(o[1]=__builtin_amdgcn_mfma_f32_32x32x16_bf16(PAF(2),VFR(6),o[1],0,0,0), C1,4); \
    GAPB(o[0]=__builtin_amdgcn_mfma_f32_32x32x16_bf16(PAF(3),VFR(3),o[0],0,0,0), C1,8); \
    GAPB(o[1]=__builtin_amdgcn_mfma_f32_32x32x16_bf16(PAF(3),VFR(7),o[1],0,0,0), C1,12); \
    }while(0)
  int t=1;
  #undef CMASK
  #define CMASK(P0,P1,t) do{}while(0)
  for(;t+5<NT;t+=2){
    STEP(pB0,pB1,pA0,pA1,t,true,true,true);     WAIT_BAR(2); RESC(); ROT();
    STEP(pA0,pA1,pB0,pB1,t+1,true,true,true);   WAIT_BAR(2); RESC(); ROT();
  }
  #undef CMASK
  #define CMASK(P0,P1,t) do{int jb_=(t)-(NT-4); if(jb_>=0)cmask(P0,P1,jb_,qrel,hi);}while(0)
  #define ENDW(tt) do{ if((tt)+3<NT){WAIT_BAR(2);} else if((tt)+2<NT){WAIT_BAR(1);} else {WAIT_BAR(0);} }while(0)
  for(;t+1<NT;t+=2){
    STEP(pB0,pB1,pA0,pA1,t,(t+3<NT),(t+1<NT),(t+1<NT));       ENDW(t);   RESC(); ROT();
    STEP(pA0,pA1,pB0,pB1,t+1,(t+4<NT),(t+2<NT),(t+2<NT));     ENDW(t+1); RESC(); ROT();
  }
  STEP(pB0,pB1,pA0,pA1,NT-1,false,false,false); RESC();
  { float sacc=pB0[0]+pB0[1]; _Pragma("unroll") for(int r=2;r<16;++r)sacc+=pB0[r]; _Pragma("unroll") for(int r=0;r<16;++r)sacc+=pB1[r]; l_reg+=sacc;
    pw0=(u32x4){PKW(pB0,0),PKW(pB0,2),PKW(pB0,4),PKW(pB0,6)};pw1=(u32x4){PKW(pB0,8),PKW(pB0,10),PKW(pB0,12),PKW(pB0,14)};pw2=(u32x4){PKW(pB1,0),PKW(pB1,2),PKW(pB1,4),PKW(pB1,6)};pw3=(u32x4){PKW(pB1,8),PKW(pB1,10),PKW(pB1,12),PKW(pB1,14)};
    SBAR(); pv(o,vb0+sl_cur,PAF(0),PAF(1),PAF(2),PAF(3)); }
  #undef PKW
  #undef PAF
  #undef VFR
  #undef PIN
  #undef MX3
  #undef GAPA
  #undef GAPB
  #undef EX
  #undef VRD
  #undef KRD
  #undef STEP
  #undef ENDW
  {auto rr=__builtin_amdgcn_permlane32_swap(__float_as_uint(l_reg),__float_as_uint(l_reg),false,false);l_reg=__uint_as_float(rr[0])+__uint_as_float(rr[1]);}
  if(hi==0)wsf[32+r32]=l_reg;asm volatile("s_waitcnt lgkmcnt(0)":::"memory");
  float rli[16];
  #pragma unroll
  for(int r=0;r<16;++r)rli[r]=__builtin_amdgcn_rcpf(wsf[32+crow(r,hi)]);
  bf16*Ow=O+(rowbase+q0+wid*QBLK)*OP+h*D;
  { bf16*stg=(bf16*)(shm+LDS_OST)+wid*2048;
    #pragma unroll
    for(int r=0;r<16;++r){const int orow=crow(r,hi);
      #pragma unroll
      for(int d0=0;d0<2;++d0)stg[orow*64+d0*32+r32]=__float2bfloat16(o[d0][r]*rli[r]);}
    asm volatile("s_waitcnt lgkmcnt(0)":::"memory");
    #pragma unroll
    for(int i=0;i<4;++i){const int row=i*8+(lane>>3),ch=lane&7; const u32x4 v=*(const u32x4*)(stg+row*64+ch*8); ATTN_STORE16(Ow+(long)row*OP+ch*8,v);} }
  asm volatile("s_waitcnt lgkmcnt(0)\n\ts_barrier":::"memory");
  #undef DMA_K
  #undef QX
  #undef RNEHI
  #undef SETQX
  #undef DMA_V
  #undef CMASK
  #undef START
  #undef RESC
  #undef ROT
}
constexpr int ATTN_LDS_BYTES=LDS_BYTES;
struct AttnTensors { const bf16* Q; const bf16* K; const bf16* V; bf16* O; const float* CUM; };
struct AttnUnit { int bh; int qb; };
struct StaticOrder {
  int c,G;
  __device__ __forceinline__ StaticOrder(int grid,int block):c(block),G(grid){}
  __device__ __forceinline__ bool next(int i,AttnUnit&u)const{ const int it=i*G+c; if(it>=BATCH*NHEAD*NQB)return false; u.bh=it%(BATCH*NHEAD); u.qb=NQB-1-it/(BATCH*NHEAD); return true; }
};
template<class Sched,int THRL=8> __device__ __forceinline__ void attn_phase(char*lds,const AttnTensors&T,const Sched&S,const int wv){
  AttnUnit u;
  for(int i=0;S.next(i,u);++i){ attn_unit<THRL>(u.bh/NHEAD,u.bh%NHEAD,u.qb,T.Q,T.K,T.V,T.O,T.CUM+(size_t)u.bh*SEQ,lds,wv); }
}
#undef SBAR
#undef WAIT_BAR
}

namespace mls {
typedef short bf16x8 __attribute__((ext_vector_type(8)));
typedef float f32x4v __attribute__((ext_vector_type(4)));
typedef unsigned u32x2v __attribute__((ext_vector_type(2)));
typedef unsigned u32x4v __attribute__((ext_vector_type(4)));
constexpr int QS = 136, TS = 72;
constexpr int L_Q = 0, L_K = 17408, L_KT = 34816, L_VT = 53248, L_WVT = 73984, L_SC = 94720, L_END = 103936;
constexpr float QK_SCALE = 0.08838834764831845f;
constexpr size_t G_A = 2 * MiB, G_RT = 3 * MiB, G_IT = 4 * MiB, G_EM = 5 * MiB, G_WK = 6 * MiB, G_CD = 7 * MiB, G_DL = 8 * MiB, G_UN = 9 * MiB, G_HALO = 11 * MiB;
__device__ __forceinline__ float scan_add(float v, int lane) {
#pragma unroll
    for (int o = 1; o < 64; o <<= 1) { const float t = bperm(v, (lane - o) & 63); if (lane >= o) v += t; }
    return v; }
__device__ __forceinline__ float scan_max(float v, int lane) {
#pragma unroll
    for (int o = 1; o < 64; o <<= 1) { const float t = bperm(v, (lane - o) & 63); if (lane >= o) v = fmaxf(v, t); }
    return v; }
__device__ __forceinline__ float lo_bf(unsigned w) { return __builtin_bit_cast(float, w << 16); }
__device__ __forceinline__ float hi_bf(unsigned w) { return __builtin_bit_cast(float, w & 0xffff0000u); }
typedef float f32x2_t __attribute__((ext_vector_type(2))); typedef __bf16 bf16x2_t __attribute__((ext_vector_type(2)));
__device__ __forceinline__ unsigned cvtpk(float lo, float hi) { f32x2_t v = {lo, hi}; bf16x2_t b = __builtin_convertvector(v, bf16x2_t); return __builtin_bit_cast(unsigned, b); }
__device__ __forceinline__ float fsilu(float v) { return v * __builtin_amdgcn_rcpf(1.f + __builtin_amdgcn_exp2f(-1.4426950408889634f * v)); }
}
__device__ __forceinline__ void phase_mgates(Frame& F, const float* SG) {
    using namespace mls;
    const int ptid = opaque_tid(F.wave), plane = ptid & 63, pwave = __builtin_amdgcn_readfirstlane(ptid >> 6);
    const int gw = blockIdx.x * NWAVES + pwave, NGW = F.G * NWAVES;
    float* GA = (float*)(F.ws + G_A); float* GPM = (float*)(F.ws + G_RT); float* GB = (float*)(F.ws + G_IT); float* GP63 = (float*)(F.ws + G_WK); float* GG = GP63 + BATCH * MLH * 32;
    for (int task = gw; task < BATCH * MLH * 32; task += NGW) {
        const int bh = task >> 5, c = task & 31, b = bh >> 2, h = bh & 3;
        const size_t row = (size_t)b * SEQ + 64 * c + plane;
        const float ig = SG[row * 16 + 8 + h], lf = SG[row * 16 + 12 + h];
        const float bcum = scan_add(lf, plane), aval = ig - bcum, pm = scan_max(aval, plane);
        const size_t idx = (size_t)bh * SEQ + 64 * c + plane;
        GA[idx] = aval; GPM[idx] = pm; GB[idx] = bcum;
        if (plane == 63) { GP63[task] = pm; GG[task] = bcum; }
    }
}
__device__ __forceinline__ void phase_mprep(Frame& F, const bf16* PA, const float* convw, const float* convb, bf16* SCR) {
    using namespace mls;
    const int tid = opaque_tid(F.wave), lane = tid & 63, wid = __builtin_amdgcn_readfirstlane(tid >> 6), l15 = lane & 15, q4 = lane >> 4;
    LAS unsigned char* L = F.lds;
    const float* GA = (const float*)(F.ws + G_A); const float* GPM = (const float*)(F.ws + G_RT); const float* GB = (const float*)(F.ws + G_IT); const float* GP63 = (const float*)(F.ws + G_WK); const float* GG = GP63 + BATCH * MLH * 32;
    float* GEM = (float*)(F.ws + G_EM); float* GCD = (float*)(F.ws + G_CD);
    float* DL = (float*)(F.ws + G_DL); float* UN = (float*)(F.ws + G_UN);
    const int ch2 = tid & 127, tq = __builtin_amdgcn_readfirstlane(tid >> 7); const bool isk = (wid & 1) != 0;
    const int cc = (ch2 & 63) * 2;
    const int e2 = tid & 63, sg = __builtin_amdgcn_readfirstlane(tid >> 6);
    const __amdgpu_buffer_rsrc_t rsP = __builtin_amdgcn_make_buffer_rsrc((void*)PA, 0, M * PJA * 2, 0x00020000), rsS = __builtin_amdgcn_make_buffer_rsrc((void*)SCR, 0, M * D * 4, 0x00020000);
    constexpr int S_QI = 0, S_UT = M * 512 * 2, S_NL = M * 1536 * 2;
    __syncthreads();
    for (int i = tid; i < 16 * TS / 2; i += NTHR) { ((LAS unsigned*)(L + L_VT + 128 * TS * 2))[i] = (i < TS / 2) ? 0x3F803F80u : 0u; ((LAS unsigned*)(L + L_WVT + 128 * TS * 2))[i] = 0u; }
    unsigned raw[19], vraw[8]; float g_pm, g_b, g_a, g_p63, g_g;
#define MP_BAR() asm volatile("s_waitcnt lgkmcnt(0)\n\ts_barrier" ::: "memory")
#define MP_LOAD(item) do { const int bh_ = (item) >> 5, c_ = (item) & 31, b_ = bh_ >> 2, h_ = bh_ & 3; const int r0_ = b_ * SEQ + 64 * c_; \
        const unsigned lo_raw_ = (unsigned)((isk ? PC_MK : PC_MQ) + h_ * 128 + cc) * 2u, lo_v_ = (unsigned)(PC_MV + h_ * 128 + 2 * e2) * 2u; \
        _Pragma("unroll") for (int i_ = 0; i_ < 19; ++i_) { const int tr_ = 16 * tq - 3 + i_; raw[i_] = (64 * c_ + tr_ >= 0) ? __builtin_amdgcn_raw_buffer_load_b32(rsP, lo_raw_, (r0_ + tr_) * (PJA * 2), 0) : 0u; } \
        _Pragma("unroll") for (int i_ = 0; i_ < 8; ++i_) vraw[i_] = __builtin_amdgcn_raw_buffer_load_b32(rsP, lo_v_, (r0_ + 8 * sg + i_) * (PJA * 2), 0); \
        const size_t gi_ = (size_t)bh_ * SEQ + 64 * c_ + lane; g_pm = GPM[gi_]; g_b = GB[gi_]; g_a = GA[gi_]; g_p63 = GP63[bh_ * 32 + (lane & 31)]; g_g = GG[bh_ * 32 + (lane & 31)]; } while (0)
    int it = blockIdx.x;
    if (it < BATCH * MLH * 32) MP_LOAD(it);
    for (; it < BATCH * MLH * 32; it += F.G) {
        const int bh = it >> 5, c = it & 31, b = bh >> 2, h = bh & 3; const int row0 = b * SEQ + 64 * c;
        const int cch = (isk ? 512 : 0) + h * 128 + cc;
        float w0[2], w1[2], w2[2], w3[2], cb[2];
#pragma unroll
        for (int i = 0; i < 2; ++i) { w0[i] = convw[cch + i]; w1[i] = convw[1024 + cch + i]; w2[i] = convw[2048 + cch + i]; w3[i] = convw[3072 + cch + i]; cb[i] = convb[cch + i]; }
        float mcar = 0.f;
        for (int cp = 0; cp < c; ++cp) mcar = rdl(g_g, cp) + fmaxf(mcar, rdl(g_p63, cp));
        const float Mx = fmaxf(mcar, rdl(g_p63, c)), mrow = fmaxf(g_pm, mcar);
        const float rowterm = -mrow, inter = __expf(mcar - mrow), aval = g_a, wk = __expf(g_a - Mx);
        if (wid == 0) { GEM[(size_t)bh * SEQ + 64 * c + lane] = __expf(-(g_b + mrow)); if (lane == 0) GCD[bh * 32 + c] = __expf(mcar - Mx); }
        {
            unsigned kt0[8], kt1[8];
#pragma unroll
            for (int i = 0; i < 16; i += 2) {
                float y[2][2];
#pragma unroll
                for (int u = 0; u < 2; ++u) {
                    const float a0 = w0[0] * lo_bf(raw[i + u]) + w1[0] * lo_bf(raw[i + u + 1]) + w2[0] * lo_bf(raw[i + u + 2]) + w3[0] * lo_bf(raw[i + u + 3]) + cb[0];
                    const float a1 = w0[1] * hi_bf(raw[i + u]) + w1[1] * hi_bf(raw[i + u + 1]) + w2[1] * hi_bf(raw[i + u + 2]) + w3[1] * hi_bf(raw[i + u + 3]) + cb[1];
                    y[u][0] = fsilu(a0); y[u][1] = fsilu(a1);
                    const int t = 16 * tq + i + u;
                    if (!isk) { const float q0 = y[u][0] * QK_SCALE, q1 = y[u][1] * QK_SCALE; const float itv = rdl(inter, t);
                        *(LAS unsigned*)(L + L_Q + (t * QS + cc) * 2) = cvtpk(q0, q1);
                        __builtin_amdgcn_raw_buffer_store_b32(cvtpk(q0 * itv, q1 * itv), rsS, (unsigned)((cc >> 5) * 1024 + ((cc >> 3) & 3) * 256 + (cc & 7) * 2), S_QI + (it * 4 + (t >> 4)) * 4096 + (t & 15) * 16, 0); }
                    else *(LAS unsigned*)(L + L_K + (t * QS + cc) * 2) = cvtpk(y[u][0], y[u][1]);
                }
                kt0[i >> 1] = cvtpk(y[0][0], y[1][0]); kt1[i >> 1] = cvtpk(y[0][1], y[1][1]);
            }
            if (isk) {
                *(LAS u32x4v*)(L + L_KT + (cc * TS + 16 * tq) * 2) = (u32x4v){kt0[0], kt0[1], kt0[2], kt0[3]}; *(LAS u32x4v*)(L + L_KT + (cc * TS + 16 * tq + 8) * 2) = (u32x4v){kt0[4], kt0[5], kt0[6], kt0[7]};
                *(LAS u32x4v*)(L + L_KT + ((cc + 1) * TS + 16 * tq) * 2) = (u32x4v){kt1[0], kt1[1], kt1[2], kt1[3]}; *(LAS u32x4v*)(L + L_KT + ((cc + 1) * TS + 16 * tq + 8) * 2) = (u32x4v){kt1[4], kt1[5], kt1[6], kt1[7]};
            }
            float v0[8], v1[8], wv[8];
#pragma unroll
            for (int i = 0; i < 8; ++i) { v0[i] = lo_bf(vraw[i]); v1[i] = hi_bf(vraw[i]); wv[i] = rdl(wk, 8 * sg + i); }
            *(LAS u32x4v*)(L + L_VT + ((2 * e2) * TS + 8 * sg) * 2) = (u32x4v){cvtpk(v0[0], v0[1]), cvtpk(v0[2], v0[3]), cvtpk(v0[4], v0[5]), cvtpk(v0[6], v0[7])};
            *(LAS u32x4v*)(L + L_VT + ((2 * e2 + 1) * TS + 8 * sg) * 2) = (u32x4v){cvtpk(v1[0], v1[1]), cvtpk(v1[2], v1[3]), cvtpk(v1[4], v1[5]), cvtpk(v1[6], v1[7])};
            *(LAS u32x4v*)(L + L_WVT + ((2 * e2) * TS + 8 * sg) * 2) = (u32x4v){cvtpk(v0[0] * wv[0], v0[1] * wv[1]), cvtpk(v0[2] * wv[2], v0[3] * wv[3]), cvtpk(v0[4] * wv[4], v0[5] * wv[5]), cvtpk(v0[6] * wv[6], v0[7] * wv[7])};
            *(LAS u32x4v*)(L + L_WVT + ((2 * e2 + 1) * TS + 8 * sg) * 2) = (u32x4v){cvtpk(v1[0] * wv[0], v1[1] * wv[1]), cvtpk(v1[2] * wv[2], v1[3] * wv[3]), cvtpk(v1[4] * wv[4], v1[5] * wv[5]), cvtpk(v1[6] * wv[6], v1[7] * wv[7])};
            if (wid == 0) *(LAS unsigned short*)(L + L_WVT + (128 * TS + lane) * 2) = (unsigned short)f2bf(wk);
        }
        if (it + F.G < BATCH * MLH * 32) MP_LOAD(it + F.G);
        MP_BAR();
        {
            const int tt = wid >> 1;
#pragma unroll
            for (int si = 0; si < 2; ++si) {
                const int ss = 2 * (wid & 1) + si;
                f32x4v acc = (f32x4v){0.f, 0.f, 0.f, 0.f};
                if (ss <= tt) {
#pragma unroll
                    for (int kd = 0; kd < 4; ++kd) {
                        const bf16x8 a = *(const LAS bf16x8*)(L + L_Q + ((16 * tt + l15) * QS + 32 * kd + 8 * q4) * 2);
                        const bf16x8 bb = *(const LAS bf16x8*)(L + L_K + ((16 * ss + l15) * QS + 32 * kd + 8 * q4) * 2);
                        acc = __builtin_amdgcn_mfma_f32_16x16x32_bf16(a, bb, acc, 0, 0, 0);
                    }
                }
                const int s = 16 * ss + l15; const float as_ = bperm(aval, s);
#pragma unroll
                for (int j = 0; j < 4; ++j) { const int t = 16 * tt + 4 * q4 + j; const float rt = bperm(rowterm, t);
                    const float dv = (s <= t) ? acc[j] * __expf(rt + as_) : 0.f;
                    *(LAS unsigned short*)(L + L_SC + (t * TS + s) * 2) = (unsigned short)f2bf(dv); }
            }
        }
        {
            const int db = wid;
#pragma unroll
            for (int eg = 0; eg < 9; ++eg) {
                f32x4v acc = (f32x4v){0.f, 0.f, 0.f, 0.f};
#pragma unroll
                for (int ks = 0; ks < 2; ++ks) {
                    const bf16x8 a = *(const LAS bf16x8*)(L + L_KT + ((16 * db + l15) * TS + 32 * ks + 8 * q4) * 2);
                    const bf16x8 bb = *(const LAS bf16x8*)(L + L_WVT + ((16 * eg + l15) * TS + 32 * ks + 8 * q4) * 2);
                    acc = __builtin_amdgcn_mfma_f32_16x16x32_bf16(a, bb, acc, 0, 0, 0);
                }
                if (eg < 8) { const int e = 16 * eg + l15;
                    __builtin_amdgcn_raw_buffer_store_b64((u32x2v){cvtpk(acc[0], acc[1]), cvtpk(acc[2], acc[3])}, rsS, (unsigned)((((q4 >> 1) * 16 + l15) * 16) + 8 * (q4 & 1)), S_UT + ((it * 8 + eg) * 4 + (db >> 1)) * 1024 + ((2 * db) & 3) * 256, 0); (void)e; }
                else if (l15 == 0) *(u32x2v*)((char*)UN + ((size_t)(it * 4 + (db >> 1)) * 4 + (((2 * db) & 3) + (q4 >> 1))) * 16 + 8 * (q4 & 1)) = (u32x2v){cvtpk(acc[0], acc[1]), cvtpk(acc[2], acc[3])};
            }
        }
        MP_BAR();
        for (int p = wid; p < 36; p += NWAVES) {
            const int tt = p & 3, eg = p >> 2;
            f32x4v acc = (f32x4v){0.f, 0.f, 0.f, 0.f};
#pragma unroll
            for (int ks = 0; ks < 2; ++ks) {
                const bf16x8 a = *(const LAS bf16x8*)(L + L_VT + ((16 * eg + l15) * TS + 32 * ks + 8 * q4) * 2);
                const bf16x8 bb = *(const LAS bf16x8*)(L + L_SC + ((16 * tt + l15) * TS + 32 * ks + 8 * q4) * 2);
                acc = __builtin_amdgcn_mfma_f32_16x16x32_bf16(a, bb, acc, 0, 0, 0);
            }
            if (eg < 8) __builtin_amdgcn_raw_buffer_store_b64((u32x2v){cvtpk(acc[0], acc[1]), cvtpk(acc[2], acc[3])}, rsS, (unsigned)lane * 8u, S_NL + ((it * 8 + eg) * 4 + tt) * 512, 0);
            else if (q4 == 0) DL[(size_t)(row0 + 16 * tt + l15) * 4 + h] = acc[0];
        }
        MP_BAR();
    }
#undef MP_LOAD
#undef MP_BAR
}
__device__ __forceinline__ void phase_mchain(Frame& F, const bf16* SCR, const bf16* PB, bf16* AO) {
    using namespace mls;
    const int tid = opaque_tid(F.wave), lane = tid & 63, wid = __builtin_amdgcn_readfirstlane(tid >> 6), l15 = lane & 15, q4 = lane >> 4;
    const float* GEM = (const float*)(F.ws + G_EM); const float* GCD = (const float*)(F.ws + G_CD); const float* DL = (const float*)(F.ws + G_DL); const float* UN = (const float*)(F.ws + G_UN);
    constexpr int S_QI = 0, S_UT = M * 512 * 2, S_NL = M * 1536 * 2;
    const __amdgpu_buffer_rsrc_t rsP = __builtin_amdgcn_make_buffer_rsrc((void*)SCR, 0, M * D * 4, 0x00020000), rsB = __builtin_amdgcn_make_buffer_rsrc((void*)PB, 0, M * PJB * 2, 0x00020000),
                                 rsO = __builtin_amdgcn_make_buffer_rsrc((void*)AO, 0, M * D * 2, 0x00020000), rsE = __builtin_amdgcn_make_buffer_rsrc((void*)GEM, 0, BATCH * MLH * SEQ * 4, 0x00020000),
                                 rsD = __builtin_amdgcn_make_buffer_rsrc((void*)DL, 0, M * 16, 0x00020000), rsU = __builtin_amdgcn_make_buffer_rsrc((void*)UN, 0, BATCH * MLH * 32 * 128 * 2, 0x00020000);
    const unsigned lo_o = (unsigned)(l15 * D + 4 * q4) * 2u, lo_m = (unsigned)(l15 * PJB + 4 * q4) * 2u, lo_d = (unsigned)l15 * 16u, lo_e = (unsigned)l15 * 4u;
    const int th = wid >> 2;
    for (int id = blockIdx.x * 4 + (wid & 3); id < BATCH * MLH * 8; id += F.G * 4) {
        const int bh = id >> 3, eg = id & 7, b = bh >> 2, h = bh & 3;
        const int r00 = b * SEQ;
        float Cst[4][8], nst[4][8];
#pragma unroll
        for (int kd = 0; kd < 4; ++kd)
#pragma unroll
            for (int j = 0; j < 8; ++j) { Cst[kd][j] = 0.f; nst[kd][j] = 0.f; }
        u32x4v qfA[2][4], qfB[2][4], ut[4], un[4]; u32x2v nlA[2], moA[2], nlB[2], moB[2]; float dlA[2], emA[2], dlB[2], emB[2], cd;
#define MC_LOADQ(c, qf) do { const int it_ = bh * 32 + (c); \
            _Pragma("unroll") for (int t2_ = 0; t2_ < 2; ++t2_) \
                _Pragma("unroll") for (int kd_ = 0; kd_ < 4; ++kd_) qf[t2_][kd_] = __builtin_amdgcn_raw_buffer_load_b128(rsP, (unsigned)lane * 16u, S_QI + ((it_ * 4 + 2 * th + t2_) * 4 + kd_) * 1024, 0); } while (0)
#define MC_LOADS(c, nl, mo, dl, em) do { const int r0_ = r00 + 64 * (c), it_ = bh * 32 + (c); \
            _Pragma("unroll") for (int t2_ = 0; t2_ < 2; ++t2_) { const int rt_ = r0_ + 16 * (2 * th + t2_); \
                nl[t2_] = __builtin_amdgcn_raw_buffer_load_b64(rsP, (unsigned)lane * 8u, S_NL + ((it_ * 8 + eg) * 4 + 2 * th + t2_) * 512, 0); mo[t2_] = __builtin_amdgcn_raw_buffer_load_b64(rsB, lo_m, (rt_ * PJB + PB_MO + h * 128 + 16 * eg) * 2, 0); \
                dl[t2_] = __builtin_bit_cast(float, __builtin_amdgcn_raw_buffer_load_b32(rsD, lo_d, (rt_ * 4 + h) * 4, 0)); em[t2_] = __builtin_bit_cast(float, __builtin_amdgcn_raw_buffer_load_b32(rsE, lo_e, (bh * SEQ + 64 * (c) + 16 * (2 * th + t2_)) * 4, 0)); } } while (0)
#define MC_LOADU(c) do { const int it_ = bh * 32 + (c); \
            _Pragma("unroll") for (int kd_ = 0; kd_ < 4; ++kd_) { ut[kd_] = __builtin_amdgcn_raw_buffer_load_b128(rsP, (unsigned)lane * 16u, S_UT + ((it_ * 8 + eg) * 4 + kd_) * 1024, 0); \
                un[kd_] = __builtin_amdgcn_raw_buffer_load_b128(rsU, (unsigned)q4 * 16u, (it_ * 4 + kd_) * 64, 0); } \
            cd = GCD[it_]; } while (0)
#define MC_STEP(c, qf, nl, mo, dl, em, qfN, nlN, moN, dlN, emN) do { const int r0_ = r00 + 64 * (c); \
            if ((c) + 1 < SEQ / 64) { MC_LOADQ((c) + 1, qfN); MC_LOADS((c) + 1, nlN, moN, dlN, emN); } \
            f32x4v acc_[2], accd_[2]; \
            _Pragma("unroll") for (int t2_ = 0; t2_ < 2; ++t2_) { acc_[t2_] = (f32x4v){lo_bf(nl[t2_].x), hi_bf(nl[t2_].x), lo_bf(nl[t2_].y), hi_bf(nl[t2_].y)}; accd_[t2_] = (f32x4v){q4 == 0 ? dl[t2_] : 0.f, 0.f, 0.f, 0.f}; } \
            _Pragma("unroll") for (int kd_ = 0; kd_ < 4; ++kd_) { \
                const bf16x8 af_ = __builtin_bit_cast(bf16x8, (u32x4v){cvtpk(Cst[kd_][0], Cst[kd_][1]), cvtpk(Cst[kd_][2], Cst[kd_][3]), cvtpk(Cst[kd_][4], Cst[kd_][5]), cvtpk(Cst[kd_][6], Cst[kd_][7])}); \
                const bf16x8 nf_ = __builtin_bit_cast(bf16x8, (u32x4v){cvtpk(nst[kd_][0], nst[kd_][1]), cvtpk(nst[kd_][2], nst[kd_][3]), cvtpk(nst[kd_][4], nst[kd_][5]), cvtpk(nst[kd_][6], nst[kd_][7])}); \
                _Pragma("unroll") for (int t2_ = 0; t2_ < 2; ++t2_) { acc_[t2_] = __builtin_amdgcn_mfma_f32_16x16x32_bf16(af_, __builtin_bit_cast(bf16x8, qf[t2_][kd_]), acc_[t2_], 0, 0, 0); \
                    accd_[t2_] = __builtin_amdgcn_mfma_f32_16x16x32_bf16(nf_, __builtin_bit_cast(bf16x8, qf[t2_][kd_]), accd_[t2_], 0, 0, 0); } } \
            _Pragma("unroll") for (int t2_ = 0; t2_ < 2; ++t2_) { \
                const float den_ = bperm(accd_[t2_][0], l15); const float rd_ = 1.0f / fmaxf(fabsf(den_), em[t2_]); \
                const float o0_ = acc_[t2_][0] * rd_ * lo_bf(mo[t2_].x), o1_ = acc_[t2_][1] * rd_ * hi_bf(mo[t2_].x), o2_ = acc_[t2_][2] * rd_ * lo_bf(mo[t2_].y), o3_ = acc_[t2_][3] * rd_ * hi_bf(mo[t2_].y); \
                __builtin_amdgcn_raw_buffer_store_b64((u32x2v){cvtpk(o0_, o1_), cvtpk(o2_, o3_)}, rsO, lo_o, ((r0_ + 16 * (2 * th + t2_)) * D + 512 + h * 128 + 16 * eg) * 2, 0); } \
            _Pragma("unroll") for (int kd_ = 0; kd_ < 4; ++kd_) { const unsigned uw_[4] = {ut[kd_].x, ut[kd_].y, ut[kd_].z, ut[kd_].w}; const unsigned nw_[4] = {un[kd_].x, un[kd_].y, un[kd_].z, un[kd_].w}; \
                _Pragma("unroll") for (int j_ = 0; j_ < 4; ++j_) { Cst[kd_][2 * j_] = cd * Cst[kd_][2 * j_] + lo_bf(uw_[j_]); Cst[kd_][2 * j_ + 1] = cd * Cst[kd_][2 * j_ + 1] + hi_bf(uw_[j_]); \
                    nst[kd_][2 * j_] = (l15 == 0) ? cd * nst[kd_][2 * j_] + lo_bf(nw_[j_]) : 0.f; nst[kd_][2 * j_ + 1] = (l15 == 0) ? cd * nst[kd_][2 * j_ + 1] + hi_bf(nw_[j_]) : 0.f; } } \
            if ((c) + 1 < SEQ / 64) MC_LOADU((c) + 1); } while (0)
        MC_LOADQ(0, qfA); MC_LOADS(0, nlA, moA, dlA, emA); MC_LOADU(0);
        for (int c = 0; c < SEQ / 64; c += 2) {
            MC_STEP(c, qfA, nlA, moA, dlA, emA, qfB, nlB, moB, dlB, emB);
            MC_STEP(c + 1, qfB, nlB, moB, dlB, emB, qfA, nlA, moA, dlA, emA);
        }
#undef MC_LOADQ
#undef MC_LOADS
#undef MC_LOADU
#undef MC_STEP
    }
}

__device__ __forceinline__ void phase_mlstm_fused(Frame& F, const bf16* P, const bf16* PBg, const float* SG, const float* convw, const float* convb, bf16* AO) {
    using namespace mls;
    constexpr int L_Q = 0, L_QI = 17408, L_K = 34816, L_KT = 52224, L_VT = 70656, L_WVT = 82176, L_SC = 93696, L_CT = 102912, L_DEN = 124672;
    const float* GA = (const float*)(F.ws + G_A); const float* GPM = (const float*)(F.ws + G_RT); const float* GB = (const float*)(F.ws + G_IT); const float* GP63 = (const float*)(F.ws + G_WK); const float* GG = GP63 + BATCH * MLH * 32;
#define ML_BAR() asm volatile("s_waitcnt lgkmcnt(0)\n\ts_barrier" ::: "memory")
    const int tid = opaque_tid(F.wave), lane = tid & 63, wid = __builtin_amdgcn_readfirstlane(tid >> 6), l15 = lane & 15, q4 = lane >> 4;
    LAS unsigned char* L = F.lds;
    for (int it = blockIdx.x; it < BATCH * MLH * 2; it += F.G) {
        const int vh = it & 1, bh = it >> 1, b = bh / MLH, h = bh % MLH;
        const size_t row00 = (size_t)b * SEQ;
        const int ch2 = tid & 127, tq = __builtin_amdgcn_readfirstlane(tid >> 7); const bool isk = (wid & 1) != 0;
        const int cc = (ch2 & 63) * 2;
        const int pcol = (isk ? PC_MK : PC_MQ) + h * 128 + cc, cch = (isk ? 512 : 0) + h * 128 + cc;
        float w0[2], w1[2], w2[2], w3[2], cb[2];
#pragma unroll
        for (int i = 0; i < 2; ++i) { w0[i] = convw[cch + i]; w1[i] = convw[1024 + cch + i]; w2[i] = convw[2048 + cch + i]; w3[i] = convw[3072 + cch + i]; cb[i] = convb[cch + i]; }
        const int e2 = tid & 31, sg = tid >> 5;
        const int vcol = PC_MV + h * 128 + vh * 64 + 2 * e2;
        f32x4v Cacc[8];
#pragma unroll
        for (int i = 0; i < 8; ++i) Cacc[i] = (f32x4v){0.f, 0.f, 0.f, 0.f};
        float mcar = 0.f;
        __syncthreads();
        for (int i = tid; i < 80 * QS / 2; i += NTHR) ((LAS unsigned*)(L + L_CT))[i] = 0u;
        for (int i = tid; i < 16 * TS / 2; i += NTHR) { ((LAS unsigned*)(L + L_VT + 64 * TS * 2))[i] = (i < TS / 2) ? 0x3F803F80u : 0u; ((LAS unsigned*)(L + L_WVT + 64 * TS * 2))[i] = 0u; }
        unsigned raw[19], vraw[4]; float g_a, g_pm, g_b, g_p63, g_g;
        const unsigned lo_raw = (unsigned)pcol * 2u, lo_v = (unsigned)((4 * sg) * PJA + vcol) * 2u, lo_o = (unsigned)((4 * q4) * PJB + l15) * 2u, lo_ao = (unsigned)((4 * q4) * D + l15) * 2u;
        const __amdgpu_buffer_rsrc_t rsP = __builtin_amdgcn_make_buffer_rsrc((void*)P, 0, M * PJA * 2, 0x00020000), rsB = __builtin_amdgcn_make_buffer_rsrc((void*)PBg, 0, M * PJB * 2, 0x00020000),
                                     rsO = __builtin_amdgcn_make_buffer_rsrc((void*)AO, 0, M * D * 2, 0x00020000);
        const int r00 = (int)row00;
#define MLS_LOAD(c) do { _Pragma("unroll") for (int i_ = 0; i_ < 19; ++i_) { const int tr_ = 64 * (c) + 16 * tq - 3 + i_; raw[i_] = (tr_ >= 0) ? __builtin_amdgcn_raw_buffer_load_b32(rsP, lo_raw, (r00 + tr_) * (PJA * 2), 0) : 0u; } \
        _Pragma("unroll") for (int i_ = 0; i_ < 4; ++i_) vraw[i_] = __builtin_amdgcn_raw_buffer_load_b32(rsP, lo_v, (r00 + 64 * (c) + i_) * (PJA * 2), 0); \
        { const size_t gi_ = (size_t)bh * SEQ + 64 * (c) + lane; g_a = GA[gi_]; g_pm = GPM[gi_]; g_b = GB[gi_]; g_p63 = GP63[bh * 32 + (c)]; g_g = GG[bh * 32 + (c)]; } } while (0)
        MLS_LOAD(0);
        for (int c = 0; c < SEQ / 64; ++c) {
            const size_t row0 = row00 + 64 * c;
            const float bcum = g_b, aval = g_a, pm = g_pm, pm63 = g_p63, gsum = g_g;
            const float Mx = fmaxf(mcar, pm63), mrow = fmaxf(pm, mcar);
            const float rowterm = -mrow, inter = __expf(mcar - mrow), emt = __expf(-(bcum + mrow)), wk = __expf(aval - Mx), cdec = __expf(mcar - Mx);
            mcar = gsum + Mx;
            {
                unsigned kt0[8], kt1[8];
#pragma unroll
                for (int i = 0; i < 16; i += 2) {
                    float y[2][2];
#pragma unroll
                    for (int u = 0; u < 2; ++u) {
                        float a0 = w0[0] * lo_bf(raw[i + u]) + w1[0] * lo_bf(raw[i + u + 1]) + w2[0] * lo_bf(raw[i + u + 2]) + w3[0] * lo_bf(raw[i + u + 3]) + cb[0];
                        float a1 = w0[1] * hi_bf(raw[i + u]) + w1[1] * hi_bf(raw[i + u + 1]) + w2[1] * hi_bf(raw[i + u + 2]) + w3[1] * hi_bf(raw[i + u + 3]) + cb[1];
                        y[u][0] = fsilu(a0); y[u][1] = fsilu(a1);
                        const int t = 16 * tq + i + u;
                        if (!isk) { const float q0 = y[u][0] * QK_SCALE, q1 = y[u][1] * QK_SCALE; const float itv = rdl(inter, t);
                            *(LAS unsigned*)(L + L_Q + (t * QS + cc) * 2) = cvtpk(q0, q1); *(LAS unsigned*)(L + L_QI + (t * QS + cc) * 2) = cvtpk(q0 * itv, q1 * itv); }
                        else *(LAS unsigned*)(L + L_K + (t * QS + cc) * 2) = cvtpk(y[u][0], y[u][1]);
                    }
                    kt0[i >> 1] = cvtpk(y[0][0], y[1][0]); kt1[i >> 1] = cvtpk(y[0][1], y[1][1]);
                }
                if (isk) {
                    *(LAS u32x4v*)(L + L_KT + (cc * TS + 16 * tq) * 2) = (u32x4v){kt0[0], kt0[1], kt0[2], kt0[3]}; *(LAS u32x4v*)(L + L_KT + (cc * TS + 16 * tq + 8) * 2) = (u32x4v){kt0[4], kt0[5], kt0[6], kt0[7]};
                    *(LAS u32x4v*)(L + L_KT + ((cc + 1) * TS + 16 * tq) * 2) = (u32x4v){kt1[0], kt1[1], kt1[2], kt1[3]}; *(LAS u32x4v*)(L + L_KT + ((cc + 1) * TS + 16 * tq + 8) * 2) = (u32x4v){kt1[4], kt1[5], kt1[6], kt1[7]};
                }
            }
            {
                float v0[4], v1[4], wv[4];
#pragma unroll
                for (int i = 0; i < 4; ++i) { v0[i] = lo_bf(vraw[i]); v1[i] = hi_bf(vraw[i]); wv[i] = bperm(wk, 4 * sg + i); }
                *(LAS u32x2v*)(L + L_VT + ((2 * e2) * TS + 4 * sg) * 2) = (u32x2v){cvtpk(v0[0], v0[1]), cvtpk(v0[2], v0[3])};
                *(LAS u32x2v*)(L + L_VT + ((2 * e2 + 1) * TS + 4 * sg) * 2) = (u32x2v){cvtpk(v1[0], v1[1]), cvtpk(v1[2], v1[3])};
                *(LAS u32x2v*)(L + L_WVT + ((2 * e2) * TS + 4 * sg) * 2) = (u32x2v){cvtpk(v0[0] * wv[0], v0[1] * wv[1]), cvtpk(v0[2] * wv[2], v0[3] * wv[3])};
                *(LAS u32x2v*)(L + L_WVT + ((2 * e2 + 1) * TS + 4 * sg) * 2) = (u32x2v){cvtpk(v1[0] * wv[0], v1[1] * wv[1]), cvtpk(v1[2] * wv[2], v1[3] * wv[3])};
                if (wid == 0) *(LAS unsigned short*)(L + L_WVT + (64 * TS + lane) * 2) = (unsigned short)f2bf(wk);
            }
            if (c + 1 < SEQ / 64) MLS_LOAD(c + 1);
            ML_BAR();
            {
                const int tt = wid >> 1;
#pragma unroll
                for (int si = 0; si < 2; ++si) {
                    const int ss = 2 * (wid & 1) + si;
                    f32x4v acc = (f32x4v){0.f, 0.f, 0.f, 0.f};
                    if (ss <= tt) {
#pragma unroll
                        for (int kd = 0; kd < 4; ++kd) {
                            const bf16x8 a = *(const LAS bf16x8*)(L + L_Q + ((16 * tt + l15) * QS + 32 * kd + 8 * q4) * 2);
                            const bf16x8 bb = *(const LAS bf16x8*)(L + L_K + ((16 * ss + l15) * QS + 32 * kd + 8 * q4) * 2);
                            acc = __builtin_amdgcn_mfma_f32_16x16x32_bf16(a, bb, acc, 0, 0, 0);
                        }
                    }
                    const int s = 16 * ss + l15; const float as_ = bperm(aval, s);
#pragma unroll
                    for (int j = 0; j < 4; ++j) { const int t = 16 * tt + 4 * q4 + j; const float rt = bperm(rowterm, t);
                        const float dv = (s <= t) ? acc[j] * __expf(rt + as_) : 0.f;
                        *(LAS unsigned short*)(L + L_SC + (t * TS + s) * 2) = (unsigned short)f2bf(dv); }
                }
            }
            unsigned short mog[16];
            if (wid < 4) {
#pragma unroll
                for (int tt = 0; tt < 4; ++tt)
#pragma unroll
                    for (int j = 0; j < 4; ++j) mog[tt * 4 + j] = __builtin_amdgcn_raw_buffer_load_b16(rsB, lo_o, (((int)row0 + 16 * tt + j) * PJB + PB_MO + h * 128 + vh * 64 + 16 * wid) * 2, 0);
            }
            ML_BAR();
            f32x4v acc[4];
            if (wid < 5) {
                const int eg = wid;
#pragma unroll
                for (int tt = 0; tt < 4; ++tt) {
                    acc[tt] = (f32x4v){0.f, 0.f, 0.f, 0.f};
#pragma unroll
                    for (int ks = 0; ks < 2; ++ks) {
                        const bf16x8 a = *(const LAS bf16x8*)(L + L_SC + ((16 * tt + l15) * TS + 32 * ks + 8 * q4) * 2);
                        const bf16x8 bb = *(const LAS bf16x8*)(L + L_VT + ((16 * eg + l15) * TS + 32 * ks + 8 * q4) * 2);
                        acc[tt] = __builtin_amdgcn_mfma_f32_16x16x32_bf16(a, bb, acc[tt], 0, 0, 0);
                    }
#pragma unroll
                    for (int kd = 0; kd < 4; ++kd) {
                        const bf16x8 a = *(const LAS bf16x8*)(L + L_QI + ((16 * tt + l15) * QS + 32 * kd + 8 * q4) * 2);
                        const bf16x8 bb = *(const LAS bf16x8*)(L + L_CT + ((16 * eg + l15) * QS + 32 * kd + 8 * q4) * 2);
                        acc[tt] = __builtin_amdgcn_mfma_f32_16x16x32_bf16(a, bb, acc[tt], 0, 0, 0);
                    }
                }
                asm volatile("s_waitcnt lgkmcnt(0)" ::: "memory");
#pragma unroll
                for (int db = 0; db < 8; ++db) {
                    Cacc[db] = Cacc[db] * cdec;
#pragma unroll
                    for (int ks = 0; ks < 2; ++ks) {
                        const bf16x8 a = *(const LAS bf16x8*)(L + L_KT + ((16 * db + l15) * TS + 32 * ks + 8 * q4) * 2);
                        const bf16x8 bb = *(const LAS bf16x8*)(L + L_WVT + ((16 * eg + l15) * TS + 32 * ks + 8 * q4) * 2);
                        Cacc[db] = __builtin_amdgcn_mfma_f32_16x16x32_bf16(a, bb, Cacc[db], 0, 0, 0);
                    }
                    *(LAS u32x2v*)(L + L_CT + ((16 * eg + l15) * QS + 16 * db + 4 * q4) * 2) = (u32x2v){cvtpk(Cacc[db][0], Cacc[db][1]), cvtpk(Cacc[db][2], Cacc[db][3])};
                }
                if (wid == 4 && l15 == 0) {
#pragma unroll
                    for (int tt = 0; tt < 4; ++tt) *(LAS f32x4v*)(L + L_DEN + (16 * tt + 4 * q4) * 4) = acc[tt];
                }
            }
            ML_BAR();
            if (wid < 4) {
#pragma unroll
                for (int tt = 0; tt < 4; ++tt) {
                    const f32x4v den = *(const LAS f32x4v*)(L + L_DEN + (16 * tt + 4 * q4) * 4);
#pragma unroll
                    for (int j = 0; j < 4; ++j) { const int t = 16 * tt + 4 * q4 + j; const float et = bperm(emt, t);
                        const float hv = acc[tt][j] / fmaxf(fabsf(den[j]), et);
                        __builtin_amdgcn_raw_buffer_store_b16((unsigned short)f2bf(hv * bf2f(mog[tt * 4 + j])), rsO, lo_ao, (((int)row0 + 16 * tt + j) * D + 512 + h * 128 + vh * 64 + 16 * wid) * 2, 0); }
                }
            }
        }
#undef MLS_LOAD
#undef ML_BAR
    }
}


__global__ void __launch_bounds__(NTHR, 2) fwd_kernel(Args args) {
    extern __shared__ __attribute__((aligned(16))) unsigned char lds[];
    Frame F;
    F.lds = (LAS unsigned char*)lds;
    F.MISC = (volatile LAS unsigned*)(F.lds + MISC_OFF);
    F.wave = __builtin_amdgcn_readfirstlane((int)threadIdx.x >> 6);
    F.G = gridDim.x;
    F.ws = args.ws; F.out = args.out;
#pragma unroll
    for (int i = 0; i < 18; ++i) F.in[i] = args.in[i];
    F.ctl = (gu32*)(F.ws + WS_CTL);
    for (int u = threadIdx.x; u < (LDS_BYTES - LDSCTL_OFF) / 4; u += NTHR) ((LAS unsigned*)(F.lds + LDSCTL_OFF))[u] = 0u;
    __syncthreads();
    XcdBarrier bar = xcd_barrier_post((unsigned*)(F.ctl + CW_BAR), F.MISC + 8, F.wave);
#define GRID_BAR() xcd_barrier(bar)

    const float* x = F.in[0];
    bf16* XB = (bf16*)(F.ws + WS_XB); bf16* AO = (bf16*)(F.ws + WS_AO); bf16* PA = (bf16*)(F.ws + WS_PA); bf16* PB = (bf16*)(F.ws + WS_PB);
    bf16* HB = PA; bf16* MG = PA;
    float* SG = (float*)(F.ws + WS_SG); float* CUM = (float*)(F.ws + WS_CUM); float* SS = (float*)(F.ws + WS_SS);
    float* out = F.out;
    const bf16* W1IN = (const bf16*)(F.ws + WS_W1IN); const bf16* W1OUT = (const bf16*)(F.ws + WS_W1OUT); const bf16* WIN = (const bf16*)(F.ws + WS_WIN);
    const bf16* WCAT = (const bf16*)(F.ws + WS_WCAT); const bf16* WOUT = (const bf16*)(F.ws + WS_WOUT); const bf16* W2IN = (const bf16*)(F.ws + WS_W2IN); const bf16* W2OUT = (const bf16*)(F.ws + WS_W2OUT);
#define STAGGER(step) do { if (STAG_ON) { const unsigned long long t0_ = __builtin_amdgcn_s_memrealtime(); const unsigned long long w_ = (unsigned long long)((blockIdx.x & 7u) * (unsigned)(step)); while (__builtin_amdgcn_s_memrealtime() - t0_ < w_) __builtin_amdgcn_s_sleep(8); } } while (0)
#define GEMM_PHASE(EpiT, gobj, eobj) do { pg8::StaticOrder S_; S_.init((gobj).M, (gobj).N, F.G, (int)blockIdx.x); pg8::gemm_phase<EpiT, pg8::StaticOrder, true, true>(F.lds, gobj, S_, eobj, F.wave); } while (0)
#define REP(b) ((REP_MASK >> (b)) & 1)

    phase_weights(F);
    phase_x_prep(F, x, XB, SS);
    GRID_BAR();
    STAGGER(430);
    { pg8::Gemm g{XB, W1IN, M, NFF, D, D, D}; pg8::EpiSwigluF E{HB, SS}; GEMM_PHASE(pg8::EpiSwigluF, g, E); if (REP(0)) GEMM_PHASE(pg8::EpiSwigluF, g, E); }
    GRID_BAR();
    { pg8::Gemm g{HB, W1OUT, M, D, DFF, DFF, DFF}; pg8::EpiResidB<false> E{XB, nullptr, SS, 0.5f}; GEMM_PHASE(pg8::EpiResidB<false>, g, E); }
    GRID_BAR();
    STAGGER(460);
    { pg8::Gemm g{XB, WIN, M, NPJ, D, D, D}; pg8::EpiProjF E{PA, PB, SG, SS, F.in[6], F.in[9], F.in[10]}; GEMM_PHASE(pg8::EpiProjF, g, E); if (REP(2)) GEMM_PHASE(pg8::EpiProjF, g, E); }
    GRID_BAR();
    phase_cumsum(F, SG, CUM);
    phase_mgates(F, SG);
    GRID_BAR();
    if (MLSTM_FUSED) { phase_mlstm_fused(F, PA, PB, SG, F.in[7], F.in[8], AO); if (REP(3)) phase_mlstm_fused(F, PA, PB, SG, F.in[7], F.in[8], AO); }
    else {
    phase_mprep(F, PA, F.in[7], F.in[8], (bf16*)out);
    if (REP(3)) phase_mprep(F, PA, F.in[7], F.in[8], (bf16*)out);
    GRID_BAR();
    phase_mchain(F, (const bf16*)out, PB, AO);
    if (REP(7)) phase_mchain(F, (const bf16*)out, PB, AO);
    }
    { const attn_body::AttnTensors AT{(const attn_body::bf16*)(PA + PC_FQ), (const attn_body::bf16*)(PA + PC_FK), (const attn_body::bf16*)(PA + PC_FV), (attn_body::bf16*)AO, CUM};
      const attn_body::StaticOrder SA((int)F.G, (int)blockIdx.x); attn_body::attn_phase<attn_body::StaticOrder>((char*)lds, AT, SA, F.wave);
      if (REP(4)) attn_body::attn_phase<attn_body::StaticOrder>((char*)lds, AT, SA, F.wave); }
    GRID_BAR();
    { pg8::Gemm g{AO, WCAT, M, D, D, D, D}; pg8::EpiMergeF E{PB, MG}; GEMM_PHASE(pg8::EpiMergeF, g, E); if (REP(5)) GEMM_PHASE(pg8::EpiMergeF, g, E); }
    GRID_BAR();
    { pg8::Gemm g{MG, WOUT, M, D, D, D, D}; pg8::EpiResidB<false> E{XB, nullptr, SS, 1.0f}; GEMM_PHASE(pg8::EpiResidB<false>, g, E); }
    GRID_BAR();
    STAGGER(430);
    { pg8::Gemm g{XB, W2IN, M, NFF, D, D, D}; pg8::EpiSwigluF E{HB, SS}; GEMM_PHASE(pg8::EpiSwigluF, g, E); }
    GRID_BAR();
    { pg8::Gemm g{HB, W2OUT, M, D, DFF, DFF, DFF}; pg8::EpiResidB<true> E{XB, out, SS, 0.5f}; GEMM_PHASE(pg8::EpiResidB<true>, g, E); if (REP(1)) GEMM_PHASE(pg8::EpiResidB<true>, g, E); }
    GRID_BAR();
    phase_final_scale(F, out, SS, F.in[17]);
}

extern "C" void kernel_launch(void* const* d_in, const int* in_sizes, int n_in, void* d_out, int out_size, void* d_ws, size_t ws_size, hipStream_t stream) {
    static int grid = 0;
    if (grid == 0) {
        if (n_in != 18 || in_sizes[0] != M * D || out_size != M * D || ws_size < WS_END) { fprintf(stderr, "kernel_launch: unexpected shapes (n_in %d, in0 %d, out %d, ws %zu)\n", n_in, n_in > 0 ? in_sizes[0] : -1, out_size, ws_size); grid = -1; return; }
        int dev = 0, cus = 0, per_cu = 0;
        if (hipGetDevice(&dev) != hipSuccess || hipDeviceGetAttribute(&cus, hipDeviceAttributeMultiprocessorCount, dev) != hipSuccess) { grid = -1; return; }
        if (hipFuncSetAttribute((const void*)fwd_kernel, hipFuncAttributeMaxDynamicSharedMemorySize, LDS_BYTES) != hipSuccess) { grid = -1; return; }
        if (hipOccupancyMaxActiveBlocksPerMultiprocessor(&per_cu, (const void*)fwd_kernel, NTHR, LDS_BYTES) != hipSuccess || per_cu < 1) { fprintf(stderr, "occupancy query says %d\n", per_cu); }
        (void)hipGetLastError();
        grid = cus;
    }
    if (grid < 0) return;
    if (hipMemsetAsync((char*)d_ws + WS_CTL, 0, CTL_ZERO_BYTES, stream) != hipSuccess) return;
    Args a{};
    for (int i = 0; i < 18; ++i) a.in[i] = (const float*)d_in[i];
    a.out = (float*)d_out; a.ws = (unsigned char*)d_ws;
    hipLaunchKernelGGL(fwd_kernel, dim3(grid), dim3(NTHR), LDS_BYTES, stream, a);
}
```

```cpp
#include <hip/hip_runtime.h>
#include <cstdio>
#include <cstdint>

#define GAS __attribute__((address_space(1)))
#define LAS __attribute__((address_space(3)))
typedef unsigned short bf16;
typedef unsigned v4u __attribute__((ext_vector_type(4)));
typedef float f32x4 __attribute__((ext_vector_type(4)));
typedef GAS unsigned gu32;
#define RLX_AGENT __ATOMIC_RELAXED, __HIP_MEMORY_SCOPE_AGENT

constexpr int BATCH = 32, SEQ = 2048, D = 1024, M = BATCH * SEQ;
constexpr int DFF = 2816, NFF = 2 * DFF;
constexpr int INC = 5648;
constexpr int PJA = 3072, PJB = 2560;
constexpr int FOXH = 8, FHD = 64, MLH = 4, MHD = 128;
constexpr int PC_FQ = 0, PC_FK = 512, PC_FV = 1024, PC_MQ = 1536, PC_MK = 2048, PC_MV = 2560;
constexpr int PB_MO = 0, PB_GA = 512, PB_GB = 1536;
constexpr float RMS_EPS = 1e-6f;
constexpr float LOG2E = 1.4426950408889634f;
constexpr float QSCALE2 = 0.125f * LOG2E;
constexpr int NWAVES = 8, NTHR = 512;
#ifndef STAG_ON
#define STAG_ON 0
#endif
#ifndef MLSTM_FUSED
#define MLSTM_FUSED 1
#endif
#ifndef REP_MASK
#define REP_MASK 0
#endif

constexpr size_t MiB = 1u << 20;
constexpr size_t WS_CTL = 0, CTL_ZERO_BYTES = 1 * MiB;
constexpr size_t WS_W1IN = 2 * MiB, WS_W1OUT = 13 * MiB, WS_WIN = 19 * MiB, WS_WCAT = 31 * MiB, WS_WOUT = 33 * MiB, WS_W2IN = 35 * MiB, WS_W2OUT = 46 * MiB;
constexpr int NPJ = 5888;
constexpr size_t WS_SG = 52 * MiB;
constexpr size_t WS_CUM = 56 * MiB;
constexpr size_t WS_SS = 58 * MiB;
constexpr size_t WS_XB = 64 * MiB;
constexpr size_t WS_AO = 192 * MiB;
constexpr size_t WS_PA = 320 * MiB;
constexpr size_t WS_PB = 704 * MiB;
constexpr size_t WS_END = 1024 * MiB;
constexpr int CW_BAR = 4096;
constexpr int CW_QKN = 32768;

constexpr int LDS_BYTES = 147456;
constexpr int RING_BYTES = 131072, LDSCTL_OFF = RING_BYTES, MISC_OFF = LDSCTL_OFF + 320;

__device__ __forceinline__ float bf2f(bf16 v) { return __builtin_bit_cast(float, (unsigned)v << 16); }
__device__ __forceinline__ unsigned f2bf(float f) { unsigned u = __builtin_bit_cast(unsigned, f); return (u + 0x7fffu + ((u >> 16) & 1u)) >> 16; }
__device__ __forceinline__ unsigned pk2(float lo, float hi) { return f2bf(lo) | (f2bf(hi) << 16); }
__device__ __forceinline__ float sigmoidf_(float v) { return 1.f / (1.f + __expf(-v)); }
__device__ __forceinline__ float logsigmoidf_(float v) { return fminf(v, 0.f) - log1pf(__expf(-fabsf(v))); }
__device__ __forceinline__ float siluf_(float v) { return v / (1.f + __expf(-v)); }

#define XB_TMO      128
#define XB_XCNT(j)  (256  + 64 * (j))
#define XB_XSUB(j)  (1280 + 64 * (j))
#define XB_XGEN(j)  (2304 + 64 * (j))
#define XB_TOP      3328
#define XB_TOPGEN   3392
#define XCD_BAR_WORDS 3456
#define XB_SPIN_CAP (1u << 22)

__device__ __forceinline__ unsigned xb_ld(unsigned* p)              { return __hip_atomic_load(p, __ATOMIC_RELAXED, __HIP_MEMORY_SCOPE_AGENT); }
__device__ __forceinline__ unsigned xb_add(unsigned* p, unsigned v) { return __hip_atomic_fetch_add(p, v, __ATOMIC_RELAXED, __HIP_MEMORY_SCOPE_AGENT); }
__device__ __forceinline__ unsigned xb_xcc_id() { return (unsigned)__builtin_amdgcn_s_getreg((3 << 11) | 20) & 0xFu; }
#define XB_SPIN(cond, bar) do { unsigned _sp = 0; while (cond) { __builtin_amdgcn_s_sleep(1); \
    if ((++_sp & 255u) == 0u) { if (xb_ld(&(bar)[XB_TMO])) break; if (_sp > XB_SPIN_CAP) { atomicAdd(&(bar)[XB_TMO], 1u); break; } } } } while (0)

struct XcdBarrier { unsigned* bar; unsigned x; volatile LAS unsigned* st; int wv; };

__device__ __forceinline__ bool xb_leader(int wv) { int l = (int)__builtin_amdgcn_mbcnt_hi(~0u, __builtin_amdgcn_mbcnt_lo(~0u, 0u)); asm volatile("" : "+v"(l)); return wv == 0 && l == 0; }
__device__ __forceinline__ XcdBarrier xcd_barrier_post(unsigned* bar, volatile LAS unsigned* st, int wv) {
    XcdBarrier b; b.bar = bar; b.x = xb_xcc_id(); b.st = st; b.wv = wv;
    if (xb_leader(wv)) (void)xb_add(&bar[XB_XCNT(b.x)], 1u);
    return b;
}
__device__ __forceinline__ void xcd_barrier_complete(unsigned* bar, unsigned x, unsigned& nloc, unsigned& nx) {
    const unsigned G = gridDim.x * gridDim.y * gridDim.z;
    unsigned sum, cnt, mine, sp = 0u;
    for (;;) {
        sum = 0u; cnt = 0u; mine = 0u;
#pragma unroll
        for (unsigned j = 0; j < 16; ++j) { const unsigned c = xb_ld(&bar[XB_XCNT(j)]); sum += c; cnt += (c > 0u) ? 1u : 0u; mine = (j == x) ? c : mine; }
        if (sum == G) break;
        __builtin_amdgcn_s_sleep(1);
        if ((++sp & 255u) == 0u) { if (xb_ld(&bar[XB_TMO])) break; if (sp > XB_SPIN_CAP) { atomicAdd(&bar[XB_TMO], 1u); break; } }
    }
    nloc = mine > 0u ? mine : 1u; nx = cnt > 0u ? cnt : 1u;
}
__device__ __forceinline__ void xcd_barrier(const XcdBarrier& b) {
    asm volatile("s_waitcnt vmcnt(0)" ::: "memory");
    __syncthreads();
    if (xb_leader(b.wv)) {
        unsigned* bar = b.bar;
        __builtin_amdgcn_s_waitcnt(0);
        unsigned nloc = b.st[0], nx = b.st[1];
        if (nloc == 0u) { xcd_barrier_complete(bar, b.x, nloc, nx); b.st[0] = nloc; b.st[1] = nx; }
        const unsigned old = xb_add(&bar[XB_XSUB(b.x)], 1u);
        const unsigned gen = old / nloc;
        if (old + 1u == (gen + 1u) * nloc) {
            __builtin_amdgcn_fence(__ATOMIC_RELEASE, "agent");
            asm volatile("s_waitcnt vmcnt(0)" ::: "memory");
            const unsigned og = xb_add(&bar[XB_TOP], 1u);
            const unsigned tg = og / nx;
            if (og + 1u == (tg + 1u) * nx) xb_add(&bar[XB_TOPGEN], 1u);
            else XB_SPIN(xb_ld(&bar[XB_TOPGEN]) == tg, bar);
            __builtin_amdgcn_fence(__ATOMIC_ACQUIRE, "agent");
            xb_add(&bar[XB_XGEN(b.x)], 1u);
            asm volatile("s_waitcnt vmcnt(0)" ::: "memory");
        } else {
            XB_SPIN(xb_ld(&bar[XB_XGEN(b.x)]) == gen, bar);
            __builtin_amdgcn_fence(__ATOMIC_ACQUIRE, "agent");
            asm volatile("s_waitcnt vmcnt(0)" ::: "memory");
        }
    }
    __syncthreads();
}

struct Frame {
    LAS unsigned char* lds;
    volatile LAS unsigned* MISC;
    gu32* ctl;
    int wave, G;
    const float* in[18];
    float* out;
    unsigned char* ws;
};
struct Args { const float* in[18]; float* out; unsigned char* ws; };

__device__ __forceinline__ int lane_id() { return (int)__builtin_amdgcn_mbcnt_hi(~0u, __builtin_amdgcn_mbcnt_lo(~0u, 0u)); }
__device__ __forceinline__ int opaque_tid(int wv) { int t = wv * 64 + lane_id(); asm volatile("" : "+v"(t)); return t; }
__device__ __forceinline__ float bperm(float v, int idx) { return __builtin_bit_cast(float, __builtin_amdgcn_ds_bpermute(idx << 2, __builtin_bit_cast(int, v))); }
__device__ __forceinline__ float rdl(float v, int idx) { return __builtin_bit_cast(float, __builtin_amdgcn_readlane(__builtin_bit_cast(int, v), idx)); }
__device__ __forceinline__ float shx(float v, int lane, int mask) { return bperm(v, lane ^ mask); }
__device__ __forceinline__ float wave_sum(float v, int lane) {
#pragma unroll
    for (int o = 1; o < 64; o <<= 1) v += shx(v, lane, o);
    return v;
}

__device__ __forceinline__ void phase_x_prep(Frame& F, const float* X, bf16* XB, float* SS) {
    const int ptid = opaque_tid(F.wave), plane = ptid & 63, pwave = __builtin_amdgcn_readfirstlane(ptid >> 6);
    const int gw = blockIdx.x * NWAVES + pwave, NGW = F.G * NWAVES;
    for (int m = gw; m < M; m += NGW) {
        const GAS f32x4* xr = (const GAS f32x4*)(X + (size_t)m * D) + plane;
        f32x4 v[4]; float s = 0.f;
#pragma unroll
        for (int j = 0; j < 4; ++j) { v[j] = xr[64 * j]; s += (v[j].x * v[j].x + v[j].y * v[j].y) + (v[j].z * v[j].z + v[j].w * v[j].w); }
        s = wave_sum(s, plane);
        GAS unsigned long long* o8 = (GAS unsigned long long*)(XB + (size_t)m * D) + plane;
#pragma unroll
        for (int j = 0; j < 4; ++j) o8[64 * j] = (unsigned long long)pk2(v[j].x, v[j].y) | ((unsigned long long)pk2(v[j].z, v[j].w) << 32);
        if (plane < 16) SS[(size_t)m * 16 + plane] = (plane == 0) ? s : 0.f;
    }
}
__device__ __forceinline__ void phase_final_scale(Frame& F, float* X, const float* SS, const float* gain) {
    const int ptid = opaque_tid(F.wave), plane = ptid & 63, pwave = __builtin_amdgcn_readfirstlane(ptid >> 6);
    const int gw = blockIdx.x * NWAVES + pwave, NGW = F.G * NWAVES;
    f32x4 g[4];
#pragma unroll
    for (int j = 0; j < 4; ++j) g[j] = *((const GAS f32x4*)gain + plane + 64 * j);
    for (int m = gw; m < M; m += NGW) {
        GAS f32x4* xr = (GAS f32x4*)(X + (size_t)m * D) + plane;
        f32x4 v[4];
#pragma unroll
        for (int j = 0; j < 4; ++j) v[j] = xr[64 * j];
        float s = SS[(size_t)m * 16 + (plane & 15)];
#pragma unroll
        for (int o = 1; o < 16; o <<= 1) s += shx(s, plane, o);
        const float r = 1.0f / sqrtf(s * (1.f / D) + RMS_EPS);
#pragma unroll
        for (int j = 0; j < 4; ++j) xr[64 * j] = v[j] * r * g[j];
    }
}

__device__ __forceinline__ void phase_cumsum(Frame& F, const float* SG, float* CUM) {
    const int ptid = opaque_tid(F.wave), plane = ptid & 63, pwave = __builtin_amdgcn_readfirstlane(ptid >> 6); (void)plane; (void)pwave;
    const int gw = blockIdx.x * NWAVES + pwave, NGW = F.G * NWAVES;
    for (int it = gw; it < BATCH * FOXH; it += NGW) {
        const int b = it / FOXH, h = it % FOXH;
        float v[32]; float s = 0.f;
#pragma unroll
        for (int i = 0; i < 32; ++i) { s += SG[(size_t)(b * SEQ + plane * 32 + i) * 16 + h]; v[i] = s; }
        float incl = s;
#pragma unroll
        for (int o = 1; o < 64; o <<= 1) { const float t = bperm(incl, (plane - o) & 63); if (plane >= o) incl += t; }
        const float excl = incl - s;
#pragma unroll
        for (int i = 0; i < 32; ++i) CUM[(size_t)it * SEQ + plane * 32 + i] = v[i] + excl;
    }
}


namespace pg8 {
#define PG8_LAS __attribute__((address_space(3)))
typedef unsigned short bf16_t;
typedef short bf16x8 __attribute__((ext_vector_type(8)));
typedef float f32x4 __attribute__((ext_vector_type(4)));
typedef unsigned u32x4 __attribute__((ext_vector_type(4)));
constexpr int RSTD_LDS_OFF = 131072 + 1024;
constexpr int BM = 256, BK = 64, HALF = 128, HTB = HALF * BK * 2  , STAGE_BYTES = 8 * HTB, NXCD = 8, WGM = 8;

__host__ __device__ __forceinline__ int lds_byte(int r, int c) { const int st = (r >> 4) * 2 + (c >> 5), rr = r & 15, cc = c & 31, ob = rr * 64 + cc * 2; return st * 1024 + (ob ^ (((ob >> 9) & 1) << 5)); }
__host__ __device__ __forceinline__ void stage_rc(int b, int& R, int& C) { const int st = b / 1024, sb = b % 1024, swz = sb ^ (((sb >> 9) & 1) << 5); R = (st >> 1) * 16 + swz / 64; C = (st & 1) * 32 + (swz % 64) / 2; }
__host__ __device__ __forceinline__ int perm32(int rho) { const int n = rho >> 4, i = rho & 15; return 8 * (i >> 2) + 4 * n + (i & 3); }

struct Unit { int pm, pn; };
struct Gemm { const bf16_t* A; const bf16_t* Bt; int M, N, K, lda, ldb; };

struct StaticOrder {
    int nM, nN, nwg, G, c;
    __host__ __device__ void init(int M, int N, int G_, int c_) { nM = M / BM; nN = N / BM; nwg = nM * nN; G = G_; c = c_; }
    __host__ __device__ bool next(int i, Unit& u) const {
        const long L = (long)i * G + c; if (L >= nwg) return false;
        int wgid = (int)L; { const int q = nwg / NXCD, r = nwg % NXCD, xcd = wgid % NXCD, off = wgid / NXCD; wgid = (xcd < r ? xcd * (q + 1) : r * (q + 1) + (xcd - r) * q) + off; }
        const int nig = WGM * nN, gid = wgid / nig, fm = gid * WGM, gsz = (nM - fm) < WGM ? (nM - fm) : WGM;
        u.pm = fm + ((wgid % nig) % gsz); u.pn = (wgid % nig) / gsz; return true;
    }
    __device__ __forceinline__ void a_ready(const Unit&) const {}
    __device__ __forceinline__ void done(const Unit&) const {}
};

__device__ __forceinline__ unsigned cvt_pk_bf16(float lo, float hi) { unsigned r; asm volatile("v_cvt_pk_bf16_f32 %0, %1, %2" : "=v"(r) : "v"(lo), "v"(hi)); return r; }
template <class Epi, class Sched, bool ALIGN_EPI = false, bool SP2 = false>
__device__ __forceinline__ void gemm_phase(PG8_LAS unsigned char* lds, const Gemm g, const Sched& S, const Epi& E, const int wv) {
    int tid_ = wv * 64 + (int)__builtin_amdgcn_mbcnt_hi(~0u, __builtin_amdgcn_mbcnt_lo(~0u, 0u)); asm volatile("" : "+v"(tid_));
    const int tid = tid_, wid = __builtin_amdgcn_readfirstlane(tid >> 6), lane = tid & 63, wr = wid >> 2, wc = wid & 3, fr = lane & 15, fq = lane >> 4;
    const int K = g.K, nt = K / BK;
    unsigned voffA[2], voffB[2];
#pragma unroll
    for (int i = 0; i < 2; ++i) { int R, C; stage_rc(tid * 16 + i * 8192, R, C); const int Rb = Epi::PERM ? ((R & ~31) + perm32(R & 31)) : R;
        voffA[i] = (unsigned)(R * g.lda + C) * 2u; voffB[i] = (unsigned)(Rb * g.ldb + C) * 2u; }
    const size_t kstep = (size_t)(BK * 2);
    const size_t hstepA = (size_t)HALF * g.lda * 2, hstepB = (size_t)HALF * g.ldb * 2;
    const size_t tstepA = 2 * hstepA, tstepB = 2 * hstepB;
    const unsigned ldsw = (unsigned)wid * 1024u;
    const int aoff = lds_byte(wr * 64 + fr, fq * 8), boff = lds_byte(wc * 32 + fr, fq * 8);
#define PG8_SA(b, h) (((b) * 2 + (h)) * HTB)
#define PG8_SB(b, h) ((4 + (b) * 2 + (h)) * HTB)
#define PG8_STAGE(bufoff, gbase, voff) do { _Pragma("unroll") for (int _i = 0; _i < 2; ++_i) \
        __builtin_amdgcn_global_load_lds((const unsigned*)((const char*)(gbase) + (voff)[_i]), (PG8_LAS unsigned*)(lds + (bufoff) + ldsw + _i * 8192), 16, 0, 0); } while (0)
#define PG8_LDA(dst, b, h) do { _Pragma("unroll") for (int m = 0; m < 4; ++m) _Pragma("unroll") for (int k = 0; k < 2; ++k) dst[m][k] = *(const PG8_LAS bf16x8*)(lds + PG8_SA(b, h) + aoff + m * 2048 + k * 1024); } while (0)
#define PG8_LDB(dst, b, h) do { _Pragma("unroll") for (int n = 0; n < 2; ++n) _Pragma("unroll") for (int k = 0; k < 2; ++k) dst[n][k] = *(const PG8_LAS bf16x8*)(lds + PG8_SB(b, h) + boff + n * 2048 + k * 1024); } while (0)
#define PG8_MMA(ai, bj, At, Bt) do { __builtin_amdgcn_s_setprio(1); _Pragma("unroll") for (int m = 0; m < 4; ++m) _Pragma("unroll") for (int n = 0; n < 2; ++n) _Pragma("unroll") for (int k = 0; k < 2; ++k) \
        acc[ai][bj][m][n] = __builtin_amdgcn_mfma_f32_16x16x32_bf16(Bt[n][k], At[m][k], acc[ai][bj][m][n], 0, 0, 0); __builtin_amdgcn_s_setprio(0); } while (0)
#define PG8_WAIT_V(n) asm volatile("s_waitcnt vmcnt(" #n ")" ::: "memory")
#define PG8_WAIT_L(n) asm volatile("s_waitcnt lgkmcnt(" #n ")" ::: "memory")
#define PG8_BAR __builtin_amdgcn_s_barrier()
#define PG8_SCHED __builtin_amdgcn_sched_barrier(0)
    Unit cur, nxt; int ui = 0; int rs_pm = -1; (void)rs_pm;
    if (!S.next(0, cur)) return;
    f32x4 acc[2][2][4][2];
#pragma unroll
    for (int a = 0; a < 2; ++a)
#pragma unroll
        for (int b = 0; b < 2; ++b)
#pragma unroll
            for (int m = 0; m < 4; ++m)
#pragma unroll
                for (int n = 0; n < 2; ++n) acc[a][b][m][n] = (f32x4){0.f, 0.f, 0.f, 0.f};
    bf16x8 At[4][2], B0[2][2], B1[2][2];
    const char* cA = (const char*)g.A + (size_t)cur.pm * tstepA; const char* cB = (const char*)g.Bt + (size_t)cur.pn * tstepB;
    S.a_ready(cur);
    if constexpr (SP2) {
        PG8_STAGE(PG8_SB(0, 0), cB, voffB); PG8_STAGE(PG8_SB(0, 1), cB + hstepB, voffB); PG8_STAGE(PG8_SA(0, 0), cA, voffA); PG8_STAGE(PG8_SA(0, 1), cA + hstepA, voffA);
        if (wr == 1) PG8_BAR;
        PG8_WAIT_V(2); PG8_BAR;
        PG8_STAGE(PG8_SB(1, 0), cB + kstep, voffB); PG8_STAGE(PG8_SA(1, 0), cA + kstep, voffA); PG8_STAGE(PG8_SB(1, 1), cB + hstepB + kstep, voffB);
        PG8_WAIT_V(6); PG8_BAR;
    } else {
        PG8_STAGE(PG8_SB(0, 0), cB, voffB); PG8_STAGE(PG8_SA(0, 0), cA, voffA); PG8_STAGE(PG8_SB(0, 1), cB + hstepB, voffB); PG8_STAGE(PG8_SA(0, 1), cA + hstepA, voffA);
        if (wr == 1) PG8_BAR;
        PG8_WAIT_V(4); PG8_BAR;
        PG8_STAGE(PG8_SB(1, 0), cB + kstep, voffB); PG8_STAGE(PG8_SA(1, 0), cA + kstep, voffA); PG8_STAGE(PG8_SB(1, 1), cB + hstepB + kstep, voffB);
        PG8_WAIT_V(6); PG8_BAR;
    }
    for (;;) {
        const bool has_next = S.next(ui + 1, nxt);
        const char* nA = has_next ? (const char*)g.A + (size_t)nxt.pm * tstepA : cA; const char* nB = has_next ? (const char*)g.Bt + (size_t)nxt.pn * tstepB : cB;
        for (int t = 0; t < nt; t += 2) {
            const bool last = (t == nt - 2);
            const char* a1 = cA + (size_t)(t + 1) * kstep;
            const char* a2 = last ? nA : cA + (size_t)(t + 2) * kstep; const char* b2 = last ? nB : cB + (size_t)(t + 2) * kstep;
            const char* a3 = a2 + kstep; const char* b3 = b2 + kstep;
            if (last && has_next) S.a_ready(nxt);
            if constexpr (Epi::HOOK) { if (t == Epi::HOOK_T) E.mid(acc, cur, wr, wc, fr, fq); }
            if constexpr (SP2) {
            PG8_LDB(B0, 0, 0); PG8_LDB(B1, 0, 1); PG8_SCHED; PG8_LDA(At, 0, 0); PG8_STAGE(PG8_SA(1, 1), a1 + hstepA, voffA);
            PG8_WAIT_V(8); PG8_WAIT_L(0); PG8_BAR; PG8_MMA(0, 0, At, B0); PG8_MMA(0, 1, At, B1); PG8_BAR; PG8_SCHED;
            PG8_LDA(At, 0, 1); PG8_STAGE(PG8_SB(0, 0), b2, voffB); PG8_STAGE(PG8_SB(0, 1), b2 + hstepB, voffB); PG8_STAGE(PG8_SA(0, 0), a2, voffA);
            PG8_WAIT_V(8); PG8_WAIT_L(0); PG8_BAR; PG8_MMA(1, 0, At, B0); PG8_MMA(1, 1, At, B1); PG8_BAR; PG8_SCHED;
            PG8_LDB(B0, 1, 0); PG8_LDB(B1, 1, 1); PG8_SCHED; PG8_LDA(At, 1, 0); PG8_STAGE(PG8_SA(0, 1), a2 + hstepA, voffA);
            PG8_WAIT_V(8); PG8_WAIT_L(0); PG8_BAR; PG8_MMA(0, 0, At, B0); PG8_MMA(0, 1, At, B1); PG8_BAR; PG8_SCHED;
            PG8_LDA(At, 1, 1); PG8_STAGE(PG8_SB(1, 0), b3, voffB); PG8_STAGE(PG8_SB(1, 1), b3 + hstepB, voffB); PG8_STAGE(PG8_SA(1, 0), a3, voffA);
            PG8_WAIT_V(8); PG8_WAIT_L(0); PG8_BAR; PG8_MMA(1, 0, At, B0); PG8_MMA(1, 1, At, B1); PG8_BAR; PG8_SCHED;
            } else {
            PG8_LDB(B0, 0, 0); PG8_SCHED; PG8_LDA(At, 0, 0); PG8_STAGE(PG8_SA(1, 1), a1 + hstepA, voffA);
            PG8_WAIT_L(8); PG8_BAR; PG8_WAIT_L(0); PG8_MMA(0, 0, At, B0); PG8_BAR; PG8_SCHED;
            PG8_LDB(B1, 0, 1); PG8_STAGE(PG8_SB(0, 0), b2, voffB);
            PG8_BAR; PG8_WAIT_L(0); PG8_MMA(0, 1, At, B1); PG8_BAR;
            PG8_LDA(At, 0, 1); PG8_STAGE(PG8_SA(0, 0), a2, voffA);
            PG8_BAR; PG8_WAIT_L(0); PG8_MMA(1, 0, At, B0); PG8_BAR; PG8_SCHED;
            PG8_STAGE(PG8_SB(0, 1), b2 + hstepB, voffB);
            PG8_WAIT_V(6); PG8_BAR; PG8_MMA(1, 1, At, B1); PG8_BAR;
            PG8_LDB(B0, 1, 0); PG8_SCHED; PG8_LDA(At, 1, 0); PG8_STAGE(PG8_SA(0, 1), a2 + hstepA, voffA);
            PG8_WAIT_L(8); PG8_BAR; PG8_WAIT_L(0); PG8_MMA(0, 0, At, B0); PG8_BAR; PG8_SCHED;
            PG8_LDB(B1, 1, 1); PG8_STAGE(PG8_SB(1, 0), b3, voffB);
            PG8_BAR; PG8_WAIT_L(0); PG8_MMA(0, 1, At, B1); PG8_BAR;
            PG8_LDA(At, 1, 1); PG8_STAGE(PG8_SA(1, 0), a3, voffA);
            PG8_BAR; PG8_WAIT_L(0); PG8_MMA(1, 0, At, B0); PG8_BAR; PG8_SCHED;
            PG8_STAGE(PG8_SB(1, 1), b3 + hstepB, voffB);
            PG8_WAIT_V(6); PG8_BAR; PG8_MMA(1, 1, At, B1); PG8_BAR;
            }
        }
        if constexpr (ALIGN_EPI) { if (wr == 0) PG8_BAR; }
        if constexpr (Epi::RSTD) { if (cur.pm != rs_pm) {
                const int row_ = tid >> 1, hf_ = tid & 1; const float* sp_ = E.SS + ((size_t)cur.pm * BM + row_) * 16 + hf_ * 8; const f32x4 p0_ = *(const f32x4*)sp_, p1_ = *(const f32x4*)(sp_ + 4);
                float s_ = ((p0_[0] + p0_[1]) + (p0_[2] + p0_[3])) + ((p1_[0] + p1_[1]) + (p1_[2] + p1_[3])); s_ += shx(s_, lane, 1);
                if (hf_ == 0) *(PG8_LAS float*)(lds + RSTD_LDS_OFF + row_ * 4) = 1.0f / sqrtf(s_ * (1.0f / D) + RMS_EPS);
                asm volatile("s_waitcnt lgkmcnt(0)\n\ts_barrier" ::: "memory"); rs_pm = cur.pm; } }
        if constexpr (!Epi::AFTER_DRAIN) { E(acc, cur, wr, wc, fr, fq, lds); S.done(cur); }
        if (!has_next) break;
#pragma unroll
        for (int a = 0; a < 2; ++a)
#pragma unroll
            for (int b = 0; b < 2; ++b)
#pragma unroll
                for (int m = 0; m < 4; ++m)
#pragma unroll
                    for (int n = 0; n < 2; ++n) acc[a][b][m][n] = (f32x4){0.f, 0.f, 0.f, 0.f};
        cur = nxt; cA = nA; cB = nB; ++ui;
        if constexpr (ALIGN_EPI) { if (wr == 1) PG8_BAR; }
    }
    PG8_WAIT_V(0);
    if constexpr (!ALIGN_EPI) { if (wr == 0) PG8_BAR; }
    PG8_BAR;
    if constexpr (Epi::AFTER_DRAIN) { E.fused(acc, cur, wr, wc, fr, fq, lds, wid, lane); S.done(cur); }
#undef PG8_SA
#undef PG8_SB
#undef PG8_STAGE
#undef PG8_LDA
#undef PG8_LDB
#undef PG8_MMA
#undef PG8_WAIT_V
#undef PG8_WAIT_L
#undef PG8_BAR
#undef PG8_SCHED
}
}

namespace pg8 {
__device__ __forceinline__ float fsig(float v) { return __builtin_amdgcn_rcpf(1.f + __builtin_amdgcn_exp2f(-1.4426950408889634f * v)); }
__device__ __forceinline__ u32x4 pack8(const f32x4 a, const f32x4 b) { u32x4 w; w.x = cvt_pk_bf16(a[0], a[1]); w.y = cvt_pk_bf16(a[2], a[3]); w.z = cvt_pk_bf16(b[0], b[1]); w.w = cvt_pk_bf16(b[2], b[3]); return w; }
__device__ __forceinline__ void unpack8(const u32x4 w, f32x4& a, f32x4& b) {
    a[0] = __builtin_bit_cast(float, w.x << 16); a[1] = __builtin_bit_cast(float, w.x & 0xffff0000u); a[2] = __builtin_bit_cast(float, w.y << 16); a[3] = __builtin_bit_cast(float, w.y & 0xffff0000u);
    b[0] = __builtin_bit_cast(float, w.z << 16); b[1] = __builtin_bit_cast(float, w.z & 0xffff0000u); b[2] = __builtin_bit_cast(float, w.w << 16); b[3] = __builtin_bit_cast(float, w.w & 0xffff0000u); }
#define PIN16(a) asm volatile("" : "+v"(a[0][0][0]), "+v"(a[0][0][1]), "+v"(a[0][1][0]), "+v"(a[0][1][1]), "+v"(a[0][2][0]), "+v"(a[0][2][1]), "+v"(a[0][3][0]), "+v"(a[0][3][1]), \
    "+v"(a[1][0][0]), "+v"(a[1][0][1]), "+v"(a[1][1][0]), "+v"(a[1][1][1]), "+v"(a[1][2][0]), "+v"(a[1][2][1]), "+v"(a[1][3][0]), "+v"(a[1][3][1]))
__device__ __forceinline__ float dot4(const f32x4 a) { return (a[0] * a[0] + a[1] * a[1]) + (a[2] * a[2] + a[3] * a[3]); }
__device__ __forceinline__ void row_rstd(PG8_LAS unsigned char* lds, int wr, int fr, float (&rs)[2][4]) {
#pragma unroll
    for (int ai = 0; ai < 2; ++ai)
#pragma unroll
        for (int m = 0; m < 4; ++m) rs[ai][m] = *(const PG8_LAS float*)(lds + RSTD_LDS_OFF + (ai * HALF + wr * 64 + m * 16 + fr) * 4);
}
struct EpiSwigluF { static constexpr bool PERM = true, AFTER_DRAIN = false, HOOK = false, RSTD = true; static constexpr int HOOK_T = 0; bf16_t* H; const float* SS;
    __device__ __forceinline__ void operator()(const f32x4 (&acc)[2][2][4][2], const Unit& u, int wr, int wc, int fr, int fq, PG8_LAS unsigned char* lds) const {
        const int row0 = u.pm * BM + wr * 64 + fr, col0 = u.pn * 128 + wc * 32 + 8 * fq;
        for (int rp_ = 0; rp_ < 1 + ((REP_MASK >> 6) & 1); ++rp_) {
        float rs[2][4]; row_rstd(lds, wr, fr, rs);
#pragma unroll
        for (int ai = 0; ai < 2; ++ai)
#pragma unroll
            for (int m = 0; m < 4; ++m) { bf16_t* rowp = H + (size_t)(row0 + ai * HALF + m * 16) * DFF + col0; const float r = rs[ai][m];
                f32x4 h0, h1;
#pragma unroll
                for (int i = 0; i < 4; ++i) { const float g0 = acc[ai][0][m][0][i] * r, g1 = acc[ai][0][m][1][i] * r; h0[i] = g0 * fsig(g0) * (acc[ai][1][m][0][i] * r); h1[i] = g1 * fsig(g1) * (acc[ai][1][m][1][i] * r); }
                __builtin_nontemporal_store(pack8(h0, h1), (u32x4*)rowp); }
        }
    } };
template <bool FINAL> struct EpiResidB { static constexpr bool PERM = true, AFTER_DRAIN = false, HOOK = false, RSTD = false; static constexpr int HOOK_T = 0; bf16_t* XB; float* Of; float* SS; float coef;
    __device__ __forceinline__ void operator()(const f32x4 (&acc)[2][2][4][2], const Unit& u, int wr, int wc, int fr, int fq, PG8_LAS unsigned char* lds) const {
        const int row0 = u.pm * BM + wr * 64 + fr, col0 = u.pn * BM + wc * 32 + 8 * fq;
        u32x4 rr[2][4][2];
#pragma unroll
        for (int ai = 0; ai < 2; ++ai)
#pragma unroll
            for (int m = 0; m < 4; ++m)
#pragma unroll
                for (int bj = 0; bj < 2; ++bj) rr[ai][m][bj] = *(const u32x4*)(XB + (size_t)(row0 + ai * HALF + m * 16) * D + col0 + bj * HALF);
        PIN16(rr);
#pragma unroll
        for (int ai = 0; ai < 2; ++ai)
#pragma unroll
            for (int m = 0; m < 4; ++m) { const size_t row = (size_t)(row0 + ai * HALF + m * 16); float ssq = 0.f;
#pragma unroll
                for (int bj = 0; bj < 2; ++bj) { const int c = col0 + bj * HALF; f32x4 r0, r1; unpack8(rr[ai][m][bj], r0, r1);
                    f32x4 v0 = r0 + acc[ai][bj][m][0] * coef, v1 = r1 + acc[ai][bj][m][1] * coef;
                    if (FINAL) { *(f32x4*)(Of + row * D + c) = v0; *(f32x4*)(Of + row * D + c + 4) = v1; }
                    else { const u32x4 w = pack8(v0, v1); *(u32x4*)(XB + row * D + c) = w; unpack8(w, v0, v1); }
                    ssq += dot4(v0) + dot4(v1); }
                ssq += shx(ssq, fq * 16 + fr, 16); ssq += shx(ssq, fq * 16 + fr, 32);
                if (fq == 0) SS[row * 16 + 4 * u.pn + wc] = ssq; }
    } };
struct EpiProjF { static constexpr bool PERM = true, AFTER_DRAIN = false, HOOK = false, RSTD = true; static constexpr int HOOK_T = 0; bf16_t* PA; bf16_t* PB; float* SG; const float* SS; const float* fb; const float* ib; const float* mfb; unsigned* QKN;
    __device__ __forceinline__ void operator()(const f32x4 (&acc)[2][2][4][2], const Unit& u, int wr, int wc, int fr, int fq, PG8_LAS unsigned char* lds) const {
        const int row0 = u.pm * BM + wr * 64 + fr;
        float rs[2][4]; row_rstd(lds, wr, fr, rs);
        if (u.pn < 22) {
            const int act = u.pn < 2 ? 0 : (u.pn < 12 ? 1 : 2); const int col0 = (u.pn < 12 ? u.pn : u.pn - 12) * BM + wc * 32 + 8 * fq;
            bf16_t* base = u.pn < 12 ? PA : PB; const int pitch = u.pn < 12 ? PJA : PJB;
            float nmx[2] = {0.f, 0.f};
#pragma unroll
            for (int ai = 0; ai < 2; ++ai)
#pragma unroll
                for (int m = 0; m < 4; ++m) { bf16_t* rowp = base + (size_t)(row0 + ai * HALF + m * 16) * pitch + col0; const float r = rs[ai][m] * (act == 0 ? QSCALE2 : 1.0f);
#pragma unroll
                    for (int bj = 0; bj < 2; ++bj) { f32x4 v0 = acc[ai][bj][m][0] * r, v1 = acc[ai][bj][m][1] * r;
                        if (u.pn < 4) { float p = dot4(v0) + dot4(v1); p += shx(p, fq * 16 + fr, 16); p += shx(p, fq * 16 + fr, 32); nmx[bj] = fmaxf(nmx[bj], p); }
                        if (act == 2) {
#pragma unroll
                            for (int i = 0; i < 4; ++i) { v0[i] = fsig(v0[i]); v1[i] = fsig(v1[i]); } }
                        __builtin_nontemporal_store(pack8(v0, v1), (u32x4*)(rowp + bj * HALF)); } }
            if (u.pn < 4) {
#pragma unroll
                for (int bj = 0; bj < 2; ++bj) { float p = nmx[bj];
#pragma unroll
                    for (int o = 1; o < 16; o <<= 1) p = fmaxf(p, shx(p, fq * 16 + fr, o));
                    if (fr == 0 && fq == 0) atomicMax(QKN + (((u.pm >> 3) * 8 + 4 * (u.pn & 1) + 2 * bj + (wc >> 1)) * 4 + 2 * (u.pn >> 1) + (wc & 1)), __builtin_bit_cast(unsigned, p)); } }
        } else if (wc == 0 && fq < 2) {
            const f32x4 b0 = fq == 0 ? *(const f32x4*)fb : *(const f32x4*)ib, b1 = fq == 0 ? *(const f32x4*)(fb + 4) : *(const f32x4*)mfb;
#pragma unroll
            for (int ai = 0; ai < 2; ++ai)
#pragma unroll
                for (int m = 0; m < 4; ++m) { float* sp = SG + (size_t)(row0 + ai * HALF + m * 16) * 16 + 8 * fq; const float r = rs[ai][m];
                    f32x4 v0 = acc[ai][0][m][0] * r + b0, v1 = acc[ai][0][m][1] * r + b1;
#pragma unroll
                    for (int i = 0; i < 4; ++i) { if (fq == 0) v0[i] = logsigmoidf_(v0[i]); v1[i] = logsigmoidf_(v1[i]); }
                    *(f32x4*)sp = v0; *(f32x4*)(sp + 4) = v1; }
        }
    } };
struct EpiMergeF { static constexpr bool PERM = true, AFTER_DRAIN = false, HOOK = true, RSTD = false; static constexpr int HOOK_T = 8; const bf16_t* PB; bf16_t* MG;
    __device__ __forceinline__ void mid(f32x4 (&acc)[2][2][4][2], const Unit& u, int wr, int wc, int fr, int fq) const {
        int row0 = u.pm * BM + wr * 64 + fr, col0 = u.pn * BM + wc * 32 + 8 * fq; asm volatile("" : "+v"(row0), "+v"(col0));
#pragma unroll
        for (int ai = 0; ai < 2; ++ai) {
            u32x4 gg[2][4][2];
#pragma unroll
            for (int m = 0; m < 4; ++m)
#pragma unroll
                for (int bj = 0; bj < 2; ++bj) { const bf16_t* rowp = PB + (size_t)(row0 + ai * HALF + m * 16) * PJB + col0 + bj * HALF; gg[0][m][bj] = *(const u32x4*)(rowp + PB_GA); gg[1][m][bj] = *(const u32x4*)(rowp + PB_GB); }
            PIN16(gg);
#pragma unroll
            for (int m = 0; m < 4; ++m) {
#pragma unroll
                for (int bj = 0; bj < 2; ++bj) { f32x4 a0, a1, b0, b1; unpack8(gg[0][m][bj], a0, a1); unpack8(gg[1][m][bj], b0, b1);
#pragma unroll
                    for (int i = 0; i < 4; ++i) { acc[ai][bj][m][0][i] *= a0[i] * __builtin_amdgcn_rcpf(fmaxf(b0[i], 1e-30f)); acc[ai][bj][m][1][i] *= a1[i] * __builtin_amdgcn_rcpf(fmaxf(b1[i], 1e-30f)); } } } }
    }
    __device__ __forceinline__ void operator()(const f32x4 (&acc)[2][2][4][2], const Unit& u, int wr, int wc, int fr, int fq, PG8_LAS unsigned char* lds) const {
        const int row0 = u.pm * BM + wr * 64 + fr, col0 = u.pn * BM + wc * 32 + 8 * fq;
        u32x4 gb[2][4][2];
#pragma unroll
        for (int ai = 0; ai < 2; ++ai)
#pragma unroll
            for (int m = 0; m < 4; ++m)
#pragma unroll
                for (int bj = 0; bj < 2; ++bj) gb[ai][m][bj] = *(const u32x4*)(PB + (size_t)(row0 + ai * HALF + m * 16) * PJB + PB_GB + col0 + bj * HALF);
        PIN16(gb);
#pragma unroll
        for (int ai = 0; ai < 2; ++ai)
#pragma unroll
            for (int m = 0; m < 4; ++m) { const size_t row = (size_t)(row0 + ai * HALF + m * 16);
#pragma unroll
                for (int bj = 0; bj < 2; ++bj) { const int c = col0 + bj * HALF; f32x4 b0, b1; unpack8(gb[ai][m][bj], b0, b1);
                    *(u32x4*)(MG + row * D + c) = pack8(b0 * acc[ai][bj][m][0], b1 * acc[ai][bj][m][1]); } }
    } };
}

__device__ __forceinline__ void transpose_item(const float* W, int N, int scol0, bf16* WT, int ldt, int drow0, int k0, int kdst0, LAS float* scr, int lane, const float* gain) {
#pragma unroll 8
    for (int i = 0; i < 32; ++i) { const int kk = 2 * i + (lane >> 5); const float gk = gain ? gain[k0 + kk] : 1.0f; scr[kk * 33 + (lane & 31)] = W[(size_t)(k0 + kk) * N + scol0 + (lane & 31)] * gk; }
    asm volatile("s_waitcnt lgkmcnt(0)" ::: "memory");
    const int c = lane & 7;
#pragma unroll
    for (int j = 0; j < 4; ++j) { const int n = (lane >> 3) + 8 * j; const LAS float* s = scr + (8 * c) * 33 + n;
        v4u o; o.x = pk2(s[0 * 33], s[1 * 33]); o.y = pk2(s[2 * 33], s[3 * 33]); o.z = pk2(s[4 * 33], s[5 * 33]); o.w = pk2(s[6 * 33], s[7 * 33]);
        *(GAS v4u*)(WT + (size_t)(drow0 + n) * ldt + kdst0 + k0 + 8 * c) = o; }
    asm volatile("s_waitcnt lgkmcnt(0)" ::: "memory");
}
__device__ __forceinline__ void phase_weights(Frame& F) {
    const int ptid = opaque_tid(F.wave), plane = ptid & 63, pwave = __builtin_amdgcn_readfirstlane(ptid >> 6); (void)plane; (void)pwave;
    LAS float* scr = (LAS float*)(F.lds + pwave * 16384);
    const int gw = blockIdx.x * NWAVES + pwave, NGW = F.G * NWAVES;
    constexpr int PJ = PJA + PJB; constexpr int I_IN = (D / 64) * (NFF / 32), I_OUT = (DFF / 64) * (D / 32), I_PJ = (D / 64) * (PJ / 32), I_UP = (512 / 64) * (D / 32), I_WO = (D / 64) * (D / 32);
    constexpr int NITEMS = 2 * I_IN + 2 * I_OUT + I_PJ + 2 * I_UP + I_WO;
    for (int it = gw; it < NITEMS; it += NGW) {
        int r = it;
        if (r < 2 * I_IN) { const int which = r / I_IN; r -= which * I_IN; const int ndb = NFF / 32, kb = r / ndb, db = r % ndb, n = db * 32, pn = n >> 8, j = n & 255;
            const int sc = (j < 128) ? pn * 128 + j : DFF + pn * 128 + (j - 128);
            transpose_item(F.in[which ? 15 : 2], NFF, sc, (bf16*)(F.ws + (which ? WS_W2IN : WS_W1IN)), D, n, kb * 64, 0, scr, plane, F.in[which ? 14 : 1]); continue; }
        r -= 2 * I_IN;
        if (r < 2 * I_OUT) { const int which = r / I_OUT; r -= which * I_OUT; const int ndb = D / 32, kb = r / ndb, db = r % ndb;
            transpose_item(F.in[which ? 16 : 3], D, db * 32, (bf16*)(F.ws + (which ? WS_W2OUT : WS_W1OUT)), DFF, db * 32, kb * 64, 0, scr, plane, nullptr); continue; }
        r -= 2 * I_OUT;
        if (r < I_PJ) { const int ndb = PJ / 32, kb = r / ndb, db = r % ndb, n = db * 32; const int sc = n + (n < 1536 ? 0 : (n < 3072 ? 8 : 16));
            transpose_item(F.in[5], INC, sc, (bf16*)(F.ws + WS_WIN), D, n, kb * 64, 0, scr, plane, F.in[4]); continue; }
        r -= I_PJ;
        if (r < 2 * I_UP) { const int which = r / I_UP; r -= which * I_UP; const int ndb = D / 32, kb = r / ndb, db = r % ndb;
            transpose_item(F.in[which ? 12 : 11], D, db * 32, (bf16*)(F.ws + WS_WCAT), D, db * 32, kb * 64, which ? 512 : 0, scr, plane, nullptr); continue; }
        r -= 2 * I_UP;
        { const int ndb = D / 32, kb = r / ndb, db = r % ndb; transpose_item(F.in[13], D, db * 32, (bf16*)(F.ws + WS_WOUT), D, db * 32, kb * 64, 0, scr, plane, nullptr); }
    }
    { bf16* WT = (bf16*)(F.ws + WS_WIN); const float* W = F.in[5];
      for (int idx = blockIdx.x * NTHR + ptid; idx < 256 * 128; idx += F.G * NTHR) { const int row = idx >> 7, k8 = (idx & 127) * 8; v4u o = {0u, 0u, 0u, 0u};
          if (row < 16) { const int sc = row < 8 ? 1536 + row : (row < 12 ? 3080 + (row - 8) : 3084 + (row - 12)); float v[8];
#pragma unroll
              for (int i = 0; i < 8; ++i) v[i] = W[(size_t)(k8 + i) * INC + sc] * F.in[4][k8 + i];
              o.x = pk2(v[0], v[1]); o.y = pk2(v[2], v[3]); o.z = pk2(v[4], v[5]); o.w = pk2(v[6], v[7]); }
          *(GAS v4u*)(WT + (size_t)(PJ + row) * D + k8) = o; } }
}

#include <hip/hip_bf16.h>
#include <cmath>
namespace attn_body {
using bf16=__hip_bfloat16;
using bf16x8=__attribute__((ext_vector_type(8)))short;
using s16x4=__attribute__((ext_vector_type(4)))short;
using f32x16=__attribute__((ext_vector_type(16)))float;
using u32x4=__attribute__((ext_vector_type(4)))unsigned;
constexpr int BATCH=32,NHEAD=8,SEQ=2048,D=64,DM=3072,OP=1024;
constexpr int NW=8,QBLK=32,QB=QBLK*NW,KVBLK=64,NQB=SEQ/QB;
constexpr int ATTN_PITCH=DM, ATTN_UNIT_ROWS=QB;
__device__ __forceinline__ int crow(int r,int hi){return (r&3)+8*(r>>2)+4*hi;}
#define SBAR() __builtin_amdgcn_sched_barrier(0)
__device__ __forceinline__ void cmask(f32x16&p0,f32x16&p1,int jb,int qrel,int hi){
  const float NEG=-INFINITY; int kb=64*jb+4*hi;
  #pragma unroll
  for(int r=0;r<16;++r){int kv=kb+(r&3)+8*(r>>2); if(kv>qrel)p0[r]=NEG; if(kv+32>qrel)p1[r]=NEG;}
}

constexpr int NSLOT=3, SLOTB=8192;
constexpr int LDS_K=0, LDS_V=NSLOT*SLOTB, LDS_WS=2*NSLOT*SLOTB, LDS_OST=LDS_WS+NW*64*4, LDS_BIAS=LDS_OST+NW*4096, LDS_ROWB=LDS_BIAS+SEQ*8, LDS_BYTES=LDS_ROWB+QB*4;
constexpr float C2=0.125f*1.4426950408889634f;
__device__ __forceinline__ void glds16(const void*gsrc,unsigned lds_dst){unsigned keep;
  asm volatile("s_mov_b32 %0, m0\n\ts_mov_b32 m0, %2\n\ts_nop 0\n\tglobal_load_lds_dwordx4 %1, off\n\ts_mov_b32 m0, %0":"=&s"(keep):"v"(gsrc),"s"(lds_dst):"memory");}
__device__ __forceinline__ float max3f(float a,float b,float c){float r;asm("v_max3_f32 %0, %1, %2, %3":"=v"(r):"v"(a),"v"(b),"v"(c));return r;}
__device__ __forceinline__ float max2f(float a,float b){float r;asm("v_max_f32_e32 %0, %1, %2":"=v"(r):"v"(a),"v"(b));return r;}
__device__ __forceinline__ float fadd_s(float a,float b){float r;asm("v_add_f32_e32 %0, %1, %2":"=v"(r):"v"(a),"v"(b));return r;}
__device__ __forceinline__ float fsub_s(float a,float b){float r;asm("v_sub_f32_e32 %0, %1, %2":"=v"(r):"v"(a),"v"(b));return r;}
typedef float f32x2_t __attribute__((ext_vector_type(2))); typedef __bf16 bf16x2_t __attribute__((ext_vector_type(2)));
__device__ __forceinline__ unsigned cvtpk_s(float lo,float hi){f32x2_t v={lo,hi};bf16x2_t b=__builtin_convertvector(v,bf16x2_t);return __builtin_bit_cast(unsigned,b);}
#define WAIT_BAR(N) asm volatile("s_waitcnt vmcnt(" #N ") lgkmcnt(0)\n\ts_barrier":::"memory")

__device__ __forceinline__ void qkt(f32x16&p0,f32x16&p1,const char*Kslot,const bf16x8*qr,int r32,int hi,bf16x8 kx0,bf16x8 kx1,bf16x8 qx){
  const char*kb=Kslot+hi*1024+r32*16;
  #pragma unroll
  for(int d0=0;d0<4;++d0){
    const bf16x8 b0=*reinterpret_cast<const bf16x8*>(kb+d0*2048);
    const bf16x8 b1=*reinterpret_cast<const bf16x8*>(kb+d0*2048+512);
    if(d0==0){p0=__builtin_amdgcn_mfma_f32_32x32x16_bf16(b0,qr[0],f32x16{},0,0,0);p1=__builtin_amdgcn_mfma_f32_32x32x16_bf16(b1,qr[0],f32x16{},0,0,0);}
    else{p0=__builtin_amdgcn_mfma_f32_32x32x16_bf16(b0,qr[d0],p0,0,0,0);p1=__builtin_amdgcn_mfma_f32_32x32x16_bf16(b1,qr[d0],p1,0,0,0);}}
  p0=__builtin_amdgcn_mfma_f32_32x32x16_bf16(kx0,qx,p0,0,0,0);p1=__builtin_amdgcn_mfma_f32_32x32x16_bf16(kx1,qx,p1,0,0,0);
}
typedef __attribute__((address_space(3))) const char* lds_cptr;
typedef short v4i16_t __attribute__((ext_vector_type(4)));
__device__ __forceinline__ void kload8(bf16x8*kf,lds_cptr kp){
  kf[0]=*(const __attribute__((address_space(3))) bf16x8*)(kp);      kf[1]=*(const __attribute__((address_space(3))) bf16x8*)(kp+512);
  kf[2]=*(const __attribute__((address_space(3))) bf16x8*)(kp+2048); kf[3]=*(const __attribute__((address_space(3))) bf16x8*)(kp+2560);
  kf[4]=*(const __attribute__((address_space(3))) bf16x8*)(kp+4096); kf[5]=*(const __attribute__((address_space(3))) bf16x8*)(kp+4608);
  kf[6]=*(const __attribute__((address_space(3))) bf16x8*)(kp+6144); kf[7]=*(const __attribute__((address_space(3))) bf16x8*)(kp+6656);
}
__device__ __forceinline__ void kload2(bf16x8*kf,lds_cptr kp,int j){ kf[2*j]=*(const __attribute__((address_space(3))) bf16x8*)(kp+j*2048); kf[2*j+1]=*(const __attribute__((address_space(3))) bf16x8*)(kp+j*2048+512); }
typedef unsigned u32x2_t __attribute__((ext_vector_type(2)));
__device__ __forceinline__ bf16x8 kxfrag(lds_cptr tbl,int kv,int hi){ u32x2_t b=*(const __attribute__((address_space(3))) u32x2_t*)(tbl+kv*8); if(hi){b.x=0u;b.y=0u;} const u32x4 w={b.x,b.y,hi?0u:0x3F803F80u,0u}; return __builtin_bit_cast(bf16x8,w); }
__device__ __forceinline__ s16x4 vtr(lds_cptr p){ return __builtin_bit_cast(s16x4,__builtin_amdgcn_ds_read_tr16_b64_v4i16((__attribute__((address_space(3))) v4i16_t*)p)); }
__device__ __forceinline__ float rowmax(const f32x16&p0,const f32x16&p1){
  float a=max3f(p0[0],p0[1],p1[0]),b=max3f(p0[2],p0[3],p1[1]);a=max3f(a,p1[2],p1[3]);
  #pragma unroll
  for(int r=4;r<16;r+=4){a=max3f(a,p0[r],p0[r+1]);b=max3f(b,p0[r+2],p0[r+3]);a=max3f(a,p1[r],p1[r+1]);b=max3f(b,p1[r+2],p1[r+3]);}
  const float m=max2f(a,b);
  auto rr=__builtin_amdgcn_permlane32_swap(__float_as_uint(m),__float_as_uint(m),false,false);
  return max2f(__uint_as_float(rr[0]),__uint_as_float(rr[1]));
}
__device__ __forceinline__ void pv(f32x16*o,int vb,bf16x8 pa0,bf16x8 pa1,bf16x8 pa2,bf16x8 pa3){
  #pragma unroll
  for(int d0=0;d0<2;++d0){s16x4 lo[4],hi[4];
    #pragma unroll
    for(int ks=0;ks<4;++ks){
      asm volatile("ds_read_b64_tr_b16 %0,%1 offset:%c2":"=&v"(lo[ks]):"v"(vb),"i"(d0*4096+ks*1024):"memory");
      asm volatile("ds_read_b64_tr_b16 %0,%1 offset:%c2":"=&v"(hi[ks]):"v"(vb),"i"(d0*4096+ks*1024+512):"memory");}
    asm volatile("s_waitcnt lgkmcnt(0)":::"memory");SBAR();
    #define PK(k) (bf16x8){lo[k][0],lo[k][1],lo[k][2],lo[k][3],hi[k][0],hi[k][1],hi[k][2],hi[k][3]}
    o[d0]=__builtin_amdgcn_mfma_f32_32x32x16_bf16(pa0,PK(0),o[d0],0,0,0);
    o[d0]=__builtin_amdgcn_mfma_f32_32x32x16_bf16(pa1,PK(1),o[d0],0,0,0);
    o[d0]=__builtin_amdgcn_mfma_f32_32x32x16_bf16(pa2,PK(2),o[d0],0,0,0);
    o[d0]=__builtin_amdgcn_mfma_f32_32x32x16_bf16(pa3,PK(3),o[d0],0,0,0);
    #undef PK
  }
}

#ifndef ATTN_STORE16
#define ATTN_STORE16(p,v) (*(u32x4*)(p)=(v))
#endif
template<int THRL> __device__ __forceinline__ void attn_unit(int b,int h,int qb,const bf16*Q,const bf16*__restrict__ K,const bf16*__restrict__ V,bf16*O,const float*CUMh,char*shm,const int wv,const float qkb){
  int tid_=wv*64+(int)__builtin_amdgcn_mbcnt_hi(~0u,__builtin_amdgcn_mbcnt_lo(~0u,0u)); asm volatile("":"+v"(tid_)); const int tid=tid_,lane=tid&63,r32=lane&31,hi=lane>>5; const int wid=__builtin_amdgcn_readfirstlane(tid>>6);
  const long rowbase=(long)b*SEQ; const int q0=qb*QB;
  const bf16*Qw=Q+(rowbase+q0+wid*QBLK)*DM+h*D;
  int t0; { const int NTF_=(q0+QB)/KVBLK; const float cref_=CUMh[q0]; const float ce_=(lane<NTF_-4)?CUMh[64*lane+63]:cref_;
    const bool sk_=(lane<NTF_-4)&&(qkb+(cref_-ce_)*1.4426950408889634f<-160.f); const unsigned long long nb_=~__ballot(sk_); t0=__builtin_amdgcn_readfirstlane((int)__builtin_ctzll(nb_))&~1; }
  const bf16*Kh=K+(rowbase+(long)t0*KVBLK)*DM+h*D,*Vh=V+(rowbase+(long)t0*KVBLK)*DM+h*D;
  const unsigned lds0=(unsigned)(uintptr_t)shm;
  float*wsf=(float*)(shm+LDS_WS)+wid*64;
  const bf16*ksrc=Kh+(long)lane*DM+wid*8;
  const bf16*vsrc=Vh+(long)(16*(wid&3)+(lane>>2))*DM+(wid>>2)*32+(lane&3)*8;
  const unsigned kdst=lds0+LDS_K+wid*1024, vdst=lds0+LDS_V+wid*1024;
  #define DMA_K(t,slot) glds16(ksrc+(long)(t)*KVBLK*DM,(unsigned)__builtin_amdgcn_readfirstlane(kdst+(slot)))
  #define DMA_V(t,slot) glds16(vsrc+(long)(t)*KVBLK*DM,(unsigned)__builtin_amdgcn_readfirstlane(vdst+(slot)))
  const int vb0=(int)(lds0+LDS_V)+((lane>>4)&1)*32+(lane&3)*8+(4*hi+((lane&15)>>2))*64;
  const char*Kbase=shm+LDS_K; bf16x8 kf[8];
  const lds_cptr shm3=(lds_cptr)shm; const lds_cptr kp0=shm3+LDS_K+hi*1024+r32*16; const lds_cptr vp0=shm3+LDS_V+((lane>>4)&1)*32+(lane&3)*8+(4*hi+((lane&15)>>2))*64;
  const int NT=(q0+QB)/KVBLK-t0;
  DMA_K(0,0);DMA_V(0,0);DMA_K(1,SLOTB);
  bf16x8 qr[4];
  #pragma unroll
  for(int d0=0;d0<4;++d0)qr[d0]=*reinterpret_cast<const bf16x8*>(&Qw[(long)r32*DM+d0*16+hi*8]);
  const int qrel=wid*QBLK+r32;
  { const float cref=CUMh[q0]; __attribute__((address_space(3))) unsigned*bt=(__attribute__((address_space(3))) unsigned*)(shm3+LDS_BIAS); __attribute__((address_space(3))) float*rb=(__attribute__((address_space(3))) float*)(shm3+LDS_ROWB);
    for(int kv=KVBLK*t0+tid;kv<q0+QB;kv+=NW*64){ const float bias=(cref-CUMh[kv])*1.4426950408889634f;
      const unsigned u1=__builtin_bit_cast(unsigned,bias); const unsigned h1=(u1+0x7fffu+((u1>>16)&1u))&0xffff0000u; const float r1=bias-__builtin_bit_cast(float,h1);
      const unsigned u2=__builtin_bit_cast(unsigned,r1);   const unsigned h2=(u2+0x7fffu+((u2>>16)&1u))&0xffff0000u; const float r2=r1-__builtin_bit_cast(float,h2);
      const unsigned u3=__builtin_bit_cast(unsigned,r2);   const unsigned h3=(u3+0x7fffu+((u3>>16)&1u))&0xffff0000u;
      bt[2*kv]=(h1>>16)|h2; bt[2*kv+1]=(h3>>16)|0x3F800000u; if(kv>=q0)rb[kv-q0]=bias; } }
  const lds_cptr btab=shm3+LDS_BIAS+t0*(KVBLK*8); u32x4 qxw={hi?0u:0x3F803F80u,0u,0u,0u};
  #define QX __builtin_bit_cast(bf16x8,qxw)
  #define RNEHI(u) (((u)+0x7fffu+(((u)>>16)&1u))&0xffff0000u)
  #define SETQX() do{ const float nm_=-mhat; const unsigned a1_=RNEHI(__builtin_bit_cast(unsigned,nm_)); const float s1_=nm_-__builtin_bit_cast(float,a1_); \
      const unsigned a2_=RNEHI(__builtin_bit_cast(unsigned,s1_)); const float s2_=s1_-__builtin_bit_cast(float,a2_); const unsigned a3_=RNEHI(__builtin_bit_cast(unsigned,s2_)); \
      qxw.y=hi?0u:(a1_|0x3F80u); qxw.z=hi?0u:((a2_>>16)|a3_); }while(0)
  float mhat=0.f,l_reg=0.f;f32x16 o[2];o[0]=f32x16{};o[1]=f32x16{};
  #define CMASK(P0,P1,t) do{int jb_=(t)-(NT-4); if(jb_>=0)cmask(P0,P1,jb_,qrel,hi);}while(0)
  bool resc=false;
  #define START(P0,P1) do{ const float rm=rowmax(P0,P1); resc=false; \
    { const float dl=max2f(rm,0.f); mhat=fadd_s(mhat,dl); \
      _Pragma("unroll") for(int r=0;r<16;++r){P0[r]=fsub_s(P0[r],dl);P1[r]=fsub_s(P1[r],dl);} \
      SETQX(); } \
    _Pragma("unroll") for(int r=0;r<16;++r)P0[r]=__builtin_amdgcn_exp2f(P0[r]); }while(0)
  #define RESC() do{ if(resc){ asm volatile("s_waitcnt lgkmcnt(0)":::"memory"); \
      _Pragma("unroll") for(int d_=0;d_<2;++d_) _Pragma("unroll") for(int r=0;r<16;++r)o[d_][r]*=wsf[crow(r,hi)]; } }while(0)
  f32x16 pA0,pA1,pB0,pB1;
  int sl_prev=0,sl_cur=0,sl_next=SLOTB;
  #define ROT() do{sl_prev=sl_cur;sl_cur=sl_next;sl_next=(sl_next==(NSLOT-1)*SLOTB)?0:sl_next+SLOTB;}while(0)
  DMA_K(2,2*SLOTB);
  WAIT_BAR(3);
  mhat=*(const __attribute__((address_space(3))) float*)(shm3+LDS_ROWB+qrel*4);
  SETQX();
  qkt(pA0,pA1,Kbase,qr,r32,hi,kxfrag(btab,r32,hi),kxfrag(btab,32+r32,hi),QX);asm volatile("s_nop 15\n\ts_nop 7":"+v"(pA0),"+v"(pA1));CMASK(pA0,pA1,0);
  START(pA0,pA1);
  _Pragma("unroll") for(int r=0;r<16;++r)pA1[r]=__builtin_amdgcn_exp2f(pA1[r]);
  WAIT_BAR(0);
  DMA_K(3,0);DMA_V(1,SLOTB);
  ROT();
  kload8(kf,kp0+sl_cur);
  WAIT_BAR(2);
  s16x4 vlo[8],vhi[8]; u32x4 pw0,pw1,pw2,pw3;
  #define PKW(P,B) cvtpk_s(P[B],P[B+1])
  #define PAF(k) __builtin_bit_cast(bf16x8,pw##k)
  #define VFR(i) (bf16x8){vlo[i][0],vlo[i][1],vlo[i][2],vlo[i][3],vhi[i][0],vhi[i][1],vhi[i][2],vhi[i][3]}
  #define PIN(x) asm volatile("":"+v"(x))
  #define MX3(a,b,c) __builtin_fmaxf(__builtin_fmaxf((a),(b)),(c))
  #define GAPA(MF,A0,A1,A2,A3,W0,W1,PW) do{ MF; sacc+=A0; sacc+=A1; sacc+=A2; sacc+=A3; PIN(sacc); W0; W1; PIN(PW); SBAR(); }while(0)
  #define EX(v) __builtin_amdgcn_exp2f(v)
  #define GAPB(MF,X,B) do{ MF; X[B]=EX(X[B]); X[B+1]=EX(X[B+1]); X[B+2]=EX(X[B+2]); X[B+3]=EX(X[B+3]); PIN(X); SBAR(); }while(0)
  #define VRD(i) do{ vlo[i]=vtr(vp_+(((i)>>2)*4096+((i)&3)*1024)); vhi[i]=vtr(vp_+(((i)>>2)*4096+((i)&3)*1024+512)); }while(0)
  #define KRD(G,j) do{ if(G){ kload2(kf,kp0+sl_next,j); SBAR(); } }while(0)
  #define STEP(C0,C1,P0,P1,t,GK,GV,GL) do{ SBAR(); \
    const lds_cptr vp_=vp0+sl_prev; \
    const bf16x8 kx0_=kxfrag(btab,64*(t)+r32,hi), kx1_=kxfrag(btab,64*(t)+32+r32,hi); \
    VRD(0); SBAR(); float sacc=(P0[0]+P0[1]); \
    GAPA(C0=__builtin_amdgcn_mfma_f32_32x32x16_bf16(kf[0],qr[0],f32x16{},0,0,0), P0[2],P0[3],P0[4],P0[5],     pw0[0]=PKW(P0,0), pw0[1]=PKW(P0,2), pw0); \
    VRD(4); SBAR(); GAPA(C1=__builtin_amdgcn_mfma_f32_32x32x16_bf16(kf[1],qr[0],f32x16{},0,0,0), P0[6],P0[7],P0[8],P0[9],     pw0[2]=PKW(P0,4), pw0[3]=PKW(P0,6), pw0); \
    VRD(1); SBAR(); GAPA(C0=__builtin_amdgcn_mfma_f32_32x32x16_bf16(kf[2],qr[1],C0,0,0,0),   P0[10],P0[11],P0[12],P0[13], pw1[0]=PKW(P0,8), pw1[1]=PKW(P0,10), pw1); \
    VRD(5); SBAR(); GAPA(C1=__builtin_amdgcn_mfma_f32_32x32x16_bf16(kf[3],qr[1],C1,0,0,0),   P0[14],P0[15],P1[0],P1[1],   pw1[2]=PKW(P0,12),pw1[3]=PKW(P0,14), pw1); \
    VRD(2); SBAR(); GAPA(C0=__builtin_amdgcn_mfma_f32_32x32x16_bf16(kf[4],qr[2],C0,0,0,0),   P1[2],P1[3],P1[4],P1[5],     pw2[0]=PKW(P1,0), pw2[1]=PKW(P1,2), pw2); \
    VRD(6); SBAR(); GAPA(C1=__builtin_amdgcn_mfma_f32_32x32x16_bf16(kf[5],qr[2],C1,0,0,0),   P1[6],P1[7],P1[8],P1[9],     pw2[2]=PKW(P1,4), pw2[3]=PKW(P1,6), pw2); \
    VRD(3); SBAR(); GAPA(C0=__builtin_amdgcn_mfma_f32_32x32x16_bf16(kf[6],qr[3],C0,0,0,0),   P1[10],P1[11],P1[12],P1[13], pw3[0]=PKW(P1,8), pw3[1]=PKW(P1,10), pw3); \
    VRD(7); SBAR(); GAPA(C1=__builtin_amdgcn_mfma_f32_32x32x16_bf16(kf[7],qr[3],C1,0,0,0),   P1[14],P1[15],0.f,0.f,       pw3[2]=PKW(P1,12),pw3[3]=PKW(P1,14), pw3); \
    C0=__builtin_amdgcn_mfma_f32_32x32x16_bf16(kx0_,QX,C0,0,0,0); C1=__builtin_amdgcn_mfma_f32_32x32x16_bf16(kx1_,QX,C1,0,0,0); SBAR(); \
    l_reg+=sacc; \
    if(GK){DMA_K((t)+3,sl_cur);} if(GV){DMA_V((t)+1,sl_next);} \
    CMASK(C0,C1,t); \
    { float a=MX3(C0[0],C0[1],C1[0]),b=MX3(C0[2],C0[3],C1[1]); a=MX3(a,C1[2],C1[3]); \
      _Pragma("unroll") for(int r=4;r<16;r+=4){a=MX3(a,C0[r],C0[r+1]);b=MX3(b,C0[r+2],C0[r+3]);a=MX3(a,C1[r],C1[r+1]);b=MX3(b,C1[r+2],C1[r+3]);} \
      float rm=__builtin_fmaxf(a,b); { auto rr=__builtin_amdgcn_permlane32_swap(__float_as_uint(rm),__float_as_uint(rm),false,false); rm=__builtin_fmaxf(__uint_as_float(rr[0]),__uint_as_float(rr[1])); } \
      resc=false; \
      if(__builtin_expect(__any(rm>(float)THRL),0)){ const float dl=__builtin_fmaxf(rm,0.f); mhat+=dl; \
        _Pragma("unroll") for(int r=0;r<16;++r){C0[r]-=dl;C1[r]-=dl;} \
        SETQX(); \
        const float f=__builtin_amdgcn_exp2f(-dl); l_reg*=f; if(hi==0)wsf[r32]=f; resc=true; } } \
    SBAR(); \
    GAPB(o[0]=__builtin_amdgcn_mfma_f32_32x32x16_bf16(PAF(0),VFR(0),o[0],0,0,0), C0,0); \
    GAPB(o[1]=__builtin_amdgcn_mfma_f32_32x32x16_bf16(PAF(0),VFR(4),o[1],0,0,0), C0,4); \
    KRD(GL,0); GAPB(o[0]=__builtin_amdgcn_mfma_f32_32x32x16_bf16(PAF(1),VFR(1),o[0],0,0,0), C0,8); \
    KRD(GL,1); GAPB(o[1]=__builtin_amdgcn_mfma_f32_32x32x16_bf16(PAF(1),VFR(5),o[1],0,0,0), C0,12); \
    KRD(GL,2); GAPB(o[0]=__builtin_amdgcn_mfma_f32_32x32x16_bf16(PAF(2),VFR(2),o[0],0,0,0), C1,0); \
    KRD(GL,3); GAPB(o[1]=__builtin_amdgcn_mfma_f32_32x32x16_bf16(PAF(2),VFR(6),o[1],0,0,0), C1,4); \
    GAPB(o[0]=__builtin_amdgcn_mfma_f32_32x32x16_bf16(PAF(3),VFR(3),o[0],0,0,0), C1,8); \
    GAPB(o[1]=__builtin_amdgcn_mfma_f32_32x32x16_bf16(PAF(3),VFR(7),o[1],0,0,0), C1,12); \
    }while(0)
  int t=1;
  #undef CMASK
  #define CMASK(P0,P1,t) do{}while(0)
  for(;t+5<NT;t+=2){
    STEP(pB0,pB1,pA0,pA1,t,true,true,true);     WAIT_BAR(2); RESC(); ROT();
    STEP(pA0,pA1,pB0,pB1,t+1,true,true,true);   WAIT_BAR(2); RESC(); ROT();
  }
  #undef CMASK
  #define CMASK(P0,P1,t) do{int jb_=(t)-(NT-4); if(jb_>=0)cmask(P0,P1,jb_,qrel,hi);}while(0)
  #define ENDW(tt) do{ if((tt)+3<NT){WAIT_BAR(2);} else if((tt)+2<NT){WAIT_BAR(1);} else {WAIT_BAR(0);} }while(0)
  for(;t+1<NT;t+=2){
    STEP(pB0,pB1,pA0,pA1,t,(t+3<NT),(t+1<NT),(t+1<NT));       ENDW(t);   RESC(); ROT();
    STEP(pA0,pA1,pB0,pB1,t+1,(t+4<NT),(t+2<NT),(t+2<NT));     ENDW(t+1); RESC(); ROT();
  }
  STEP(pB0,pB1,pA0,pA1,NT-1,false,false,false); RESC();
  { float sacc=pB0[0]+pB0[1]; _Pragma("unroll") for(int r=2;r<16;++r)sacc+=pB0[r]; _Pragma("unroll") for(int r=0;r<16;++r)sacc+=pB1[r]; l_reg+=sacc;
    pw0=(u32x4){PKW(pB0,0),PKW(pB0,2),PKW(pB0,4),PKW(pB0,6)};pw1=(u32x4){PKW(pB0,8),PKW(pB0,10),PKW(pB0,12),PKW(pB0,14)};pw2=(u32x4){PKW(pB1,0),PKW(pB1,2),PKW(pB1,4),PKW(pB1,6)};pw3=(u32x4){PKW(pB1,8),PKW(pB1,10),PKW(pB1,12),PKW(pB1,14)};
    SBAR(); pv(o,vb0+sl_cur,PAF(0),PAF(1),PAF(2),PAF(3)); }
  #undef PKW
  #undef PAF
  #undef VFR
  #undef PIN
  #undef MX3
  #undef GAPA
  #undef GAPB
  #undef EX
  #undef VRD
  #undef KRD
  #undef STEP
  #undef ENDW
  {auto rr=__builtin_amdgcn_permlane32_swap(__float_as_uint(l_reg),__float_as_uint(l_reg),false,false);l_reg=__uint_as_float(rr[0])+__uint_as_float(rr[1]);}
  if(hi==0)wsf[32+r32]=l_reg;asm volatile("s_waitcnt lgkmcnt(0)":::"memory");
  float rli[16];
  #pragma unroll
  for(int r=0;r<16;++r)rli[r]=__builtin_amdgcn_rcpf(wsf[32+crow(r,hi)]);
  bf16*Ow=O+(rowbase+q0+wid*QBLK)*OP+h*D;
  { bf16*stg=(bf16*)(shm+LDS_OST)+wid*2048;
    #pragma unroll
    for(int r=0;r<16;++r){const int orow=crow(r,hi);
      #pragma unroll
      for(int d0=0;d0<2;++d0)stg[orow*64+d0*32+r32]=__float2bfloat16(o[d0][r]*rli[r]);}
    asm volatile("s_waitcnt lgkmcnt(0)":::"memory");
    #pragma unroll
    for(int i=0;i<4;++i){const int row=i*8+(lane>>3),ch=lane&7; const u32x4 v=*(const u32x4*)(stg+row*64+ch*8); ATTN_STORE16(Ow+(long)row*OP+ch*8,v);} }
  asm volatile("s_waitcnt lgkmcnt(0)\n\ts_barrier":::"memory");
  #undef DMA_K
  #undef QX
  #undef RNEHI
  #undef SETQX
  #undef DMA_V
  #undef CMASK
  #undef START
  #undef RESC
  #undef ROT
}
constexpr int ATTN_LDS_BYTES=LDS_BYTES;
struct AttnTensors { const bf16* Q; const bf16* K; const bf16* V; bf16* O; const float* CUM; const unsigned* QKN; };
struct AttnUnit { int bh; int qb; };
struct StaticOrder {
  int c,G;
  __device__ __forceinline__ StaticOrder(int grid,int block):c(block),G(grid){}
  __device__ __forceinline__ bool next(int i,AttnUnit&u)const{ const int it=i*G+c; if(it>=BATCH*NHEAD*NQB)return false; u.bh=it%(BATCH*NHEAD); u.qb=NQB-1-it/(BATCH*NHEAD); return true; }
};
template<class Sched,int THRL=8> __device__ __forceinline__ void attn_phase(char*lds,const AttnTensors&T,const Sched&S,const int wv){
  AttnUnit u;
  for(int i=0;S.next(i,u);++i){ const unsigned*n4=T.QKN+u.bh*4; const float qkb=1.03f*sqrtf(__builtin_bit_cast(float,n4[0])+__builtin_bit_cast(float,n4[1]))*sqrtf(__builtin_bit_cast(float,n4[2])+__builtin_bit_cast(float,n4[3]))+1.0f;
    attn_unit<THRL>(u.bh/NHEAD,u.bh%NHEAD,u.qb,T.Q,T.K,T.V,T.O,T.CUM+(size_t)u.bh*SEQ,lds,wv,qkb); }
}
#undef SBAR
#undef WAIT_BAR
}

namespace mls {
typedef short bf16x8 __attribute__((ext_vector_type(8)));
typedef float f32x4v __attribute__((ext_vector_type(4)));
typedef unsigned u32x2v __attribute__((ext_vector_type(2)));
typedef unsigned u32x4v __attribute__((ext_vector_type(4)));
constexpr int QS = 136, TS = 72;
constexpr int L_Q = 0, L_K = 17408, L_KT = 34816, L_VT = 53248, L_WVT = 73984, L_SC = 94720, L_END = 103936;
constexpr float QK_SCALE = 0.08838834764831845f;
constexpr size_t G_A = 2 * MiB, G_RT = 3 * MiB, G_IT = 4 * MiB, G_EM = 5 * MiB, G_WK = 6 * MiB, G_CD = 7 * MiB, G_DL = 8 * MiB, G_UN = 9 * MiB, G_HALO = 11 * MiB;
__device__ __forceinline__ float scan_add(float v, int lane) {
#pragma unroll
    for (int o = 1; o < 64; o <<= 1) { const float t = bperm(v, (lane - o) & 63); if (lane >= o) v += t; }
    return v; }
__device__ __forceinline__ float scan_max(float v, int lane) {
#pragma unroll
    for (int o = 1; o < 64; o <<= 1) { const float t = bperm(v, (lane - o) & 63); if (lane >= o) v = fmaxf(v, t); }
    return v; }
__device__ __forceinline__ float lo_bf(unsigned w) { return __builtin_bit_cast(float, w << 16); }
__device__ __forceinline__ float hi_bf(unsigned w) { return __builtin_bit_cast(float, w & 0xffff0000u); }
typedef float f32x2_t __attribute__((ext_vector_type(2))); typedef __bf16 bf16x2_t __attribute__((ext_vector_type(2)));
__device__ __forceinline__ unsigned cvtpk(float lo, float hi) { f32x2_t v = {lo, hi}; bf16x2_t b = __builtin_convertvector(v, bf16x2_t); return __builtin_bit_cast(unsigned, b); }
__device__ __forceinline__ float fsilu(float v) { return v * __builtin_amdgcn_rcpf(1.f + __builtin_amdgcn_exp2f(-1.4426950408889634f * v)); }
}
__device__ __forceinline__ void phase_mgates(Frame& F, const float* SG) {
    using namespace mls;
    const int ptid = opaque_tid(F.wave), plane = ptid & 63, pwave = __builtin_amdgcn_readfirstlane(ptid >> 6);
    const int gw = blockIdx.x * NWAVES + pwave, NGW = F.G * NWAVES;
    float* GA = (float*)(F.ws + G_A); float* GPM = (float*)(F.ws + G_RT); float* GB = (float*)(F.ws + G_IT); float* GP63 = (float*)(F.ws + G_WK); float* GG = GP63 + BATCH * MLH * 32;
    for (int task = gw; task < BATCH * MLH * 32; task += NGW) {
        const int bh = task >> 5, c = task & 31, b = bh >> 2, h = bh & 3;
        const size_t row = (size_t)b * SEQ + 64 * c + plane;
        const float ig = SG[row * 16 + 8 + h], lf = SG[row * 16 + 12 + h];
        const float bcum = scan_add(lf, plane), aval = ig - bcum, pm = scan_max(aval, plane);
        const size_t idx = (size_t)bh * SEQ + 64 * c + plane;
        GA[idx] = aval; GPM[idx] = pm; GB[idx] = bcum;
        if (plane == 63) { GP63[task] = pm; GG[task] = bcum; }
    }
}
__device__ __forceinline__ void phase_mprep(Frame& F, const bf16* PA, const float* convw, const float* convb, bf16* SCR) {
    using namespace mls;
    const int tid = opaque_tid(F.wave), lane = tid & 63, wid = __builtin_amdgcn_readfirstlane(tid >> 6), l15 = lane & 15, q4 = lane >> 4;
    LAS unsigned char* L = F.lds;
    const float* GA = (const float*)(F.ws + G_A); const float* GPM = (const float*)(F.ws + G_RT); const float* GB = (const float*)(F.ws + G_IT); const float* GP63 = (const float*)(F.ws + G_WK); const float* GG = GP63 + BATCH * MLH * 32;
    float* GEM = (float*)(F.ws + G_EM); float* GCD = (float*)(F.ws + G_CD);
    float* DL = (float*)(F.ws + G_DL); float* UN = (float*)(F.ws + G_UN);
    const int ch2 = tid & 127, tq = __builtin_amdgcn_readfirstlane(tid >> 7); const bool isk = (wid & 1) != 0;
    const int cc = (ch2 & 63) * 2;
    const int e2 = tid & 63, sg = __builtin_amdgcn_readfirstlane(tid >> 6);
    const __amdgpu_buffer_rsrc_t rsP = __builtin_amdgcn_make_buffer_rsrc((void*)PA, 0, M * PJA * 2, 0x00020000), rsS = __builtin_amdgcn_make_buffer_rsrc((void*)SCR, 0, M * D * 4, 0x00020000);
    constexpr int S_QI = 0, S_UT = M * 512 * 2, S_NL = M * 1536 * 2;
    __syncthreads();
    for (int i = tid; i < 16 * TS / 2; i += NTHR) { ((LAS unsigned*)(L + L_VT + 128 * TS * 2))[i] = (i < TS / 2) ? 0x3F803F80u : 0u; ((LAS unsigned*)(L + L_WVT + 128 * TS * 2))[i] = 0u; }
    unsigned raw[19], vraw[8]; float g_pm, g_b, g_a, g_p63, g_g;
#define MP_BAR() asm volatile("s_waitcnt lgkmcnt(0)\n\ts_barrier" ::: "memory")
#define MP_LOAD(item) do { const int bh_ = (item) >> 5, c_ = (item) & 31, b_ = bh_ >> 2, h_ = bh_ & 3; const int r0_ = b_ * SEQ + 64 * c_; \
        const unsigned lo_raw_ = (unsigned)((isk ? PC_MK : PC_MQ) + h_ * 128 + cc) * 2u, lo_v_ = (unsigned)(PC_MV + h_ * 128 + 2 * e2) * 2u; \
        _Pragma("unroll") for (int i_ = 0; i_ < 19; ++i_) { const int tr_ = 16 * tq - 3 + i_; raw[i_] = (64 * c_ + tr_ >= 0) ? __builtin_amdgcn_raw_buffer_load_b32(rsP, lo_raw_, (r0_ + tr_) * (PJA * 2), 0) : 0u; } \
        _Pragma("unroll") for (int i_ = 0; i_ < 8; ++i_) vraw[i_] = __builtin_amdgcn_raw_buffer_load_b32(rsP, lo_v_, (r0_ + 8 * sg + i_) * (PJA * 2), 0); \
        const size_t gi_ = (size_t)bh_ * SEQ + 64 * c_ + lane; g_pm = GPM[gi_]; g_b = GB[gi_]; g_a = GA[gi_]; g_p63 = GP63[bh_ * 32 + (lane & 31)]; g_g = GG[bh_ * 32 + (lane & 31)]; } while (0)
    int it = blockIdx.x;
    if (it < BATCH * MLH * 32) MP_LOAD(it);
    for (; it < BATCH * MLH * 32; it += F.G) {
        const int bh = it >> 5, c = it & 31, b = bh >> 2, h = bh & 3; const int row0 = b * SEQ + 64 * c;
        const int cch = (isk ? 512 : 0) + h * 128 + cc;
        float w0[2], w1[2], w2[2], w3[2], cb[2];
#pragma unroll
        for (int i = 0; i < 2; ++i) { w0[i] = convw[cch + i]; w1[i] = convw[1024 + cch + i]; w2[i] = convw[2048 + cch + i]; w3[i] = convw[3072 + cch + i]; cb[i] = convb[cch + i]; }
        float mcar = 0.f;
        for (int cp = 0; cp < c; ++cp) mcar = rdl(g_g, cp) + fmaxf(mcar, rdl(g_p63, cp));
        const float Mx = fmaxf(mcar, rdl(g_p63, c)), mrow = fmaxf(g_pm, mcar);
        const float rowterm = -mrow, inter = __expf(mcar - mrow), aval = g_a, wk = __expf(g_a - Mx);
        if (wid == 0) { GEM[(size_t)bh * SEQ + 64 * c + lane] = __expf(-(g_b + mrow)); if (lane == 0) GCD[bh * 32 + c] = __expf(mcar - Mx); }
        {
            unsigned kt0[8], kt1[8];
#pragma unroll
            for (int i = 0; i < 16; i += 2) {
                float y[2][2];
#pragma unroll
                for (int u = 0; u < 2; ++u) {
                    const float a0 = w0[0] * lo_bf(raw[i + u]) + w1[0] * lo_bf(raw[i + u + 1]) + w2[0] * lo_bf(raw[i + u + 2]) + w3[0] * lo_bf(raw[i + u + 3]) + cb[0];
                    const float a1 = w0[1] * hi_bf(raw[i + u]) + w1[1] * hi_bf(raw[i + u + 1]) + w2[1] * hi_bf(raw[i + u + 2]) + w3[1] * hi_bf(raw[i + u + 3]) + cb[1];
                    y[u][0] = fsilu(a0); y[u][1] = fsilu(a1);
                    const int t = 16 * tq + i + u;
                    if (!isk) { const float q0 = y[u][0] * QK_SCALE, q1 = y[u][1] * QK_SCALE; const float itv = rdl(inter, t);
                        *(LAS unsigned*)(L + L_Q + (t * QS + cc) * 2) = cvtpk(q0, q1);
                        __builtin_amdgcn_raw_buffer_store_b32(cvtpk(q0 * itv, q1 * itv), rsS, (unsigned)((cc >> 5) * 1024 + ((cc >> 3) & 3) * 256 + (cc & 7) * 2), S_QI + (it * 4 + (t >> 4)) * 4096 + (t & 15) * 16, 0); }
                    else *(LAS unsigned*)(L + L_K + (t * QS + cc) * 2) = cvtpk(y[u][0], y[u][1]);
                }
                kt0[i >> 1] = cvtpk(y[0][0], y[1][0]); kt1[i >> 1] = cvtpk(y[0][1], y[1][1]);
            }
            if (isk) {
                *(LAS u32x4v*)(L + L_KT + (cc * TS + 16 * tq) * 2) = (u32x4v){kt0[0], kt0[1], kt0[2], kt0[3]}; *(LAS u32x4v*)(L + L_KT + (cc * TS + 16 * tq + 8) * 2) = (u32x4v){kt0[4], kt0[5], kt0[6], kt0[7]};
                *(LAS u32x4v*)(L + L_KT + ((cc + 1) * TS + 16 * tq) * 2) = (u32x4v){kt1[0], kt1[1], kt1[2], kt1[3]}; *(LAS u32x4v*)(L + L_KT + ((cc + 1) * TS + 16 * tq + 8) * 2) = (u32x4v){kt1[4], kt1[5], kt1[6], kt1[7]};
            }
            float v0[8], v1[8], wv[8];
#pragma unroll
            for (int i = 0; i < 8; ++i) { v0[i] = lo_bf(vraw[i]); v1[i] = hi_bf(vraw[i]); wv[i] = rdl(wk, 8 * sg + i); }
            *(LAS u32x4v*)(L + L_VT + ((2 * e2) * TS + 8 * sg) * 2) = (u32x4v){cvtpk(v0[0], v0[1]), cvtpk(v0[2], v0[3]), cvtpk(v0[4], v0[5]), cvtpk(v0[6], v0[7])};
            *(LAS u32x4v*)(L + L_VT + ((2 * e2 + 1) * TS + 8 * sg) * 2) = (u32x4v){cvtpk(v1[0], v1[1]), cvtpk(v1[2], v1[3]), cvtpk(v1[4], v1[5]), cvtpk(v1[6], v1[7])};
            *(LAS u32x4v*)(L + L_WVT + ((2 * e2) * TS + 8 * sg) * 2) = (u32x4v){cvtpk(v0[0] * wv[0], v0[1] * wv[1]), cvtpk(v0[2] * wv[2], v0[3] * wv[3]), cvtpk(v0[4] * wv[4], v0[5] * wv[5]), cvtpk(v0[6] * wv[6], v0[7] * wv[7])};
            *(LAS u32x4v*)(L + L_WVT + ((2 * e2 + 1) * TS + 8 * sg) * 2) = (u32x4v){cvtpk(v1[0] * wv[0], v1[1] * wv[1]), cvtpk(v1[2] * wv[2], v1[3] * wv[3]), cvtpk(v1[4] * wv[4], v1[5] * wv[5]), cvtpk(v1[6] * wv[6], v1[7] * wv[7])};
            if (wid == 0) *(LAS unsigned short*)(L + L_WVT + (128 * TS + lane) * 2) = (unsigned short)f2bf(wk);
        }
        if (it + F.G < BATCH * MLH * 32) MP_LOAD(it + F.G);
        MP_BAR();
        {
            const int tt = wid >> 1;
#pragma unroll
            for (int si = 0; si < 2; ++si) {
                const int ss = 2 * (wid & 1) + si;
                f32x4v acc = (f32x4v){0.f, 0.f, 0.f, 0.f};
                if (ss <= tt) {
#pragma unroll
                    for (int kd = 0; kd < 4; ++kd) {
                        const bf16x8 a = *(const LAS bf16x8*)(L + L_Q + ((16 * tt + l15) * QS + 32 * kd + 8 * q4) * 2);
                        const bf16x8 bb = *(const LAS bf16x8*)(L + L_K + ((16 * ss + l15) * QS + 32 * kd + 8 * q4) * 2);
                        acc = __builtin_amdgcn_mfma_f32_16x16x32_bf16(a, bb, acc, 0, 0, 0);
                    }
                }
                const int s = 16 * ss + l15; const float as_ = bperm(aval, s);
#pragma unroll
                for (int j = 0; j < 4; ++j) { const int t = 16 * tt + 4 * q4 + j; const float rt = bperm(rowterm, t);
                    const float dv = (s <= t) ? acc[j] * __expf(rt + as_) : 0.f;
                    *(LAS unsigned short*)(L + L_SC + (t * TS + s) * 2) = (unsigned short)f2bf(dv); }
            }
        }
        {
            const int db = wid;
#pragma unroll
            for (int eg = 0; eg < 9; ++eg) {
                f32x4v acc = (f32x4v){0.f, 0.f, 0.f, 0.f};
#pragma unroll
                for (int ks = 0; ks < 2; ++ks) {
                    const bf16x8 a = *(const LAS bf16x8*)(L + L_KT + ((16 * db + l15) * TS + 32 * ks + 8 * q4) * 2);
                    const bf16x8 bb = *(const LAS bf16x8*)(L + L_WVT + ((16 * eg + l15) * TS + 32 * ks + 8 * q4) * 2);
                    acc = __builtin_amdgcn_mfma_f32_16x16x32_bf16(a, bb, acc, 0, 0, 0);
                }
                if (eg < 8) { const int e = 16 * eg + l15;
                    __builtin_amdgcn_raw_buffer_store_b64((u32x2v){cvtpk(acc[0], acc[1]), cvtpk(acc[2], acc[3])}, rsS, (unsigned)((((q4 >> 1) * 16 + l15) * 16) + 8 * (q4 & 1)), S_UT + ((it * 8 + eg) * 4 + (db >> 1)) * 1024 + ((2 * db) & 3) * 256, 0); (void)e; }
                else if (l15 == 0) *(u32x2v*)((char*)UN + ((size_t)(it * 4 + (db >> 1)) * 4 + (((2 * db) & 3) + (q4 >> 1))) * 16 + 8 * (q4 & 1)) = (u32x2v){cvtpk(acc[0], acc[1]), cvtpk(acc[2], acc[3])};
            }
        }
        MP_BAR();
        for (int p = wid; p < 36; p += NWAVES) {
            const int tt = p & 3, eg = p >> 2;
            f32x4v acc = (f32x4v){0.f, 0.f, 0.f, 0.f};
#pragma unroll
            for (int ks = 0; ks < 2; ++ks) {
                const bf16x8 a = *(const LAS bf16x8*)(L + L_VT + ((16 * eg + l15) * TS + 32 * ks + 8 * q4) * 2);
                const bf16x8 bb = *(const LAS bf16x8*)(L + L_SC + ((16 * tt + l15) * TS + 32 * ks + 8 * q4) * 2);
                acc = __builtin_amdgcn_mfma_f32_16x16x32_bf16(a, bb, acc, 0, 0, 0);
            }
            if (eg < 8) __builtin_amdgcn_raw_buffer_store_b64((u32x2v){cvtpk(acc[0], acc[1]), cvtpk(acc[2], acc[3])}, rsS, (unsigned)lane * 8u, S_NL + ((it * 8 + eg) * 4 + tt) * 512, 0);
            else if (q4 == 0) DL[(size_t)(row0 + 16 * tt + l15) * 4 + h] = acc[0];
        }
        MP_BAR();
    }
#undef MP_LOAD
#undef MP_BAR
}
__device__ __forceinline__ void phase_mchain(Frame& F, const bf16* SCR, const bf16* PB, bf16* AO) {
    using namespace mls;
    const int tid = opaque_tid(F.wave), lane = tid & 63, wid = __builtin_amdgcn_readfirstlane(tid >> 6), l15 = lane & 15, q4 = lane >> 4;
    const float* GEM = (const float*)(F.ws + G_EM); const float* GCD = (const float*)(F.ws + G_CD); const float* DL = (const float*)(F.ws + G_DL); const float* UN = (const float*)(F.ws + G_UN);
    constexpr int S_QI = 0, S_UT = M * 512 * 2, S_NL = M * 1536 * 2;
    const __amdgpu_buffer_rsrc_t rsP = __builtin_amdgcn_make_buffer_rsrc((void*)SCR, 0, M * D * 4, 0x00020000), rsB = __builtin_amdgcn_make_buffer_rsrc((void*)PB, 0, M * PJB * 2, 0x00020000),
                                 rsO = __builtin_amdgcn_make_buffer_rsrc((void*)AO, 0, M * D * 2, 0x00020000), rsE = __builtin_amdgcn_make_buffer_rsrc((void*)GEM, 0, BATCH * MLH * SEQ * 4, 0x00020000),
                                 rsD = __builtin_amdgcn_make_buffer_rsrc((void*)DL, 0, M * 16, 0x00020000), rsU = __builtin_amdgcn_make_buffer_rsrc((void*)UN, 0, BATCH * MLH * 32 * 128 * 2, 0x00020000);
    const unsigned lo_o = (unsigned)(l15 * D + 4 * q4) * 2u, lo_m = (unsigned)(l15 * PJB + 4 * q4) * 2u, lo_d = (unsigned)l15 * 16u, lo_e = (unsigned)l15 * 4u;
    const int th = wid >> 2;
    for (int id = blockIdx.x * 4 + (wid & 3); id < BATCH * MLH * 8; id += F.G * 4) {
        const int bh = id >> 3, eg = id & 7, b = bh >> 2, h = bh & 3;
        const int r00 = b * SEQ;
        float Cst[4][8], nst[4][8];
#pragma unroll
        for (int kd = 0; kd < 4; ++kd)
#pragma unroll
            for (int j = 0; j < 8; ++j) { Cst[kd][j] = 0.f; nst[kd][j] = 0.f; }
        u32x4v qfA[2][4], qfB[2][4], ut[4], un[4]; u32x2v nlA[2], moA[2], nlB[2], moB[2]; float dlA[2], emA[2], dlB[2], emB[2], cd;
#define MC_LOADQ(c, qf) do { const int it_ = bh * 32 + (c); \
            _Pragma("unroll") for (int t2_ = 0; t2_ < 2; ++t2_) \
                _Pragma("unroll") for (int kd_ = 0; kd_ < 4; ++kd_) qf[t2_][kd_] = __builtin_amdgcn_raw_buffer_load_b128(rsP, (unsigned)lane * 16u, S_QI + ((it_ * 4 + 2 * th + t2_) * 4 + kd_) * 1024, 0); } while (0)
#define MC_LOADS(c, nl, mo, dl, em) do { const int r0_ = r00 + 64 * (c), it_ = bh * 32 + (c); \
            _Pragma("unroll") for (int t2_ = 0; t2_ < 2; ++t2_) { const int rt_ = r0_ + 16 * (2 * th + t2_); \
                nl[t2_] = __builtin_amdgcn_raw_buffer_load_b64(rsP, (unsigned)lane * 8u, S_NL + ((it_ * 8 + eg) * 4 + 2 * th + t2_) * 512, 0); mo[t2_] = __builtin_amdgcn_raw_buffer_load_b64(rsB, lo_m, (rt_ * PJB + PB_MO + h * 128 + 16 * eg) * 2, 0); \
                dl[t2_] = __builtin_bit_cast(float, __builtin_amdgcn_raw_buffer_load_b32(rsD, lo_d, (rt_ * 4 + h) * 4, 0)); em[t2_] = __builtin_bit_cast(float, __builtin_amdgcn_raw_buffer_load_b32(rsE, lo_e, (bh * SEQ + 64 * (c) + 16 * (2 * th + t2_)) * 4, 0)); } } while (0)
#define MC_LOADU(c) do { const int it_ = bh * 32 + (c); \
            _Pragma("unroll") for (int kd_ = 0; kd_ < 4; ++kd_) { ut[kd_] = __builtin_amdgcn_raw_buffer_load_b128(rsP, (unsigned)lane * 16u, S_UT + ((it_ * 8 + eg) * 4 + kd_) * 1024, 0); \
                un[kd_] = __builtin_amdgcn_raw_buffer_load_b128(rsU, (unsigned)q4 * 16u, (it_ * 4 + kd_) * 64, 0); } \
            cd = GCD[it_]; } while (0)
#define MC_STEP(c, qf, nl, mo, dl, em, qfN, nlN, moN, dlN, emN) do { const int r0_ = r00 + 64 * (c); \
            if ((c) + 1 < SEQ / 64) { MC_LOADQ((c) + 1, qfN); MC_LOADS((c) + 1, nlN, moN, dlN, emN); } \
            f32x4v acc_[2], accd_[2]; \
            _Pragma("unroll") for (int t2_ = 0; t2_ < 2; ++t2_) { acc_[t2_] = (f32x4v){lo_bf(nl[t2_].x), hi_bf(nl[t2_].x), lo_bf(nl[t2_].y), hi_bf(nl[t2_].y)}; accd_[t2_] = (f32x4v){q4 == 0 ? dl[t2_] : 0.f, 0.f, 0.f, 0.f}; } \
            _Pragma("unroll") for (int kd_ = 0; kd_ < 4; ++kd_) { \
                const bf16x8 af_ = __builtin_bit_cast(bf16x8, (u32x4v){cvtpk(Cst[kd_][0], Cst[kd_][1]), cvtpk(Cst[kd_][2], Cst[kd_][3]), cvtpk(Cst[kd_][4], Cst[kd_][5]), cvtpk(Cst[kd_][6], Cst[kd_][7])}); \
                const bf16x8 nf_ = __builtin_bit_cast(bf16x8, (u32x4v){cvtpk(nst[kd_][0], nst[kd_][1]), cvtpk(nst[kd_][2], nst[kd_][3]), cvtpk(nst[kd_][4], nst[kd_][5]), cvtpk(nst[kd_][6], nst[kd_][7])}); \
                _Pragma("unroll") for (int t2_ = 0; t2_ < 2; ++t2_) { acc_[t2_] = __builtin_amdgcn_mfma_f32_16x16x32_bf16(af_, __builtin_bit_cast(bf16x8, qf[t2_][kd_]), acc_[t2_], 0, 0, 0); \
                    accd_[t2_] = __builtin_amdgcn_mfma_f32_16x16x32_bf16(nf_, __builtin_bit_cast(bf16x8, qf[t2_][kd_]), accd_[t2_], 0, 0, 0); } } \
            _Pragma("unroll") for (int t2_ = 0; t2_ < 2; ++t2_) { \
                const float den_ = bperm(accd_[t2_][0], l15); const float rd_ = 1.0f / fmaxf(fabsf(den_), em[t2_]); \
                const float o0_ = acc_[t2_][0] * rd_ * lo_bf(mo[t2_].x), o1_ = acc_[t2_][1] * rd_ * hi_bf(mo[t2_].x), o2_ = acc_[t2_][2] * rd_ * lo_bf(mo[t2_].y), o3_ = acc_[t2_][3] * rd_ * hi_bf(mo[t2_].y); \
                __builtin_amdgcn_raw_buffer_store_b64((u32x2v){cvtpk(o0_, o1_), cvtpk(o2_, o3_)}, rsO, lo_o, ((r0_ + 16 * (2 * th + t2_)) * D + 512 + h * 128 + 16 * eg) * 2, 0); } \
            _Pragma("unroll") for (int kd_ = 0; kd_ < 4; ++kd_) { const unsigned uw_[4] = {ut[kd_].x, ut[kd_].y, ut[kd_].z, ut[kd_].w}; const unsigned nw_[4] = {un[kd_].x, un[kd_].y, un[kd_].z, un[kd_].w}; \
                _Pragma("unroll") for (int j_ = 0; j_ < 4; ++j_) { Cst[kd_][2 * j_] = cd * Cst[kd_][2 * j_] + lo_bf(uw_[j_]); Cst[kd_][2 * j_ + 1] = cd * Cst[kd_][2 * j_ + 1] + hi_bf(uw_[j_]); \
                    nst[kd_][2 * j_] = (l15 == 0) ? cd * nst[kd_][2 * j_] + lo_bf(nw_[j_]) : 0.f; nst[kd_][2 * j_ + 1] = (l15 == 0) ? cd * nst[kd_][2 * j_ + 1] + hi_bf(nw_[j_]) : 0.f; } } \
            if ((c) + 1 < SEQ / 64) MC_LOADU((c) + 1); } while (0)
        MC_LOADQ(0, qfA); MC_LOADS(0, nlA, moA, dlA, emA); MC_LOADU(0);
        for (int c = 0; c < SEQ / 64; c += 2) {
            MC_STEP(c, qfA, nlA, moA, dlA, emA, qfB, nlB, moB, dlB, emB);
            MC_STEP(c + 1, qfB, nlB, moB, dlB, emB, qfA, nlA, moA, dlA, emA);
        }
#undef MC_LOADQ
#undef MC_LOADS
#undef MC_LOADU
#undef MC_STEP
    }
}

__device__ __forceinline__ void phase_mlstm_fused(Frame& F, const bf16* P, const bf16* PBg, const float* SG, const float* convw, const float* convb, bf16* AO) {
    using namespace mls;
    constexpr int L_Q = 0, L_QI = 17408, L_K = 34816, L_KT = 52224, L_VT = 70656, L_WVT = 82176, L_SC = 93696, L_CT = 102912, L_DEN = 124672;
    const float* GA = (const float*)(F.ws + G_A); const float* GPM = (const float*)(F.ws + G_RT); const float* GB = (const float*)(F.ws + G_IT); const float* GP63 = (const float*)(F.ws + G_WK); const float* GG = GP63 + BATCH * MLH * 32;
#define ML_BAR() asm volatile("s_waitcnt lgkmcnt(0)\n\ts_barrier" ::: "memory")
    const int tid = opaque_tid(F.wave), lane = tid & 63, wid = __builtin_amdgcn_readfirstlane(tid >> 6), l15 = lane & 15, q4 = lane >> 4;
    LAS unsigned char* L = F.lds;
    for (int it = blockIdx.x; it < BATCH * MLH * 2; it += F.G) {
        const int vh = it & 1, bh = it >> 1, b = bh / MLH, h = bh % MLH;
        const size_t row00 = (size_t)b * SEQ;
        const int ch2 = tid & 127, tq = __builtin_amdgcn_readfirstlane(tid >> 7); const bool isk = (wid & 1) != 0;
        const int cc = (ch2 & 63) * 2;
        const int pcol = (isk ? PC_MK : PC_MQ) + h * 128 + cc, cch = (isk ? 512 : 0) + h * 128 + cc;
        float w0[2], w1[2], w2[2], w3[2], cb[2];
#pragma unroll
        for (int i = 0; i < 2; ++i) { w0[i] = convw[cch + i]; w1[i] = convw[1024 + cch + i]; w2[i] = convw[2048 + cch + i]; w3[i] = convw[3072 + cch + i]; cb[i] = convb[cch + i]; }
        const int e2 = tid & 31, sg = tid >> 5;
        const int vcol = PC_MV + h * 128 + vh * 64 + 2 * e2;
        f32x4v Cacc[8];
#pragma unroll
        for (int i = 0; i < 8; ++i) Cacc[i] = (f32x4v){0.f, 0.f, 0.f, 0.f};
        float mcar = 0.f;
        __syncthreads();
        for (int i = tid; i < 80 * QS / 2; i += NTHR) ((LAS unsigned*)(L + L_CT))[i] = 0u;
        for (int i = tid; i < 16 * TS / 2; i += NTHR) { ((LAS unsigned*)(L + L_VT + 64 * TS * 2))[i] = (i < TS / 2) ? 0x3F803F80u : 0u; ((LAS unsigned*)(L + L_WVT + 64 * TS * 2))[i] = 0u; }
        unsigned raw[19], vraw[4]; float g_a, g_pm, g_b, g_p63, g_g;
        const unsigned lo_raw = (unsigned)pcol * 2u, lo_v = (unsigned)((4 * sg) * PJA + vcol) * 2u, lo_o = (unsigned)((4 * q4) * PJB + l15) * 2u, lo_ao = (unsigned)((4 * q4) * D + l15) * 2u;
        const __amdgpu_buffer_rsrc_t rsP = __builtin_amdgcn_make_buffer_rsrc((void*)P, 0, M * PJA * 2, 0x00020000), rsB = __builtin_amdgcn_make_buffer_rsrc((void*)PBg, 0, M * PJB * 2, 0x00020000),
                                     rsO = __builtin_amdgcn_make_buffer_rsrc((void*)AO, 0, M * D * 2, 0x00020000);
        const int r00 = (int)row00;
#define MLS_LOAD(c) do { _Pragma("unroll") for (int i_ = 0; i_ < 19; ++i_) { const int tr_ = 64 * (c) + 16 * tq - 3 + i_; raw[i_] = (tr_ >= 0) ? __builtin_amdgcn_raw_buffer_load_b32(rsP, lo_raw, (r00 + tr_) * (PJA * 2), 0) : 0u; } \
        _Pragma("unroll") for (int i_ = 0; i_ < 4; ++i_) vraw[i_] = __builtin_amdgcn_raw_buffer_load_b32(rsP, lo_v, (r00 + 64 * (c) + i_) * (PJA * 2), 0); \
        { const size_t gi_ = (size_t)bh * SEQ + 64 * (c) + lane; g_a = GA[gi_]; g_pm = GPM[gi_]; g_b = GB[gi_]; g_p63 = GP63[bh * 32 + (c)]; g_g = GG[bh * 32 + (c)]; } } while (0)
        MLS_LOAD(0);
        for (int c = 0; c < SEQ / 64; ++c) {
            const size_t row0 = row00 + 64 * c;
            const float bcum = g_b, aval = g_a, pm = g_pm, pm63 = g_p63, gsum = g_g;
            const float Mx = fmaxf(mcar, pm63), mrow = fmaxf(pm, mcar);
            const float rowterm = -mrow, inter = __expf(mcar - mrow), emt = __expf(-(bcum + mrow)), wk = __expf(aval - Mx), cdec = __expf(mcar - Mx);
            mcar = gsum + Mx;
            {
                unsigned kt0[8], kt1[8];
#pragma unroll
                for (int i = 0; i < 16; i += 2) {
                    float y[2][2];
#pragma unroll
                    for (int u = 0; u < 2; ++u) {
                        float a0 = w0[0] * lo_bf(raw[i + u]) + w1[0] * lo_bf(raw[i + u + 1]) + w2[0] * lo_bf(raw[i + u + 2]) + w3[0] * lo_bf(raw[i + u + 3]) + cb[0];
                        float a1 = w0[1] * hi_bf(raw[i + u]) + w1[1] * hi_bf(raw[i + u + 1]) + w2[1] * hi_bf(raw[i + u + 2]) + w3[1] * hi_bf(raw[i + u + 3]) + cb[1];
                        y[u][0] = fsilu(a0); y[u][1] = fsilu(a1);
                        const int t = 16 * tq + i + u;
                        if (!isk) { const float q0 = y[u][0] * QK_SCALE, q1 = y[u][1] * QK_SCALE; const float itv = rdl(inter, t);
                            *(LAS unsigned*)(L + L_Q + (t * QS + cc) * 2) = cvtpk(q0, q1); *(LAS unsigned*)(L + L_QI + (t * QS + cc) * 2) = cvtpk(q0 * itv, q1 * itv); }
                        else *(LAS unsigned*)(L + L_K + (t * QS + cc) * 2) = cvtpk(y[u][0], y[u][1]);
                    }
                    kt0[i >> 1] = cvtpk(y[0][0], y[1][0]); kt1[i >> 1] = cvtpk(y[0][1], y[1][1]);
                }
                if (isk) {
                    *(LAS u32x4v*)(L + L_KT + (cc * TS + 16 * tq) * 2) = (u32x4v){kt0[0], kt0[1], kt0[2], kt0[3]}; *(LAS u32x4v*)(L + L_KT + (cc * TS + 16 * tq + 8) * 2) = (u32x4v){kt0[4], kt0[5], kt0[6], kt0[7]};
                    *(LAS u32x4v*)(L + L_KT + ((cc + 1) * TS + 16 * tq) * 2) = (u32x4v){kt1[0], kt1[1], kt1[2], kt1[3]}; *(LAS u32x4v*)(L + L_KT + ((cc + 1) * TS + 16 * tq + 8) * 2) = (u32x4v){kt1[4], kt1[5], kt1[6], kt1[7]};
                }
            }
            {
                float v0[4], v1[4], wv[4];
#pragma unroll
                for (int i = 0; i < 4; ++i) { v0[i] = lo_bf(vraw[i]); v1[i] = hi_bf(vraw[i]); wv[i] = bperm(wk, 4 * sg + i); }
                *(LAS u32x2v*)(L + L_VT + ((2 * e2) * TS + 4 * sg) * 2) = (u32x2v){cvtpk(v0[0], v0[1]), cvtpk(v0[2], v0[3])};
                *(LAS u32x2v*)(L + L_VT + ((2 * e2 + 1) * TS + 4 * sg) * 2) = (u32x2v){cvtpk(v1[0], v1[1]), cvtpk(v1[2], v1[3])};
                *(LAS u32x2v*)(L + L_WVT + ((2 * e2) * TS + 4 * sg) * 2) = (u32x2v){cvtpk(v0[0] * wv[0], v0[1] * wv[1]), cvtpk(v0[2] * wv[2], v0[3] * wv[3])};
                *(LAS u32x2v*)(L + L_WVT + ((2 * e2 + 1) * TS + 4 * sg) * 2) = (u32x2v){cvtpk(v1[0] * wv[0], v1[1] * wv[1]), cvtpk(v1[2] * wv[2], v1[3] * wv[3])};
                if (wid == 0) *(LAS unsigned short*)(L + L_WVT + (64 * TS + lane) * 2) = (unsigned short)f2bf(wk);
            }
            if (c + 1 < SEQ / 64) MLS_LOAD(c + 1);
            ML_BAR();
            {
                const int tt = wid >> 1;
#pragma unroll
                for (int si = 0; si < 2; ++si) {
                    const int ss = 2 * (wid & 1) + si;
                    f32x4v acc = (f32x4v){0.f, 0.f, 0.f, 0.f};
                    if (ss <= tt) {
#pragma unroll
                        for (int kd = 0; kd < 4; ++kd) {
                            const bf16x8 a = *(const LAS bf16x8*)(L + L_Q + ((16 * tt + l15) * QS + 32 * kd + 8 * q4) * 2);
                            const bf16x8 bb = *(const LAS bf16x8*)(L + L_K + ((16 * ss + l15) * QS + 32 * kd + 8 * q4) * 2);
                            acc = __builtin_amdgcn_mfma_f32_16x16x32_bf16(a, bb, acc, 0, 0, 0);
                        }
                    }
                    const int s = 16 * ss + l15; const float as_ = bperm(aval, s);
#pragma unroll
                    for (int j = 0; j < 4; ++j) { const int t = 16 * tt + 4 * q4 + j; const float rt = bperm(rowterm, t);
                        const float dv = (s <= t) ? acc[j] * __expf(rt + as_) : 0.f;
                        *(LAS unsigned short*)(L + L_SC + (t * TS + s) * 2) = (unsigned short)f2bf(dv); }
                }
            }
            unsigned short mog[16];
            if (wid < 4) {
#pragma unroll
                for (int tt = 0; tt < 4; ++tt)
#pragma unroll
                    for (int j = 0; j < 4; ++j) mog[tt * 4 + j] = __builtin_amdgcn_raw_buffer_load_b16(rsB, lo_o, (((int)row0 + 16 * tt + j) * PJB + PB_MO + h * 128 + vh * 64 + 16 * wid) * 2, 0);
            }
            ML_BAR();
            f32x4v acc[4];
            if (wid < 5) {
                const int eg = wid;
#pragma unroll
                for (int tt = 0; tt < 4; ++tt) {
                    acc[tt] = (f32x4v){0.f, 0.f, 0.f, 0.f};
#pragma unroll
                    for (int ks = 0; ks < 2; ++ks) {
                        const bf16x8 a = *(const LAS bf16x8*)(L + L_SC + ((16 * tt + l15) * TS + 32 * ks + 8 * q4) * 2);
                        const bf16x8 bb = *(const LAS bf16x8*)(L + L_VT + ((16 * eg + l15) * TS + 32 * ks + 8 * q4) * 2);
                        acc[tt] = __builtin_amdgcn_mfma_f32_16x16x32_bf16(a, bb, acc[tt], 0, 0, 0);
                    }
#pragma unroll
                    for (int kd = 0; kd < 4; ++kd) {
                        const bf16x8 a = *(const LAS bf16x8*)(L + L_QI + ((16 * tt + l15) * QS + 32 * kd + 8 * q4) * 2);
                        const bf16x8 bb = *(const LAS bf16x8*)(L + L_CT + ((16 * eg + l15) * QS + 32 * kd + 8 * q4) * 2);
                        acc[tt] = __builtin_amdgcn_mfma_f32_16x16x32_bf16(a, bb, acc[tt], 0, 0, 0);
                    }
                }
                asm volatile("s_waitcnt lgkmcnt(0)" ::: "memory");
#pragma unroll
                for (int db = 0; db < 8; ++db) {
                    Cacc[db] = Cacc[db] * cdec;
#pragma unroll
                    for (int ks = 0; ks < 2; ++ks) {
                        const bf16x8 a = *(const LAS bf16x8*)(L + L_KT + ((16 * db + l15) * TS + 32 * ks + 8 * q4) * 2);
                        const bf16x8 bb = *(const LAS bf16x8*)(L + L_WVT + ((16 * eg + l15) * TS + 32 * ks + 8 * q4) * 2);
                        Cacc[db] = __builtin_amdgcn_mfma_f32_16x16x32_bf16(a, bb, Cacc[db], 0, 0, 0);
                    }
                    *(LAS u32x2v*)(L + L_CT + ((16 * eg + l15) * QS + 16 * db + 4 * q4) * 2) = (u32x2v){cvtpk(Cacc[db][0], Cacc[db][1]), cvtpk(Cacc[db][2], Cacc[db][3])};
                }
                if (wid == 4 && l15 == 0) {
#pragma unroll
                    for (int tt = 0; tt < 4; ++tt) *(LAS f32x4v*)(L + L_DEN + (16 * tt + 4 * q4) * 4) = acc[tt];
                }
            }
            ML_BAR();
            if (wid < 4) {
#pragma unroll
                for (int tt = 0; tt < 4; ++tt) {
                    const f32x4v den = *(const LAS f32x4v*)(L + L_DEN + (16 * tt + 4 * q4) * 4);
#pragma unroll
                    for (int j = 0; j < 4; ++j) { const int t = 16 * tt + 4 * q4 + j; const float et = bperm(emt, t);
                        const float hv = acc[tt][j] / fmaxf(fabsf(den[j]), et);
                        __builtin_amdgcn_raw_buffer_store_b16((unsigned short)f2bf(hv * bf2f(mog[tt * 4 + j])), rsO, lo_ao, (((int)row0 + 16 * tt + j) * D + 512 + h * 128 + vh * 64 + 16 * wid) * 2, 0); }
                }
            }
        }
#undef MLS_LOAD
#undef ML_BAR
    }
}


__global__ void __launch_bounds__(NTHR, 2) fwd_kernel(Args args) {
    extern __shared__ __attribute__((aligned(16))) unsigned char lds[];
    Frame F;
    F.lds = (LAS unsigned char*)lds;
    F.MISC = (volatile LAS unsigned*)(F.lds + MISC_OFF);
    F.wave = __builtin_amdgcn_readfirstlane((int)threadIdx.x >> 6);
    F.G = gridDim.x;
    F.ws = args.ws; F.out = args.out;
#pragma unroll
    for (int i = 0; i < 18; ++i) F.in[i] = args.in[i];
    F.ctl = (gu32*)(F.ws + WS_CTL);
    for (int u = threadIdx.x; u < (LDS_BYTES - LDSCTL_OFF) / 4; u += NTHR) ((LAS unsigned*)(F.lds + LDSCTL_OFF))[u] = 0u;
    __syncthreads();
    XcdBarrier bar = xcd_barrier_post((unsigned*)(F.ctl + CW_BAR), F.MISC + 8, F.wave);
#define GRID_BAR() xcd_barrier(bar)

    const float* x = F.in[0];
    bf16* XB = (bf16*)(F.ws + WS_XB); bf16* AO = (bf16*)(F.ws + WS_AO); bf16* PA = (bf16*)(F.ws + WS_PA); bf16* PB = (bf16*)(F.ws + WS_PB);
    bf16* HB = PA; bf16* MG = PA;
    float* SG = (float*)(F.ws + WS_SG); float* CUM = (float*)(F.ws + WS_CUM); float* SS = (float*)(F.ws + WS_SS);
    float* out = F.out;
    const bf16* W1IN = (const bf16*)(F.ws + WS_W1IN); const bf16* W1OUT = (const bf16*)(F.ws + WS_W1OUT); const bf16* WIN = (const bf16*)(F.ws + WS_WIN);
    const bf16* WCAT = (const bf16*)(F.ws + WS_WCAT); const bf16* WOUT = (const bf16*)(F.ws + WS_WOUT); const bf16* W2IN = (const bf16*)(F.ws + WS_W2IN); const bf16* W2OUT = (const bf16*)(F.ws + WS_W2OUT);
#define STAGGER(step) do { if (STAG_ON) { const unsigned long long t0_ = __builtin_amdgcn_s_memrealtime(); const unsigned long long w_ = (unsigned long long)((blockIdx.x & 7u) * (unsigned)(step)); while (__builtin_amdgcn_s_memrealtime() - t0_ < w_) __builtin_amdgcn_s_sleep(8); } } while (0)
#define GEMM_PHASE(EpiT, gobj, eobj) do { pg8::StaticOrder S_; S_.init((gobj).M, (gobj).N, F.G, (int)blockIdx.x); pg8::gemm_phase<EpiT, pg8::StaticOrder, true, true>(F.lds, gobj, S_, eobj, F.wave); } while (0)
#define REP(b) ((REP_MASK >> (b)) & 1)

    phase_weights(F);
    phase_x_prep(F, x, XB, SS);
    GRID_BAR();
    STAGGER(430);
    { pg8::Gemm g{XB, W1IN, M, NFF, D, D, D}; pg8::EpiSwigluF E{HB, SS}; GEMM_PHASE(pg8::EpiSwigluF, g, E); if (REP(0)) GEMM_PHASE(pg8::EpiSwigluF, g, E); }
    GRID_BAR();
    { pg8::Gemm g{HB, W1OUT, M, D, DFF, DFF, DFF}; pg8::EpiResidB<false> E{XB, nullptr, SS, 0.5f}; GEMM_PHASE(pg8::EpiResidB<false>, g, E); }
    GRID_BAR();
    STAGGER(460);
    { pg8::Gemm g{XB, WIN, M, NPJ, D, D, D}; pg8::EpiProjF E{PA, PB, SG, SS, F.in[6], F.in[9], F.in[10], (unsigned*)(F.ctl + CW_QKN)}; GEMM_PHASE(pg8::EpiProjF, g, E); if (REP(2)) GEMM_PHASE(pg8::EpiProjF, g, E); }
    GRID_BAR();
    phase_cumsum(F, SG, CUM);
    phase_mgates(F, SG);
    GRID_BAR();
    if (MLSTM_FUSED) { phase_mlstm_fused(F, PA, PB, SG, F.in[7], F.in[8], AO); if (REP(3)) phase_mlstm_fused(F, PA, PB, SG, F.in[7], F.in[8], AO); }
    else {
    phase_mprep(F, PA, F.in[7], F.in[8], (bf16*)out);
    if (REP(3)) phase_mprep(F, PA, F.in[7], F.in[8], (bf16*)out);
    GRID_BAR();
    phase_mchain(F, (const bf16*)out, PB, AO);
    if (REP(7)) phase_mchain(F, (const bf16*)out, PB, AO);
    }
    { const attn_body::AttnTensors AT{(const attn_body::bf16*)(PA + PC_FQ), (const attn_body::bf16*)(PA + PC_FK), (const attn_body::bf16*)(PA + PC_FV), (attn_body::bf16*)AO, CUM, (const unsigned*)(F.ctl + CW_QKN)};
      const attn_body::StaticOrder SA((int)F.G, (int)blockIdx.x); attn_body::attn_phase<attn_body::StaticOrder>((char*)lds, AT, SA, F.wave);
      if (REP(4)) attn_body::attn_phase<attn_body::StaticOrder>((char*)lds, AT, SA, F.wave); }
    GRID_BAR();
    { pg8::Gemm g{AO, WCAT, M, D, D, D, D}; pg8::EpiMergeF E{PB, MG}; GEMM_PHASE(pg8::EpiMergeF, g, E); if (REP(5)) GEMM_PHASE(pg8::EpiMergeF, g, E); }
    GRID_BAR();
    { pg8::Gemm g{MG, WOUT, M, D, D, D, D}; pg8::EpiResidB<false> E{XB, nullptr, SS, 1.0f}; GEMM_PHASE(pg8::EpiResidB<false>, g, E); }
    GRID_BAR();
    STAGGER(430);
    { pg8::Gemm g{XB, W2IN, M, NFF, D, D, D}; pg8::EpiSwigluF E{HB, SS}; GEMM_PHASE(pg8::EpiSwigluF, g, E); }
    GRID_BAR();
    { pg8::Gemm g{HB, W2OUT, M, D, DFF, DFF, DFF}; pg8::EpiResidB<true> E{XB, out, SS, 0.5f}; GEMM_PHASE(pg8::EpiResidB<true>, g, E); if (REP(1)) GEMM_PHASE(pg8::EpiResidB<true>, g, E); }
    GRID_BAR();
    phase_final_scale(F, out, SS, F.in[17]);
}

extern "C" void kernel_launch(void* const* d_in, const int* in_sizes, int n_in, void* d_out, int out_size, void* d_ws, size_t ws_size, hipStream_t stream) {
    static int grid = 0;
    if (grid == 0) {
        if (n_in != 18 || in_sizes[0] != M * D || out_size != M * D || ws_size < WS_END) { fprintf(stderr, "kernel_launch: unexpected shapes (n_in %d, in0 %d, out %d, ws %zu)\n", n_in, n_in > 0 ? in_sizes[0] : -1, out_size, ws_size); grid = -1; return; }
        int dev = 0, cus = 0, per_cu = 0;
        if (hipGetDevice(&dev) != hipSuccess || hipDeviceGetAttribute(&cus, hipDeviceAttributeMultiprocessorCount, dev) != hipSuccess) { grid = -1; return; }
        if (hipFuncSetAttribute((const void*)fwd_kernel, hipFuncAttributeMaxDynamicSharedMemorySize, LDS_BYTES) != hipSuccess) { grid = -1; return; }
        if (hipOccupancyMaxActiveBlocksPerMultiprocessor(&per_cu, (const void*)fwd_kernel, NTHR, LDS_BYTES) != hipSuccess || per_cu < 1) { fprintf(stderr, "occupancy query says %d\n", per_cu); }
        (void)hipGetLastError();
        grid = cus;
    }
    if (grid < 0) return;
    if (hipMemsetAsync((char*)d_ws + WS_CTL, 0, CTL_ZERO_BYTES, stream) != hipSuccess) return;
    Args a{};
    for (int i = 0; i < 18; ++i) a.in[i] = (const float*)d_in[i];
    a.out = (float*)d_out; a.ws = (unsigned char*)d_ws;
    hipLaunchKernelGGL(fwd_kernel, dim3(grid), dim3(NTHR), LDS_BYTES, stream, a);
}
```

```cpp
#include <hip/hip_runtime.h>
#include <cstdio>
#include <cstdint>

#define GAS __attribute__((address_space(1)))
#define LAS __attribute__((address_space(3)))
typedef unsigned short bf16;
typedef unsigned v4u __attribute__((ext_vector_type(4)));
typedef float f32x4 __attribute__((ext_vector_type(4)));
typedef GAS unsigned gu32;
#define RLX_AGENT __ATOMIC_RELAXED, __HIP_MEMORY_SCOPE_AGENT

constexpr int BATCH = 32, SEQ = 2048, D = 1024, M = BATCH * SEQ;
constexpr int DFF = 2816, NFF = 2 * DFF;
constexpr int INC = 5648;
constexpr int PJA = 3072, PJB = 2560;
constexpr int FOXH = 8, FHD = 64, MLH = 4, MHD = 128;
constexpr int PC_FQ = 0, PC_FK = 512, PC_FV = 1024, PC_MQ = 1536, PC_MK = 2048, PC_MV = 2560;
constexpr int PB_MO = 0, PB_GA = 512, PB_GB = 1536;
constexpr float RMS_EPS = 1e-6f;
constexpr float LOG2E = 1.4426950408889634f;
constexpr float QSCALE2 = 0.125f * LOG2E;
constexpr int NWAVES = 8, NTHR = 512;
#ifndef STAG_ON
#define STAG_ON 0
#endif
#ifndef MLSTM_FUSED
#define MLSTM_FUSED 2
#endif
#ifndef REP_MASK
#define REP_MASK 0
#endif

constexpr size_t MiB = 1u << 20;
constexpr size_t WS_CTL = 0, CTL_ZERO_BYTES = 1 * MiB;
constexpr size_t WS_W1IN = 2 * MiB, WS_W1OUT = 13 * MiB, WS_WIN = 19 * MiB, WS_WCAT = 31 * MiB, WS_WOUT = 33 * MiB, WS_W2IN = 35 * MiB, WS_W2OUT = 46 * MiB;
constexpr int NPJ = 5888;
constexpr size_t WS_SG = 52 * MiB;
constexpr size_t WS_CUM = 56 * MiB;
constexpr size_t WS_SS = 58 * MiB;
constexpr size_t WS_XB = 64 * MiB;
constexpr size_t WS_AO = 192 * MiB;
constexpr size_t WS_PA = 320 * MiB;
constexpr size_t WS_PB = 704 * MiB;
constexpr size_t WS_END = 1024 * MiB;
constexpr int CW_BAR = 4096;
constexpr int CW_AQ = 8192;
constexpr int CW_QKN = 32768;

constexpr int LDS_BYTES = 147456;
constexpr int RING_BYTES = 131072, LDSCTL_OFF = RING_BYTES, MISC_OFF = LDSCTL_OFF + 320;

__device__ __forceinline__ float bf2f(bf16 v) { return __builtin_bit_cast(float, (unsigned)v << 16); }
__device__ __forceinline__ unsigned f2bf(float f) { unsigned u = __builtin_bit_cast(unsigned, f); return (u + 0x7fffu + ((u >> 16) & 1u)) >> 16; }
__device__ __forceinline__ unsigned pk2(float lo, float hi) { return f2bf(lo) | (f2bf(hi) << 16); }
__device__ __forceinline__ float sigmoidf_(float v) { return 1.f / (1.f + __expf(-v)); }
__device__ __forceinline__ float logsigmoidf_(float v) { return fminf(v, 0.f) - log1pf(__expf(-fabsf(v))); }
__device__ __forceinline__ float siluf_(float v) { return v / (1.f + __expf(-v)); }

#define XB_TMO      128
#define XB_XCNT(j)  (256  + 64 * (j))
#define XB_XSUB(j)  (1280 + 64 * (j))
#define XB_XGEN(j)  (2304 + 64 * (j))
#define XB_TOP      3328
#define XB_TOPGEN   3392
#define XCD_BAR_WORDS 3456
#define XB_SPIN_CAP (1u << 22)

__device__ __forceinline__ unsigned xb_ld(unsigned* p)              { return __hip_atomic_load(p, __ATOMIC_RELAXED, __HIP_MEMORY_SCOPE_AGENT); }
__device__ __forceinline__ unsigned xb_add(unsigned* p, unsigned v) { return __hip_atomic_fetch_add(p, v, __ATOMIC_RELAXED, __HIP_MEMORY_SCOPE_AGENT); }
__device__ __forceinline__ unsigned xb_xcc_id() { return (unsigned)__builtin_amdgcn_s_getreg((3 << 11) | 20) & 0xFu; }
#define XB_SPIN(cond, bar) do { unsigned _sp = 0; while (cond) { __builtin_amdgcn_s_sleep(1); \
    if ((++_sp & 255u) == 0u) { if (xb_ld(&(bar)[XB_TMO])) break; if (_sp > XB_SPIN_CAP) { atomicAdd(&(bar)[XB_TMO], 1u); break; } } } } while (0)

struct XcdBarrier { unsigned* bar; unsigned x; volatile LAS unsigned* st; int wv; };

__device__ __forceinline__ bool xb_leader(int wv) { int l = (int)__builtin_amdgcn_mbcnt_hi(~0u, __builtin_amdgcn_mbcnt_lo(~0u, 0u)); asm volatile("" : "+v"(l)); return wv == 0 && l == 0; }
__device__ __forceinline__ XcdBarrier xcd_barrier_post(unsigned* bar, volatile LAS unsigned* st, int wv) {
    XcdBarrier b; b.bar = bar; b.x = xb_xcc_id(); b.st = st; b.wv = wv;
    if (xb_leader(wv)) (void)xb_add(&bar[XB_XCNT(b.x)], 1u);
    return b;
}
__device__ __forceinline__ void xcd_barrier_complete(unsigned* bar, unsigned x, unsigned& nloc, unsigned& nx) {
    const unsigned G = gridDim.x * gridDim.y * gridDim.z;
    unsigned sum, cnt, mine, sp = 0u;
    for (;;) {
        sum = 0u; cnt = 0u; mine = 0u;
#pragma unroll
        for (unsigned j = 0; j < 16; ++j) { const unsigned c = xb_ld(&bar[XB_XCNT(j)]); sum += c; cnt += (c > 0u) ? 1u : 0u; mine = (j == x) ? c : mine; }
        if (sum == G) break;
        __builtin_amdgcn_s_sleep(1);
        if ((++sp & 255u) == 0u) { if (xb_ld(&bar[XB_TMO])) break; if (sp > XB_SPIN_CAP) { atomicAdd(&bar[XB_TMO], 1u); break; } }
    }
    nloc = mine > 0u ? mine : 1u; nx = cnt > 0u ? cnt : 1u;
}
__device__ __forceinline__ void xcd_barrier(const XcdBarrier& b) {
    asm volatile("s_waitcnt vmcnt(0)" ::: "memory");
    __syncthreads();
    if (xb_leader(b.wv)) {
        unsigned* bar = b.bar;
        __builtin_amdgcn_s_waitcnt(0);
        unsigned nloc = b.st[0], nx = b.st[1];
        if (nloc == 0u) { xcd_barrier_complete(bar, b.x, nloc, nx); b.st[0] = nloc; b.st[1] = nx; }
        const unsigned old = xb_add(&bar[XB_XSUB(b.x)], 1u);
        const unsigned gen = old / nloc;
        if (old + 1u == (gen + 1u) * nloc) {
            __builtin_amdgcn_fence(__ATOMIC_RELEASE, "agent");
            asm volatile("s_waitcnt vmcnt(0)" ::: "memory");
            const unsigned og = xb_add(&bar[XB_TOP], 1u);
            const unsigned tg = og / nx;
            if (og + 1u == (tg + 1u) * nx) xb_add(&bar[XB_TOPGEN], 1u);
            else XB_SPIN(xb_ld(&bar[XB_TOPGEN]) == tg, bar);
            __builtin_amdgcn_fence(__ATOMIC_ACQUIRE, "agent");
            xb_add(&bar[XB_XGEN(b.x)], 1u);
            asm volatile("s_waitcnt vmcnt(0)" ::: "memory");
        } else {
            XB_SPIN(xb_ld(&bar[XB_XGEN(b.x)]) == gen, bar);
            __builtin_amdgcn_fence(__ATOMIC_ACQUIRE, "agent");
            asm volatile("s_waitcnt vmcnt(0)" ::: "memory");
        }
    }
    __syncthreads();
}

struct Frame {
    LAS unsigned char* lds;
    volatile LAS unsigned* MISC;
    gu32* ctl;
    int wave, G;
    const float* in[18];
    float* out;
    unsigned char* ws;
};
struct Args { const float* in[18]; float* out; unsigned char* ws; };

__device__ __forceinline__ int lane_id() { return (int)__builtin_amdgcn_mbcnt_hi(~0u, __builtin_amdgcn_mbcnt_lo(~0u, 0u)); }
__device__ __forceinline__ int opaque_tid(int wv) { int t = wv * 64 + lane_id(); asm volatile("" : "+v"(t)); return t; }
__device__ __forceinline__ float bperm(float v, int idx) { return __builtin_bit_cast(float, __builtin_amdgcn_ds_bpermute(idx << 2, __builtin_bit_cast(int, v))); }
__device__ __forceinline__ float rdl(float v, int idx) { return __builtin_bit_cast(float, __builtin_amdgcn_readlane(__builtin_bit_cast(int, v), idx)); }
__device__ __forceinline__ float shx(float v, int lane, int mask) { return bperm(v, lane ^ mask); }
__device__ __forceinline__ float wave_sum(float v, int lane) {
#pragma unroll
    for (int o = 1; o < 64; o <<= 1) v += shx(v, lane, o);
    return v;
}

__device__ __forceinline__ void phase_x_prep(Frame& F, const float* X, bf16* XB, float* SS) {
    const int ptid = opaque_tid(F.wave), plane = ptid & 63, pwave = __builtin_amdgcn_readfirstlane(ptid >> 6);
    const int gw = blockIdx.x * NWAVES + pwave, NGW = F.G * NWAVES;
    for (int m = gw; m < M; m += NGW) {
        const GAS f32x4* xr = (const GAS f32x4*)(X + (size_t)m * D) + plane;
        f32x4 v[4]; float s = 0.f;
#pragma unroll
        for (int j = 0; j < 4; ++j) { v[j] = xr[64 * j]; s += (v[j].x * v[j].x + v[j].y * v[j].y) + (v[j].z * v[j].z + v[j].w * v[j].w); }
        s = wave_sum(s, plane);
        GAS unsigned long long* o8 = (GAS unsigned long long*)(XB + (size_t)m * D) + plane;
#pragma unroll
        for (int j = 0; j < 4; ++j) o8[64 * j] = (unsigned long long)pk2(v[j].x, v[j].y) | ((unsigned long long)pk2(v[j].z, v[j].w) << 32);
        if (plane < 16) SS[(size_t)m * 16 + plane] = (plane == 0) ? s : 0.f;
    }
}
__device__ __forceinline__ void phase_final_scale(Frame& F, float* X, const float* SS, const float* gain) {
    const int ptid = opaque_tid(F.wave), plane = ptid & 63, pwave = __builtin_amdgcn_readfirstlane(ptid >> 6);
    const int gw = blockIdx.x * NWAVES + pwave, NGW = F.G * NWAVES;
    f32x4 g[4];
#pragma unroll
    for (int j = 0; j < 4; ++j) g[j] = *((const GAS f32x4*)gain + plane + 64 * j);
    for (int m = gw; m < M; m += NGW) {
        GAS f32x4* xr = (GAS f32x4*)(X + (size_t)m * D) + plane;
        f32x4 v[4];
#pragma unroll
        for (int j = 0; j < 4; ++j) v[j] = xr[64 * j];
        float s = SS[(size_t)m * 16 + (plane & 15)];
#pragma unroll
        for (int o = 1; o < 16; o <<= 1) s += shx(s, plane, o);
        const float r = 1.0f / sqrtf(s * (1.f / D) + RMS_EPS);
#pragma unroll
        for (int j = 0; j < 4; ++j) xr[64 * j] = v[j] * r * g[j];
    }
}

__device__ __forceinline__ void phase_cumsum(Frame& F, const float* SG, float* CUM) {
    const int ptid = opaque_tid(F.wave), plane = ptid & 63, pwave = __builtin_amdgcn_readfirstlane(ptid >> 6); (void)plane; (void)pwave;
    const int gw = blockIdx.x * NWAVES + pwave, NGW = F.G * NWAVES;
    for (int it = gw; it < BATCH * FOXH; it += NGW) {
        const int b = it / FOXH, h = it % FOXH;
        float v[32]; float s = 0.f;
#pragma unroll
        for (int i = 0; i < 32; ++i) { s += SG[(size_t)(b * SEQ + plane * 32 + i) * 16 + h]; v[i] = s; }
        float incl = s;
#pragma unroll
        for (int o = 1; o < 64; o <<= 1) { const float t = bperm(incl, (plane - o) & 63); if (plane >= o) incl += t; }
        const float excl = incl - s;
#pragma unroll
        for (int i = 0; i < 32; ++i) CUM[(size_t)it * SEQ + plane * 32 + i] = v[i] + excl;
    }
}


namespace pg8 {
#define PG8_LAS __attribute__((address_space(3)))
typedef unsigned short bf16_t;
typedef short bf16x8 __attribute__((ext_vector_type(8)));
typedef float f32x4 __attribute__((ext_vector_type(4)));
typedef unsigned u32x4 __attribute__((ext_vector_type(4)));
constexpr int RSTD_LDS_OFF = 131072 + 1024;
constexpr int BM = 256, BK = 64, HALF = 128, HTB = HALF * BK * 2  , STAGE_BYTES = 8 * HTB, NXCD = 8, WGM = 8;

__host__ __device__ __forceinline__ int lds_byte(int r, int c) { const int st = (r >> 4) * 2 + (c >> 5), rr = r & 15, cc = c & 31, ob = rr * 64 + cc * 2; return st * 1024 + (ob ^ (((ob >> 9) & 1) << 5)); }
__host__ __device__ __forceinline__ void stage_rc(int b, int& R, int& C) { const int st = b / 1024, sb = b % 1024, swz = sb ^ (((sb >> 9) & 1) << 5); R = (st >> 1) * 16 + swz / 64; C = (st & 1) * 32 + (swz % 64) / 2; }
__host__ __device__ __forceinline__ int perm32(int rho) { const int n = rho >> 4, i = rho & 15; return 8 * (i >> 2) + 4 * n + (i & 3); }

struct Unit { int pm, pn; };
struct Gemm { const bf16_t* A; const bf16_t* Bt; int M, N, K, lda, ldb; };

struct StaticOrder {
    int nM, nN, nwg, G, c;
    __host__ __device__ void init(int M, int N, int G_, int c_) { nM = M / BM; nN = N / BM; nwg = nM * nN; G = G_; c = c_; }
    __host__ __device__ bool next(int i, Unit& u) const {
        const long L = (long)i * G + c; if (L >= nwg) return false;
        int wgid = (int)L; { const int q = nwg / NXCD, r = nwg % NXCD, xcd = wgid % NXCD, off = wgid / NXCD; wgid = (xcd < r ? xcd * (q + 1) : r * (q + 1) + (xcd - r) * q) + off; }
        const int nig = WGM * nN, gid = wgid / nig, fm = gid * WGM, gsz = (nM - fm) < WGM ? (nM - fm) : WGM;
        u.pm = fm + ((wgid % nig) % gsz); u.pn = (wgid % nig) / gsz; return true;
    }
    __device__ __forceinline__ void a_ready(const Unit&) const {}
    __device__ __forceinline__ void done(const Unit&) const {}
};

__device__ __forceinline__ unsigned cvt_pk_bf16(float lo, float hi) { unsigned r; asm volatile("v_cvt_pk_bf16_f32 %0, %1, %2" : "=v"(r) : "v"(lo), "v"(hi)); return r; }
template <class Epi, class Sched, bool ALIGN_EPI = false, bool SP2 = false>
__device__ __forceinline__ void gemm_phase(PG8_LAS unsigned char* lds, const Gemm g, const Sched& S, const Epi& E, const int wv) {
    int tid_ = wv * 64 + (int)__builtin_amdgcn_mbcnt_hi(~0u, __builtin_amdgcn_mbcnt_lo(~0u, 0u)); asm volatile("" : "+v"(tid_));
    const int tid = tid_, wid = __builtin_amdgcn_readfirstlane(tid >> 6), lane = tid & 63, wr = wid >> 2, wc = wid & 3, fr = lane & 15, fq = lane >> 4;
    const int K = g.K, nt = K / BK;
    unsigned voffA[2], voffB[2];
#pragma unroll
    for (int i = 0; i < 2; ++i) { int R, C; stage_rc(tid * 16 + i * 8192, R, C); const int Rb = Epi::PERM ? ((R & ~31) + perm32(R & 31)) : R;
        voffA[i] = (unsigned)(R * g.lda + C) * 2u; voffB[i] = (unsigned)(Rb * g.ldb + C) * 2u; }
    const size_t kstep = (size_t)(BK * 2);
    const size_t hstepA = (size_t)HALF * g.lda * 2, hstepB = (size_t)HALF * g.ldb * 2;
    const size_t tstepA = 2 * hstepA, tstepB = 2 * hstepB;
    const unsigned ldsw = (unsigned)wid * 1024u;
    const int aoff = lds_byte(wr * 64 + fr, fq * 8), boff = lds_byte(wc * 32 + fr, fq * 8);
#define PG8_SA(b, h) (((b) * 2 + (h)) * HTB)
#define PG8_SB(b, h) ((4 + (b) * 2 + (h)) * HTB)
#define PG8_STAGE(bufoff, gbase, voff) do { _Pragma("unroll") for (int _i = 0; _i < 2; ++_i) \
        __builtin_amdgcn_global_load_lds((const unsigned*)((const char*)(gbase) + (voff)[_i]), (PG8_LAS unsigned*)(lds + (bufoff) + ldsw + _i * 8192), 16, 0, 0); } while (0)
#define PG8_LDA(dst, b, h) do { _Pragma("unroll") for (int m = 0; m < 4; ++m) _Pragma("unroll") for (int k = 0; k < 2; ++k) dst[m][k] = *(const PG8_LAS bf16x8*)(lds + PG8_SA(b, h) + aoff + m * 2048 + k * 1024); } while (0)
#define PG8_LDB(dst, b, h) do { _Pragma("unroll") for (int n = 0; n < 2; ++n) _Pragma("unroll") for (int k = 0; k < 2; ++k) dst[n][k] = *(const PG8_LAS bf16x8*)(lds + PG8_SB(b, h) + boff + n * 2048 + k * 1024); } while (0)
#define PG8_MMA(ai, bj, At, Bt) do { __builtin_amdgcn_s_setprio(1); _Pragma("unroll") for (int m = 0; m < 4; ++m) _Pragma("unroll") for (int n = 0; n < 2; ++n) _Pragma("unroll") for (int k = 0; k < 2; ++k) \
        acc[ai][bj][m][n] = __builtin_amdgcn_mfma_f32_16x16x32_bf16(Bt[n][k], At[m][k], acc[ai][bj][m][n], 0, 0, 0); __builtin_amdgcn_s_setprio(0); } while (0)
#define PG8_WAIT_V(n) asm volatile("s_waitcnt vmcnt(" #n ")" ::: "memory")
#define PG8_WAIT_L(n) asm volatile("s_waitcnt lgkmcnt(" #n ")" ::: "memory")
#define PG8_BAR __builtin_amdgcn_s_barrier()
#define PG8_SCHED __builtin_amdgcn_sched_barrier(0)
    Unit cur, nxt; int ui = 0; int rs_pm = -1; (void)rs_pm;
    if (!S.next(0, cur)) return;
    f32x4 acc[2][2][4][2];
#pragma unroll
    for (int a = 0; a < 2; ++a)
#pragma unroll
        for (int b = 0; b < 2; ++b)
#pragma unroll
            for (int m = 0; m < 4; ++m)
#pragma unroll
                for (int n = 0; n < 2; ++n) acc[a][b][m][n] = (f32x4){0.f, 0.f, 0.f, 0.f};
    bf16x8 At[4][2], B0[2][2], B1[2][2];
    const char* cA = (const char*)g.A + (size_t)cur.pm * tstepA; const char* cB = (const char*)g.Bt + (size_t)cur.pn * tstepB;
    S.a_ready(cur);
    if constexpr (SP2) {
        PG8_STAGE(PG8_SB(0, 0), cB, voffB); PG8_STAGE(PG8_SB(0, 1), cB + hstepB, voffB); PG8_STAGE(PG8_SA(0, 0), cA, voffA); PG8_STAGE(PG8_SA(0, 1), cA + hstepA, voffA);
        if (wr == 1) PG8_BAR;
        PG8_WAIT_V(2); PG8_BAR;
        PG8_STAGE(PG8_SB(1, 0), cB + kstep, voffB); PG8_STAGE(PG8_SA(1, 0), cA + kstep, voffA); PG8_STAGE(PG8_SB(1, 1), cB + hstepB + kstep, voffB);
        PG8_WAIT_V(6); PG8_BAR;
    } else {
        PG8_STAGE(PG8_SB(0, 0), cB, voffB); PG8_STAGE(PG8_SA(0, 0), cA, voffA); PG8_STAGE(PG8_SB(0, 1), cB + hstepB, voffB); PG8_STAGE(PG8_SA(0, 1), cA + hstepA, voffA);
        if (wr == 1) PG8_BAR;
        PG8_WAIT_V(4); PG8_BAR;
        PG8_STAGE(PG8_SB(1, 0), cB + kstep, voffB); PG8_STAGE(PG8_SA(1, 0), cA + kstep, voffA); PG8_STAGE(PG8_SB(1, 1), cB + hstepB + kstep, voffB);
        PG8_WAIT_V(6); PG8_BAR;
    }
    for (;;) {
        const bool has_next = S.next(ui + 1, nxt);
        const char* nA = has_next ? (const char*)g.A + (size_t)nxt.pm * tstepA : cA; const char* nB = has_next ? (const char*)g.Bt + (size_t)nxt.pn * tstepB : cB;
        for (int t = 0; t < nt; t += 2) {
            const bool last = (t == nt - 2);
            const char* a1 = cA + (size_t)(t + 1) * kstep;
            const char* a2 = last ? nA : cA + (size_t)(t + 2) * kstep; const char* b2 = last ? nB : cB + (size_t)(t + 2) * kstep;
            const char* a3 = a2 + kstep; const char* b3 = b2 + kstep;
            if (last && has_next) S.a_ready(nxt);
            if constexpr (Epi::HOOK) { if (t == Epi::HOOK_T) E.mid(acc, cur, wr, wc, fr, fq); }
            if constexpr (SP2) {
            PG8_LDB(B0, 0, 0); PG8_LDB(B1, 0, 1); PG8_SCHED; PG8_LDA(At, 0, 0); PG8_STAGE(PG8_SA(1, 1), a1 + hstepA, voffA);
            PG8_WAIT_V(8); PG8_WAIT_L(0); PG8_BAR; PG8_MMA(0, 0, At, B0); PG8_MMA(0, 1, At, B1); PG8_BAR; PG8_SCHED;
            PG8_LDA(At, 0, 1); PG8_STAGE(PG8_SB(0, 0), b2, voffB); PG8_STAGE(PG8_SB(0, 1), b2 + hstepB, voffB); PG8_STAGE(PG8_SA(0, 0), a2, voffA);
            PG8_WAIT_V(8); PG8_WAIT_L(0); PG8_BAR; PG8_MMA(1, 0, At, B0); PG8_MMA(1, 1, At, B1); PG8_BAR; PG8_SCHED;
            PG8_LDB(B0, 1, 0); PG8_LDB(B1, 1, 1); PG8_SCHED; PG8_LDA(At, 1, 0); PG8_STAGE(PG8_SA(0, 1), a2 + hstepA, voffA);
            PG8_WAIT_V(8); PG8_WAIT_L(0); PG8_BAR; PG8_MMA(0, 0, At, B0); PG8_MMA(0, 1, At, B1); PG8_BAR; PG8_SCHED;
            PG8_LDA(At, 1, 1); PG8_STAGE(PG8_SB(1, 0), b3, voffB); PG8_STAGE(PG8_SB(1, 1), b3 + hstepB, voffB); PG8_STAGE(PG8_SA(1, 0), a3, voffA);
            PG8_WAIT_V(8); PG8_WAIT_L(0); PG8_BAR; PG8_MMA(1, 0, At, B0); PG8_MMA(1, 1, At, B1); PG8_BAR; PG8_SCHED;
            } else {
            PG8_LDB(B0, 0, 0); PG8_SCHED; PG8_LDA(At, 0, 0); PG8_STAGE(PG8_SA(1, 1), a1 + hstepA, voffA);
            PG8_WAIT_L(8); PG8_BAR; PG8_WAIT_L(0); PG8_MMA(0, 0, At, B0); PG8_BAR; PG8_SCHED;
            PG8_LDB(B1, 0, 1); PG8_STAGE(PG8_SB(0, 0), b2, voffB);
            PG8_BAR; PG8_WAIT_L(0); PG8_MMA(0, 1, At, B1); PG8_BAR;
            PG8_LDA(At, 0, 1); PG8_STAGE(PG8_SA(0, 0), a2, voffA);
            PG8_BAR; PG8_WAIT_L(0); PG8_MMA(1, 0, At, B0); PG8_BAR; PG8_SCHED;
            PG8_STAGE(PG8_SB(0, 1), b2 + hstepB, voffB);
            PG8_WAIT_V(6); PG8_BAR; PG8_MMA(1, 1, At, B1); PG8_BAR;
            PG8_LDB(B0, 1, 0); PG8_SCHED; PG8_LDA(At, 1, 0); PG8_STAGE(PG8_SA(0, 1), a2 + hstepA, voffA);
            PG8_WAIT_L(8); PG8_BAR; PG8_WAIT_L(0); PG8_MMA(0, 0, At, B0); PG8_BAR; PG8_SCHED;
            PG8_LDB(B1, 1, 1); PG8_STAGE(PG8_SB(1, 0), b3, voffB);
            PG8_BAR; PG8_WAIT_L(0); PG8_MMA(0, 1, At, B1); PG8_BAR;
            PG8_LDA(At, 1, 1); PG8_STAGE(PG8_SA(1, 0), a3, voffA);
            PG8_BAR; PG8_WAIT_L(0); PG8_MMA(1, 0, At, B0); PG8_BAR; PG8_SCHED;
            PG8_STAGE(PG8_SB(1, 1), b3 + hstepB, voffB);
            PG8_WAIT_V(6); PG8_BAR; PG8_MMA(1, 1, At, B1); PG8_BAR;
            }
        }
        if constexpr (ALIGN_EPI) { if (wr == 0) PG8_BAR; }
        if constexpr (Epi::RSTD) { if (cur.pm != rs_pm) {
                const int row_ = tid >> 1, hf_ = tid & 1; const float* sp_ = E.SS + ((size_t)cur.pm * BM + row_) * 16 + hf_ * 8; const f32x4 p0_ = *(const f32x4*)sp_, p1_ = *(const f32x4*)(sp_ + 4);
                float s_ = ((p0_[0] + p0_[1]) + (p0_[2] + p0_[3])) + ((p1_[0] + p1_[1]) + (p1_[2] + p1_[3])); s_ += shx(s_, lane, 1);
                if (hf_ == 0) *(PG8_LAS float*)(lds + RSTD_LDS_OFF + row_ * 4) = 1.0f / sqrtf(s_ * (1.0f / D) + RMS_EPS);
                asm volatile("s_waitcnt lgkmcnt(0)\n\ts_barrier" ::: "memory"); rs_pm = cur.pm; } }
        if constexpr (!Epi::AFTER_DRAIN) { E(acc, cur, wr, wc, fr, fq, lds); S.done(cur); }
        if (!has_next) break;
#pragma unroll
        for (int a = 0; a < 2; ++a)
#pragma unroll
            for (int b = 0; b < 2; ++b)
#pragma unroll
                for (int m = 0; m < 4; ++m)
#pragma unroll
                    for (int n = 0; n < 2; ++n) acc[a][b][m][n] = (f32x4){0.f, 0.f, 0.f, 0.f};
        cur = nxt; cA = nA; cB = nB; ++ui;
        if constexpr (ALIGN_EPI) { if (wr == 1) PG8_BAR; }
    }
    PG8_WAIT_V(0);
    if constexpr (!ALIGN_EPI) { if (wr == 0) PG8_BAR; }
    PG8_BAR;
    if constexpr (Epi::AFTER_DRAIN) { E.fused(acc, cur, wr, wc, fr, fq, lds, wid, lane); S.done(cur); }
#undef PG8_SA
#undef PG8_SB
#undef PG8_STAGE
#undef PG8_LDA
#undef PG8_LDB
#undef PG8_MMA
#undef PG8_WAIT_V
#undef PG8_WAIT_L
#undef PG8_BAR
#undef PG8_SCHED
}
}

namespace pg8 {
__device__ __forceinline__ float fsig(float v) { return __builtin_amdgcn_rcpf(1.f + __builtin_amdgcn_exp2f(-1.4426950408889634f * v)); }
__device__ __forceinline__ u32x4 pack8(const f32x4 a, const f32x4 b) { u32x4 w; w.x = cvt_pk_bf16(a[0], a[1]); w.y = cvt_pk_bf16(a[2], a[3]); w.z = cvt_pk_bf16(b[0], b[1]); w.w = cvt_pk_bf16(b[2], b[3]); return w; }
__device__ __forceinline__ void unpack8(const u32x4 w, f32x4& a, f32x4& b) {
    a[0] = __builtin_bit_cast(float, w.x << 16); a[1] = __builtin_bit_cast(float, w.x & 0xffff0000u); a[2] = __builtin_bit_cast(float, w.y << 16); a[3] = __builtin_bit_cast(float, w.y & 0xffff0000u);
    b[0] = __builtin_bit_cast(float, w.z << 16); b[1] = __builtin_bit_cast(float, w.z & 0xffff0000u); b[2] = __builtin_bit_cast(float, w.w << 16); b[3] = __builtin_bit_cast(float, w.w & 0xffff0000u); }
#define PIN16(a) asm volatile("" : "+v"(a[0][0][0]), "+v"(a[0][0][1]), "+v"(a[0][1][0]), "+v"(a[0][1][1]), "+v"(a[0][2][0]), "+v"(a[0][2][1]), "+v"(a[0][3][0]), "+v"(a[0][3][1]), \
    "+v"(a[1][0][0]), "+v"(a[1][0][1]), "+v"(a[1][1][0]), "+v"(a[1][1][1]), "+v"(a[1][2][0]), "+v"(a[1][2][1]), "+v"(a[1][3][0]), "+v"(a[1][3][1]))
__device__ __forceinline__ float dot4(const f32x4 a) { return (a[0] * a[0] + a[1] * a[1]) + (a[2] * a[2] + a[3] * a[3]); }
__device__ __forceinline__ void row_rstd(PG8_LAS unsigned char* lds, int wr, int fr, float (&rs)[2][4]) {
#pragma unroll
    for (int ai = 0; ai < 2; ++ai)
#pragma unroll
        for (int m = 0; m < 4; ++m) rs[ai][m] = *(const PG8_LAS float*)(lds + RSTD_LDS_OFF + (ai * HALF + wr * 64 + m * 16 + fr) * 4);
}
struct EpiSwigluF { static constexpr bool PERM = true, AFTER_DRAIN = false, HOOK = false, RSTD = true; static constexpr int HOOK_T = 0; bf16_t* H; const float* SS;
    __device__ __forceinline__ void operator()(const f32x4 (&acc)[2][2][4][2], const Unit& u, int wr, int wc, int fr, int fq, PG8_LAS unsigned char* lds) const {
        const int row0 = u.pm * BM + wr * 64 + fr, col0 = u.pn * 128 + wc * 32 + 8 * fq;
        for (int rp_ = 0; rp_ < 1 + ((REP_MASK >> 6) & 1); ++rp_) {
        float rs[2][4]; row_rstd(lds, wr, fr, rs);
#pragma unroll
        for (int ai = 0; ai < 2; ++ai)
#pragma unroll
            for (int m = 0; m < 4; ++m) { bf16_t* rowp = H + (size_t)(row0 + ai * HALF + m * 16) * DFF + col0; const float r = rs[ai][m];
                f32x4 h0, h1;
#pragma unroll
                for (int i = 0; i < 4; ++i) { const float g0 = acc[ai][0][m][0][i] * r, g1 = acc[ai][0][m][1][i] * r; h0[i] = g0 * fsig(g0) * (acc[ai][1][m][0][i] * r); h1[i] = g1 * fsig(g1) * (acc[ai][1][m][1][i] * r); }
                __builtin_nontemporal_store(pack8(h0, h1), (u32x4*)rowp); }
        }
    } };
template <bool FINAL> struct EpiResidB { static constexpr bool PERM = true, AFTER_DRAIN = false, HOOK = false, RSTD = false; static constexpr int HOOK_T = 0; bf16_t* XB; float* Of; float* SS; float coef;
    __device__ __forceinline__ void operator()(const f32x4 (&acc)[2][2][4][2], const Unit& u, int wr, int wc, int fr, int fq, PG8_LAS unsigned char* lds) const {
        const int row0 = u.pm * BM + wr * 64 + fr, col0 = u.pn * BM + wc * 32 + 8 * fq;
        u32x4 rr[2][4][2];
#pragma unroll
        for (int ai = 0; ai < 2; ++ai)
#pragma unroll
            for (int m = 0; m < 4; ++m)
#pragma unroll
                for (int bj = 0; bj < 2; ++bj) rr[ai][m][bj] = *(const u32x4*)(XB + (size_t)(row0 + ai * HALF + m * 16) * D + col0 + bj * HALF);
        PIN16(rr);
#pragma unroll
        for (int ai = 0; ai < 2; ++ai)
#pragma unroll
            for (int m = 0; m < 4; ++m) { const size_t row = (size_t)(row0 + ai * HALF + m * 16); float ssq = 0.f;
#pragma unroll
                for (int bj = 0; bj < 2; ++bj) { const int c = col0 + bj * HALF; f32x4 r0, r1; unpack8(rr[ai][m][bj], r0, r1);
                    f32x4 v0 = r0 + acc[ai][bj][m][0] * coef, v1 = r1 + acc[ai][bj][m][1] * coef;
                    if (FINAL) { *(f32x4*)(Of + row * D + c) = v0; *(f32x4*)(Of + row * D + c + 4) = v1; }
                    else { const u32x4 w = pack8(v0, v1); *(u32x4*)(XB + row * D + c) = w; unpack8(w, v0, v1); }
                    ssq += dot4(v0) + dot4(v1); }
                ssq += shx(ssq, fq * 16 + fr, 16); ssq += shx(ssq, fq * 16 + fr, 32);
                if (fq == 0) SS[row * 16 + 4 * u.pn + wc] = ssq; }
    } };
struct EpiProjF { static constexpr bool PERM = true, AFTER_DRAIN = false, HOOK = false, RSTD = true; static constexpr int HOOK_T = 0; bf16_t* PA; bf16_t* PB; float* SG; const float* SS; const float* fb; const float* ib; const float* mfb; unsigned* QKN;
    __device__ __forceinline__ void operator()(const f32x4 (&acc)[2][2][4][2], const Unit& u, int wr, int wc, int fr, int fq, PG8_LAS unsigned char* lds) const {
        const int row0 = u.pm * BM + wr * 64 + fr;
        float rs[2][4]; row_rstd(lds, wr, fr, rs);
        if (u.pn < 22) {
            const int act = u.pn < 2 ? 0 : (u.pn < 12 ? 1 : 2); const int col0 = (u.pn < 12 ? u.pn : u.pn - 12) * BM + wc * 32 + 8 * fq;
            bf16_t* base = u.pn < 12 ? PA : PB; const int pitch = u.pn < 12 ? PJA : PJB;
            float nmx[2] = {0.f, 0.f};
#pragma unroll
            for (int ai = 0; ai < 2; ++ai)
#pragma unroll
                for (int m = 0; m < 4; ++m) { bf16_t* rowp = base + (size_t)(row0 + ai * HALF + m * 16) * pitch + col0; const float r = rs[ai][m] * (act == 0 ? QSCALE2 : 1.0f);
#pragma unroll
                    for (int bj = 0; bj < 2; ++bj) { f32x4 v0 = acc[ai][bj][m][0] * r, v1 = acc[ai][bj][m][1] * r;
                        if (u.pn < 4) { float p = dot4(v0) + dot4(v1); p += shx(p, fq * 16 + fr, 16); p += shx(p, fq * 16 + fr, 32); nmx[bj] = fmaxf(nmx[bj], p); }
                        if (act == 2) {
#pragma unroll
                            for (int i = 0; i < 4; ++i) { v0[i] = fsig(v0[i]); v1[i] = fsig(v1[i]); } }
                        __builtin_nontemporal_store(pack8(v0, v1), (u32x4*)(rowp + bj * HALF)); } }
            if (u.pn < 4) {
#pragma unroll
                for (int bj = 0; bj < 2; ++bj) { float p = nmx[bj];
#pragma unroll
                    for (int o = 1; o < 16; o <<= 1) p = fmaxf(p, shx(p, fq * 16 + fr, o));
                    if (fr == 0 && fq == 0) atomicMax(QKN + (((u.pm >> 3) * 8 + 4 * (u.pn & 1) + 2 * bj + (wc >> 1)) * 4 + 2 * (u.pn >> 1) + (wc & 1)), __builtin_bit_cast(unsigned, p)); } }
        } else if (wc == 0 && fq < 2) {
            const f32x4 b0 = fq == 0 ? *(const f32x4*)fb : *(const f32x4*)ib, b1 = fq == 0 ? *(const f32x4*)(fb + 4) : *(const f32x4*)mfb;
#pragma unroll
            for (int ai = 0; ai < 2; ++ai)
#pragma unroll
                for (int m = 0; m < 4; ++m) { float* sp = SG + (size_t)(row0 + ai * HALF + m * 16) * 16 + 8 * fq; const float r = rs[ai][m];
                    f32x4 v0 = acc[ai][0][m][0] * r + b0, v1 = acc[ai][0][m][1] * r + b1;
#pragma unroll
                    for (int i = 0; i < 4; ++i) { if (fq == 0) v0[i] = logsigmoidf_(v0[i]); v1[i] = logsigmoidf_(v1[i]); }
                    *(f32x4*)sp = v0; *(f32x4*)(sp + 4) = v1; }
        }
    } };
struct EpiMergeF { static constexpr bool PERM = true, AFTER_DRAIN = false, HOOK = true, RSTD = false; static constexpr int HOOK_T = 8; const bf16_t* PB; bf16_t* MG;
    __device__ __forceinline__ void mid(f32x4 (&acc)[2][2][4][2], const Unit& u, int wr, int wc, int fr, int fq) const {
        int row0 = u.pm * BM + wr * 64 + fr, col0 = u.pn * BM + wc * 32 + 8 * fq; asm volatile("" : "+v"(row0), "+v"(col0));
#pragma unroll
        for (int ai = 0; ai < 2; ++ai) {
            u32x4 gg[2][4][2];
#pragma unroll
            for (int m = 0; m < 4; ++m)
#pragma unroll
                for (int bj = 0; bj < 2; ++bj) { const bf16_t* rowp = PB + (size_t)(row0 + ai * HALF + m * 16) * PJB + col0 + bj * HALF; gg[0][m][bj] = *(const u32x4*)(rowp + PB_GA); gg[1][m][bj] = *(const u32x4*)(rowp + PB_GB); }
            PIN16(gg);
#pragma unroll
            for (int m = 0; m < 4; ++m) {
#pragma unroll
                for (int bj = 0; bj < 2; ++bj) { f32x4 a0, a1, b0, b1; unpack8(gg[0][m][bj], a0, a1); unpack8(gg[1][m][bj], b0, b1);
#pragma unroll
                    for (int i = 0; i < 4; ++i) { acc[ai][bj][m][0][i] *= a0[i] * __builtin_amdgcn_rcpf(fmaxf(b0[i], 1e-30f)); acc[ai][bj][m][1][i] *= a1[i] * __builtin_amdgcn_rcpf(fmaxf(b1[i], 1e-30f)); } } } }
    }
    __device__ __forceinline__ void operator()(const f32x4 (&acc)[2][2][4][2], const Unit& u, int wr, int wc, int fr, int fq, PG8_LAS unsigned char* lds) const {
        const int row0 = u.pm * BM + wr * 64 + fr, col0 = u.pn * BM + wc * 32 + 8 * fq;
        u32x4 gb[2][4][2];
#pragma unroll
        for (int ai = 0; ai < 2; ++ai)
#pragma unroll
            for (int m = 0; m < 4; ++m)
#pragma unroll
                for (int bj = 0; bj < 2; ++bj) gb[ai][m][bj] = *(const u32x4*)(PB + (size_t)(row0 + ai * HALF + m * 16) * PJB + PB_GB + col0 + bj * HALF);
        PIN16(gb);
#pragma unroll
        for (int ai = 0; ai < 2; ++ai)
#pragma unroll
            for (int m = 0; m < 4; ++m) { const size_t row = (size_t)(row0 + ai * HALF + m * 16);
#pragma unroll
                for (int bj = 0; bj < 2; ++bj) { const int c = col0 + bj * HALF; f32x4 b0, b1; unpack8(gb[ai][m][bj], b0, b1);
                    *(u32x4*)(MG + row * D + c) = pack8(b0 * acc[ai][bj][m][0], b1 * acc[ai][bj][m][1]); } }
    } };
}

__device__ __forceinline__ void transpose_item(const float* W, int N, int scol0, bf16* WT, int ldt, int drow0, int k0, int kdst0, LAS float* scr, int lane, const float* gain) {
#pragma unroll 8
    for (int i = 0; i < 32; ++i) { const int kk = 2 * i + (lane >> 5); const float gk = gain ? gain[k0 + kk] : 1.0f; scr[kk * 33 + (lane & 31)] = W[(size_t)(k0 + kk) * N + scol0 + (lane & 31)] * gk; }
    asm volatile("s_waitcnt lgkmcnt(0)" ::: "memory");
    const int c = lane & 7;
#pragma unroll
    for (int j = 0; j < 4; ++j) { const int n = (lane >> 3) + 8 * j; const LAS float* s = scr + (8 * c) * 33 + n;
        v4u o; o.x = pk2(s[0 * 33], s[1 * 33]); o.y = pk2(s[2 * 33], s[3 * 33]); o.z = pk2(s[4 * 33], s[5 * 33]); o.w = pk2(s[6 * 33], s[7 * 33]);
        *(GAS v4u*)(WT + (size_t)(drow0 + n) * ldt + kdst0 + k0 + 8 * c) = o; }
    asm volatile("s_waitcnt lgkmcnt(0)" ::: "memory");
}
__device__ __forceinline__ void phase_weights(Frame& F) {
    const int ptid = opaque_tid(F.wave), plane = ptid & 63, pwave = __builtin_amdgcn_readfirstlane(ptid >> 6); (void)plane; (void)pwave;
    LAS float* scr = (LAS float*)(F.lds + pwave * 16384);
    const int gw = blockIdx.x * NWAVES + pwave, NGW = F.G * NWAVES;
    constexpr int PJ = PJA + PJB; constexpr int I_IN = (D / 64) * (NFF / 32), I_OUT = (DFF / 64) * (D / 32), I_PJ = (D / 64) * (PJ / 32), I_UP = (512 / 64) * (D / 32), I_WO = (D / 64) * (D / 32);
    constexpr int NITEMS = 2 * I_IN + 2 * I_OUT + I_PJ + 2 * I_UP + I_WO;
    for (int it = gw; it < NITEMS; it += NGW) {
        int r = it;
        if (r < 2 * I_IN) { const int which = r / I_IN; r -= which * I_IN; const int ndb = NFF / 32, kb = r / ndb, db = r % ndb, n = db * 32, pn = n >> 8, j = n & 255;
            const int sc = (j < 128) ? pn * 128 + j : DFF + pn * 128 + (j - 128);
            transpose_item(F.in[which ? 15 : 2], NFF, sc, (bf16*)(F.ws + (which ? WS_W2IN : WS_W1IN)), D, n, kb * 64, 0, scr, plane, F.in[which ? 14 : 1]); continue; }
        r -= 2 * I_IN;
        if (r < 2 * I_OUT) { const int which = r / I_OUT; r -= which * I_OUT; const int ndb = D / 32, kb = r / ndb, db = r % ndb;
            transpose_item(F.in[which ? 16 : 3], D, db * 32, (bf16*)(F.ws + (which ? WS_W2OUT : WS_W1OUT)), DFF, db * 32, kb * 64, 0, scr, plane, nullptr); continue; }
        r -= 2 * I_OUT;
        if (r < I_PJ) { const int ndb = PJ / 32, kb = r / ndb, db = r % ndb, n = db * 32; const int sc = n + (n < 1536 ? 0 : (n < 3072 ? 8 : 16));
            transpose_item(F.in[5], INC, sc, (bf16*)(F.ws + WS_WIN), D, n, kb * 64, 0, scr, plane, F.in[4]); continue; }
        r -= I_PJ;
        if (r < 2 * I_UP) { const int which = r / I_UP; r -= which * I_UP; const int ndb = D / 32, kb = r / ndb, db = r % ndb;
            transpose_item(F.in[which ? 12 : 11], D, db * 32, (bf16*)(F.ws + WS_WCAT), D, db * 32, kb * 64, which ? 512 : 0, scr, plane, nullptr); continue; }
        r -= 2 * I_UP;
        { const int ndb = D / 32, kb = r / ndb, db = r % ndb; transpose_item(F.in[13], D, db * 32, (bf16*)(F.ws + WS_WOUT), D, db * 32, kb * 64, 0, scr, plane, nullptr); }
    }
    { bf16* WT = (bf16*)(F.ws + WS_WIN); const float* W = F.in[5];
      for (int idx = blockIdx.x * NTHR + ptid; idx < 256 * 128; idx += F.G * NTHR) { const int row = idx >> 7, k8 = (idx & 127) * 8; v4u o = {0u, 0u, 0u, 0u};
          if (row < 16) { const int sc = row < 8 ? 1536 + row : (row < 12 ? 3080 + (row - 8) : 3084 + (row - 12)); float v[8];
#pragma unroll
              for (int i = 0; i < 8; ++i) v[i] = W[(size_t)(k8 + i) * INC + sc] * F.in[4][k8 + i];
              o.x = pk2(v[0], v[1]); o.y = pk2(v[2], v[3]); o.z = pk2(v[4], v[5]); o.w = pk2(v[6], v[7]); }
          *(GAS v4u*)(WT + (size_t)(PJ + row) * D + k8) = o; } }
}

#include <hip/hip_bf16.h>
#include <cmath>
namespace attn_body {
using bf16=__hip_bfloat16;
using bf16x8=__attribute__((ext_vector_type(8)))short;
using s16x4=__attribute__((ext_vector_type(4)))short;
using f32x16=__attribute__((ext_vector_type(16)))float;
using u32x4=__attribute__((ext_vector_type(4)))unsigned;
constexpr int BATCH=32,NHEAD=8,SEQ=2048,D=64,DM=3072,OP=1024;
constexpr int NW=8,QBLK=32,QB=QBLK*NW,KVBLK=64,NQB=SEQ/QB;
constexpr int ATTN_PITCH=DM, ATTN_UNIT_ROWS=QB;
__device__ __forceinline__ int crow(int r,int hi){return (r&3)+8*(r>>2)+4*hi;}
#define SBAR() __builtin_amdgcn_sched_barrier(0)
__device__ __forceinline__ void cmask(f32x16&p0,f32x16&p1,int jb,int qrel,int hi){
  const float NEG=-INFINITY; int kb=64*jb+4*hi;
  #pragma unroll
  for(int r=0;r<16;++r){int kv=kb+(r&3)+8*(r>>2); if(kv>qrel)p0[r]=NEG; if(kv+32>qrel)p1[r]=NEG;}
}

constexpr int NSLOT=3, SLOTB=8192;
constexpr int LDS_K=0, LDS_V=NSLOT*SLOTB, LDS_WS=2*NSLOT*SLOTB, LDS_OST=LDS_WS+NW*64*4, LDS_BIAS=LDS_OST+NW*4096, LDS_ROWB=LDS_BIAS+SEQ*8, LDS_BYTES=LDS_ROWB+QB*4;
constexpr float C2=0.125f*1.4426950408889634f;
__device__ __forceinline__ void glds16(const void*gsrc,unsigned lds_dst){unsigned keep;
  asm volatile("s_mov_b32 %0, m0\n\ts_mov_b32 m0, %2\n\ts_nop 0\n\tglobal_load_lds_dwordx4 %1, off\n\ts_mov_b32 m0, %0":"=&s"(keep):"v"(gsrc),"s"(lds_dst):"memory");}
__device__ __forceinline__ float max3f(float a,float b,float c){float r;asm("v_max3_f32 %0, %1, %2, %3":"=v"(r):"v"(a),"v"(b),"v"(c));return r;}
__device__ __forceinline__ float max2f(float a,float b){float r;asm("v_max_f32_e32 %0, %1, %2":"=v"(r):"v"(a),"v"(b));return r;}
__device__ __forceinline__ float fadd_s(float a,float b){float r;asm("v_add_f32_e32 %0, %1, %2":"=v"(r):"v"(a),"v"(b));return r;}
__device__ __forceinline__ float fsub_s(float a,float b){float r;asm("v_sub_f32_e32 %0, %1, %2":"=v"(r):"v"(a),"v"(b));return r;}
typedef float f32x2_t __attribute__((ext_vector_type(2))); typedef __bf16 bf16x2_t __attribute__((ext_vector_type(2)));
__device__ __forceinline__ unsigned cvtpk_s(float lo,float hi){f32x2_t v={lo,hi};bf16x2_t b=__builtin_convertvector(v,bf16x2_t);return __builtin_bit_cast(unsigned,b);}
#define WAIT_BAR(N) asm volatile("s_waitcnt vmcnt(" #N ") lgkmcnt(0)\n\ts_barrier":::"memory")

__device__ __forceinline__ void qkt(f32x16&p0,f32x16&p1,const char*Kslot,const bf16x8*qr,int r32,int hi,bf16x8 kx0,bf16x8 kx1,bf16x8 qx){
  const char*kb=Kslot+hi*1024+r32*16;
  #pragma unroll
  for(int d0=0;d0<4;++d0){
    const bf16x8 b0=*reinterpret_cast<const bf16x8*>(kb+d0*2048);
    const bf16x8 b1=*reinterpret_cast<const bf16x8*>(kb+d0*2048+512);
    if(d0==0){p0=__builtin_amdgcn_mfma_f32_32x32x16_bf16(b0,qr[0],f32x16{},0,0,0);p1=__builtin_amdgcn_mfma_f32_32x32x16_bf16(b1,qr[0],f32x16{},0,0,0);}
    else{p0=__builtin_amdgcn_mfma_f32_32x32x16_bf16(b0,qr[d0],p0,0,0,0);p1=__builtin_amdgcn_mfma_f32_32x32x16_bf16(b1,qr[d0],p1,0,0,0);}}
  p0=__builtin_amdgcn_mfma_f32_32x32x16_bf16(kx0,qx,p0,0,0,0);p1=__builtin_amdgcn_mfma_f32_32x32x16_bf16(kx1,qx,p1,0,0,0);
}
typedef __attribute__((address_space(3))) const char* lds_cptr;
typedef short v4i16_t __attribute__((ext_vector_type(4)));
__device__ __forceinline__ void kload8(bf16x8*kf,lds_cptr kp){
  kf[0]=*(const __attribute__((address_space(3))) bf16x8*)(kp);      kf[1]=*(const __attribute__((address_space(3))) bf16x8*)(kp+512);
  kf[2]=*(const __attribute__((address_space(3))) bf16x8*)(kp+2048); kf[3]=*(const __attribute__((address_space(3))) bf16x8*)(kp+2560);
  kf[4]=*(const __attribute__((address_space(3))) bf16x8*)(kp+4096); kf[5]=*(const __attribute__((address_space(3))) bf16x8*)(kp+4608);
  kf[6]=*(const __attribute__((address_space(3))) bf16x8*)(kp+6144); kf[7]=*(const __attribute__((address_space(3))) bf16x8*)(kp+6656);
}
__device__ __forceinline__ void kload2(bf16x8*kf,lds_cptr kp,int j){ kf[2*j]=*(const __attribute__((address_space(3))) bf16x8*)(kp+j*2048); kf[2*j+1]=*(const __attribute__((address_space(3))) bf16x8*)(kp+j*2048+512); }
typedef unsigned u32x2_t __attribute__((ext_vector_type(2)));
__device__ __forceinline__ bf16x8 kxfrag(lds_cptr tbl,int kv,int hi){ u32x2_t b=*(const __attribute__((address_space(3))) u32x2_t*)(tbl+kv*8); if(hi){b.x=0u;b.y=0u;} const u32x4 w={b.x,b.y,hi?0u:0x3F803F80u,0u}; return __builtin_bit_cast(bf16x8,w); }
__device__ __forceinline__ s16x4 vtr(lds_cptr p){ return __builtin_bit_cast(s16x4,__builtin_amdgcn_ds_read_tr16_b64_v4i16((__attribute__((address_space(3))) v4i16_t*)p)); }
__device__ __forceinline__ float rowmax(const f32x16&p0,const f32x16&p1){
  float a=max3f(p0[0],p0[1],p1[0]),b=max3f(p0[2],p0[3],p1[1]);a=max3f(a,p1[2],p1[3]);
  #pragma unroll
  for(int r=4;r<16;r+=4){a=max3f(a,p0[r],p0[r+1]);b=max3f(b,p0[r+2],p0[r+3]);a=max3f(a,p1[r],p1[r+1]);b=max3f(b,p1[r+2],p1[r+3]);}
  const float m=max2f(a,b);
  auto rr=__builtin_amdgcn_permlane32_swap(__float_as_uint(m),__float_as_uint(m),false,false);
  return max2f(__uint_as_float(rr[0]),__uint_as_float(rr[1]));
}
__device__ __forceinline__ void pv(f32x16*o,int vb,bf16x8 pa0,bf16x8 pa1,bf16x8 pa2,bf16x8 pa3){
  #pragma unroll
  for(int d0=0;d0<2;++d0){s16x4 lo[4],hi[4];
    #pragma unroll
    for(int ks=0;ks<4;++ks){
      asm volatile("ds_read_b64_tr_b16 %0,%1 offset:%c2":"=&v"(lo[ks]):"v"(vb),"i"(d0*4096+ks*1024):"memory");
      asm volatile("ds_read_b64_tr_b16 %0,%1 offset:%c2":"=&v"(hi[ks]):"v"(vb),"i"(d0*4096+ks*1024+512):"memory");}
    asm volatile("s_waitcnt lgkmcnt(0)":::"memory");SBAR();
    #define PK(k) (bf16x8){lo[k][0],lo[k][1],lo[k][2],lo[k][3],hi[k][0],hi[k][1],hi[k][2],hi[k][3]}
    o[d0]=__builtin_amdgcn_mfma_f32_32x32x16_bf16(pa0,PK(0),o[d0],0,0,0);
    o[d0]=__builtin_amdgcn_mfma_f32_32x32x16_bf16(pa1,PK(1),o[d0],0,0,0);
    o[d0]=__builtin_amdgcn_mfma_f32_32x32x16_bf16(pa2,PK(2),o[d0],0,0,0);
    o[d0]=__builtin_amdgcn_mfma_f32_32x32x16_bf16(pa3,PK(3),o[d0],0,0,0);
    #undef PK
  }
}

#ifndef ATTN_STORE16
#define ATTN_STORE16(p,v) (*(u32x4*)(p)=(v))
#endif
template<int THRL> __device__ __forceinline__ void attn_unit(int b,int h,int qb,const bf16*Q,const bf16*__restrict__ K,const bf16*__restrict__ V,bf16*O,const float*CUMh,char*shm,const int wv,const float qkb){
  int tid_=wv*64+(int)__builtin_amdgcn_mbcnt_hi(~0u,__builtin_amdgcn_mbcnt_lo(~0u,0u)); asm volatile("":"+v"(tid_)); const int tid=tid_,lane=tid&63,r32=lane&31,hi=lane>>5; const int wid=__builtin_amdgcn_readfirstlane(tid>>6);
  const long rowbase=(long)b*SEQ; const int q0=qb*QB;
  const bf16*Qw=Q+(rowbase+q0+wid*QBLK)*DM+h*D;
  int t0; { const int NTF_=(q0+QB)/KVBLK; const float cref_=CUMh[q0]; const float ce_=(lane<NTF_-4)?CUMh[64*lane+63]:cref_;
    const bool sk_=(lane<NTF_-4)&&(qkb+(cref_-ce_)*1.4426950408889634f<-160.f); const unsigned long long nb_=~__ballot(sk_); t0=__builtin_amdgcn_readfirstlane((int)__builtin_ctzll(nb_))&~1; }
  const bf16*Kh=K+(rowbase+(long)t0*KVBLK)*DM+h*D,*Vh=V+(rowbase+(long)t0*KVBLK)*DM+h*D;
  const unsigned lds0=(unsigned)(uintptr_t)shm;
  float*wsf=(float*)(shm+LDS_WS)+wid*64;
  const bf16*ksrc=Kh+(long)lane*DM+wid*8;
  const bf16*vsrc=Vh+(long)(16*(wid&3)+(lane>>2))*DM+(wid>>2)*32+(lane&3)*8;
  const unsigned kdst=lds0+LDS_K+wid*1024, vdst=lds0+LDS_V+wid*1024;
  #define DMA_K(t,slot) glds16(ksrc+(long)(t)*KVBLK*DM,(unsigned)__builtin_amdgcn_readfirstlane(kdst+(slot)))
  #define DMA_V(t,slot) glds16(vsrc+(long)(t)*KVBLK*DM,(unsigned)__builtin_amdgcn_readfirstlane(vdst+(slot)))
  const int vb0=(int)(lds0+LDS_V)+((lane>>4)&1)*32+(lane&3)*8+(4*hi+((lane&15)>>2))*64;
  const char*Kbase=shm+LDS_K; bf16x8 kf[8];
  const lds_cptr shm3=(lds_cptr)shm; const lds_cptr kp0=shm3+LDS_K+hi*1024+r32*16; const lds_cptr vp0=shm3+LDS_V+((lane>>4)&1)*32+(lane&3)*8+(4*hi+((lane&15)>>2))*64;
  const int NT=(q0+QB)/KVBLK-t0;
  DMA_K(0,0);DMA_V(0,0);DMA_K(1,SLOTB);
  bf16x8 qr[4];
  #pragma unroll
  for(int d0=0;d0<4;++d0)qr[d0]=*reinterpret_cast<const bf16x8*>(&Qw[(long)r32*DM+d0*16+hi*8]);
  const int qrel=wid*QBLK+r32;
  { const float cref=CUMh[q0]; __attribute__((address_space(3))) unsigned*bt=(__attribute__((address_space(3))) unsigned*)(shm3+LDS_BIAS); __attribute__((address_space(3))) float*rb=(__attribute__((address_space(3))) float*)(shm3+LDS_ROWB);
    for(int kv=KVBLK*t0+tid;kv<q0+QB;kv+=NW*64){ const float bias=(cref-CUMh[kv])*1.4426950408889634f;
      const unsigned u1=__builtin_bit_cast(unsigned,bias); const unsigned h1=(u1+0x7fffu+((u1>>16)&1u))&0xffff0000u; const float r1=bias-__builtin_bit_cast(float,h1);
      const unsigned u2=__builtin_bit_cast(unsigned,r1);   const unsigned h2=(u2+0x7fffu+((u2>>16)&1u))&0xffff0000u; const float r2=r1-__builtin_bit_cast(float,h2);
      const unsigned u3=__builtin_bit_cast(unsigned,r2);   const unsigned h3=(u3+0x7fffu+((u3>>16)&1u))&0xffff0000u;
      bt[2*kv]=(h1>>16)|h2; bt[2*kv+1]=(h3>>16)|0x3F800000u; if(kv>=q0)rb[kv-q0]=bias; } }
  const lds_cptr btab=shm3+LDS_BIAS+t0*(KVBLK*8); u32x4 qxw={hi?0u:0x3F803F80u,0u,0u,0u};
  #define QX __builtin_bit_cast(bf16x8,qxw)
  #define RNEHI(u) (((u)+0x7fffu+(((u)>>16)&1u))&0xffff0000u)
  #define SETQX() do{ const float nm_=-mhat; const unsigned a1_=RNEHI(__builtin_bit_cast(unsigned,nm_)); const float s1_=nm_-__builtin_bit_cast(float,a1_); \
      const unsigned a2_=RNEHI(__builtin_bit_cast(unsigned,s1_)); const float s2_=s1_-__builtin_bit_cast(float,a2_); const unsigned a3_=RNEHI(__builtin_bit_cast(unsigned,s2_)); \
      qxw.y=hi?0u:(a1_|0x3F80u); qxw.z=hi?0u:((a2_>>16)|a3_); }while(0)
  float mhat=0.f,l_reg=0.f;f32x16 o[2];o[0]=f32x16{};o[1]=f32x16{};
  #define CMASK(P0,P1,t) do{int jb_=(t)-(NT-4); if(jb_>=0)cmask(P0,P1,jb_,qrel,hi);}while(0)
  bool resc=false;
  #define START(P0,P1) do{ const float rm=rowmax(P0,P1); resc=false; \
    { const float dl=max2f(rm,0.f); mhat=fadd_s(mhat,dl); \
      _Pragma("unroll") for(int r=0;r<16;++r){P0[r]=fsub_s(P0[r],dl);P1[r]=fsub_s(P1[r],dl);} \
      SETQX(); } \
    _Pragma("unroll") for(int r=0;r<16;++r)P0[r]=__builtin_amdgcn_exp2f(P0[r]); }while(0)
  #define RESC() do{ if(resc){ asm volatile("s_waitcnt lgkmcnt(0)":::"memory"); \
      _Pragma("unroll") for(int d_=0;d_<2;++d_) _Pragma("unroll") for(int r=0;r<16;++r)o[d_][r]*=wsf[crow(r,hi)]; } }while(0)
  f32x16 pA0,pA1,pB0,pB1;
  int sl_prev=0,sl_cur=0,sl_next=SLOTB;
  #define ROT() do{sl_prev=sl_cur;sl_cur=sl_next;sl_next=(sl_next==(NSLOT-1)*SLOTB)?0:sl_next+SLOTB;}while(0)
  DMA_K(2,2*SLOTB);
  WAIT_BAR(3);
  mhat=*(const __attribute__((address_space(3))) float*)(shm3+LDS_ROWB+qrel*4);
  SETQX();
  qkt(pA0,pA1,Kbase,qr,r32,hi,kxfrag(btab,r32,hi),kxfrag(btab,32+r32,hi),QX);asm volatile("s_nop 15\n\ts_nop 7":"+v"(pA0),"+v"(pA1));CMASK(pA0,pA1,0);
  START(pA0,pA1);
  _Pragma("unroll") for(int r=0;r<16;++r)pA1[r]=__builtin_amdgcn_exp2f(pA1[r]);
  WAIT_BAR(0);
  DMA_K(3,0);DMA_V(1,SLOTB);
  ROT();
  kload8(kf,kp0+sl_cur);
  WAIT_BAR(2);
  s16x4 vlo[8],vhi[8]; u32x4 pw0,pw1,pw2,pw3;
  #define PKW(P,B) cvtpk_s(P[B],P[B+1])
  #define PAF(k) __builtin_bit_cast(bf16x8,pw##k)
  #define VFR(i) (bf16x8){vlo[i][0],vlo[i][1],vlo[i][2],vlo[i][3],vhi[i][0],vhi[i][1],vhi[i][2],vhi[i][3]}
  #define PIN(x) asm volatile("":"+v"(x))
  #define MX3(a,b,c) __builtin_fmaxf(__builtin_fmaxf((a),(b)),(c))
  #define GAPA(MF,A0,A1,A2,A3,W0,W1,PW) do{ MF; sacc+=A0; sacc+=A1; sacc+=A2; sacc+=A3; PIN(sacc); W0; W1; PIN(PW); SBAR(); }while(0)
  #define EX(v) __builtin_amdgcn_exp2f(v)
  #define GAPB(MF,X,B) do{ MF; X[B]=EX(X[B]); X[B+1]=EX(X[B+1]); X[B+2]=EX(X[B+2]); X[B+3]=EX(X[B+3]); PIN(X); SBAR(); }while(0)
  #define VRD(i) do{ vlo[i]=vtr(vp_+(((i)>>2)*4096+((i)&3)*1024)); vhi[i]=vtr(vp_+(((i)>>2)*4096+((i)&3)*1024+512)); }while(0)
  #define KRD(G,j) do{ if(G){ kload2(kf,kp0+sl_next,j); SBAR(); } }while(0)
  #define STEP(C0,C1,P0,P1,t,GK,GV,GL) do{ SBAR(); \
    const lds_cptr vp_=vp0+sl_prev; \
    const bf16x8 kx0_=kxfrag(btab,64*(t)+r32,hi), kx1_=kxfrag(btab,64*(t)+32+r32,hi); \
    VRD(0); SBAR(); float sacc=(P0[0]+P0[1]); \
    GAPA(C0=__builtin_amdgcn_mfma_f32_32x32x16_bf16(kf[0],qr[0],f32x16{},0,0,0), P0[2],P0[3],P0[4],P0[5],     pw0[0]=PKW(P0,0), pw0[1]=PKW(P0,2), pw0); \
    VRD(4); SBAR(); GAPA(C1=__builtin_amdgcn_mfma_f32_32x32x16_bf16(kf[1],qr[0],f32x16{},0,0,0), P0[6],P0[7],P0[8],P0[9],     pw0[2]=PKW(P0,4), pw0[3]=PKW(P0,6), pw0); \
    VRD(1); SBAR(); GAPA(C0=__builtin_amdgcn_mfma_f32_32x32x16_bf16(kf[2],qr[1],C0,0,0,0),   P0[10],P0[11],P0[12],P0[13], pw1[0]=PKW(P0,8), pw1[1]=PKW(P0,10), pw1); \
    VRD(5); SBAR(); GAPA(C1=__builtin_amdgcn_mfma_f32_32x32x16_bf16(kf[3],qr[1],C1,0,0,0),   P0[14],P0[15],P1[0],P1[1],   pw1[2]=PKW(P0,12),pw1[3]=PKW(P0,14), pw1); \
    VRD(2); SBAR(); GAPA(C0=__builtin_amdgcn_mfma_f32_32x32x16_bf16(kf[4],qr[2],C0,0,0,0),   P1[2],P1[3],P1[4],P1[5],     pw2[0]=PKW(P1,0), pw2[1]=PKW(P1,2), pw2); \
    VRD(6); SBAR(); GAPA(C1=__builtin_amdgcn_mfma_f32_32x32x16_bf16(kf[5],qr[2],C1,0,0,0),   P1[6],P1[7],P1[8],P1[9],     pw2[2]=PKW(P1,4), pw2[3]=PKW(P1,6), pw2); \
    VRD(3); SBAR(); GAPA(C0=__builtin_amdgcn_mfma_f32_32x32x16_bf16(kf[6],qr[3],C0,0,0,0),   P1[10],P1[11],P1[12],P1[13], pw3[0]=PKW(P1,8), pw3[1]=PKW(P1,10), pw3); \
    VRD(7); SBAR(); GAPA(C1=__builtin_amdgcn_mfma_f32_32x32x16_bf16(kf[7],qr[3],C1,0,0,0),   P1[14],P1[15],0.f,0.f,       pw3[2]=PKW(P1,12),pw3[3]=PKW(P1,14), pw3); \
    C0=__builtin_amdgcn_mfma_f32_32x32x16_bf16(kx0_,QX,C0,0,0,0); C1=__builtin_amdgcn_mfma_f32_32x32x16_bf16(kx1_,QX,C1,0,0,0); SBAR(); \
    l_reg+=sacc; \
    if(GK){DMA_K((t)+3,sl_cur);} if(GV){DMA_V((t)+1,sl_next);} \
    CMASK(C0,C1,t); \
    { float a=MX3(C0[0],C0[1],C1[0]),b=MX3(C0[2],C0[3],C1[1]); a=MX3(a,C1[2],C1[3]); \
      _Pragma("unroll") for(int r=4;r<16;r+=4){a=MX3(a,C0[r],C0[r+1]);b=MX3(b,C0[r+2],C0[r+3]);a=MX3(a,C1[r],C1[r+1]);b=MX3(b,C1[r+2],C1[r+3]);} \
      float rm=__builtin_fmaxf(a,b); { auto rr=__builtin_amdgcn_permlane32_swap(__float_as_uint(rm),__float_as_uint(rm),false,false); rm=__builtin_fmaxf(__uint_as_float(rr[0]),__uint_as_float(rr[1])); } \
      resc=false; \
      if(__builtin_expect(__any(rm>(float)THRL),0)){ const float dl=__builtin_fmaxf(rm,0.f); mhat+=dl; \
        _Pragma("unroll") for(int r=0;r<16;++r){C0[r]-=dl;C1[r]-=dl;} \
        SETQX(); \
        const float f=__builtin_amdgcn_exp2f(-dl); l_reg*=f; if(hi==0)wsf[r32]=f; resc=true; } } \
    SBAR(); \
    GAPB(o[0]=__builtin_amdgcn_mfma_f32_32x32x16_bf16(PAF(0),VFR(0),o[0],0,0,0), C0,0); \
    GAPB(o[1]=__builtin_amdgcn_mfma_f32_32x32x16_bf16(PAF(0),VFR(4),o[1],0,0,0), C0,4); \
    KRD(GL,0); GAPB(o[0]=__builtin_amdgcn_mfma_f32_32x32x16_bf16(PAF(1),VFR(1),o[0],0,0,0), C0,8); \
    KRD(GL,1); GAPB(o[1]=__builtin_amdgcn_mfma_f32_32x32x16_bf16(PAF(1),VFR(5),o[1],0,0,0), C0,12); \
    KRD(GL,2); GAPB(o[0]=__builtin_amdgcn_mfma_f32_32x32x16_bf16(PAF(2),VFR(2),o[0],0,0,0), C1,0); \
    KRD(GL,3); GAPB(o[1]=__builtin_amdgcn_mfma_f32_32x32x16_bf16(PAF(2),VFR(6),o[1],0,0,0), C1,4); \
    GAPB(o[0]=__builtin_amdgcn_mfma_f32_32x32x16_bf16(PAF(3),VFR(3),o[0],0,0,0), C1,8); \
    GAPB(o[1]=__builtin_amdgcn_mfma_f32_32x32x16_bf16(PAF(3),VFR(7),o[1],0,0,0), C1,12); \
    }while(0)
  int t=1;
  #undef CMASK
  #define CMASK(P0,P1,t) do{}while(0)
  for(;t+5<NT;t+=2){
    STEP(pB0,pB1,pA0,pA1,t,true,true,true);     WAIT_BAR(2); RESC(); ROT();
    STEP(pA0,pA1,pB0,pB1,t+1,true,true,true);   WAIT_BAR(2); RESC(); ROT();
  }
  #undef CMASK
  #define CMASK(P0,P1,t) do{int jb_=(t)-(NT-4); if(jb_>=0)cmask(P0,P1,jb_,qrel,hi);}while(0)
  #define ENDW(tt) do{ if((tt)+3<NT){WAIT_BAR(2);} else if((tt)+2<NT){WAIT_BAR(1);} else {WAIT_BAR(0);} }while(0)
  for(;t+1<NT;t+=2){
    STEP(pB0,pB1,pA0,pA1,t,(t+3<NT),(t+1<NT),(t+1<NT));       ENDW(t);   RESC(); ROT();
    STEP(pA0,pA1,pB0,pB1,t+1,(t+4<NT),(t+2<NT),(t+2<NT));     ENDW(t+1); RESC(); ROT();
  }
  STEP(pB0,pB1,pA0,pA1,NT-1,false,false,false); RESC();
  { float sacc=pB0[0]+pB0[1]; _Pragma("unroll") for(int r=2;r<16;++r)sacc+=pB0[r]; _Pragma("unroll") for(int r=0;r<16;++r)sacc+=pB1[r]; l_reg+=sacc;
    pw0=(u32x4){PKW(pB0,0),PKW(pB0,2),PKW(pB0,4),PKW(pB0,6)};pw1=(u32x4){PKW(pB0,8),PKW(pB0,10),PKW(pB0,12),PKW(pB0,14)};pw2=(u32x4){PKW(pB1,0),PKW(pB1,2),PKW(pB1,4),PKW(pB1,6)};pw3=(u32x4){PKW(pB1,8),PKW(pB1,10),PKW(pB1,12),PKW(pB1,14)};
    SBAR(); pv(o,vb0+sl_cur,PAF(0),PAF(1),PAF(2),PAF(3)); }
  #undef PKW
  #undef PAF
  #undef VFR
  #undef PIN
  #undef MX3
  #undef GAPA
  #undef GAPB
  #undef EX
  #undef VRD
  #undef KRD
  #undef STEP
  #undef ENDW
  {auto rr=__builtin_amdgcn_permlane32_swap(__float_as_uint(l_reg),__float_as_uint(l_reg),false,false);l_reg=__uint_as_float(rr[0])+__uint_as_float(rr[1]);}
  if(hi==0)wsf[32+r32]=l_reg;asm volatile("s_waitcnt lgkmcnt(0)":::"memory");
  float rli[16];
  #pragma unroll
  for(int r=0;r<16;++r)rli[r]=__builtin_amdgcn_rcpf(wsf[32+crow(r,hi)]);
  bf16*Ow=O+(rowbase+q0+wid*QBLK)*OP+h*D;
  { bf16*stg=(bf16*)(shm+LDS_OST)+wid*2048;
    #pragma unroll
    for(int r=0;r<16;++r){const int orow=crow(r,hi);
      #pragma unroll
      for(int d0=0;d0<2;++d0)stg[orow*64+d0*32+r32]=__float2bfloat16(o[d0][r]*rli[r]);}
    asm volatile("s_waitcnt lgkmcnt(0)":::"memory");
    #pragma unroll
    for(int i=0;i<4;++i){const int row=i*8+(lane>>3),ch=lane&7; const u32x4 v=*(const u32x4*)(stg+row*64+ch*8); ATTN_STORE16(Ow+(long)row*OP+ch*8,v);} }
  asm volatile("s_waitcnt lgkmcnt(0)\n\ts_barrier":::"memory");
  #undef DMA_K
  #undef QX
  #undef RNEHI
  #undef SETQX
  #undef DMA_V
  #undef CMASK
  #undef START
  #undef RESC
  #undef ROT
}
constexpr int ATTN_LDS_BYTES=LDS_BYTES;
struct AttnTensors { const bf16* Q; const bf16* K; const bf16* V; bf16* O; const float* CUM; const unsigned* QKN; };
struct AttnUnit { int bh; int qb; };
struct StaticOrder {
  int c,G;
  __device__ __forceinline__ StaticOrder(int grid,int block):c(block),G(grid){}
  __device__ __forceinline__ bool next(int i,AttnUnit&u)const{ const int it=i*G+c; if(it>=BATCH*NHEAD*NQB)return false; u.bh=it%(BATCH*NHEAD); u.qb=NQB-1-it/(BATCH*NHEAD); return true; }
};
template<int THRL=8> __device__ __forceinline__ void attn_phase_queue(char*lds,const AttnTensors&T,unsigned*head,volatile __attribute__((address_space(3))) unsigned*slot,const int wv){
  for(;;){
    if(wv==0){ int l=(int)__builtin_amdgcn_mbcnt_hi(~0u,__builtin_amdgcn_mbcnt_lo(~0u,0u)); asm volatile("":"+v"(l)); if(l==0) *slot=__hip_atomic_fetch_add(head,1u,__ATOMIC_RELAXED,__HIP_MEMORY_SCOPE_AGENT); }
    asm volatile("s_waitcnt vmcnt(0) lgkmcnt(0)\n\ts_barrier":::"memory");
    const unsigned it=*slot;
    asm volatile("s_waitcnt lgkmcnt(0)\n\ts_barrier":::"memory");
    if(it>=(unsigned)(BATCH*NHEAD*NQB))break;
    const int bh=(int)(it%(unsigned)(BATCH*NHEAD)),qb=NQB-1-(int)(it/(unsigned)(BATCH*NHEAD));
    const unsigned*n4=T.QKN+bh*4; const float qkb=1.03f*sqrtf(__builtin_bit_cast(float,n4[0])+__builtin_bit_cast(float,n4[1]))*sqrtf(__builtin_bit_cast(float,n4[2])+__builtin_bit_cast(float,n4[3]))+1.0f;
    attn_unit<THRL>(bh/NHEAD,bh%NHEAD,qb,T.Q,T.K,T.V,T.O,T.CUM+(size_t)bh*SEQ,lds,wv,qkb);
  }
}
template<class Sched,int THRL=8> __device__ __forceinline__ void attn_phase(char*lds,const AttnTensors&T,const Sched&S,const int wv){
  AttnUnit u;
  for(int i=0;S.next(i,u);++i){ const unsigned*n4=T.QKN+u.bh*4; const float qkb=1.03f*sqrtf(__builtin_bit_cast(float,n4[0])+__builtin_bit_cast(float,n4[1]))*sqrtf(__builtin_bit_cast(float,n4[2])+__builtin_bit_cast(float,n4[3]))+1.0f;
    attn_unit<THRL>(u.bh/NHEAD,u.bh%NHEAD,u.qb,T.Q,T.K,T.V,T.O,T.CUM+(size_t)u.bh*SEQ,lds,wv,qkb); }
}
#undef SBAR
#undef WAIT_BAR
}

namespace mls {
typedef short bf16x8 __attribute__((ext_vector_type(8)));
typedef float f32x4v __attribute__((ext_vector_type(4)));
typedef unsigned u32x2v __attribute__((ext_vector_type(2)));
typedef unsigned u32x4v __attribute__((ext_vector_type(4)));
constexpr int QS = 136, TS = 72;
constexpr int L_Q = 0, L_K = 17408, L_KT = 34816, L_VT = 53248, L_WVT = 73984, L_SC = 94720, L_END = 103936;
constexpr float QK_SCALE = 0.08838834764831845f;
constexpr size_t G_A = 2 * MiB, G_RT = 3 * MiB, G_IT = 4 * MiB, G_EM = 5 * MiB, G_WK = 6 * MiB, G_CD = 7 * MiB, G_DL = 8 * MiB, G_UN = 9 * MiB, G_HALO = 11 * MiB;
__device__ __forceinline__ float scan_add(float v, int lane) {
#pragma unroll
    for (int o = 1; o < 64; o <<= 1) { const float t = bperm(v, (lane - o) & 63); if (lane >= o) v += t; }
    return v; }
__device__ __forceinline__ float scan_max(float v, int lane) {
#pragma unroll
    for (int o = 1; o < 64; o <<= 1) { const float t = bperm(v, (lane - o) & 63); if (lane >= o) v = fmaxf(v, t); }
    return v; }
__device__ __forceinline__ float lo_bf(unsigned w) { return __builtin_bit_cast(float, w << 16); }
__device__ __forceinline__ float hi_bf(unsigned w) { return __builtin_bit_cast(float, w & 0xffff0000u); }
typedef float f32x2_t __attribute__((ext_vector_type(2))); typedef __bf16 bf16x2_t __attribute__((ext_vector_type(2)));
__device__ __forceinline__ unsigned cvtpk(float lo, float hi) { f32x2_t v = {lo, hi}; bf16x2_t b = __builtin_convertvector(v, bf16x2_t); return __builtin_bit_cast(unsigned, b); }
__device__ __forceinline__ float fsilu(float v) { return v * __builtin_amdgcn_rcpf(1.f + __builtin_amdgcn_exp2f(-1.4426950408889634f * v)); }
}
__device__ __forceinline__ void phase_mgates(Frame& F, const float* SG) {
    using namespace mls;
    const int ptid = opaque_tid(F.wave), plane = ptid & 63, pwave = __builtin_amdgcn_readfirstlane(ptid >> 6);
    const int gw = blockIdx.x * NWAVES + pwave, NGW = F.G * NWAVES;
    float* GA = (float*)(F.ws + G_A); float* GPM = (float*)(F.ws + G_RT); float* GB = (float*)(F.ws + G_IT); float* GP63 = (float*)(F.ws + G_WK); float* GG = GP63 + BATCH * MLH * 32;
    for (int task = gw; task < BATCH * MLH * 32; task += NGW) {
        const int bh = task >> 5, c = task & 31, b = bh >> 2, h = bh & 3;
        const size_t row = (size_t)b * SEQ + 64 * c + plane;
        const float ig = SG[row * 16 + 8 + h], lf = SG[row * 16 + 12 + h];
        const float bcum = scan_add(lf, plane), aval = ig - bcum, pm = scan_max(aval, plane);
        const size_t idx = (size_t)bh * SEQ + 64 * c + plane;
        GA[idx] = aval; GPM[idx] = pm; GB[idx] = bcum;
        if (plane == 63) { GP63[task] = pm; GG[task] = bcum; }
    }
}
__device__ __forceinline__ void phase_mprep(Frame& F, const bf16* PA, const float* convw, const float* convb, bf16* SCR) {
    using namespace mls;
    const int tid = opaque_tid(F.wave), lane = tid & 63, wid = __builtin_amdgcn_readfirstlane(tid >> 6), l15 = lane & 15, q4 = lane >> 4;
    LAS unsigned char* L = F.lds;
    const float* GA = (const float*)(F.ws + G_A); const float* GPM = (const float*)(F.ws + G_RT); const float* GB = (const float*)(F.ws + G_IT); const float* GP63 = (const float*)(F.ws + G_WK); const float* GG = GP63 + BATCH * MLH * 32;
    float* GEM = (float*)(F.ws + G_EM); float* GCD = (float*)(F.ws + G_CD);
    float* DL = (float*)(F.ws + G_DL); float* UN = (float*)(F.ws + G_UN);
    const int ch2 = tid & 127, tq = __builtin_amdgcn_readfirstlane(tid >> 7); const bool isk = (wid & 1) != 0;
    const int cc = (ch2 & 63) * 2;
    const int e2 = tid & 63, sg = __builtin_amdgcn_readfirstlane(tid >> 6);
    const __amdgpu_buffer_rsrc_t rsP = __builtin_amdgcn_make_buffer_rsrc((void*)PA, 0, M * PJA * 2, 0x00020000), rsS = __builtin_amdgcn_make_buffer_rsrc((void*)SCR, 0, M * D * 4, 0x00020000);
    constexpr int S_QI = 0, S_UT = M * 512 * 2, S_NL = M * 1536 * 2;
    __syncthreads();
    for (int i = tid; i < 16 * TS / 2; i += NTHR) { ((LAS unsigned*)(L + L_VT + 128 * TS * 2))[i] = (i < TS / 2) ? 0x3F803F80u : 0u; ((LAS unsigned*)(L + L_WVT + 128 * TS * 2))[i] = 0u; }
    unsigned raw[19], vraw[8]; float g_pm, g_b, g_a, g_p63, g_g;
#define MP_BAR() asm volatile("s_waitcnt lgkmcnt(0)\n\ts_barrier" ::: "memory")
#define MP_LOAD(item) do { const int bh_ = (item) >> 5, c_ = (item) & 31, b_ = bh_ >> 2, h_ = bh_ & 3; const int r0_ = b_ * SEQ + 64 * c_; \
        const unsigned lo_raw_ = (unsigned)((isk ? PC_MK : PC_MQ) + h_ * 128 + cc) * 2u, lo_v_ = (unsigned)(PC_MV + h_ * 128 + 2 * e2) * 2u; \
        _Pragma("unroll") for (int i_ = 0; i_ < 19; ++i_) { const int tr_ = 16 * tq - 3 + i_; raw[i_] = (64 * c_ + tr_ >= 0) ? __builtin_amdgcn_raw_buffer_load_b32(rsP, lo_raw_, (r0_ + tr_) * (PJA * 2), 0) : 0u; } \
        _Pragma("unroll") for (int i_ = 0; i_ < 8; ++i_) vraw[i_] = __builtin_amdgcn_raw_buffer_load_b32(rsP, lo_v_, (r0_ + 8 * sg + i_) * (PJA * 2), 0); \
        const size_t gi_ = (size_t)bh_ * SEQ + 64 * c_ + lane; g_pm = GPM[gi_]; g_b = GB[gi_]; g_a = GA[gi_]; g_p63 = GP63[bh_ * 32 + (lane & 31)]; g_g = GG[bh_ * 32 + (lane & 31)]; } while (0)
    int it = blockIdx.x;
    if (it < BATCH * MLH * 32) MP_LOAD(it);
    for (; it < BATCH * MLH * 32; it += F.G) {
        const int bh = it >> 5, c = it & 31, b = bh >> 2, h = bh & 3; const int row0 = b * SEQ + 64 * c;
        const int cch = (isk ? 512 : 0) + h * 128 + cc;
        float w0[2], w1[2], w2[2], w3[2], cb[2];
#pragma unroll
        for (int i = 0; i < 2; ++i) { w0[i] = convw[cch + i]; w1[i] = convw[1024 + cch + i]; w2[i] = convw[2048 + cch + i]; w3[i] = convw[3072 + cch + i]; cb[i] = convb[cch + i]; }
        float mcar = 0.f;
        for (int cp = 0; cp < c; ++cp) mcar = rdl(g_g, cp) + fmaxf(mcar, rdl(g_p63, cp));
        const float Mx = fmaxf(mcar, rdl(g_p63, c)), mrow = fmaxf(g_pm, mcar);
        const float rowterm = -mrow, inter = __expf(mcar - mrow), aval = g_a, wk = __expf(g_a - Mx);
        if (wid == 0) { GEM[(size_t)bh * SEQ + 64 * c + lane] = __expf(-(g_b + mrow)); if (lane == 0) GCD[bh * 32 + c] = __expf(mcar - Mx); }
        {
            unsigned kt0[8], kt1[8];
#pragma unroll
            for (int i = 0; i < 16; i += 2) {
                float y[2][2];
#pragma unroll
                for (int u = 0; u < 2; ++u) {
                    const float a0 = w0[0] * lo_bf(raw[i + u]) + w1[0] * lo_bf(raw[i + u + 1]) + w2[0] * lo_bf(raw[i + u + 2]) + w3[0] * lo_bf(raw[i + u + 3]) + cb[0];
                    const float a1 = w0[1] * hi_bf(raw[i + u]) + w1[1] * hi_bf(raw[i + u + 1]) + w2[1] * hi_bf(raw[i + u + 2]) + w3[1] * hi_bf(raw[i + u + 3]) + cb[1];
                    y[u][0] = fsilu(a0); y[u][1] = fsilu(a1);
                    const int t = 16 * tq + i + u;
                    if (!isk) { const float q0 = y[u][0] * QK_SCALE, q1 = y[u][1] * QK_SCALE; const float itv = rdl(inter, t);
                        *(LAS unsigned*)(L + L_Q + (t * QS + cc) * 2) = cvtpk(q0, q1);
                        __builtin_amdgcn_raw_buffer_store_b32(cvtpk(q0 * itv, q1 * itv), rsS, (unsigned)((cc >> 5) * 1024 + ((cc >> 3) & 3) * 256 + (cc & 7) * 2), S_QI + (it * 4 + (t >> 4)) * 4096 + (t & 15) * 16, 0); }
                    else *(LAS unsigned*)(L + L_K + (t * QS + cc) * 2) = cvtpk(y[u][0], y[u][1]);
                }
                kt0[i >> 1] = cvtpk(y[0][0], y[1][0]); kt1[i >> 1] = cvtpk(y[0][1], y[1][1]);
            }
            if (isk) {
                *(LAS u32x4v*)(L + L_KT + (cc * TS + 16 * tq) * 2) = (u32x4v){kt0[0], kt0[1], kt0[2], kt0[3]}; *(LAS u32x4v*)(L + L_KT + (cc * TS + 16 * tq + 8) * 2) = (u32x4v){kt0[4], kt0[5], kt0[6], kt0[7]};
                *(LAS u32x4v*)(L + L_KT + ((cc + 1) * TS + 16 * tq) * 2) = (u32x4v){kt1[0], kt1[1], kt1[2], kt1[3]}; *(LAS u32x4v*)(L + L_KT + ((cc + 1) * TS + 16 * tq + 8) * 2) = (u32x4v){kt1[4], kt1[5], kt1[6], kt1[7]};
            }
            float v0[8], v1[8], wv[8];
#pragma unroll
            for (int i = 0; i < 8; ++i) { v0[i] = lo_bf(vraw[i]); v1[i] = hi_bf(vraw[i]); wv[i] = rdl(wk, 8 * sg + i); }
            *(LAS u32x4v*)(L + L_VT + ((2 * e2) * TS + 8 * sg) * 2) = (u32x4v){cvtpk(v0[0], v0[1]), cvtpk(v0[2], v0[3]), cvtpk(v0[4], v0[5]), cvtpk(v0[6], v0[7])};
            *(LAS u32x4v*)(L + L_VT + ((2 * e2 + 1) * TS + 8 * sg) * 2) = (u32x4v){cvtpk(v1[0], v1[1]), cvtpk(v1[2], v1[3]), cvtpk(v1[4], v1[5]), cvtpk(v1[6], v1[7])};
            *(LAS u32x4v*)(L + L_WVT + ((2 * e2) * TS + 8 * sg) * 2) = (u32x4v){cvtpk(v0[0] * wv[0], v0[1] * wv[1]), cvtpk(v0[2] * wv[2], v0[3] * wv[3]), cvtpk(v0[4] * wv[4], v0[5] * wv[5]), cvtpk(v0[6] * wv[6], v0[7] * wv[7])};
            *(LAS u32x4v*)(L + L_WVT + ((2 * e2 + 1) * TS + 8 * sg) * 2) = (u32x4v){cvtpk(v1[0] * wv[0], v1[1] * wv[1]), cvtpk(v1[2] * wv[2], v1[3] * wv[3]), cvtpk(v1[4] * wv[4], v1[5] * wv[5]), cvtpk(v1[6] * wv[6], v1[7] * wv[7])};
            if (wid == 0) *(LAS unsigned short*)(L + L_WVT + (128 * TS + lane) * 2) = (unsigned short)f2bf(wk);
        }
        if (it + F.G < BATCH * MLH * 32) MP_LOAD(it + F.G);
        MP_BAR();
        {
            const int tt = wid >> 1;
#pragma unroll
            for (int si = 0; si < 2; ++si) {
                const int ss = 2 * (wid & 1) + si;
                f32x4v acc = (f32x4v){0.f, 0.f, 0.f, 0.f};
                if (ss <= tt) {
#pragma unroll
                    for (int kd = 0; kd < 4; ++kd) {
                        const bf16x8 a = *(const LAS bf16x8*)(L + L_Q + ((16 * tt + l15) * QS + 32 * kd + 8 * q4) * 2);
                        const bf16x8 bb = *(const LAS bf16x8*)(L + L_K + ((16 * ss + l15) * QS + 32 * kd + 8 * q4) * 2);
                        acc = __builtin_amdgcn_mfma_f32_16x16x32_bf16(a, bb, acc, 0, 0, 0);
                    }
                }
                const int s = 16 * ss + l15; const float as_ = bperm(aval, s);
#pragma unroll
                for (int j = 0; j < 4; ++j) { const int t = 16 * tt + 4 * q4 + j; const float rt = bperm(rowterm, t);
                    const float dv = (s <= t) ? acc[j] * __expf(rt + as_) : 0.f;
                    *(LAS unsigned short*)(L + L_SC + (t * TS + s) * 2) = (unsigned short)f2bf(dv); }
            }
        }
        {
            const int db = wid;
#pragma unroll
            for (int eg = 0; eg < 9; ++eg) {
                f32x4v acc = (f32x4v){0.f, 0.f, 0.f, 0.f};
#pragma unroll
                for (int ks = 0; ks < 2; ++ks) {
                    const bf16x8 a = *(const LAS bf16x8*)(L + L_KT + ((16 * db + l15) * TS + 32 * ks + 8 * q4) * 2);
                    const bf16x8 bb = *(const LAS bf16x8*)(L + L_WVT + ((16 * eg + l15) * TS + 32 * ks + 8 * q4) * 2);
                    acc = __builtin_amdgcn_mfma_f32_16x16x32_bf16(a, bb, acc, 0, 0, 0);
                }
                if (eg < 8) { const int e = 16 * eg + l15;
                    __builtin_amdgcn_raw_buffer_store_b64((u32x2v){cvtpk(acc[0], acc[1]), cvtpk(acc[2], acc[3])}, rsS, (unsigned)((((q4 >> 1) * 16 + l15) * 16) + 8 * (q4 & 1)), S_UT + ((it * 8 + eg) * 4 + (db >> 1)) * 1024 + ((2 * db) & 3) * 256, 0); (void)e; }
                else if (l15 == 0) *(u32x2v*)((char*)UN + ((size_t)(it * 4 + (db >> 1)) * 4 + (((2 * db) & 3) + (q4 >> 1))) * 16 + 8 * (q4 & 1)) = (u32x2v){cvtpk(acc[0], acc[1]), cvtpk(acc[2], acc[3])};
            }
        }
        MP_BAR();
        for (int p = wid; p < 36; p += NWAVES) {
            const int tt = p & 3, eg = p >> 2;
            f32x4v acc = (f32x4v){0.f, 0.f, 0.f, 0.f};
#pragma unroll
            for (int ks = 0; ks < 2; ++ks) {
                const bf16x8 a = *(const LAS bf16x8*)(L + L_VT + ((16 * eg + l15) * TS + 32 * ks + 8 * q4) * 2);
                const bf16x8 bb = *(const LAS bf16x8*)(L + L_SC + ((16 * tt + l15) * TS + 32 * ks + 8 * q4) * 2);
                acc = __builtin_amdgcn_mfma_f32_16x16x32_bf16(a, bb, acc, 0, 0, 0);
            }
            if (eg < 8) __builtin_amdgcn_raw_buffer_store_b64((u32x2v){cvtpk(acc[0], acc[1]), cvtpk(acc[2], acc[3])}, rsS, (unsigned)lane * 8u, S_NL + ((it * 8 + eg) * 4 + tt) * 512, 0);
            else if (q4 == 0) DL[(size_t)(row0 + 16 * tt + l15) * 4 + h] = acc[0];
        }
        MP_BAR();
    }
#undef MP_LOAD
#undef MP_BAR
}
__device__ __forceinline__ void phase_mchain(Frame& F, const bf16* SCR, const bf16* PB, bf16* AO) {
    using namespace mls;
    const int tid = opaque_tid(F.wave), lane = tid & 63, wid = __builtin_amdgcn_readfirstlane(tid >> 6), l15 = lane & 15, q4 = lane >> 4;
    const float* GEM = (const float*)(F.ws + G_EM); const float* GCD = (const float*)(F.ws + G_CD); const float* DL = (const float*)(F.ws + G_DL); const float* UN = (const float*)(F.ws + G_UN);
    constexpr int S_QI = 0, S_UT = M * 512 * 2, S_NL = M * 1536 * 2;
    const __amdgpu_buffer_rsrc_t rsP = __builtin_amdgcn_make_buffer_rsrc((void*)SCR, 0, M * D * 4, 0x00020000), rsB = __builtin_amdgcn_make_buffer_rsrc((void*)PB, 0, M * PJB * 2, 0x00020000),
                                 rsO = __builtin_amdgcn_make_buffer_rsrc((void*)AO, 0, M * D * 2, 0x00020000), rsE = __builtin_amdgcn_make_buffer_rsrc((void*)GEM, 0, BATCH * MLH * SEQ * 4, 0x00020000),
                                 rsD = __builtin_amdgcn_make_buffer_rsrc((void*)DL, 0, M * 16, 0x00020000), rsU = __builtin_amdgcn_make_buffer_rsrc((void*)UN, 0, BATCH * MLH * 32 * 128 * 2, 0x00020000);
    const unsigned lo_o = (unsigned)(l15 * D + 4 * q4) * 2u, lo_m = (unsigned)(l15 * PJB + 4 * q4) * 2u, lo_d = (unsigned)l15 * 16u, lo_e = (unsigned)l15 * 4u;
    const int th = wid >> 2;
    for (int id = blockIdx.x * 4 + (wid & 3); id < BATCH * MLH * 8; id += F.G * 4) {
        const int bh = id >> 3, eg = id & 7, b = bh >> 2, h = bh & 3;
        const int r00 = b * SEQ;
        float Cst[4][8], nst[4][8];
#pragma unroll
        for (int kd = 0; kd < 4; ++kd)
#pragma unroll
            for (int j = 0; j < 8; ++j) { Cst[kd][j] = 0.f; nst[kd][j] = 0.f; }
        u32x4v qfA[2][4], qfB[2][4], ut[4], un[4]; u32x2v nlA[2], moA[2], nlB[2], moB[2]; float dlA[2], emA[2], dlB[2], emB[2], cd;
#define MC_LOADQ(c, qf) do { const int it_ = bh * 32 + (c); \
            _Pragma("unroll") for (int t2_ = 0; t2_ < 2; ++t2_) \
                _Pragma("unroll") for (int kd_ = 0; kd_ < 4; ++kd_) qf[t2_][kd_] = __builtin_amdgcn_raw_buffer_load_b128(rsP, (unsigned)lane * 16u, S_QI + ((it_ * 4 + 2 * th + t2_) * 4 + kd_) * 1024, 0); } while (0)
#define MC_LOADS(c, nl, mo, dl, em) do { const int r0_ = r00 + 64 * (c), it_ = bh * 32 + (c); \
            _Pragma("unroll") for (int t2_ = 0; t2_ < 2; ++t2_) { const int rt_ = r0_ + 16 * (2 * th + t2_); \
                nl[t2_] = __builtin_amdgcn_raw_buffer_load_b64(rsP, (unsigned)lane * 8u, S_NL + ((it_ * 8 + eg) * 4 + 2 * th + t2_) * 512, 0); mo[t2_] = __builtin_amdgcn_raw_buffer_load_b64(rsB, lo_m, (rt_ * PJB + PB_MO + h * 128 + 16 * eg) * 2, 0); \
                dl[t2_] = __builtin_bit_cast(float, __builtin_amdgcn_raw_buffer_load_b32(rsD, lo_d, (rt_ * 4 + h) * 4, 0)); em[t2_] = __builtin_bit_cast(float, __builtin_amdgcn_raw_buffer_load_b32(rsE, lo_e, (bh * SEQ + 64 * (c) + 16 * (2 * th + t2_)) * 4, 0)); } } while (0)
#define MC_LOADU(c) do { const int it_ = bh * 32 + (c); \
            _Pragma("unroll") for (int kd_ = 0; kd_ < 4; ++kd_) { ut[kd_] = __builtin_amdgcn_raw_buffer_load_b128(rsP, (unsigned)lane * 16u, S_UT + ((it_ * 8 + eg) * 4 + kd_) * 1024, 0); \
                un[kd_] = __builtin_amdgcn_raw_buffer_load_b128(rsU, (unsigned)q4 * 16u, (it_ * 4 + kd_) * 64, 0); } \
            cd = GCD[it_]; } while (0)
#define MC_STEP(c, qf, nl, mo, dl, em, qfN, nlN, moN, dlN, emN) do { const int r0_ = r00 + 64 * (c); \
            if ((c) + 1 < SEQ / 64) { MC_LOADQ((c) + 1, qfN); MC_LOADS((c) + 1, nlN, moN, dlN, emN); } \
            f32x4v acc_[2], accd_[2]; \
            _Pragma("unroll") for (int t2_ = 0; t2_ < 2; ++t2_) { acc_[t2_] = (f32x4v){lo_bf(nl[t2_].x), hi_bf(nl[t2_].x), lo_bf(nl[t2_].y), hi_bf(nl[t2_].y)}; accd_[t2_] = (f32x4v){q4 == 0 ? dl[t2_] : 0.f, 0.f, 0.f, 0.f}; } \
            _Pragma("unroll") for (int kd_ = 0; kd_ < 4; ++kd_) { \
                const bf16x8 af_ = __builtin_bit_cast(bf16x8, (u32x4v){cvtpk(Cst[kd_][0], Cst[kd_][1]), cvtpk(Cst[kd_][2], Cst[kd_][3]), cvtpk(Cst[kd_][4], Cst[kd_][5]), cvtpk(Cst[kd_][6], Cst[kd_][7])}); \
                const bf16x8 nf_ = __builtin_bit_cast(bf16x8, (u32x4v){cvtpk(nst[kd_][0], nst[kd_][1]), cvtpk(nst[kd_][2], nst[kd_][3]), cvtpk(nst[kd_][4], nst[kd_][5]), cvtpk(nst[kd_][6], nst[kd_][7])}); \
                _Pragma("unroll") for (int t2_ = 0; t2_ < 2; ++t2_) { acc_[t2_] = __builtin_amdgcn_mfma_f32_16x16x32_bf16(af_, __builtin_bit_cast(bf16x8, qf[t2_][kd_]), acc_[t2_], 0, 0, 0); \
                    accd_[t2_] = __builtin_amdgcn_mfma_f32_16x16x32_bf16(nf_, __builtin_bit_cast(bf16x8, qf[t2_][kd_]), accd_[t2_], 0, 0, 0); } } \
            _Pragma("unroll") for (int t2_ = 0; t2_ < 2; ++t2_) { \
                const float den_ = bperm(accd_[t2_][0], l15); const float rd_ = 1.0f / fmaxf(fabsf(den_), em[t2_]); \
                const float o0_ = acc_[t2_][0] * rd_ * lo_bf(mo[t2_].x), o1_ = acc_[t2_][1] * rd_ * hi_bf(mo[t2_].x), o2_ = acc_[t2_][2] * rd_ * lo_bf(mo[t2_].y), o3_ = acc_[t2_][3] * rd_ * hi_bf(mo[t2_].y); \
                __builtin_amdgcn_raw_buffer_store_b64((u32x2v){cvtpk(o0_, o1_), cvtpk(o2_, o3_)}, rsO, lo_o, ((r0_ + 16 * (2 * th + t2_)) * D + 512 + h * 128 + 16 * eg) * 2, 0); } \
            _Pragma("unroll") for (int kd_ = 0; kd_ < 4; ++kd_) { const unsigned uw_[4] = {ut[kd_].x, ut[kd_].y, ut[kd_].z, ut[kd_].w}; const unsigned nw_[4] = {un[kd_].x, un[kd_].y, un[kd_].z, un[kd_].w}; \
                _Pragma("unroll") for (int j_ = 0; j_ < 4; ++j_) { Cst[kd_][2 * j_] = cd * Cst[kd_][2 * j_] + lo_bf(uw_[j_]); Cst[kd_][2 * j_ + 1] = cd * Cst[kd_][2 * j_ + 1] + hi_bf(uw_[j_]); \
                    nst[kd_][2 * j_] = (l15 == 0) ? cd * nst[kd_][2 * j_] + lo_bf(nw_[j_]) : 0.f; nst[kd_][2 * j_ + 1] = (l15 == 0) ? cd * nst[kd_][2 * j_ + 1] + hi_bf(nw_[j_]) : 0.f; } } \
            if ((c) + 1 < SEQ / 64) MC_LOADU((c) + 1); } while (0)
        MC_LOADQ(0, qfA); MC_LOADS(0, nlA, moA, dlA, emA); MC_LOADU(0);
        for (int c = 0; c < SEQ / 64; c += 2) {
            MC_STEP(c, qfA, nlA, moA, dlA, emA, qfB, nlB, moB, dlB, emB);
            MC_STEP(c + 1, qfB, nlB, moB, dlB, emB, qfA, nlA, moA, dlA, emA);
        }
#undef MC_LOADQ
#undef MC_LOADS
#undef MC_LOADU
#undef MC_STEP
    }
}

__device__ __forceinline__ void phase_mlstm_fused(Frame& F, const bf16* P, const bf16* PBg, const float* SG, const float* convw, const float* convb, bf16* AO) {
    using namespace mls;
    constexpr int L_Q = 0, L_QI = 17408, L_K = 34816, L_KT = 52224, L_VT = 70656, L_WVT = 82176, L_SC = 93696, L_CT = 102912, L_DEN = 124672;
    const float* GA = (const float*)(F.ws + G_A); const float* GPM = (const float*)(F.ws + G_RT); const float* GB = (const float*)(F.ws + G_IT); const float* GP63 = (const float*)(F.ws + G_WK); const float* GG = GP63 + BATCH * MLH * 32;
#define ML_BAR() asm volatile("s_waitcnt lgkmcnt(0)\n\ts_barrier" ::: "memory")
    const int tid = opaque_tid(F.wave), lane = tid & 63, wid = __builtin_amdgcn_readfirstlane(tid >> 6), l15 = lane & 15, q4 = lane >> 4;
    LAS unsigned char* L = F.lds;
    for (int it = blockIdx.x; it < BATCH * MLH * 2; it += F.G) {
        const int vh = it & 1, bh = it >> 1, b = bh / MLH, h = bh % MLH;
        const size_t row00 = (size_t)b * SEQ;
        const int ch2 = tid & 127, tq = __builtin_amdgcn_readfirstlane(tid >> 7); const bool isk = (wid & 1) != 0;
        const int cc = (ch2 & 63) * 2;
        const int pcol = (isk ? PC_MK : PC_MQ) + h * 128 + cc, cch = (isk ? 512 : 0) + h * 128 + cc;
        float w0[2], w1[2], w2[2], w3[2], cb[2];
#pragma unroll
        for (int i = 0; i < 2; ++i) { w0[i] = convw[cch + i]; w1[i] = convw[1024 + cch + i]; w2[i] = convw[2048 + cch + i]; w3[i] = convw[3072 + cch + i]; cb[i] = convb[cch + i]; }
        const int e2 = tid & 31, sg = tid >> 5;
        const int vcol = PC_MV + h * 128 + vh * 64 + 2 * e2;
        f32x4v Cacc[8];
#pragma unroll
        for (int i = 0; i < 8; ++i) Cacc[i] = (f32x4v){0.f, 0.f, 0.f, 0.f};
        float mcar = 0.f;
        __syncthreads();
        for (int i = tid; i < 80 * QS / 2; i += NTHR) ((LAS unsigned*)(L + L_CT))[i] = 0u;
        for (int i = tid; i < 16 * TS / 2; i += NTHR) { ((LAS unsigned*)(L + L_VT + 64 * TS * 2))[i] = (i < TS / 2) ? 0x3F803F80u : 0u; ((LAS unsigned*)(L + L_WVT + 64 * TS * 2))[i] = 0u; }
        unsigned raw[19], vraw[4]; float g_a, g_pm, g_b, g_p63, g_g;
        const unsigned lo_raw = (unsigned)pcol * 2u, lo_v = (unsigned)((4 * sg) * PJA + vcol) * 2u, lo_o = (unsigned)((4 * q4) * PJB + l15) * 2u, lo_ao = (unsigned)((4 * q4) * D + l15) * 2u;
        const __amdgpu_buffer_rsrc_t rsP = __builtin_amdgcn_make_buffer_rsrc((void*)P, 0, M * PJA * 2, 0x00020000), rsB = __builtin_amdgcn_make_buffer_rsrc((void*)PBg, 0, M * PJB * 2, 0x00020000),
                                     rsO = __builtin_amdgcn_make_buffer_rsrc((void*)AO, 0, M * D * 2, 0x00020000);
        const int r00 = (int)row00;
#define MLS_LOAD(c) do { _Pragma("unroll") for (int i_ = 0; i_ < 19; ++i_) { const int tr_ = 64 * (c) + 16 * tq - 3 + i_; raw[i_] = (tr_ >= 0) ? __builtin_amdgcn_raw_buffer_load_b32(rsP, lo_raw, (r00 + tr_) * (PJA * 2), 0) : 0u; } \
        _Pragma("unroll") for (int i_ = 0; i_ < 4; ++i_) vraw[i_] = __builtin_amdgcn_raw_buffer_load_b32(rsP, lo_v, (r00 + 64 * (c) + i_) * (PJA * 2), 0); \
        { const size_t gi_ = (size_t)bh * SEQ + 64 * (c) + lane; g_a = GA[gi_]; g_pm = GPM[gi_]; g_b = GB[gi_]; g_p63 = GP63[bh * 32 + (c)]; g_g = GG[bh * 32 + (c)]; } } while (0)
        MLS_LOAD(0);
        for (int c = 0; c < SEQ / 64; ++c) {
            const size_t row0 = row00 + 64 * c;
            const float bcum = g_b, aval = g_a, pm = g_pm, pm63 = g_p63, gsum = g_g;
            const float Mx = fmaxf(mcar, pm63), mrow = fmaxf(pm, mcar);
            const float rowterm = -mrow, inter = __expf(mcar - mrow), emt = __expf(-(bcum + mrow)), wk = __expf(aval - Mx), cdec = __expf(mcar - Mx);
            mcar = gsum + Mx;
            {
                unsigned kt0[8], kt1[8];
#pragma unroll
                for (int i = 0; i < 16; i += 2) {
                    float y[2][2];
#pragma unroll
                    for (int u = 0; u < 2; ++u) {
                        float a0 = w0[0] * lo_bf(raw[i + u]) + w1[0] * lo_bf(raw[i + u + 1]) + w2[0] * lo_bf(raw[i + u + 2]) + w3[0] * lo_bf(raw[i + u + 3]) + cb[0];
                        float a1 = w0[1] * hi_bf(raw[i + u]) + w1[1] * hi_bf(raw[i + u + 1]) + w2[1] * hi_bf(raw[i + u + 2]) + w3[1] * hi_bf(raw[i + u + 3]) + cb[1];
                        y[u][0] = fsilu(a0); y[u][1] = fsilu(a1);
                        const int t = 16 * tq + i + u;
                        if (!isk) { const float q0 = y[u][0] * QK_SCALE, q1 = y[u][1] * QK_SCALE; const float itv = rdl(inter, t);
                            *(LAS unsigned*)(L + L_Q + (t * QS + cc) * 2) = cvtpk(q0, q1); *(LAS unsigned*)(L + L_QI + (t * QS + cc) * 2) = cvtpk(q0 * itv, q1 * itv); }
                        else *(LAS unsigned*)(L + L_K + (t * QS + cc) * 2) = cvtpk(y[u][0], y[u][1]);
                    }
                    kt0[i >> 1] = cvtpk(y[0][0], y[1][0]); kt1[i >> 1] = cvtpk(y[0][1], y[1][1]);
                }
                if (isk) {
                    *(LAS u32x4v*)(L + L_KT + (cc * TS + 16 * tq) * 2) = (u32x4v){kt0[0], kt0[1], kt0[2], kt0[3]}; *(LAS u32x4v*)(L + L_KT + (cc * TS + 16 * tq + 8) * 2) = (u32x4v){kt0[4], kt0[5], kt0[6], kt0[7]};
                    *(LAS u32x4v*)(L + L_KT + ((cc + 1) * TS + 16 * tq) * 2) = (u32x4v){kt1[0], kt1[1], kt1[2], kt1[3]}; *(LAS u32x4v*)(L + L_KT + ((cc + 1) * TS + 16 * tq + 8) * 2) = (u32x4v){kt1[4], kt1[5], kt1[6], kt1[7]};
                }
            }
            {
                float v0[4], v1[4], wv[4];
#pragma unroll
                for (int i = 0; i < 4; ++i) { v0[i] = lo_bf(vraw[i]); v1[i] = hi_bf(vraw[i]); wv[i] = bperm(wk, 4 * sg + i); }
                *(LAS u32x2v*)(L + L_VT + ((2 * e2) * TS + 4 * sg) * 2) = (u32x2v){cvtpk(v0[0], v0[1]), cvtpk(v0[2], v0[3])};
                *(LAS u32x2v*)(L + L_VT + ((2 * e2 + 1) * TS + 4 * sg) * 2) = (u32x2v){cvtpk(v1[0], v1[1]), cvtpk(v1[2], v1[3])};
                *(LAS u32x2v*)(L + L_WVT + ((2 * e2) * TS + 4 * sg) * 2) = (u32x2v){cvtpk(v0[0] * wv[0], v0[1] * wv[1]), cvtpk(v0[2] * wv[2], v0[3] * wv[3])};
                *(LAS u32x2v*)(L + L_WVT + ((2 * e2 + 1) * TS + 4 * sg) * 2) = (u32x2v){cvtpk(v1[0] * wv[0], v1[1] * wv[1]), cvtpk(v1[2] * wv[2], v1[3] * wv[3])};
                if (wid == 0) *(LAS unsigned short*)(L + L_WVT + (64 * TS + lane) * 2) = (unsigned short)f2bf(wk);
            }
            if (c + 1 < SEQ / 64) MLS_LOAD(c + 1);
            ML_BAR();
            {
                const int tt = wid >> 1;
#pragma unroll
                for (int si = 0; si < 2; ++si) {
                    const int ss = 2 * (wid & 1) + si;
                    f32x4v acc = (f32x4v){0.f, 0.f, 0.f, 0.f};
                    if (ss <= tt) {
#pragma unroll
                        for (int kd = 0; kd < 4; ++kd) {
                            const bf16x8 a = *(const LAS bf16x8*)(L + L_Q + ((16 * tt + l15) * QS + 32 * kd + 8 * q4) * 2);
                            const bf16x8 bb = *(const LAS bf16x8*)(L + L_K + ((16 * ss + l15) * QS + 32 * kd + 8 * q4) * 2);
                            acc = __builtin_amdgcn_mfma_f32_16x16x32_bf16(a, bb, acc, 0, 0, 0);
                        }
                    }
                    const int s = 16 * ss + l15; const float as_ = bperm(aval, s);
#pragma unroll
                    for (int j = 0; j < 4; ++j) { const int t = 16 * tt + 4 * q4 + j; const float rt = bperm(rowterm, t);
                        const float dv = (s <= t) ? acc[j] * __expf(rt + as_) : 0.f;
                        *(LAS unsigned short*)(L + L_SC + (t * TS + s) * 2) = (unsigned short)f2bf(dv); }
                }
            }
            unsigned short mog[16];
            if (wid < 4) {
#pragma unroll
                for (int tt = 0; tt < 4; ++tt)
#pragma unroll
                    for (int j = 0; j < 4; ++j) mog[tt * 4 + j] = __builtin_amdgcn_raw_buffer_load_b16(rsB, lo_o, (((int)row0 + 16 * tt + j) * PJB + PB_MO + h * 128 + vh * 64 + 16 * wid) * 2, 0);
            }
            ML_BAR();
            f32x4v acc[4];
            if (wid < 5) {
                const int eg = wid;
#pragma unroll
                for (int tt = 0; tt < 4; ++tt) {
                    acc[tt] = (f32x4v){0.f, 0.f, 0.f, 0.f};
#pragma unroll
                    for (int ks = 0; ks < 2; ++ks) {
                        const bf16x8 a = *(const LAS bf16x8*)(L + L_SC + ((16 * tt + l15) * TS + 32 * ks + 8 * q4) * 2);
                        const bf16x8 bb = *(const LAS bf16x8*)(L + L_VT + ((16 * eg + l15) * TS + 32 * ks + 8 * q4) * 2);
                        acc[tt] = __builtin_amdgcn_mfma_f32_16x16x32_bf16(a, bb, acc[tt], 0, 0, 0);
                    }
#pragma unroll
                    for (int kd = 0; kd < 4; ++kd) {
                        const bf16x8 a = *(const LAS bf16x8*)(L + L_QI + ((16 * tt + l15) * QS + 32 * kd + 8 * q4) * 2);
                        const bf16x8 bb = *(const LAS bf16x8*)(L + L_CT + ((16 * eg + l15) * QS + 32 * kd + 8 * q4) * 2);
                        acc[tt] = __builtin_amdgcn_mfma_f32_16x16x32_bf16(a, bb, acc[tt], 0, 0, 0);
                    }
                }
                asm volatile("s_waitcnt lgkmcnt(0)" ::: "memory");
#pragma unroll
                for (int db = 0; db < 8; ++db) {
                    Cacc[db] = Cacc[db] * cdec;
#pragma unroll
                    for (int ks = 0; ks < 2; ++ks) {
                        const bf16x8 a = *(const LAS bf16x8*)(L + L_KT + ((16 * db + l15) * TS + 32 * ks + 8 * q4) * 2);
                        const bf16x8 bb = *(const LAS bf16x8*)(L + L_WVT + ((16 * eg + l15) * TS + 32 * ks + 8 * q4) * 2);
                        Cacc[db] = __builtin_amdgcn_mfma_f32_16x16x32_bf16(a, bb, Cacc[db], 0, 0, 0);
                    }
                    *(LAS u32x2v*)(L + L_CT + ((16 * eg + l15) * QS + 16 * db + 4 * q4) * 2) = (u32x2v){cvtpk(Cacc[db][0], Cacc[db][1]), cvtpk(Cacc[db][2], Cacc[db][3])};
                }
                if (wid == 4 && l15 == 0) {
#pragma unroll
                    for (int tt = 0; tt < 4; ++tt) *(LAS f32x4v*)(L + L_DEN + (16 * tt + 4 * q4) * 4) = acc[tt];
                }
            }
            ML_BAR();
            if (wid < 4) {
#pragma unroll
                for (int tt = 0; tt < 4; ++tt) {
                    const f32x4v den = *(const LAS f32x4v*)(L + L_DEN + (16 * tt + 4 * q4) * 4);
#pragma unroll
                    for (int j = 0; j < 4; ++j) { const int t = 16 * tt + 4 * q4 + j; const float et = bperm(emt, t);
                        const float hv = acc[tt][j] / fmaxf(fabsf(den[j]), et);
                        __builtin_amdgcn_raw_buffer_store_b16((unsigned short)f2bf(hv * bf2f(mog[tt * 4 + j])), rsO, lo_ao, (((int)row0 + 16 * tt + j) * D + 512 + h * 128 + vh * 64 + 16 * wid) * 2, 0); }
                }
            }
        }
#undef MLS_LOAD
#undef ML_BAR
    }
}


__device__ __forceinline__ void phase_mlstm_full(Frame& F, const bf16* P, const bf16* PBg, const float* convw, const float* convb, bf16* AO, int item0, int item_stride) {
    using namespace mls;
    constexpr int L_Q = 0, L_K = 17408, L_KT = 34816, L_VT = 53248, L_WVT = 71680, L_SC = 90112, L_DEN = 99328  , L_NS = 100096  , L_WK = 100608  , L_IT = 100864, L_EM = 101120;
    const float* GA = (const float*)(F.ws + G_A); const float* GPM = (const float*)(F.ws + G_RT); const float* GB = (const float*)(F.ws + G_IT); const float* GP63 = (const float*)(F.ws + G_WK); const float* GG = GP63 + BATCH * MLH * 32;
#define ML_BAR() asm volatile("s_waitcnt lgkmcnt(0)\n\ts_barrier" ::: "memory")
    const int tid = opaque_tid(F.wave), lane = tid & 63, wid = __builtin_amdgcn_readfirstlane(tid >> 6), l15 = lane & 15, q4 = lane >> 4;
    LAS unsigned char* L = F.lds;
    for (int bh = item0; bh < BATCH * MLH; bh += item_stride) {
        const int b = bh >> 2, h = bh & 3;
        const int r00 = b * SEQ;
        const int ch2 = tid & 127, tq = __builtin_amdgcn_readfirstlane(tid >> 7); const bool isk = (wid & 1) != 0;
        const int cc = (ch2 & 63) * 2;
        const int pcol = (isk ? PC_MK : PC_MQ) + h * 128 + cc, cch = (isk ? 512 : 0) + h * 128 + cc;
        float w0[2], w1[2], w2[2], w3[2], cb[2];
#pragma unroll
        for (int i = 0; i < 2; ++i) { w0[i] = convw[cch + i]; w1[i] = convw[1024 + cch + i]; w2[i] = convw[2048 + cch + i]; w3[i] = convw[3072 + cch + i]; cb[i] = convb[cch + i]; }
        const int e2 = tid & 63, sg = wid;
        f32x4v Cacc[8];
#pragma unroll
        for (int i = 0; i < 8; ++i) Cacc[i] = (f32x4v){0.f, 0.f, 0.f, 0.f};
        float mcar = 0.f;
        __syncthreads();
        if (tid < 128) *(LAS float*)(L + L_NS + tid * 4) = 0.f;
        unsigned raw[19], vraw[8]; float g_a, g_pm, g_b, g_p63, g_g;
        const unsigned lo_raw = (unsigned)pcol * 2u, lo_v = (unsigned)(PC_MV + h * 128 + 2 * e2) * 2u, lo_o = (unsigned)(l15 * PJB + 4 * q4) * 2u, lo_ao = (unsigned)(l15 * D + 4 * q4) * 2u;
        const __amdgpu_buffer_rsrc_t rsP = __builtin_amdgcn_make_buffer_rsrc((void*)P, 0, M * PJA * 2, 0x00020000), rsB = __builtin_amdgcn_make_buffer_rsrc((void*)PBg, 0, M * PJB * 2, 0x00020000),
                                     rsO = __builtin_amdgcn_make_buffer_rsrc((void*)AO, 0, M * D * 2, 0x00020000);
#define MLF_LOAD(c) do { _Pragma("unroll") for (int i_ = 0; i_ < 19; ++i_) { const int tr_ = 64 * (c) + 16 * tq - 3 + i_; raw[i_] = (tr_ >= 0) ? __builtin_amdgcn_raw_buffer_load_b32(rsP, lo_raw, (r00 + tr_) * (PJA * 2), 0) : 0u; } \
        _Pragma("unroll") for (int i_ = 0; i_ < 8; ++i_) vraw[i_] = __builtin_amdgcn_raw_buffer_load_b32(rsP, lo_v, (r00 + 64 * (c) + 8 * sg + i_) * (PJA * 2), 0); \
        { const size_t gi_ = (size_t)bh * SEQ + 64 * (c) + lane; g_a = GA[gi_]; g_pm = GPM[gi_]; g_b = GB[gi_]; g_p63 = GP63[bh * 32 + (c)]; g_g = GG[bh * 32 + (c)]; } } while (0)
        MLF_LOAD(0);
        for (int c = 0; c < SEQ / 64; ++c) {
            const int row0 = r00 + 64 * c;
            const float Mx = fmaxf(mcar, g_p63), mrow = fmaxf(g_pm, mcar);
            const float rowterm = -mrow, inter = __expf(mcar - mrow), emt = __expf(-(g_b + mrow)), aval = g_a, wk = __expf(g_a - Mx), cdec = __expf(mcar - Mx);
            mcar = g_g + Mx;
            {
                unsigned kt0[8], kt1[8];
#pragma unroll
                for (int i = 0; i < 16; i += 2) {
                    float y[2][2];
#pragma unroll
                    for (int u = 0; u < 2; ++u) {
                        const float a0 = w0[0] * lo_bf(raw[i + u]) + w1[0] * lo_bf(raw[i + u + 1]) + w2[0] * lo_bf(raw[i + u + 2]) + w3[0] * lo_bf(raw[i + u + 3]) + cb[0];
                        const float a1 = w0[1] * hi_bf(raw[i + u]) + w1[1] * hi_bf(raw[i + u + 1]) + w2[1] * hi_bf(raw[i + u + 2]) + w3[1] * hi_bf(raw[i + u + 3]) + cb[1];
                        y[u][0] = fsilu(a0); y[u][1] = fsilu(a1);
                        const int t = 16 * tq + i + u;
                        if (!isk) *(LAS unsigned*)(L + L_Q + (t * QS + cc) * 2) = cvtpk(y[u][0] * QK_SCALE, y[u][1] * QK_SCALE);
                        else *(LAS unsigned*)(L + L_K + (t * QS + cc) * 2) = cvtpk(y[u][0], y[u][1]);
                    }
                    kt0[i >> 1] = cvtpk(y[0][0], y[1][0]); kt1[i >> 1] = cvtpk(y[0][1], y[1][1]);
                }
                if (isk) {
                    *(LAS u32x4v*)(L + L_KT + (cc * TS + 16 * tq) * 2) = (u32x4v){kt0[0], kt0[1], kt0[2], kt0[3]}; *(LAS u32x4v*)(L + L_KT + (cc * TS + 16 * tq + 8) * 2) = (u32x4v){kt0[4], kt0[5], kt0[6], kt0[7]};
                    *(LAS u32x4v*)(L + L_KT + ((cc + 1) * TS + 16 * tq) * 2) = (u32x4v){kt1[0], kt1[1], kt1[2], kt1[3]}; *(LAS u32x4v*)(L + L_KT + ((cc + 1) * TS + 16 * tq + 8) * 2) = (u32x4v){kt1[4], kt1[5], kt1[6], kt1[7]};
                }
                float v0[8], v1[8], wv[8];
#pragma unroll
                for (int i = 0; i < 8; ++i) { v0[i] = lo_bf(vraw[i]); v1[i] = hi_bf(vraw[i]); wv[i] = rdl(wk, 8 * sg + i); }
                *(LAS u32x4v*)(L + L_VT + ((2 * e2) * TS + 8 * sg) * 2) = (u32x4v){cvtpk(v0[0], v0[1]), cvtpk(v0[2], v0[3]), cvtpk(v0[4], v0[5]), cvtpk(v0[6], v0[7])};
                *(LAS u32x4v*)(L + L_VT + ((2 * e2 + 1) * TS + 8 * sg) * 2) = (u32x4v){cvtpk(v1[0], v1[1]), cvtpk(v1[2], v1[3]), cvtpk(v1[4], v1[5]), cvtpk(v1[6], v1[7])};
                *(LAS u32x4v*)(L + L_WVT + ((2 * e2) * TS + 8 * sg) * 2) = (u32x4v){cvtpk(v0[0] * wv[0], v0[1] * wv[1]), cvtpk(v0[2] * wv[2], v0[3] * wv[3]), cvtpk(v0[4] * wv[4], v0[5] * wv[5]), cvtpk(v0[6] * wv[6], v0[7] * wv[7])};
                *(LAS u32x4v*)(L + L_WVT + ((2 * e2 + 1) * TS + 8 * sg) * 2) = (u32x4v){cvtpk(v1[0] * wv[0], v1[1] * wv[1]), cvtpk(v1[2] * wv[2], v1[3] * wv[3]), cvtpk(v1[4] * wv[4], v1[5] * wv[5]), cvtpk(v1[6] * wv[6], v1[7] * wv[7])};
                if (wid == 0) { *(LAS float*)(L + L_WK + lane * 4) = wk; *(LAS float*)(L + L_IT + lane * 4) = inter; *(LAS float*)(L + L_EM + lane * 4) = emt; }
            }
            if (c + 1 < SEQ / 64) MLF_LOAD(c + 1);
            ML_BAR();
            {
                const int tt = wid >> 1; float rs[4] = {0.f, 0.f, 0.f, 0.f};
#pragma unroll
                for (int si = 0; si < 2; ++si) {
                    const int ss = 2 * (wid & 1) + si;
                    f32x4v acc = (f32x4v){0.f, 0.f, 0.f, 0.f};
                    if (ss <= tt) {
#pragma unroll
                        for (int kd = 0; kd < 4; ++kd) {
                            const bf16x8 a = *(const LAS bf16x8*)(L + L_Q + ((16 * tt + l15) * QS + 32 * kd + 8 * q4) * 2);
                            const bf16x8 bb = *(const LAS bf16x8*)(L + L_K + ((16 * ss + l15) * QS + 32 * kd + 8 * q4) * 2);
                            acc = __builtin_amdgcn_mfma_f32_16x16x32_bf16(a, bb, acc, 0, 0, 0);
                        }
                    }
                    const int s = 16 * ss + l15; const float as_ = bperm(aval, s);
#pragma unroll
                    for (int j = 0; j < 4; ++j) { const int t = 16 * tt + 4 * q4 + j; const float rt = bperm(rowterm, t);
                        const float dv = (s <= t) ? acc[j] * __expf(rt + as_) : 0.f; const unsigned db_ = cvtpk(dv, 0.f);
                        *(LAS unsigned short*)(L + L_SC + (t * TS + s) * 2) = (unsigned short)db_; rs[j] += lo_bf(db_); }
                }
#pragma unroll
                for (int j = 0; j < 4; ++j) {
#pragma unroll
                    for (int o = 1; o < 16; o <<= 1) rs[j] += shx(rs[j], lane, o);
                    if (l15 == 0) *(LAS float*)(L + L_DEN + ((wid & 1) * 64 + 16 * tt + 4 * q4 + j) * 4) = rs[j]; }
                { const int t = tid >> 3, dg = tid & 7; float dn = 0.f;
#pragma unroll
                  for (int i4 = 0; i4 < 2; ++i4) { const u32x4v qw = *(const LAS u32x4v*)(L + L_Q + (t * QS + 16 * dg + 8 * i4) * 2); const f32x4v n0 = *(const LAS f32x4v*)(L + L_NS + (16 * dg + 8 * i4) * 4), n1 = *(const LAS f32x4v*)(L + L_NS + (16 * dg + 8 * i4 + 4) * 4);
                      dn += lo_bf(qw.x) * n0[0] + hi_bf(qw.x) * n0[1] + lo_bf(qw.y) * n0[2] + hi_bf(qw.y) * n0[3] + lo_bf(qw.z) * n1[0] + hi_bf(qw.z) * n1[1] + lo_bf(qw.w) * n1[2] + hi_bf(qw.w) * n1[3]; }
                  dn += shx(dn, lane, 1); dn += shx(dn, lane, 2); dn += shx(dn, lane, 4);
                  if (dg == 0) *(LAS float*)(L + L_DEN + (128 + t) * 4) = dn * *(const LAS float*)(L + L_IT + t * 4); }
            }
            u32x2v mog[4];
#pragma unroll
            for (int tt = 0; tt < 4; ++tt) mog[tt] = __builtin_amdgcn_raw_buffer_load_b64(rsB, lo_o, ((row0 + 16 * tt) * PJB + PB_MO + h * 128 + 16 * wid) * 2, 0);
            ML_BAR();
            {
                const int g = wid;
                bf16x8 cf[4];
#pragma unroll
                for (int kd = 0; kd < 4; ++kd) cf[kd] = __builtin_bit_cast(bf16x8, (u32x4v){cvtpk(Cacc[2 * kd][0], Cacc[2 * kd][1]), cvtpk(Cacc[2 * kd][2], Cacc[2 * kd][3]), cvtpk(Cacc[2 * kd + 1][0], Cacc[2 * kd + 1][1]), cvtpk(Cacc[2 * kd + 1][2], Cacc[2 * kd + 1][3])});
#pragma unroll
                for (int tt = 0; tt < 4; ++tt) {
                    f32x4v acc = (f32x4v){0.f, 0.f, 0.f, 0.f}, acc2 = (f32x4v){0.f, 0.f, 0.f, 0.f};
#pragma unroll
                    for (int ks = 0; ks < 2; ++ks) {
                        const bf16x8 a = *(const LAS bf16x8*)(L + L_VT + ((16 * g + l15) * TS + 32 * ks + 8 * q4) * 2);
                        const bf16x8 bb = *(const LAS bf16x8*)(L + L_SC + ((16 * tt + l15) * TS + 32 * ks + 8 * q4) * 2);
                        acc = __builtin_amdgcn_mfma_f32_16x16x32_bf16(a, bb, acc, 0, 0, 0);
                    }
#pragma unroll
                    for (int kd = 0; kd < 4; ++kd) {
                        const u32x2v qa = *(const LAS u32x2v*)(L + L_Q + ((16 * tt + l15) * QS + 32 * kd + 4 * q4) * 2), qb = *(const LAS u32x2v*)(L + L_Q + ((16 * tt + l15) * QS + 32 * kd + 16 + 4 * q4) * 2);
                        acc2 = __builtin_amdgcn_mfma_f32_16x16x32_bf16(cf[kd], __builtin_bit_cast(bf16x8, (u32x4v){qa.x, qa.y, qb.x, qb.y}), acc2, 0, 0, 0);
                    }
                    const int t = 16 * tt + l15;
                    const float itv = *(const LAS float*)(L + L_IT + t * 4), etv = *(const LAS float*)(L + L_EM + t * 4);
                    const float den = (*(const LAS float*)(L + L_DEN + t * 4) + *(const LAS float*)(L + L_DEN + (64 + t) * 4)) + *(const LAS float*)(L + L_DEN + (128 + t) * 4);
                    const float rd = 1.0f / fmaxf(fabsf(den), etv);
                    const float o0 = (acc[0] + itv * acc2[0]) * rd * lo_bf(mog[tt].x), o1 = (acc[1] + itv * acc2[1]) * rd * hi_bf(mog[tt].x), o2 = (acc[2] + itv * acc2[2]) * rd * lo_bf(mog[tt].y), o3 = (acc[3] + itv * acc2[3]) * rd * hi_bf(mog[tt].y);
                    __builtin_amdgcn_raw_buffer_store_b64((u32x2v){cvtpk(o0, o1), cvtpk(o2, o3)}, rsO, lo_ao, ((row0 + 16 * tt) * D + 512 + h * 128 + 16 * g) * 2, 0);
                }
#pragma unroll
                for (int db = 0; db < 8; ++db) {
                    Cacc[db] = Cacc[db] * cdec;
#pragma unroll
                    for (int ks = 0; ks < 2; ++ks) {
                        const bf16x8 a = *(const LAS bf16x8*)(L + L_KT + ((16 * db + l15) * TS + 32 * ks + 8 * q4) * 2);
                        const bf16x8 bb = *(const LAS bf16x8*)(L + L_WVT + ((16 * g + l15) * TS + 32 * ks + 8 * q4) * 2);
                        Cacc[db] = __builtin_amdgcn_mfma_f32_16x16x32_bf16(a, bb, Cacc[db], 0, 0, 0);
                    }
                }
                { const int d = tid >> 2, sq = tid & 3; float p = 0.f;
#pragma unroll
                  for (int i8 = 0; i8 < 2; ++i8) { const u32x4v kw = *(const LAS u32x4v*)(L + L_KT + (d * TS + 16 * sq + 8 * i8) * 2); const f32x4v a0 = *(const LAS f32x4v*)(L + L_WK + (16 * sq + 8 * i8) * 4), a1 = *(const LAS f32x4v*)(L + L_WK + (16 * sq + 8 * i8 + 4) * 4);
                      p += lo_bf(kw.x) * a0[0] + hi_bf(kw.x) * a0[1] + lo_bf(kw.y) * a0[2] + hi_bf(kw.y) * a0[3] + lo_bf(kw.z) * a1[0] + hi_bf(kw.z) * a1[1] + lo_bf(kw.w) * a1[2] + hi_bf(kw.w) * a1[3]; }
                  p += shx(p, lane, 1); p += shx(p, lane, 2);
                  if (sq == 0) { LAS float* np = (LAS float*)(L + L_NS + d * 4); *np = cdec * *np + p; } }
            }
            ML_BAR();
        }
#undef MLF_LOAD
    }
#undef ML_BAR
}

__global__ void __launch_bounds__(NTHR, 2) fwd_kernel(Args args) {
    extern __shared__ __attribute__((aligned(16))) unsigned char lds[];
    Frame F;
    F.lds = (LAS unsigned char*)lds;
    F.MISC = (volatile LAS unsigned*)(F.lds + MISC_OFF);
    F.wave = __builtin_amdgcn_readfirstlane((int)threadIdx.x >> 6);
    F.G = gridDim.x;
    F.ws = args.ws; F.out = args.out;
#pragma unroll
    for (int i = 0; i < 18; ++i) F.in[i] = args.in[i];
    F.ctl = (gu32*)(F.ws + WS_CTL);
    for (int u = threadIdx.x; u < (LDS_BYTES - LDSCTL_OFF) / 4; u += NTHR) ((LAS unsigned*)(F.lds + LDSCTL_OFF))[u] = 0u;
    __syncthreads();
    XcdBarrier bar = xcd_barrier_post((unsigned*)(F.ctl + CW_BAR), F.MISC + 8, F.wave);
#define GRID_BAR() xcd_barrier(bar)

    const float* x = F.in[0];
    bf16* XB = (bf16*)(F.ws + WS_XB); bf16* AO = (bf16*)(F.ws + WS_AO); bf16* PA = (bf16*)(F.ws + WS_PA); bf16* PB = (bf16*)(F.ws + WS_PB);
    bf16* HB = PA; bf16* MG = PA;
    float* SG = (float*)(F.ws + WS_SG); float* CUM = (float*)(F.ws + WS_CUM); float* SS = (float*)(F.ws + WS_SS);
    float* out = F.out;
    const bf16* W1IN = (const bf16*)(F.ws + WS_W1IN); const bf16* W1OUT = (const bf16*)(F.ws + WS_W1OUT); const bf16* WIN = (const bf16*)(F.ws + WS_WIN);
    const bf16* WCAT = (const bf16*)(F.ws + WS_WCAT); const bf16* WOUT = (const bf16*)(F.ws + WS_WOUT); const bf16* W2IN = (const bf16*)(F.ws + WS_W2IN); const bf16* W2OUT = (const bf16*)(F.ws + WS_W2OUT);
#define STAGGER(step) do { if (STAG_ON) { const unsigned long long t0_ = __builtin_amdgcn_s_memrealtime(); const unsigned long long w_ = (unsigned long long)((blockIdx.x & 7u) * (unsigned)(step)); while (__builtin_amdgcn_s_memrealtime() - t0_ < w_) __builtin_amdgcn_s_sleep(8); } } while (0)
#define GEMM_PHASE(EpiT, gobj, eobj) do { pg8::StaticOrder S_; S_.init((gobj).M, (gobj).N, F.G, (int)blockIdx.x); pg8::gemm_phase<EpiT, pg8::StaticOrder, true, true>(F.lds, gobj, S_, eobj, F.wave); } while (0)
#define REP(b) ((REP_MASK >> (b)) & 1)

    phase_weights(F);
    phase_x_prep(F, x, XB, SS);
    GRID_BAR();
    STAGGER(430);
    { pg8::Gemm g{XB, W1IN, M, NFF, D, D, D}; pg8::EpiSwigluF E{HB, SS}; GEMM_PHASE(pg8::EpiSwigluF, g, E); if (REP(0)) GEMM_PHASE(pg8::EpiSwigluF, g, E); }
    GRID_BAR();
    { pg8::Gemm g{HB, W1OUT, M, D, DFF, DFF, DFF}; pg8::EpiResidB<false> E{XB, nullptr, SS, 0.5f}; GEMM_PHASE(pg8::EpiResidB<false>, g, E); }
    GRID_BAR();
    STAGGER(460);
    { pg8::Gemm g{XB, WIN, M, NPJ, D, D, D}; pg8::EpiProjF E{PA, PB, SG, SS, F.in[6], F.in[9], F.in[10], (unsigned*)(F.ctl + CW_QKN)}; GEMM_PHASE(pg8::EpiProjF, g, E); if (REP(2)) GEMM_PHASE(pg8::EpiProjF, g, E); }
    GRID_BAR();
    phase_cumsum(F, SG, CUM);
    phase_mgates(F, SG);
    GRID_BAR();
    if (MLSTM_FUSED == 2) {
        if ((blockIdx.x & 1) == 0) phase_mlstm_full(F, PA, PB, F.in[7], F.in[8], AO, (int)(blockIdx.x >> 1), (int)((F.G + 1) >> 1));
        const attn_body::AttnTensors AT{(const attn_body::bf16*)(PA + PC_FQ), (const attn_body::bf16*)(PA + PC_FK), (const attn_body::bf16*)(PA + PC_FV), (attn_body::bf16*)AO, CUM, (const unsigned*)(F.ctl + CW_QKN)};
        __syncthreads();
        attn_body::attn_phase_queue((char*)lds, AT, (unsigned*)(F.ctl + CW_AQ), F.MISC + 16, F.wave);
    } else {
    if (MLSTM_FUSED) { phase_mlstm_fused(F, PA, PB, SG, F.in[7], F.in[8], AO); if (REP(3)) phase_mlstm_fused(F, PA, PB, SG, F.in[7], F.in[8], AO); }
    else {
    phase_mprep(F, PA, F.in[7], F.in[8], (bf16*)out);
    if (REP(3)) phase_mprep(F, PA, F.in[7], F.in[8], (bf16*)out);
    GRID_BAR();
    phase_mchain(F, (const bf16*)out, PB, AO);
    if (REP(7)) phase_mchain(F, (const bf16*)out, PB, AO);
    }
    { const attn_body::AttnTensors AT{(const attn_body::bf16*)(PA + PC_FQ), (const attn_body::bf16*)(PA + PC_FK), (const attn_body::bf16*)(PA + PC_FV), (attn_body::bf16*)AO, CUM, (const unsigned*)(F.ctl + CW_QKN)};
      const attn_body::StaticOrder SA((int)F.G, (int)blockIdx.x); attn_body::attn_phase<attn_body::StaticOrder>((char*)lds, AT, SA, F.wave);
      if (REP(4)) attn_body::attn_phase<attn_body::StaticOrder>((char*)lds, AT, SA, F.wave); }
    }
    GRID_BAR();
    { pg8::Gemm g{AO, WCAT, M, D, D, D, D}; pg8::EpiMergeF E{PB, MG}; GEMM_PHASE(pg8::EpiMergeF, g, E); if (REP(5)) GEMM_PHASE(pg8::EpiMergeF, g, E); }
    GRID_BAR();
    { pg8::Gemm g{MG, WOUT, M, D, D, D, D}; pg8::EpiResidB<false> E{XB, nullptr, SS, 1.0f}; GEMM_PHASE(pg8::EpiResidB<false>, g, E); }
    GRID_BAR();
    STAGGER(430);
    { pg8::Gemm g{XB, W2IN, M, NFF, D, D, D}; pg8::EpiSwigluF E{HB, SS}; GEMM_PHASE(pg8::EpiSwigluF, g, E); }
    GRID_BAR();
    { pg8::Gemm g{HB, W2OUT, M, D, DFF, DFF, DFF}; pg8::EpiResidB<true> E{XB, out, SS, 0.5f}; GEMM_PHASE(pg8::EpiResidB<true>, g, E); if (REP(1)) GEMM_PHASE(pg8::EpiResidB<true>, g, E); }
    GRID_BAR();
    phase_final_scale(F, out, SS, F.in[17]);
}

extern "C" void kernel_launch(void* const* d_in, const int* in_sizes, int n_in, void* d_out, int out_size, void* d_ws, size_t ws_size, hipStream_t stream) {
    static int grid = 0;
    if (grid == 0) {
        if (n_in != 18 || in_sizes[0] != M * D || out_size != M * D || ws_size < WS_END) { fprintf(stderr, "kernel_launch: unexpected shapes (n_in %d, in0 %d, out %d, ws %zu)\n", n_in, n_in > 0 ? in_sizes[0] : -1, out_size, ws_size); grid = -1; return; }
        int dev = 0, cus = 0, per_cu = 0;
        if (hipGetDevice(&dev) != hipSuccess || hipDeviceGetAttribute(&cus, hipDeviceAttributeMultiprocessorCount, dev) != hipSuccess) { grid = -1; return; }
        if (hipFuncSetAttribute((const void*)fwd_kernel, hipFuncAttributeMaxDynamicSharedMemorySize, LDS_BYTES) != hipSuccess) { grid = -1; return; }
        if (hipOccupancyMaxActiveBlocksPerMultiprocessor(&per_cu, (const void*)fwd_kernel, NTHR, LDS_BYTES) != hipSuccess || per_cu < 1) { fprintf(stderr, "occupancy query says %d\n", per_cu); }
        (void)hipGetLastError();
        grid = cus;
    }
    if (grid < 0) return;
    if (hipMemsetAsync((char*)d_ws + WS_CTL, 0, CTL_ZERO_BYTES, stream) != hipSuccess) return;
    Args a{};
    for (int i = 0; i < 18; ++i) a.in[i] = (const float*)d_in[i];
    a.out = (float*)d_out; a.ws = (unsigned char*)d_ws;
    hipLaunchKernelGGL(fwd_kernel, dim3(grid), dim3(NTHR), LDS_BYTES, stream, a);
}
```

```cpp
#include <hip/hip_runtime.h>
#include <cstdio>
#include <cstdint>

#define GAS __attribute__((address_space(1)))
#define LAS __attribute__((address_space(3)))
typedef unsigned short bf16;
typedef unsigned v4u __attribute__((ext_vector_type(4)));
typedef float f32x4 __attribute__((ext_vector_type(4)));
typedef GAS unsigned gu32;
#define RLX_AGENT __ATOMIC_RELAXED, __HIP_MEMORY_SCOPE_AGENT

constexpr int BATCH = 32, SEQ = 2048, D = 1024, M = BATCH * SEQ;
constexpr int DFF = 2816, NFF = 2 * DFF;
constexpr int INC = 5648;
constexpr int PJA = 3072, PJB = 2560;
constexpr int FOXH = 8, FHD = 64, MLH = 4, MHD = 128;
constexpr int PC_FQ = 0, PC_FK = 512, PC_FV = 1024, PC_MQ = 1536, PC_MK = 2048, PC_MV = 2560;
constexpr int PB_MO = 0, PB_GA = 512, PB_GB = 1536;
constexpr float RMS_EPS = 1e-6f;
constexpr float LOG2E = 1.4426950408889634f;
constexpr float QSCALE2 = 0.125f * LOG2E;
constexpr int NWAVES = 8, NTHR = 512;
#ifndef STAG_ON
#define STAG_ON 0
#endif
#ifndef MLSTM_FUSED
#define MLSTM_FUSED 2
#endif
#ifndef REP_MASK
#define REP_MASK 0
#endif

constexpr size_t MiB = 1u << 20;
constexpr size_t WS_CTL = 0, CTL_ZERO_BYTES = 1 * MiB;
constexpr size_t WS_W1IN = 2 * MiB, WS_W1OUT = 13 * MiB, WS_WIN = 19 * MiB, WS_WCAT = 31 * MiB, WS_WOUT = 33 * MiB, WS_W2IN = 35 * MiB, WS_W2OUT = 46 * MiB;
constexpr int NPJ = 5888;
constexpr size_t WS_SG = 52 * MiB;
constexpr size_t WS_CUM = 56 * MiB;
constexpr size_t WS_SS = 58 * MiB;
constexpr size_t WS_XB = 64 * MiB;
constexpr size_t WS_AO = 192 * MiB;
constexpr size_t WS_PA = 320 * MiB;
constexpr size_t WS_PB = 704 * MiB;
constexpr size_t WS_END = 1024 * MiB;
constexpr int CW_BAR = 4096;
constexpr int CW_AQ = 8192;
constexpr int CW_QKN = 32768;

constexpr int LDS_BYTES = 147456;
constexpr int RING_BYTES = 131072, LDSCTL_OFF = RING_BYTES, MISC_OFF = LDSCTL_OFF + 320;

__device__ __forceinline__ float bf2f(bf16 v) { return __builtin_bit_cast(float, (unsigned)v << 16); }
__device__ __forceinline__ unsigned f2bf(float f) { unsigned u = __builtin_bit_cast(unsigned, f); return (u + 0x7fffu + ((u >> 16) & 1u)) >> 16; }
__device__ __forceinline__ unsigned pk2(float lo, float hi) { return f2bf(lo) | (f2bf(hi) << 16); }
__device__ __forceinline__ float sigmoidf_(float v) { return 1.f / (1.f + __expf(-v)); }
__device__ __forceinline__ float logsigmoidf_(float v) { return fminf(v, 0.f) - log1pf(__expf(-fabsf(v))); }
__device__ __forceinline__ float siluf_(float v) { return v / (1.f + __expf(-v)); }

#define XB_TMO      128
#define XB_XCNT(j)  (256  + 64 * (j))
#define XB_XSUB(j)  (1280 + 64 * (j))
#define XB_XGEN(j)  (2304 + 64 * (j))
#define XB_TOP      3328
#define XB_TOPGEN   3392
#define XCD_BAR_WORDS 3456
#define XB_SPIN_CAP (1u << 22)

__device__ __forceinline__ unsigned xb_ld(unsigned* p)              { return __hip_atomic_load(p, __ATOMIC_RELAXED, __HIP_MEMORY_SCOPE_AGENT); }
__device__ __forceinline__ unsigned xb_add(unsigned* p, unsigned v) { return __hip_atomic_fetch_add(p, v, __ATOMIC_RELAXED, __HIP_MEMORY_SCOPE_AGENT); }
__device__ __forceinline__ unsigned xb_xcc_id() { return (unsigned)__builtin_amdgcn_s_getreg((3 << 11) | 20) & 0xFu; }
#define XB_SPIN(cond, bar) do { unsigned _sp = 0; while (cond) { __builtin_amdgcn_s_sleep(1); \
    if ((++_sp & 255u) == 0u) { if (xb_ld(&(bar)[XB_TMO])) break; if (_sp > XB_SPIN_CAP) { atomicAdd(&(bar)[XB_TMO], 1u); break; } } } } while (0)

struct XcdBarrier { unsigned* bar; unsigned x; volatile LAS unsigned* st; int wv; };

__device__ __forceinline__ bool xb_leader(int wv) { int l = (int)__builtin_amdgcn_mbcnt_hi(~0u, __builtin_amdgcn_mbcnt_lo(~0u, 0u)); asm volatile("" : "+v"(l)); return wv == 0 && l == 0; }
__device__ __forceinline__ XcdBarrier xcd_barrier_post(unsigned* bar, volatile LAS unsigned* st, int wv) {
    XcdBarrier b; b.bar = bar; b.x = xb_xcc_id(); b.st = st; b.wv = wv;
    if (xb_leader(wv)) (void)xb_add(&bar[XB_XCNT(b.x)], 1u);
    return b;
}
__device__ __forceinline__ void xcd_barrier_complete(unsigned* bar, unsigned x, unsigned& nloc, unsigned& nx) {
    const unsigned G = gridDim.x * gridDim.y * gridDim.z;
    unsigned sum, cnt, mine, sp = 0u;
    for (;;) {
        sum = 0u; cnt = 0u; mine = 0u;
#pragma unroll
        for (unsigned j = 0; j < 16; ++j) { const unsigned c = xb_ld(&bar[XB_XCNT(j)]); sum += c; cnt += (c > 0u) ? 1u : 0u; mine = (j == x) ? c : mine; }
        if (sum == G) break;
        __builtin_amdgcn_s_sleep(1);
        if ((++sp & 255u) == 0u) { if (xb_ld(&bar[XB_TMO])) break; if (sp > XB_SPIN_CAP) { atomicAdd(&bar[XB_TMO], 1u); break; } }
    }
    nloc = mine > 0u ? mine : 1u; nx = cnt > 0u ? cnt : 1u;
}
__device__ __forceinline__ void xcd_barrier(const XcdBarrier& b) {
    asm volatile("s_waitcnt vmcnt(0)" ::: "memory");
    __syncthreads();
    if (xb_leader(b.wv)) {
        unsigned* bar = b.bar;
        __builtin_amdgcn_s_waitcnt(0);
        unsigned nloc = b.st[0], nx = b.st[1];
        if (nloc == 0u) { xcd_barrier_complete(bar, b.x, nloc, nx); b.st[0] = nloc; b.st[1] = nx; }
        const unsigned old = xb_add(&bar[XB_XSUB(b.x)], 1u);
        const unsigned gen = old / nloc;
        if (old + 1u == (gen + 1u) * nloc) {
            __builtin_amdgcn_fence(__ATOMIC_RELEASE, "agent");
            asm volatile("s_waitcnt vmcnt(0)" ::: "memory");
            const unsigned og = xb_add(&bar[XB_TOP], 1u);
            const unsigned tg = og / nx;
            if (og + 1u == (tg + 1u) * nx) xb_add(&bar[XB_TOPGEN], 1u);
            else XB_SPIN(xb_ld(&bar[XB_TOPGEN]) == tg, bar);
            __builtin_amdgcn_fence(__ATOMIC_ACQUIRE, "agent");
            xb_add(&bar[XB_XGEN(b.x)], 1u);
            asm volatile("s_waitcnt vmcnt(0)" ::: "memory");
        } else {
            XB_SPIN(xb_ld(&bar[XB_XGEN(b.x)]) == gen, bar);
            __builtin_amdgcn_fence(__ATOMIC_ACQUIRE, "agent");
            asm volatile("s_waitcnt vmcnt(0)" ::: "memory");
        }
    }
    __syncthreads();
}

struct Frame {
    LAS unsigned char* lds;
    volatile LAS unsigned* MISC;
    gu32* ctl;
    int wave, G;
    const float* in[18];
    float* out;
    unsigned char* ws;
};
struct Args { const float* in[18]; float* out; unsigned char* ws; };

__device__ __forceinline__ int lane_id() { return (int)__builtin_amdgcn_mbcnt_hi(~0u, __builtin_amdgcn_mbcnt_lo(~0u, 0u)); }
__device__ __forceinline__ int opaque_tid(int wv) { int t = wv * 64 + lane_id(); asm volatile("" : "+v"(t)); return t; }
__device__ __forceinline__ float bperm(float v, int idx) { return __builtin_bit_cast(float, __builtin_amdgcn_ds_bpermute(idx << 2, __builtin_bit_cast(int, v))); }
__device__ __forceinline__ float rdl(float v, int idx) { return __builtin_bit_cast(float, __builtin_amdgcn_readlane(__builtin_bit_cast(int, v), idx)); }
__device__ __forceinline__ float shx(float v, int lane, int mask) { return bperm(v, lane ^ mask); }
__device__ __forceinline__ float wave_sum(float v, int lane) {
#pragma unroll
    for (int o = 1; o < 64; o <<= 1) v += shx(v, lane, o);
    return v;
}

__device__ __forceinline__ void phase_x_prep(Frame& F, const float* X, bf16* XB, float* SS) {
    const int ptid = opaque_tid(F.wave), plane = ptid & 63, pwave = __builtin_amdgcn_readfirstlane(ptid >> 6);
    const int gw = blockIdx.x * NWAVES + pwave, NGW = F.G * NWAVES;
    for (int m = gw; m < M; m += NGW) {
        const GAS f32x4* xr = (const GAS f32x4*)(X + (size_t)m * D) + plane;
        f32x4 v[4]; float s = 0.f;
#pragma unroll
        for (int j = 0; j < 4; ++j) { v[j] = xr[64 * j]; s += (v[j].x * v[j].x + v[j].y * v[j].y) + (v[j].z * v[j].z + v[j].w * v[j].w); }
        s = wave_sum(s, plane);
        GAS unsigned long long* o8 = (GAS unsigned long long*)(XB + (size_t)m * D) + plane;
#pragma unroll
        for (int j = 0; j < 4; ++j) o8[64 * j] = (unsigned long long)pk2(v[j].x, v[j].y) | ((unsigned long long)pk2(v[j].z, v[j].w) << 32);
        if (plane < 16) SS[(size_t)m * 16 + plane] = (plane == 0) ? s : 0.f;
    }
}
__device__ __forceinline__ void phase_final_scale(Frame& F, const bf16* XB, float* O, const float* SS, const float* gain) {
    const int ptid = opaque_tid(F.wave), plane = ptid & 63, pwave = __builtin_amdgcn_readfirstlane(ptid >> 6);
    const int gw = blockIdx.x * NWAVES + pwave, NGW = F.G * NWAVES;
    f32x4 g[4];
#pragma unroll
    for (int j = 0; j < 4; ++j) g[j] = *((const GAS f32x4*)gain + plane * 4 + j);
    for (int m = gw; m < M; m += NGW) {
        const v4u w0 = *((const GAS v4u*)(XB + (size_t)m * D) + plane * 2), w1 = *((const GAS v4u*)(XB + (size_t)m * D) + plane * 2 + 1);
        float s = SS[(size_t)m * 16 + (plane & 15)];
#pragma unroll
        for (int o = 1; o < 16; o <<= 1) s += shx(s, plane, o);
        const float r = 1.0f / sqrtf(s * (1.f / D) + RMS_EPS);
        const unsigned ww[8] = {w0.x, w0.y, w0.z, w0.w, w1.x, w1.y, w1.z, w1.w};
        GAS f32x4* orow = (GAS f32x4*)(O + (size_t)m * D) + plane * 4;
#pragma unroll
        for (int j = 0; j < 4; ++j) { f32x4 v; v[0] = __builtin_bit_cast(float, ww[2 * j] << 16); v[1] = __builtin_bit_cast(float, ww[2 * j] & 0xffff0000u); v[2] = __builtin_bit_cast(float, ww[2 * j + 1] << 16); v[3] = __builtin_bit_cast(float, ww[2 * j + 1] & 0xffff0000u);
            orow[j] = v * r * g[j]; }
    }
}

__device__ __forceinline__ void phase_cumsum(Frame& F, const float* SG, float* CUM) {
    const int ptid = opaque_tid(F.wave), plane = ptid & 63, pwave = __builtin_amdgcn_readfirstlane(ptid >> 6); (void)plane; (void)pwave;
    const int gw = blockIdx.x * NWAVES + pwave, NGW = F.G * NWAVES;
    for (int it = gw; it < BATCH * FOXH; it += NGW) {
        const int b = it / FOXH, h = it % FOXH;
        float v[32]; float s = 0.f;
#pragma unroll
        for (int i = 0; i < 32; ++i) { s += SG[(size_t)(b * SEQ + plane * 32 + i) * 16 + h]; v[i] = s; }
        float incl = s;
#pragma unroll
        for (int o = 1; o < 64; o <<= 1) { const float t = bperm(incl, (plane - o) & 63); if (plane >= o) incl += t; }
        const float excl = incl - s;
#pragma unroll
        for (int i = 0; i < 32; ++i) CUM[(size_t)it * SEQ + plane * 32 + i] = v[i] + excl;
    }
}


namespace pg8 {
#define PG8_LAS __attribute__((address_space(3)))
typedef unsigned short bf16_t;
typedef short bf16x8 __attribute__((ext_vector_type(8)));
typedef float f32x4 __attribute__((ext_vector_type(4)));
typedef unsigned u32x4 __attribute__((ext_vector_type(4)));
constexpr int RSTD_LDS_OFF = 131072 + 1024;
constexpr int BM = 256, BK = 64, HALF = 128, HTB = HALF * BK * 2  , STAGE_BYTES = 8 * HTB, NXCD = 8, WGM = 8;

__host__ __device__ __forceinline__ int lds_byte(int r, int c) { const int st = (r >> 4) * 2 + (c >> 5), rr = r & 15, cc = c & 31, ob = rr * 64 + cc * 2; return st * 1024 + (ob ^ (((ob >> 9) & 1) << 5)); }
__host__ __device__ __forceinline__ void stage_rc(int b, int& R, int& C) { const int st = b / 1024, sb = b % 1024, swz = sb ^ (((sb >> 9) & 1) << 5); R = (st >> 1) * 16 + swz / 64; C = (st & 1) * 32 + (swz % 64) / 2; }
__host__ __device__ __forceinline__ int perm32(int rho) { const int n = rho >> 4, i = rho & 15; return 8 * (i >> 2) + 4 * n + (i & 3); }

struct Unit { int pm, pn; };
struct Gemm { const bf16_t* A; const bf16_t* Bt; int M, N, K, lda, ldb; };

struct StaticOrder {
    int nM, nN, nwg, G, c;
    __host__ __device__ void init(int M, int N, int G_, int c_) { nM = M / BM; nN = N / BM; nwg = nM * nN; G = G_; c = c_; }
    __host__ __device__ bool next(int i, Unit& u) const {
        const long L = (long)i * G + c; if (L >= nwg) return false;
        int wgid = (int)L; { const int q = nwg / NXCD, r = nwg % NXCD, xcd = wgid % NXCD, off = wgid / NXCD; wgid = (xcd < r ? xcd * (q + 1) : r * (q + 1) + (xcd - r) * q) + off; }
        const int nig = WGM * nN, gid = wgid / nig, fm = gid * WGM, gsz = (nM - fm) < WGM ? (nM - fm) : WGM;
        u.pm = fm + ((wgid % nig) % gsz); u.pn = (wgid % nig) / gsz; return true;
    }
    __device__ __forceinline__ void a_ready(const Unit&) const {}
    __device__ __forceinline__ void done(const Unit&) const {}
};

__device__ __forceinline__ unsigned cvt_pk_bf16(float lo, float hi) { unsigned r; asm volatile("v_cvt_pk_bf16_f32 %0, %1, %2" : "=v"(r) : "v"(lo), "v"(hi)); return r; }
template <class Epi, class Sched, bool ALIGN_EPI = false, bool SP2 = false>
__device__ __forceinline__ void gemm_phase(PG8_LAS unsigned char* lds, const Gemm g, const Sched& S, const Epi& E, const int wv) {
    int tid_ = wv * 64 + (int)__builtin_amdgcn_mbcnt_hi(~0u, __builtin_amdgcn_mbcnt_lo(~0u, 0u)); asm volatile("" : "+v"(tid_));
    const int tid = tid_, wid = __builtin_amdgcn_readfirstlane(tid >> 6), lane = tid & 63, wr = wid >> 2, wc = wid & 3, fr = lane & 15, fq = lane >> 4;
    const int K = g.K, nt = K / BK;
    unsigned voffA[2], voffB[2];
#pragma unroll
    for (int i = 0; i < 2; ++i) { int R, C; stage_rc(tid * 16 + i * 8192, R, C); const int Rb = Epi::PERM ? ((R & ~31) + perm32(R & 31)) : R;
        voffA[i] = (unsigned)(R * g.lda + C) * 2u; voffB[i] = (unsigned)(Rb * g.ldb + C) * 2u; }
    const size_t kstep = (size_t)(BK * 2);
    const size_t hstepA = (size_t)HALF * g.lda * 2, hstepB = (size_t)HALF * g.ldb * 2;
    const size_t tstepA = 2 * hstepA, tstepB = 2 * hstepB;
    const unsigned ldsw = (unsigned)wid * 1024u;
    const int aoff = lds_byte(wr * 64 + fr, fq * 8), boff = lds_byte(wc * 32 + fr, fq * 8);
#define PG8_SA(b, h) (((b) * 2 + (h)) * HTB)
#define PG8_SB(b, h) ((4 + (b) * 2 + (h)) * HTB)
#define PG8_STAGE(bufoff, gbase, voff) do { _Pragma("unroll") for (int _i = 0; _i < 2; ++_i) \
        __builtin_amdgcn_global_load_lds((const unsigned*)((const char*)(gbase) + (voff)[_i]), (PG8_LAS unsigned*)(lds + (bufoff) + ldsw + _i * 8192), 16, 0, 0); } while (0)
#define PG8_LDA(dst, b, h) do { _Pragma("unroll") for (int m = 0; m < 4; ++m) _Pragma("unroll") for (int k = 0; k < 2; ++k) dst[m][k] = *(const PG8_LAS bf16x8*)(lds + PG8_SA(b, h) + aoff + m * 2048 + k * 1024); } while (0)
#define PG8_LDB(dst, b, h) do { _Pragma("unroll") for (int n = 0; n < 2; ++n) _Pragma("unroll") for (int k = 0; k < 2; ++k) dst[n][k] = *(const PG8_LAS bf16x8*)(lds + PG8_SB(b, h) + boff + n * 2048 + k * 1024); } while (0)
#define PG8_MMA(ai, bj, At, Bt) do { __builtin_amdgcn_s_setprio(1); _Pragma("unroll") for (int m = 0; m < 4; ++m) _Pragma("unroll") for (int n = 0; n < 2; ++n) _Pragma("unroll") for (int k = 0; k < 2; ++k) \
        acc[ai][bj][m][n] = __builtin_amdgcn_mfma_f32_16x16x32_bf16(Bt[n][k], At[m][k], acc[ai][bj][m][n], 0, 0, 0); __builtin_amdgcn_s_setprio(0); } while (0)
#define PG8_WAIT_V(n) asm volatile("s_waitcnt vmcnt(" #n ")" ::: "memory")
#define PG8_WAIT_L(n) asm volatile("s_waitcnt lgkmcnt(" #n ")" ::: "memory")
#define PG8_BAR __builtin_amdgcn_s_barrier()
#define PG8_SCHED __builtin_amdgcn_sched_barrier(0)
    Unit cur, nxt; int ui = 0; int rs_pm = -1; (void)rs_pm;
    if (!S.next(0, cur)) return;
    f32x4 acc[2][2][4][2];
#pragma unroll
    for (int a = 0; a < 2; ++a)
#pragma unroll
        for (int b = 0; b < 2; ++b)
#pragma unroll
            for (int m = 0; m < 4; ++m)
#pragma unroll
                for (int n = 0; n < 2; ++n) acc[a][b][m][n] = (f32x4){0.f, 0.f, 0.f, 0.f};
    bf16x8 At[4][2], B0[2][2], B1[2][2];
    const char* cA = (const char*)g.A + (size_t)cur.pm * tstepA; const char* cB = (const char*)g.Bt + (size_t)cur.pn * tstepB;
    S.a_ready(cur);
    if constexpr (SP2) {
        PG8_STAGE(PG8_SB(0, 0), cB, voffB); PG8_STAGE(PG8_SB(0, 1), cB + hstepB, voffB); PG8_STAGE(PG8_SA(0, 0), cA, voffA); PG8_STAGE(PG8_SA(0, 1), cA + hstepA, voffA);
        if (wr == 1) PG8_BAR;
        PG8_WAIT_V(2); PG8_BAR;
        PG8_STAGE(PG8_SB(1, 0), cB + kstep, voffB); PG8_STAGE(PG8_SA(1, 0), cA + kstep, voffA); PG8_STAGE(PG8_SB(1, 1), cB + hstepB + kstep, voffB);
        PG8_WAIT_V(6); PG8_BAR;
    } else {
        PG8_STAGE(PG8_SB(0, 0), cB, voffB); PG8_STAGE(PG8_SA(0, 0), cA, voffA); PG8_STAGE(PG8_SB(0, 1), cB + hstepB, voffB); PG8_STAGE(PG8_SA(0, 1), cA + hstepA, voffA);
        if (wr == 1) PG8_BAR;
        PG8_WAIT_V(4); PG8_BAR;
        PG8_STAGE(PG8_SB(1, 0), cB + kstep, voffB); PG8_STAGE(PG8_SA(1, 0), cA + kstep, voffA); PG8_STAGE(PG8_SB(1, 1), cB + hstepB + kstep, voffB);
        PG8_WAIT_V(6); PG8_BAR;
    }
    for (;;) {
        const bool has_next = S.next(ui + 1, nxt);
        const char* nA = has_next ? (const char*)g.A + (size_t)nxt.pm * tstepA : cA; const char* nB = has_next ? (const char*)g.Bt + (size_t)nxt.pn * tstepB : cB;
        for (int t = 0; t < nt; t += 2) {
            const bool last = (t == nt - 2);
            const char* a1 = cA + (size_t)(t + 1) * kstep;
            const char* a2 = last ? nA : cA + (size_t)(t + 2) * kstep; const char* b2 = last ? nB : cB + (size_t)(t + 2) * kstep;
            const char* a3 = a2 + kstep; const char* b3 = b2 + kstep;
            if (last && has_next) S.a_ready(nxt);
            if constexpr (Epi::HOOK) { if (t == Epi::HOOK_T) E.mid(acc, cur, wr, wc, fr, fq); }
            if constexpr (SP2) {
            PG8_LDB(B0, 0, 0); PG8_LDB(B1, 0, 1); PG8_SCHED; PG8_LDA(At, 0, 0); PG8_STAGE(PG8_SA(1, 1), a1 + hstepA, voffA);
            PG8_WAIT_V(8); PG8_WAIT_L(0); PG8_BAR; PG8_MMA(0, 0, At, B0); PG8_MMA(0, 1, At, B1); PG8_BAR; PG8_SCHED;
            PG8_LDA(At, 0, 1); PG8_STAGE(PG8_SB(0, 0), b2, voffB); PG8_STAGE(PG8_SB(0, 1), b2 + hstepB, voffB); PG8_STAGE(PG8_SA(0, 0), a2, voffA);
            PG8_WAIT_V(8); PG8_WAIT_L(0); PG8_BAR; PG8_MMA(1, 0, At, B0); PG8_MMA(1, 1, At, B1); PG8_BAR; PG8_SCHED;
            PG8_LDB(B0, 1, 0); PG8_LDB(B1, 1, 1); PG8_SCHED; PG8_LDA(At, 1, 0); PG8_STAGE(PG8_SA(0, 1), a2 + hstepA, voffA);
            PG8_WAIT_V(8); PG8_WAIT_L(0); PG8_BAR; PG8_MMA(0, 0, At, B0); PG8_MMA(0, 1, At, B1); PG8_BAR; PG8_SCHED;
            PG8_LDA(At, 1, 1); PG8_STAGE(PG8_SB(1, 0), b3, voffB); PG8_STAGE(PG8_SB(1, 1), b3 + hstepB, voffB); PG8_STAGE(PG8_SA(1, 0), a3, voffA);
            PG8_WAIT_V(8); PG8_WAIT_L(0); PG8_BAR; PG8_MMA(1, 0, At, B0); PG8_MMA(1, 1, At, B1); PG8_BAR; PG8_SCHED;
            } else {
            PG8_LDB(B0, 0, 0); PG8_SCHED; PG8_LDA(At, 0, 0); PG8_STAGE(PG8_SA(1, 1), a1 + hstepA, voffA);
            PG8_WAIT_L(8); PG8_BAR; PG8_WAIT_L(0); PG8_MMA(0, 0, At, B0); PG8_BAR; PG8_SCHED;
            PG8_LDB(B1, 0, 1); PG8_STAGE(PG8_SB(0, 0), b2, voffB);
            PG8_BAR; PG8_WAIT_L(0); PG8_MMA(0, 1, At, B1); PG8_BAR;
            PG8_LDA(At, 0, 1); PG8_STAGE(PG8_SA(0, 0), a2, voffA);
            PG8_BAR; PG8_WAIT_L(0); PG8_MMA(1, 0, At, B0); PG8_BAR; PG8_SCHED;
            PG8_STAGE(PG8_SB(0, 1), b2 + hstepB, voffB);
            PG8_WAIT_V(6); PG8_BAR; PG8_MMA(1, 1, At, B1); PG8_BAR;
            PG8_LDB(B0, 1, 0); PG8_SCHED; PG8_LDA(At, 1, 0); PG8_STAGE(PG8_SA(0, 1), a2 + hstepA, voffA);
            PG8_WAIT_L(8); PG8_BAR; PG8_WAIT_L(0); PG8_MMA(0, 0, At, B0); PG8_BAR; PG8_SCHED;
            PG8_LDB(B1, 1, 1); PG8_STAGE(PG8_SB(1, 0), b3, voffB);
            PG8_BAR; PG8_WAIT_L(0); PG8_MMA(0, 1, At, B1); PG8_BAR;
            PG8_LDA(At, 1, 1); PG8_STAGE(PG8_SA(1, 0), a3, voffA);
            PG8_BAR; PG8_WAIT_L(0); PG8_MMA(1, 0, At, B0); PG8_BAR; PG8_SCHED;
            PG8_STAGE(PG8_SB(1, 1), b3 + hstepB, voffB);
            PG8_WAIT_V(6); PG8_BAR; PG8_MMA(1, 1, At, B1); PG8_BAR;
            }
        }
        if constexpr (ALIGN_EPI) { if (wr == 0) PG8_BAR; }
        if constexpr (Epi::RSTD) { if (cur.pm != rs_pm) {
                const int row_ = tid >> 1, hf_ = tid & 1; const float* sp_ = E.SS + ((size_t)cur.pm * BM + row_) * 16 + hf_ * 8; const f32x4 p0_ = *(const f32x4*)sp_, p1_ = *(const f32x4*)(sp_ + 4);
                float s_ = ((p0_[0] + p0_[1]) + (p0_[2] + p0_[3])) + ((p1_[0] + p1_[1]) + (p1_[2] + p1_[3])); s_ += shx(s_, lane, 1);
                if (hf_ == 0) *(PG8_LAS float*)(lds + RSTD_LDS_OFF + row_ * 4) = 1.0f / sqrtf(s_ * (1.0f / D) + RMS_EPS);
                asm volatile("s_waitcnt lgkmcnt(0)\n\ts_barrier" ::: "memory"); rs_pm = cur.pm; } }
        if constexpr (!Epi::AFTER_DRAIN) { E(acc, cur, wr, wc, fr, fq, lds); S.done(cur); }
        if (!has_next) break;
#pragma unroll
        for (int a = 0; a < 2; ++a)
#pragma unroll
            for (int b = 0; b < 2; ++b)
#pragma unroll
                for (int m = 0; m < 4; ++m)
#pragma unroll
                    for (int n = 0; n < 2; ++n) acc[a][b][m][n] = (f32x4){0.f, 0.f, 0.f, 0.f};
        cur = nxt; cA = nA; cB = nB; ++ui;
        if constexpr (ALIGN_EPI) { if (wr == 1) PG8_BAR; }
    }
    PG8_WAIT_V(0);
    if constexpr (!ALIGN_EPI) { if (wr == 0) PG8_BAR; }
    PG8_BAR;
    if constexpr (Epi::AFTER_DRAIN) { E.fused(acc, cur, wr, wc, fr, fq, lds, wid, lane); S.done(cur); }
#undef PG8_SA
#undef PG8_SB
#undef PG8_STAGE
#undef PG8_LDA
#undef PG8_LDB
#undef PG8_MMA
#undef PG8_WAIT_V
#undef PG8_WAIT_L
#undef PG8_BAR
#undef PG8_SCHED
}
}

namespace pg8 {
__device__ __forceinline__ float fsig(float v) { return __builtin_amdgcn_rcpf(1.f + __builtin_amdgcn_exp2f(-1.4426950408889634f * v)); }
__device__ __forceinline__ u32x4 pack8(const f32x4 a, const f32x4 b) { u32x4 w; w.x = cvt_pk_bf16(a[0], a[1]); w.y = cvt_pk_bf16(a[2], a[3]); w.z = cvt_pk_bf16(b[0], b[1]); w.w = cvt_pk_bf16(b[2], b[3]); return w; }
__device__ __forceinline__ void unpack8(const u32x4 w, f32x4& a, f32x4& b) {
    a[0] = __builtin_bit_cast(float, w.x << 16); a[1] = __builtin_bit_cast(float, w.x & 0xffff0000u); a[2] = __builtin_bit_cast(float, w.y << 16); a[3] = __builtin_bit_cast(float, w.y & 0xffff0000u);
    b[0] = __builtin_bit_cast(float, w.z << 16); b[1] = __builtin_bit_cast(float, w.z & 0xffff0000u); b[2] = __builtin_bit_cast(float, w.w << 16); b[3] = __builtin_bit_cast(float, w.w & 0xffff0000u); }
#define PIN16(a) asm volatile("" : "+v"(a[0][0][0]), "+v"(a[0][0][1]), "+v"(a[0][1][0]), "+v"(a[0][1][1]), "+v"(a[0][2][0]), "+v"(a[0][2][1]), "+v"(a[0][3][0]), "+v"(a[0][3][1]), \
    "+v"(a[1][0][0]), "+v"(a[1][0][1]), "+v"(a[1][1][0]), "+v"(a[1][1][1]), "+v"(a[1][2][0]), "+v"(a[1][2][1]), "+v"(a[1][3][0]), "+v"(a[1][3][1]))
__device__ __forceinline__ float dot4(const f32x4 a) { return (a[0] * a[0] + a[1] * a[1]) + (a[2] * a[2] + a[3] * a[3]); }
__device__ __forceinline__ void row_rstd(PG8_LAS unsigned char* lds, int wr, int fr, float (&rs)[2][4]) {
#pragma unroll
    for (int ai = 0; ai < 2; ++ai)
#pragma unroll
        for (int m = 0; m < 4; ++m) rs[ai][m] = *(const PG8_LAS float*)(lds + RSTD_LDS_OFF + (ai * HALF + wr * 64 + m * 16 + fr) * 4);
}
struct EpiSwigluF { static constexpr bool PERM = true, AFTER_DRAIN = false, HOOK = false, RSTD = true; static constexpr int HOOK_T = 0; bf16_t* H; const float* SS;
    __device__ __forceinline__ void operator()(const f32x4 (&acc)[2][2][4][2], const Unit& u, int wr, int wc, int fr, int fq, PG8_LAS unsigned char* lds) const {
        const int row0 = u.pm * BM + wr * 64 + fr, col0 = u.pn * 128 + wc * 32 + 8 * fq;
        for (int rp_ = 0; rp_ < 1 + ((REP_MASK >> 6) & 1); ++rp_) {
        float rs[2][4]; row_rstd(lds, wr, fr, rs);
#pragma unroll
        for (int ai = 0; ai < 2; ++ai)
#pragma unroll
            for (int m = 0; m < 4; ++m) { bf16_t* rowp = H + (size_t)(row0 + ai * HALF + m * 16) * DFF + col0; const float r = rs[ai][m];
                f32x4 h0, h1;
#pragma unroll
                for (int i = 0; i < 4; ++i) { const float g0 = acc[ai][0][m][0][i] * r, g1 = acc[ai][0][m][1][i] * r; h0[i] = g0 * fsig(g0) * (acc[ai][1][m][0][i] * r); h1[i] = g1 * fsig(g1) * (acc[ai][1][m][1][i] * r); }
                __builtin_nontemporal_store(pack8(h0, h1), (u32x4*)rowp); }
        }
    } };
template <bool FINAL> struct EpiResidB { static constexpr bool PERM = true, AFTER_DRAIN = false, HOOK = false, RSTD = false; static constexpr int HOOK_T = 0; bf16_t* XB; float* Of; float* SS; float coef;
    __device__ __forceinline__ void operator()(const f32x4 (&acc)[2][2][4][2], const Unit& u, int wr, int wc, int fr, int fq, PG8_LAS unsigned char* lds) const {
        const int row0 = u.pm * BM + wr * 64 + fr, col0 = u.pn * BM + wc * 32 + 8 * fq;
        u32x4 rr[2][4][2];
#pragma unroll
        for (int ai = 0; ai < 2; ++ai)
#pragma unroll
            for (int m = 0; m < 4; ++m)
#pragma unroll
                for (int bj = 0; bj < 2; ++bj) rr[ai][m][bj] = *(const u32x4*)(XB + (size_t)(row0 + ai * HALF + m * 16) * D + col0 + bj * HALF);
        PIN16(rr);
#pragma unroll
        for (int ai = 0; ai < 2; ++ai)
#pragma unroll
            for (int m = 0; m < 4; ++m) { const size_t row = (size_t)(row0 + ai * HALF + m * 16); float ssq = 0.f;
#pragma unroll
                for (int bj = 0; bj < 2; ++bj) { const int c = col0 + bj * HALF; f32x4 r0, r1; unpack8(rr[ai][m][bj], r0, r1);
                    f32x4 v0 = r0 + acc[ai][bj][m][0] * coef, v1 = r1 + acc[ai][bj][m][1] * coef;
                    if (FINAL) { *(f32x4*)(Of + row * D + c) = v0; *(f32x4*)(Of + row * D + c + 4) = v1; }
                    else { const u32x4 w = pack8(v0, v1); *(u32x4*)(XB + row * D + c) = w; unpack8(w, v0, v1); }
                    ssq += dot4(v0) + dot4(v1); }
                ssq += shx(ssq, fq * 16 + fr, 16); ssq += shx(ssq, fq * 16 + fr, 32);
                if (fq == 0) SS[row * 16 + 4 * u.pn + wc] = ssq; }
    } };
struct EpiProjF { static constexpr bool PERM = true, AFTER_DRAIN = false, HOOK = false, RSTD = true; static constexpr int HOOK_T = 0; bf16_t* PA; bf16_t* PB; float* SG; const float* SS; const float* fb; const float* ib; const float* mfb; unsigned* QKN;
    __device__ __forceinline__ void operator()(const f32x4 (&acc)[2][2][4][2], const Unit& u, int wr, int wc, int fr, int fq, PG8_LAS unsigned char* lds) const {
        const int row0 = u.pm * BM + wr * 64 + fr;
        float rs[2][4]; row_rstd(lds, wr, fr, rs);
        if (u.pn < 22) {
            const int act = u.pn < 2 ? 0 : (u.pn < 12 ? 1 : 2); const int col0 = (u.pn < 12 ? u.pn : u.pn - 12) * BM + wc * 32 + 8 * fq;
            bf16_t* base = u.pn < 12 ? PA : PB; const int pitch = u.pn < 12 ? PJA : PJB;
            float nmx[2] = {0.f, 0.f};
#pragma unroll
            for (int ai = 0; ai < 2; ++ai)
#pragma unroll
                for (int m = 0; m < 4; ++m) { bf16_t* rowp = base + (size_t)(row0 + ai * HALF + m * 16) * pitch + col0; const float r = rs[ai][m] * (act == 0 ? QSCALE2 : 1.0f);
#pragma unroll
                    for (int bj = 0; bj < 2; ++bj) { f32x4 v0 = acc[ai][bj][m][0] * r, v1 = acc[ai][bj][m][1] * r;
                        if (u.pn < 4) { float p = dot4(v0) + dot4(v1); p += shx(p, fq * 16 + fr, 16); p += shx(p, fq * 16 + fr, 32); nmx[bj] = fmaxf(nmx[bj], p); }
                        if (act == 2) {
#pragma unroll
                            for (int i = 0; i < 4; ++i) { v0[i] = fsig(v0[i]); v1[i] = fsig(v1[i]); } }
                        __builtin_nontemporal_store(pack8(v0, v1), (u32x4*)(rowp + bj * HALF)); } }
            if (u.pn < 4) {
#pragma unroll
                for (int bj = 0; bj < 2; ++bj) { float p = nmx[bj];
#pragma unroll
                    for (int o = 1; o < 16; o <<= 1) p = fmaxf(p, shx(p, fq * 16 + fr, o));
                    if (fr == 0 && fq == 0) atomicMax(QKN + (((u.pm >> 3) * 8 + 4 * (u.pn & 1) + 2 * bj + (wc >> 1)) * 4 + 2 * (u.pn >> 1) + (wc & 1)), __builtin_bit_cast(unsigned, p)); } }
        } else if (wc == 0 && fq < 2) {
            const f32x4 b0 = fq == 0 ? *(const f32x4*)fb : *(const f32x4*)ib, b1 = fq == 0 ? *(const f32x4*)(fb + 4) : *(const f32x4*)mfb;
#pragma unroll
            for (int ai = 0; ai < 2; ++ai)
#pragma unroll
                for (int m = 0; m < 4; ++m) { float* sp = SG + (size_t)(row0 + ai * HALF + m * 16) * 16 + 8 * fq; const float r = rs[ai][m];
                    f32x4 v0 = acc[ai][0][m][0] * r + b0, v1 = acc[ai][0][m][1] * r + b1;
#pragma unroll
                    for (int i = 0; i < 4; ++i) { if (fq == 0) v0[i] = logsigmoidf_(v0[i]); v1[i] = logsigmoidf_(v1[i]); }
                    *(f32x4*)sp = v0; *(f32x4*)(sp + 4) = v1; }
        }
    } };
struct EpiMergeF { static constexpr bool PERM = true, AFTER_DRAIN = false, HOOK = true, RSTD = false; static constexpr int HOOK_T = 8; const bf16_t* PB; bf16_t* MG;
    __device__ __forceinline__ void mid(f32x4 (&acc)[2][2][4][2], const Unit& u, int wr, int wc, int fr, int fq) const {
        int row0 = u.pm * BM + wr * 64 + fr, col0 = u.pn * BM + wc * 32 + 8 * fq; asm volatile("" : "+v"(row0), "+v"(col0));
#pragma unroll
        for (int ai = 0; ai < 2; ++ai) {
            u32x4 gg[2][4][2];
#pragma unroll
            for (int m = 0; m < 4; ++m)
#pragma unroll
                for (int bj = 0; bj < 2; ++bj) { const bf16_t* rowp = PB + (size_t)(row0 + ai * HALF + m * 16) * PJB + col0 + bj * HALF; gg[0][m][bj] = *(const u32x4*)(rowp + PB_GA); gg[1][m][bj] = *(const u32x4*)(rowp + PB_GB); }
            PIN16(gg);
#pragma unroll
            for (int m = 0; m < 4; ++m) {
#pragma unroll
                for (int bj = 0; bj < 2; ++bj) { f32x4 a0, a1, b0, b1; unpack8(gg[0][m][bj], a0, a1); unpack8(gg[1][m][bj], b0, b1);
#pragma unroll
                    for (int i = 0; i < 4; ++i) { acc[ai][bj][m][0][i] *= a0[i] * __builtin_amdgcn_rcpf(fmaxf(b0[i], 1e-30f)); acc[ai][bj][m][1][i] *= a1[i] * __builtin_amdgcn_rcpf(fmaxf(b1[i], 1e-30f)); } } } }
    }
    __device__ __forceinline__ void operator()(const f32x4 (&acc)[2][2][4][2], const Unit& u, int wr, int wc, int fr, int fq, PG8_LAS unsigned char* lds) const {
        const int row0 = u.pm * BM + wr * 64 + fr, col0 = u.pn * BM + wc * 32 + 8 * fq;
        u32x4 gb[2][4][2];
#pragma unroll
        for (int ai = 0; ai < 2; ++ai)
#pragma unroll
            for (int m = 0; m < 4; ++m)
#pragma unroll
                for (int bj = 0; bj < 2; ++bj) gb[ai][m][bj] = *(const u32x4*)(PB + (size_t)(row0 + ai * HALF + m * 16) * PJB + PB_GB + col0 + bj * HALF);
        PIN16(gb);
#pragma unroll
        for (int ai = 0; ai < 2; ++ai)
#pragma unroll
            for (int m = 0; m < 4; ++m) { const size_t row = (size_t)(row0 + ai * HALF + m * 16);
#pragma unroll
                for (int bj = 0; bj < 2; ++bj) { const int c = col0 + bj * HALF; f32x4 b0, b1; unpack8(gb[ai][m][bj], b0, b1);
                    *(u32x4*)(MG + row * D + c) = pack8(b0 * acc[ai][bj][m][0], b1 * acc[ai][bj][m][1]); } }
    } };
}

__device__ __forceinline__ void transpose_item(const float* W, int N, int scol0, bf16* WT, int ldt, int drow0, int k0, int kdst0, LAS float* scr, int lane, const float* gain) {
#pragma unroll 8
    for (int i = 0; i < 32; ++i) { const int kk = 2 * i + (lane >> 5); const float gk = gain ? gain[k0 + kk] : 1.0f; scr[kk * 33 + (lane & 31)] = W[(size_t)(k0 + kk) * N + scol0 + (lane & 31)] * gk; }
    asm volatile("s_waitcnt lgkmcnt(0)" ::: "memory");
    const int c = lane & 7;
#pragma unroll
    for (int j = 0; j < 4; ++j) { const int n = (lane >> 3) + 8 * j; const LAS float* s = scr + (8 * c) * 33 + n;
        v4u o; o.x = pk2(s[0 * 33], s[1 * 33]); o.y = pk2(s[2 * 33], s[3 * 33]); o.z = pk2(s[4 * 33], s[5 * 33]); o.w = pk2(s[6 * 33], s[7 * 33]);
        *(GAS v4u*)(WT + (size_t)(drow0 + n) * ldt + kdst0 + k0 + 8 * c) = o; }
    asm volatile("s_waitcnt lgkmcnt(0)" ::: "memory");
}
__device__ __forceinline__ void phase_weights(Frame& F) {
    const int ptid = opaque_tid(F.wave), plane = ptid & 63, pwave = __builtin_amdgcn_readfirstlane(ptid >> 6); (void)plane; (void)pwave;
    LAS float* scr = (LAS float*)(F.lds + pwave * 16384);
    const int gw = blockIdx.x * NWAVES + pwave, NGW = F.G * NWAVES;
    constexpr int PJ = PJA + PJB; constexpr int I_IN = (D / 64) * (NFF / 32), I_OUT = (DFF / 64) * (D / 32), I_PJ = (D / 64) * (PJ / 32), I_UP = (512 / 64) * (D / 32), I_WO = (D / 64) * (D / 32);
    constexpr int NITEMS = 2 * I_IN + 2 * I_OUT + I_PJ + 2 * I_UP + I_WO;
    for (int it = gw; it < NITEMS; it += NGW) {
        int r = it;
        if (r < 2 * I_IN) { const int which = r / I_IN; r -= which * I_IN; const int ndb = NFF / 32, kb = r / ndb, db = r % ndb, n = db * 32, pn = n >> 8, j = n & 255;
            const int sc = (j < 128) ? pn * 128 + j : DFF + pn * 128 + (j - 128);
            transpose_item(F.in[which ? 15 : 2], NFF, sc, (bf16*)(F.ws + (which ? WS_W2IN : WS_W1IN)), D, n, kb * 64, 0, scr, plane, F.in[which ? 14 : 1]); continue; }
        r -= 2 * I_IN;
        if (r < 2 * I_OUT) { const int which = r / I_OUT; r -= which * I_OUT; const int ndb = D / 32, kb = r / ndb, db = r % ndb;
            transpose_item(F.in[which ? 16 : 3], D, db * 32, (bf16*)(F.ws + (which ? WS_W2OUT : WS_W1OUT)), DFF, db * 32, kb * 64, 0, scr, plane, nullptr); continue; }
        r -= 2 * I_OUT;
        if (r < I_PJ) { const int ndb = PJ / 32, kb = r / ndb, db = r % ndb, n = db * 32; const int sc = n + (n < 1536 ? 0 : (n < 3072 ? 8 : 16));
            transpose_item(F.in[5], INC, sc, (bf16*)(F.ws + WS_WIN), D, n, kb * 64, 0, scr, plane, F.in[4]); continue; }
        r -= I_PJ;
        if (r < 2 * I_UP) { const int which = r / I_UP; r -= which * I_UP; const int ndb = D / 32, kb = r / ndb, db = r % ndb;
            transpose_item(F.in[which ? 12 : 11], D, db * 32, (bf16*)(F.ws + WS_WCAT), D, db * 32, kb * 64, which ? 512 : 0, scr, plane, nullptr); continue; }
        r -= 2 * I_UP;
        { const int ndb = D / 32, kb = r / ndb, db = r % ndb; transpose_item(F.in[13], D, db * 32, (bf16*)(F.ws + WS_WOUT), D, db * 32, kb * 64, 0, scr, plane, nullptr); }
    }
    { bf16* WT = (bf16*)(F.ws + WS_WIN); const float* W = F.in[5];
      for (int idx = blockIdx.x * NTHR + ptid; idx < 256 * 128; idx += F.G * NTHR) { const int row = idx >> 7, k8 = (idx & 127) * 8; v4u o = {0u, 0u, 0u, 0u};
          if (row < 16) { const int sc = row < 8 ? 1536 + row : (row < 12 ? 3080 + (row - 8) : 3084 + (row - 12)); float v[8];
#pragma unroll
              for (int i = 0; i < 8; ++i) v[i] = W[(size_t)(k8 + i) * INC + sc] * F.in[4][k8 + i];
              o.x = pk2(v[0], v[1]); o.y = pk2(v[2], v[3]); o.z = pk2(v[4], v[5]); o.w = pk2(v[6], v[7]); }
          *(GAS v4u*)(WT + (size_t)(PJ + row) * D + k8) = o; } }
}

#include <hip/hip_bf16.h>
#include <cmath>
namespace attn_body {
using bf16=__hip_bfloat16;
using bf16x8=__attribute__((ext_vector_type(8)))short;
using s16x4=__attribute__((ext_vector_type(4)))short;
using f32x16=__attribute__((ext_vector_type(16)))float;
using u32x4=__attribute__((ext_vector_type(4)))unsigned;
constexpr int BATCH=32,NHEAD=8,SEQ=2048,D=64,DM=3072,OP=1024;
constexpr int NW=8,QBLK=32,QB=QBLK*NW,KVBLK=64,NQB=SEQ/QB;
constexpr int ATTN_PITCH=DM, ATTN_UNIT_ROWS=QB;
__device__ __forceinline__ int crow(int r,int hi){return (r&3)+8*(r>>2)+4*hi;}
#define SBAR() __builtin_amdgcn_sched_barrier(0)
__device__ __forceinline__ void cmask(f32x16&p0,f32x16&p1,int jb,int qrel,int hi){
  const float NEG=-INFINITY; int kb=64*jb+4*hi;
  #pragma unroll
  for(int r=0;r<16;++r){int kv=kb+(r&3)+8*(r>>2); if(kv>qrel)p0[r]=NEG; if(kv+32>qrel)p1[r]=NEG;}
}

constexpr int NSLOT=3, SLOTB=8192;
constexpr int LDS_K=0, LDS_V=NSLOT*SLOTB, LDS_WS=2*NSLOT*SLOTB, LDS_OST=LDS_WS+NW*64*4, LDS_BIAS=LDS_OST+NW*4096, LDS_ROWB=LDS_BIAS+SEQ*8, LDS_BYTES=LDS_ROWB+QB*4;
constexpr float C2=0.125f*1.4426950408889634f;
__device__ __forceinline__ void glds16(const void*gsrc,unsigned lds_dst){unsigned keep;
  asm volatile("s_mov_b32 %0, m0\n\ts_mov_b32 m0, %2\n\ts_nop 0\n\tglobal_load_lds_dwordx4 %1, off\n\ts_mov_b32 m0, %0":"=&s"(keep):"v"(gsrc),"s"(lds_dst):"memory");}
__device__ __forceinline__ float max3f(float a,float b,float c){float r;asm("v_max3_f32 %0, %1, %2, %3":"=v"(r):"v"(a),"v"(b),"v"(c));return r;}
__device__ __forceinline__ float max2f(float a,float b){float r;asm("v_max_f32_e32 %0, %1, %2":"=v"(r):"v"(a),"v"(b));return r;}
__device__ __forceinline__ float fadd_s(float a,float b){float r;asm("v_add_f32_e32 %0, %1, %2":"=v"(r):"v"(a),"v"(b));return r;}
__device__ __forceinline__ float fsub_s(float a,float b){float r;asm("v_sub_f32_e32 %0, %1, %2":"=v"(r):"v"(a),"v"(b));return r;}
typedef float f32x2_t __attribute__((ext_vector_type(2))); typedef __bf16 bf16x2_t __attribute__((ext_vector_type(2)));
__device__ __forceinline__ unsigned cvtpk_s(float lo,float hi){f32x2_t v={lo,hi};bf16x2_t b=__builtin_convertvector(v,bf16x2_t);return __builtin_bit_cast(unsigned,b);}
#define WAIT_BAR(N) asm volatile("s_waitcnt vmcnt(" #N ") lgkmcnt(0)\n\ts_barrier":::"memory")

__device__ __forceinline__ void qkt(f32x16&p0,f32x16&p1,const char*Kslot,const bf16x8*qr,int r32,int hi,bf16x8 kx0,bf16x8 kx1,bf16x8 qx){
  const char*kb=Kslot+hi*1024+r32*16;
  #pragma unroll
  for(int d0=0;d0<4;++d0){
    const bf16x8 b0=*reinterpret_cast<const bf16x8*>(kb+d0*2048);
    const bf16x8 b1=*reinterpret_cast<const bf16x8*>(kb+d0*2048+512);
    if(d0==0){p0=__builtin_amdgcn_mfma_f32_32x32x16_bf16(b0,qr[0],f32x16{},0,0,0);p1=__builtin_amdgcn_mfma_f32_32x32x16_bf16(b1,qr[0],f32x16{},0,0,0);}
    else{p0=__builtin_amdgcn_mfma_f32_32x32x16_bf16(b0,qr[d0],p0,0,0,0);p1=__builtin_amdgcn_mfma_f32_32x32x16_bf16(b1,qr[d0],p1,0,0,0);}}
  p0=__builtin_amdgcn_mfma_f32_32x32x16_bf16(kx0,qx,p0,0,0,0);p1=__builtin_amdgcn_mfma_f32_32x32x16_bf16(kx1,qx,p1,0,0,0);
}
typedef __attribute__((address_space(3))) const char* lds_cptr;
typedef short v4i16_t __attribute__((ext_vector_type(4)));
__device__ __forceinline__ void kload8(bf16x8*kf,lds_cptr kp){
  kf[0]=*(const __attribute__((address_space(3))) bf16x8*)(kp);      kf[1]=*(const __attribute__((address_space(3))) bf16x8*)(kp+512);
  kf[2]=*(const __attribute__((address_space(3))) bf16x8*)(kp+2048); kf[3]=*(const __attribute__((address_space(3))) bf16x8*)(kp+2560);
  kf[4]=*(const __attribute__((address_space(3))) bf16x8*)(kp+4096); kf[5]=*(const __attribute__((address_space(3))) bf16x8*)(kp+4608);
  kf[6]=*(const __attribute__((address_space(3))) bf16x8*)(kp+6144); kf[7]=*(const __attribute__((address_space(3))) bf16x8*)(kp+6656);
}
__device__ __forceinline__ void kload2(bf16x8*kf,lds_cptr kp,int j){ kf[2*j]=*(const __attribute__((address_space(3))) bf16x8*)(kp+j*2048); kf[2*j+1]=*(const __attribute__((address_space(3))) bf16x8*)(kp+j*2048+512); }
typedef unsigned u32x2_t __attribute__((ext_vector_type(2)));
__device__ __forceinline__ bf16x8 kxfrag(lds_cptr tbl,int kv,int hi){ u32x2_t b=*(const __attribute__((address_space(3))) u32x2_t*)(tbl+kv*8); if(hi){b.x=0u;b.y=0u;} const u32x4 w={b.x,b.y,hi?0u:0x3F803F80u,0u}; return __builtin_bit_cast(bf16x8,w); }
__device__ __forceinline__ s16x4 vtr(lds_cptr p){ return __builtin_bit_cast(s16x4,__builtin_amdgcn_ds_read_tr16_b64_v4i16((__attribute__((address_space(3))) v4i16_t*)p)); }
__device__ __forceinline__ float rowmax(const f32x16&p0,const f32x16&p1){
  float a=max3f(p0[0],p0[1],p1[0]),b=max3f(p0[2],p0[3],p1[1]);a=max3f(a,p1[2],p1[3]);
  #pragma unroll
  for(int r=4;r<16;r+=4){a=max3f(a,p0[r],p0[r+1]);b=max3f(b,p0[r+2],p0[r+3]);a=max3f(a,p1[r],p1[r+1]);b=max3f(b,p1[r+2],p1[r+3]);}
  const float m=max2f(a,b);
  auto rr=__builtin_amdgcn_permlane32_swap(__float_as_uint(m),__float_as_uint(m),false,false);
  return max2f(__uint_as_float(rr[0]),__uint_as_float(rr[1]));
}
__device__ __forceinline__ void pv(f32x16*o,int vb,bf16x8 pa0,bf16x8 pa1,bf16x8 pa2,bf16x8 pa3){
  #pragma unroll
  for(int d0=0;d0<2;++d0){s16x4 lo[4],hi[4];
    #pragma unroll
    for(int ks=0;ks<4;++ks){
      asm volatile("ds_read_b64_tr_b16 %0,%1 offset:%c2":"=&v"(lo[ks]):"v"(vb),"i"(d0*4096+ks*1024):"memory");
      asm volatile("ds_read_b64_tr_b16 %0,%1 offset:%c2":"=&v"(hi[ks]):"v"(vb),"i"(d0*4096+ks*1024+512):"memory");}
    asm volatile("s_waitcnt lgkmcnt(0)":::"memory");SBAR();
    #define PK(k) (bf16x8){lo[k][0],lo[k][1],lo[k][2],lo[k][3],hi[k][0],hi[k][1],hi[k][2],hi[k][3]}
    o[d0]=__builtin_amdgcn_mfma_f32_32x32x16_bf16(pa0,PK(0),o[d0],0,0,0);
    o[d0]=__builtin_amdgcn_mfma_f32_32x32x16_bf16(pa1,PK(1),o[d0],0,0,0);
    o[d0]=__builtin_amdgcn_mfma_f32_32x32x16_bf16(pa2,PK(2),o[d0],0,0,0);
    o[d0]=__builtin_amdgcn_mfma_f32_32x32x16_bf16(pa3,PK(3),o[d0],0,0,0);
    #undef PK
  }
}

#ifndef ATTN_STORE16
#define ATTN_STORE16(p,v) (*(u32x4*)(p)=(v))
#endif
template<int THRL> __device__ __forceinline__ void attn_unit(int b,int h,int qb,const bf16*Q,const bf16*__restrict__ K,const bf16*__restrict__ V,bf16*O,const float*CUMh,char*shm,const int wv,const float qkb){
  int tid_=wv*64+(int)__builtin_amdgcn_mbcnt_hi(~0u,__builtin_amdgcn_mbcnt_lo(~0u,0u)); asm volatile("":"+v"(tid_)); const int tid=tid_,lane=tid&63,r32=lane&31,hi=lane>>5; const int wid=__builtin_amdgcn_readfirstlane(tid>>6);
  const long rowbase=(long)b*SEQ; const int q0=qb*QB;
  const bf16*Qw=Q+(rowbase+q0+wid*QBLK)*DM+h*D;
  int t0; { const int NTF_=(q0+QB)/KVBLK; const float cref_=CUMh[q0]; const float ce_=(lane<NTF_-4)?CUMh[64*lane+63]:cref_;
    const bool sk_=(lane<NTF_-4)&&(qkb+(cref_-ce_)*1.4426950408889634f<-160.f); const unsigned long long nb_=~__ballot(sk_); t0=__builtin_amdgcn_readfirstlane((int)__builtin_ctzll(nb_))&~1; }
  const bf16*Kh=K+(rowbase+(long)t0*KVBLK)*DM+h*D,*Vh=V+(rowbase+(long)t0*KVBLK)*DM+h*D;
  const unsigned lds0=(unsigned)(uintptr_t)shm;
  float*wsf=(float*)(shm+LDS_WS)+wid*64;
  const bf16*ksrc=Kh+(long)lane*DM+wid*8;
  const bf16*vsrc=Vh+(long)(16*(wid&3)+(lane>>2))*DM+(wid>>2)*32+(lane&3)*8;
  const unsigned kdst=lds0+LDS_K+wid*1024, vdst=lds0+LDS_V+wid*1024;
  #define DMA_K(t,slot) glds16(ksrc+(long)(t)*KVBLK*DM,(unsigned)__builtin_amdgcn_readfirstlane(kdst+(slot)))
  #define DMA_V(t,slot) glds16(vsrc+(long)(t)*KVBLK*DM,(unsigned)__builtin_amdgcn_readfirstlane(vdst+(slot)))
  const int vb0=(int)(lds0+LDS_V)+((lane>>4)&1)*32+(lane&3)*8+(4*hi+((lane&15)>>2))*64;
  const char*Kbase=shm+LDS_K; bf16x8 kf[8];
  const lds_cptr shm3=(lds_cptr)shm; const lds_cptr kp0=shm3+LDS_K+hi*1024+r32*16; const lds_cptr vp0=shm3+LDS_V+((lane>>4)&1)*32+(lane&3)*8+(4*hi+((lane&15)>>2))*64;
  const int NT=(q0+QB)/KVBLK-t0;
  DMA_K(0,0);DMA_V(0,0);DMA_K(1,SLOTB);
  bf16x8 qr[4];
  #pragma unroll
  for(int d0=0;d0<4;++d0)qr[d0]=*reinterpret_cast<const bf16x8*>(&Qw[(long)r32*DM+d0*16+hi*8]);
  const int qrel=wid*QBLK+r32;
  { const float cref=CUMh[q0]; __attribute__((address_space(3))) unsigned*bt=(__attribute__((address_space(3))) unsigned*)(shm3+LDS_BIAS); __attribute__((address_space(3))) float*rb=(__attribute__((address_space(3))) float*)(shm3+LDS_ROWB);
    for(int kv=KVBLK*t0+tid;kv<q0+QB;kv+=NW*64){ const float bias=(cref-CUMh[kv])*1.4426950408889634f;
      const unsigned u1=__builtin_bit_cast(unsigned,bias); const unsigned h1=(u1+0x7fffu+((u1>>16)&1u))&0xffff0000u; const float r1=bias-__builtin_bit_cast(float,h1);
      const unsigned u2=__builtin_bit_cast(unsigned,r1);   const unsigned h2=(u2+0x7fffu+((u2>>16)&1u))&0xffff0000u; const float r2=r1-__builtin_bit_cast(float,h2);
      const unsigned u3=__builtin_bit_cast(unsigned,r2);   const unsigned h3=(u3+0x7fffu+((u3>>16)&1u))&0xffff0000u;
      bt[2*kv]=(h1>>16)|h2; bt[2*kv+1]=(h3>>16)|0x3F800000u; if(kv>=q0)rb[kv-q0]=bias; } }
  const lds_cptr btab=shm3+LDS_BIAS+t0*(KVBLK*8); u32x4 qxw={hi?0u:0x3F803F80u,0u,0u,0u};
  #define QX __builtin_bit_cast(bf16x8,qxw)
  #define RNEHI(u) (((u)+0x7fffu+(((u)>>16)&1u))&0xffff0000u)
  #define SETQX() do{ const float nm_=-mhat; const unsigned a1_=RNEHI(__builtin_bit_cast(unsigned,nm_)); const float s1_=nm_-__builtin_bit_cast(float,a1_); \
      const unsigned a2_=RNEHI(__builtin_bit_cast(unsigned,s1_)); const float s2_=s1_-__builtin_bit_cast(float,a2_); const unsigned a3_=RNEHI(__builtin_bit_cast(unsigned,s2_)); \
      qxw.y=hi?0u:(a1_|0x3F80u); qxw.z=hi?0u:((a2_>>16)|a3_); }while(0)
  float mhat=0.f,l_reg=0.f;f32x16 o[2];o[0]=f32x16{};o[1]=f32x16{};
  #define CMASK(P0,P1,t) do{int jb_=(t)-(NT-4); if(jb_>=0)cmask(P0,P1,jb_,qrel,hi);}while(0)
  bool resc=false;
  #define START(P0,P1) do{ const float rm=rowmax(P0,P1); resc=false; \
    { const float dl=max2f(rm,0.f); mhat=fadd_s(mhat,dl); \
      _Pragma("unroll") for(int r=0;r<16;++r){P0[r]=fsub_s(P0[r],dl);P1[r]=fsub_s(P1[r],dl);} \
      SETQX(); } \
    _Pragma("unroll") for(int r=0;r<16;++r)P0[r]=__builtin_amdgcn_exp2f(P0[r]); }while(0)
  #define RESC() do{ if(resc){ asm volatile("s_waitcnt lgkmcnt(0)":::"memory"); \
      _Pragma("unroll") for(int d_=0;d_<2;++d_) _Pragma("unroll") for(int r=0;r<16;++r)o[d_][r]*=wsf[crow(r,hi)]; } }while(0)
  f32x16 pA0,pA1,pB0,pB1;
  int sl_prev=0,sl_cur=0,sl_next=SLOTB;
  #define ROT() do{sl_prev=sl_cur;sl_cur=sl_next;sl_next=(sl_next==(NSLOT-1)*SLOTB)?0:sl_next+SLOTB;}while(0)
  DMA_K(2,2*SLOTB);
  WAIT_BAR(3);
  mhat=*(const __attribute__((address_space(3))) float*)(shm3+LDS_ROWB+qrel*4);
  SETQX();
  qkt(pA0,pA1,Kbase,qr,r32,hi,kxfrag(btab,r32,hi),kxfrag(btab,32+r32,hi),QX);asm volatile("s_nop 15\n\ts_nop 7":"+v"(pA0),"+v"(pA1));CMASK(pA0,pA1,0);
  START(pA0,pA1);
  _Pragma("unroll") for(int r=0;r<16;++r)pA1[r]=__builtin_amdgcn_exp2f(pA1[r]);
  WAIT_BAR(0);
  DMA_K(3,0);DMA_V(1,SLOTB);
  ROT();
  kload8(kf,kp0+sl_cur);
  WAIT_BAR(2);
  s16x4 vlo[8],vhi[8]; u32x4 pw0,pw1,pw2,pw3;
  #define PKW(P,B) cvtpk_s(P[B],P[B+1])
  #define PAF(k) __builtin_bit_cast(bf16x8,pw##k)
  #define VFR(i) (bf16x8){vlo[i][0],vlo[i][1],vlo[i][2],vlo[i][3],vhi[i][0],vhi[i][1],vhi[i][2],vhi[i][3]}
  #define PIN(x) asm volatile("":"+v"(x))
  #define MX3(a,b,c) __builtin_fmaxf(__builtin_fmaxf((a),(b)),(c))
  #define GAPA(MF,A0,A1,A2,A3,W0,W1,PW) do{ MF; sacc+=A0; sacc+=A1; sacc+=A2; sacc+=A3; PIN(sacc); W0; W1; PIN(PW); SBAR(); }while(0)
  #define EX(v) __builtin_amdgcn_exp2f(v)
  #define GAPB(MF,X,B) do{ MF; X[B]=EX(X[B]); X[B+1]=EX(X[B+1]); X[B+2]=EX(X[B+2]); X[B+3]=EX(X[B+3]); PIN(X); SBAR(); }while(0)
  #define VRD(i) do{ vlo[i]=vtr(vp_+(((i)>>2)*4096+((i)&3)*1024)); vhi[i]=vtr(vp_+(((i)>>2)*4096+((i)&3)*1024+512)); }while(0)
  #define KRD(G,j) do{ if(G){ kload2(kf,kp0+sl_next,j); SBAR(); } }while(0)
  #define STEP(C0,C1,P0,P1,t,GK,GV,GL) do{ SBAR(); \
    const lds_cptr vp_=vp0+sl_prev; \
    const bf16x8 kx0_=kxfrag(btab,64*(t)+r32,hi), kx1_=kxfrag(btab,64*(t)+32+r32,hi); \
    VRD(0); SBAR(); float sacc=(P0[0]+P0[1]); \
    GAPA(C0=__builtin_amdgcn_mfma_f32_32x32x16_bf16(kf[0],qr[0],f32x16{},0,0,0), P0[2],P0[3],P0[4],P0[5],     pw0[0]=PKW(P0,0), pw0[1]=PKW(P0,2), pw0); \
    VRD(4); SBAR(); GAPA(C1=__builtin_amdgcn_mfma_f32_32x32x16_bf16(kf[1],qr[0],f32x16{},0,0,0), P0[6],P0[7],P0[8],P0[9],     pw0[2]=PKW(P0,4), pw0[3]=PKW(P0,6), pw0); \
    VRD(1); SBAR(); GAPA(C0=__builtin_amdgcn_mfma_f32_32x32x16_bf16(kf[2],qr[1],C0,0,0,0),   P0[10],P0[11],P0[12],P0[13], pw1[0]=PKW(P0,8), pw1[1]=PKW(P0,10), pw1); \
    VRD(5); SBAR(); GAPA(C1=__builtin_amdgcn_mfma_f32_32x32x16_bf16(kf[3],qr[1],C1,0,0,0),   P0[14],P0[15],P1[0],P1[1],   pw1[2]=PKW(P0,12),pw1[3]=PKW(P0,14), pw1); \
    VRD(2); SBAR(); GAPA(C0=__builtin_amdgcn_mfma_f32_32x32x16_bf16(kf[4],qr[2],C0,0,0,0),   P1[2],P1[3],P1[4],P1[5],     pw2[0]=PKW(P1,0), pw2[1]=PKW(P1,2), pw2); \
    VRD(6); SBAR(); GAPA(C1=__builtin_amdgcn_mfma_f32_32x32x16_bf16(kf[5],qr[2],C1,0,0,0),   P1[6],P1[7],P1[8],P1[9],     pw2[2]=PKW(P1,4), pw2[3]=PKW(P1,6), pw2); \
    VRD(3); SBAR(); GAPA(C0=__builtin_amdgcn_mfma_f32_32x32x16_bf16(kf[6],qr[3],C0,0,0,0),   P1[10],P1[11],P1[12],P1[13], pw3[0]=PKW(P1,8), pw3[1]=PKW(P1,10), pw3); \
    VRD(7); SBAR(); GAPA(C1=__builtin_amdgcn_mfma_f32_32x32x16_bf16(kf[7],qr[3],C1,0,0,0),   P1[14],P1[15],0.f,0.f,       pw3[2]=PKW(P1,12),pw3[3]=PKW(P1,14), pw3); \
    C0=__builtin_amdgcn_mfma_f32_32x32x16_bf16(kx0_,QX,C0,0,0,0); C1=__builtin_amdgcn_mfma_f32_32x32x16_bf16(kx1_,QX,C1,0,0,0); SBAR(); \
    l_reg+=sacc; \
    if(GK){DMA_K((t)+3,sl_cur);} if(GV){DMA_V((t)+1,sl_next);} \
    CMASK(C0,C1,t); \
    { float a=MX3(C0[0],C0[1],C1[0]),b=MX3(C0[2],C0[3],C1[1]); a=MX3(a,C1[2],C1[3]); \
      _Pragma("unroll") for(int r=4;r<16;r+=4){a=MX3(a,C0[r],C0[r+1]);b=MX3(b,C0[r+2],C0[r+3]);a=MX3(a,C1[r],C1[r+1]);b=MX3(b,C1[r+2],C1[r+3]);} \
      float rm=__builtin_fmaxf(a,b); { auto rr=__builtin_amdgcn_permlane32_swap(__float_as_uint(rm),__float_as_uint(rm),false,false); rm=__builtin_fmaxf(__uint_as_float(rr[0]),__uint_as_float(rr[1])); } \
      resc=false; \
      if(__builtin_expect(__any(rm>(float)THRL),0)){ const float dl=__builtin_fmaxf(rm,0.f); mhat+=dl; \
        _Pragma("unroll") for(int r=0;r<16;++r){C0[r]-=dl;C1[r]-=dl;} \
        SETQX(); \
        const float f=__builtin_amdgcn_exp2f(-dl); l_reg*=f; if(hi==0)wsf[r32]=f; resc=true; } } \
    SBAR(); \
    GAPB(o[0]=__builtin_amdgcn_mfma_f32_32x32x16_bf16(PAF(0),VFR(0),o[0],0,0,0), C0,0); \
    GAPB(o[1]=__builtin_amdgcn_mfma_f32_32x32x16_bf16(PAF(0),VFR(4),o[1],0,0,0), C0,4); \
    KRD(GL,0); GAPB(o[0]=__builtin_amdgcn_mfma_f32_32x32x16_bf16(PAF(1),VFR(1),o[0],0,0,0), C0,8); \
    KRD(GL,1); GAPB(o[1]=__builtin_amdgcn_mfma_f32_32x32x16_bf16(PAF(1),VFR(5),o[1],0,0,0), C0,12); \
    KRD(GL,2); GAPB(o[0]=__builtin_amdgcn_mfma_f32_32x32x16_bf16(PAF(2),VFR(2),o[0],0,0,0), C1,0); \
    KRD(GL,3); GAPB(o[1]=__builtin_amdgcn_mfma_f32_32x32x16_bf16(PAF(2),VFR(6),o[1],0,0,0), C1,4); \
    GAPB(o[0]=__builtin_amdgcn_mfma_f32_32x32x16_bf16(PAF(3),VFR(3),o[0],0,0,0), C1,8); \
    GAPB(o[1]=__builtin_amdgcn_mfma_f32_32x32x16_bf16(PAF(3),VFR(7),o[1],0,0,0), C1,12); \
    }while(0)
  int t=1;
  #undef CMASK
  #define CMASK(P0,P1,t) do{}while(0)
  for(;t+5<NT;t+=2){
    STEP(pB0,pB1,pA0,pA1,t,true,true,true);     WAIT_BAR(2); RESC(); ROT();
    STEP(pA0,pA1,pB0,pB1,t+1,true,true,true);   WAIT_BAR(2); RESC(); ROT();
  }
  #undef CMASK
  #define CMASK(P0,P1,t) do{int jb_=(t)-(NT-4); if(jb_>=0)cmask(P0,P1,jb_,qrel,hi);}while(0)
  #define ENDW(tt) do{ if((tt)+3<NT){WAIT_BAR(2);} else if((tt)+2<NT){WAIT_BAR(1);} else {WAIT_BAR(0);} }while(0)
  for(;t+1<NT;t+=2){
    STEP(pB0,pB1,pA0,pA1,t,(t+3<NT),(t+1<NT),(t+1<NT));       ENDW(t);   RESC(); ROT();
    STEP(pA0,pA1,pB0,pB1,t+1,(t+4<NT),(t+2<NT),(t+2<NT));     ENDW(t+1); RESC(); ROT();
  }
  STEP(pB0,pB1,pA0,pA1,NT-1,false,false,false); RESC();
  { float sacc=pB0[0]+pB0[1]; _Pragma("unroll") for(int r=2;r<16;++r)sacc+=pB0[r]; _Pragma("unroll") for(int r=0;r<16;++r)sacc+=pB1[r]; l_reg+=sacc;
    pw0=(u32x4){PKW(pB0,0),PKW(pB0,2),PKW(pB0,4),PKW(pB0,6)};pw1=(u32x4){PKW(pB0,8),PKW(pB0,10),PKW(pB0,12),PKW(pB0,14)};pw2=(u32x4){PKW(pB1,0),PKW(pB1,2),PKW(pB1,4),PKW(pB1,6)};pw3=(u32x4){PKW(pB1,8),PKW(pB1,10),PKW(pB1,12),PKW(pB1,14)};
    SBAR(); pv(o,vb0+sl_cur,PAF(0),PAF(1),PAF(2),PAF(3)); }
  #undef PKW
  #undef PAF
  #undef VFR
  #undef PIN
  #undef MX3
  #undef GAPA
  #undef GAPB
  #undef EX
  #undef VRD
  #undef KRD
  #undef STEP
  #undef ENDW
  {auto rr=__builtin_amdgcn_permlane32_swap(__float_as_uint(l_reg),__float_as_uint(l_reg),false,false);l_reg=__uint_as_float(rr[0])+__uint_as_float(rr[1]);}
  if(hi==0)wsf[32+r32]=l_reg;asm volatile("s_waitcnt lgkmcnt(0)":::"memory");
  float rli[16];
  #pragma unroll
  for(int r=0;r<16;++r)rli[r]=__builtin_amdgcn_rcpf(wsf[32+crow(r,hi)]);
  bf16*Ow=O+(rowbase+q0+wid*QBLK)*OP+h*D;
  { bf16*stg=(bf16*)(shm+LDS_OST)+wid*2048;
    #pragma unroll
    for(int r=0;r<16;++r){const int orow=crow(r,hi);
      #pragma unroll
      for(int d0=0;d0<2;++d0)stg[orow*64+d0*32+r32]=__float2bfloat16(o[d0][r]*rli[r]);}
    asm volatile("s_waitcnt lgkmcnt(0)":::"memory");
    #pragma unroll
    for(int i=0;i<4;++i){const int row=i*8+(lane>>3),ch=lane&7; const u32x4 v=*(const u32x4*)(stg+row*64+ch*8); ATTN_STORE16(Ow+(long)row*OP+ch*8,v);} }
  asm volatile("s_waitcnt lgkmcnt(0)\n\ts_barrier":::"memory");
  #undef DMA_K
  #undef QX
  #undef RNEHI
  #undef SETQX
  #undef DMA_V
  #undef CMASK
  #undef START
  #undef RESC
  #undef ROT
}
constexpr int ATTN_LDS_BYTES=LDS_BYTES;
struct AttnTensors { const bf16* Q; const bf16* K; const bf16* V; bf16* O; const float* CUM; const unsigned* QKN; };
struct AttnUnit { int bh; int qb; };
struct StaticOrder {
  int c,G;
  __device__ __forceinline__ StaticOrder(int grid,int block):c(block),G(grid){}
  __device__ __forceinline__ bool next(int i,AttnUnit&u)const{ const int it=i*G+c; if(it>=BATCH*NHEAD*NQB)return false; u.bh=it%(BATCH*NHEAD); u.qb=NQB-1-it/(BATCH*NHEAD); return true; }
};
template<int THRL=8> __device__ __forceinline__ void attn_phase_queue(char*lds,const AttnTensors&T,unsigned*head,volatile __attribute__((address_space(3))) unsigned*slot,const int wv){
  for(;;){
    if(wv==0){ int l=(int)__builtin_amdgcn_mbcnt_hi(~0u,__builtin_amdgcn_mbcnt_lo(~0u,0u)); asm volatile("":"+v"(l)); if(l==0) *slot=__hip_atomic_fetch_add(head,1u,__ATOMIC_RELAXED,__HIP_MEMORY_SCOPE_AGENT); }
    asm volatile("s_waitcnt vmcnt(0) lgkmcnt(0)\n\ts_barrier":::"memory");
    const unsigned it=*slot;
    asm volatile("s_waitcnt lgkmcnt(0)\n\ts_barrier":::"memory");
    if(it>=(unsigned)(BATCH*NHEAD*NQB))break;
    const int bh=(int)(it%(unsigned)(BATCH*NHEAD)),qb=NQB-1-(int)(it/(unsigned)(BATCH*NHEAD));
    const unsigned*n4=T.QKN+bh*4; const float qkb=1.03f*sqrtf(__builtin_bit_cast(float,n4[0])+__builtin_bit_cast(float,n4[1]))*sqrtf(__builtin_bit_cast(float,n4[2])+__builtin_bit_cast(float,n4[3]))+1.0f;
    attn_unit<THRL>(bh/NHEAD,bh%NHEAD,qb,T.Q,T.K,T.V,T.O,T.CUM+(size_t)bh*SEQ,lds,wv,qkb);
  }
}
template<class Sched,int THRL=8> __device__ __forceinline__ void attn_phase(char*lds,const AttnTensors&T,const Sched&S,const int wv){
  AttnUnit u;
  for(int i=0;S.next(i,u);++i){ const unsigned*n4=T.QKN+u.bh*4; const float qkb=1.03f*sqrtf(__builtin_bit_cast(float,n4[0])+__builtin_bit_cast(float,n4[1]))*sqrtf(__builtin_bit_cast(float,n4[2])+__builtin_bit_cast(float,n4[3]))+1.0f;
    attn_unit<THRL>(u.bh/NHEAD,u.bh%NHEAD,u.qb,T.Q,T.K,T.V,T.O,T.CUM+(size_t)u.bh*SEQ,lds,wv,qkb); }
}
#undef SBAR
#undef WAIT_BAR
}

namespace mls {
typedef short bf16x8 __attribute__((ext_vector_type(8)));
typedef float f32x4v __attribute__((ext_vector_type(4)));
typedef unsigned u32x2v __attribute__((ext_vector_type(2)));
typedef unsigned u32x4v __attribute__((ext_vector_type(4)));
constexpr int QS = 136, TS = 72;
constexpr int L_Q = 0, L_K = 17408, L_KT = 34816, L_VT = 53248, L_WVT = 73984, L_SC = 94720, L_END = 103936;
constexpr float QK_SCALE = 0.08838834764831845f;
constexpr size_t G_A = 2 * MiB, G_RT = 3 * MiB, G_IT = 4 * MiB, G_EM = 5 * MiB, G_WK = 6 * MiB, G_CD = 7 * MiB, G_DL = 8 * MiB, G_UN = 9 * MiB, G_HALO = 11 * MiB;
__device__ __forceinline__ float scan_add(float v, int lane) {
#pragma unroll
    for (int o = 1; o < 64; o <<= 1) { const float t = bperm(v, (lane - o) & 63); if (lane >= o) v += t; }
    return v; }
__device__ __forceinline__ float scan_max(float v, int lane) {
#pragma unroll
    for (int o = 1; o < 64; o <<= 1) { const float t = bperm(v, (lane - o) & 63); if (lane >= o) v = fmaxf(v, t); }
    return v; }
__device__ __forceinline__ float lo_bf(unsigned w) { return __builtin_bit_cast(float, w << 16); }
__device__ __forceinline__ float hi_bf(unsigned w) { return __builtin_bit_cast(float, w & 0xffff0000u); }
typedef float f32x2_t __attribute__((ext_vector_type(2))); typedef __bf16 bf16x2_t __attribute__((ext_vector_type(2)));
__device__ __forceinline__ unsigned cvtpk(float lo, float hi) { f32x2_t v = {lo, hi}; bf16x2_t b = __builtin_convertvector(v, bf16x2_t); return __builtin_bit_cast(unsigned, b); }
__device__ __forceinline__ float fsilu(float v) { return v * __builtin_amdgcn_rcpf(1.f + __builtin_amdgcn_exp2f(-1.4426950408889634f * v)); }
}
__device__ __forceinline__ void phase_mgates(Frame& F, const float* SG) {
    using namespace mls;
    const int ptid = opaque_tid(F.wave), plane = ptid & 63, pwave = __builtin_amdgcn_readfirstlane(ptid >> 6);
    const int gw = blockIdx.x * NWAVES + pwave, NGW = F.G * NWAVES;
    float* GA = (float*)(F.ws + G_A); float* GPM = (float*)(F.ws + G_RT); float* GB = (float*)(F.ws + G_IT); float* GP63 = (float*)(F.ws + G_WK); float* GG = GP63 + BATCH * MLH * 32;
    for (int task = gw; task < BATCH * MLH * 32; task += NGW) {
        const int bh = task >> 5, c = task & 31, b = bh >> 2, h = bh & 3;
        const size_t row = (size_t)b * SEQ + 64 * c + plane;
        const float ig = SG[row * 16 + 8 + h], lf = SG[row * 16 + 12 + h];
        const float bcum = scan_add(lf, plane), aval = ig - bcum, pm = scan_max(aval, plane);
        const size_t idx = (size_t)bh * SEQ + 64 * c + plane;
        GA[idx] = aval; GPM[idx] = pm; GB[idx] = bcum;
        if (plane == 63) { GP63[task] = pm; GG[task] = bcum; }
    }
}
__device__ __forceinline__ void phase_mprep(Frame& F, const bf16* PA, const float* convw, const float* convb, bf16* SCR) {
    using namespace mls;
    const int tid = opaque_tid(F.wave), lane = tid & 63, wid = __builtin_amdgcn_readfirstlane(tid >> 6), l15 = lane & 15, q4 = lane >> 4;
    LAS unsigned char* L = F.lds;
    const float* GA = (const float*)(F.ws + G_A); const float* GPM = (const float*)(F.ws + G_RT); const float* GB = (const float*)(F.ws + G_IT); const float* GP63 = (const float*)(F.ws + G_WK); const float* GG = GP63 + BATCH * MLH * 32;
    float* GEM = (float*)(F.ws + G_EM); float* GCD = (float*)(F.ws + G_CD);
    float* DL = (float*)(F.ws + G_DL); float* UN = (float*)(F.ws + G_UN);
    const int ch2 = tid & 127, tq = __builtin_amdgcn_readfirstlane(tid >> 7); const bool isk = (wid & 1) != 0;
    const int cc = (ch2 & 63) * 2;
    const int e2 = tid & 63, sg = __builtin_amdgcn_readfirstlane(tid >> 6);
    const __amdgpu_buffer_rsrc_t rsP = __builtin_amdgcn_make_buffer_rsrc((void*)PA, 0, M * PJA * 2, 0x00020000), rsS = __builtin_amdgcn_make_buffer_rsrc((void*)SCR, 0, M * D * 4, 0x00020000);
    constexpr int S_QI = 0, S_UT = M * 512 * 2, S_NL = M * 1536 * 2;
    __syncthreads();
    for (int i = tid; i < 16 * TS / 2; i += NTHR) { ((LAS unsigned*)(L + L_VT + 128 * TS * 2))[i] = (i < TS / 2) ? 0x3F803F80u : 0u; ((LAS unsigned*)(L + L_WVT + 128 * TS * 2))[i] = 0u; }
    unsigned raw[19], vraw[8]; float g_pm, g_b, g_a, g_p63, g_g;
#define MP_BAR() asm volatile("s_waitcnt lgkmcnt(0)\n\ts_barrier" ::: "memory")
#define MP_LOAD(item) do { const int bh_ = (item) >> 5, c_ = (item) & 31, b_ = bh_ >> 2, h_ = bh_ & 3; const int r0_ = b_ * SEQ + 64 * c_; \
        const unsigned lo_raw_ = (unsigned)((isk ? PC_MK : PC_MQ) + h_ * 128 + cc) * 2u, lo_v_ = (unsigned)(PC_MV + h_ * 128 + 2 * e2) * 2u; \
        _Pragma("unroll") for (int i_ = 0; i_ < 19; ++i_) { const int tr_ = 16 * tq - 3 + i_; raw[i_] = (64 * c_ + tr_ >= 0) ? __builtin_amdgcn_raw_buffer_load_b32(rsP, lo_raw_, (r0_ + tr_) * (PJA * 2), 0) : 0u; } \
        _Pragma("unroll") for (int i_ = 0; i_ < 8; ++i_) vraw[i_] = __builtin_amdgcn_raw_buffer_load_b32(rsP, lo_v_, (r0_ + 8 * sg + i_) * (PJA * 2), 0); \
        const size_t gi_ = (size_t)bh_ * SEQ + 64 * c_ + lane; g_pm = GPM[gi_]; g_b = GB[gi_]; g_a = GA[gi_]; g_p63 = GP63[bh_ * 32 + (lane & 31)]; g_g = GG[bh_ * 32 + (lane & 31)]; } while (0)
    int it = blockIdx.x;
    if (it < BATCH * MLH * 32) MP_LOAD(it);
    for (; it < BATCH * MLH * 32; it += F.G) {
        const int bh = it >> 5, c = it & 31, b = bh >> 2, h = bh & 3; const int row0 = b * SEQ + 64 * c;
        const int cch = (isk ? 512 : 0) + h * 128 + cc;
        float w0[2], w1[2], w2[2], w3[2], cb[2];
#pragma unroll
        for (int i = 0; i < 2; ++i) { w0[i] = convw[cch + i]; w1[i] = convw[1024 + cch + i]; w2[i] = convw[2048 + cch + i]; w3[i] = convw[3072 + cch + i]; cb[i] = convb[cch + i]; }
        float mcar = 0.f;
        for (int cp = 0; cp < c; ++cp) mcar = rdl(g_g, cp) + fmaxf(mcar, rdl(g_p63, cp));
        const float Mx = fmaxf(mcar, rdl(g_p63, c)), mrow = fmaxf(g_pm, mcar);
        const float rowterm = -mrow, inter = __expf(mcar - mrow), aval = g_a, wk = __expf(g_a - Mx);
        if (wid == 0) { GEM[(size_t)bh * SEQ + 64 * c + lane] = __expf(-(g_b + mrow)); if (lane == 0) GCD[bh * 32 + c] = __expf(mcar - Mx); }
        {
            unsigned kt0[8], kt1[8];
#pragma unroll
            for (int i = 0; i < 16; i += 2) {
                float y[2][2];
#pragma unroll
                for (int u = 0; u < 2; ++u) {
                    const float a0 = w0[0] * lo_bf(raw[i + u]) + w1[0] * lo_bf(raw[i + u + 1]) + w2[0] * lo_bf(raw[i + u + 2]) + w3[0] * lo_bf(raw[i + u + 3]) + cb[0];
                    const float a1 = w0[1] * hi_bf(raw[i + u]) + w1[1] * hi_bf(raw[i + u + 1]) + w2[1] * hi_bf(raw[i + u + 2]) + w3[1] * hi_bf(raw[i + u + 3]) + cb[1];
                    y[u][0] = fsilu(a0); y[u][1] = fsilu(a1);
                    const int t = 16 * tq + i + u;
                    if (!isk) { const float q0 = y[u][0] * QK_SCALE, q1 = y[u][1] * QK_SCALE; const float itv = rdl(inter, t);
                        *(LAS unsigned*)(L + L_Q + (t * QS + cc) * 2) = cvtpk(q0, q1);
                        __builtin_amdgcn_raw_buffer_store_b32(cvtpk(q0 * itv, q1 * itv), rsS, (unsigned)((cc >> 5) * 1024 + ((cc >> 3) & 3) * 256 + (cc & 7) * 2), S_QI + (it * 4 + (t >> 4)) * 4096 + (t & 15) * 16, 0); }
                    else *(LAS unsigned*)(L + L_K + (t * QS + cc) * 2) = cvtpk(y[u][0], y[u][1]);
                }
                kt0[i >> 1] = cvtpk(y[0][0], y[1][0]); kt1[i >> 1] = cvtpk(y[0][1], y[1][1]);
            }
            if (isk) {
                *(LAS u32x4v*)(L + L_KT + (cc * TS + 16 * tq) * 2) = (u32x4v){kt0[0], kt0[1], kt0[2], kt0[3]}; *(LAS u32x4v*)(L + L_KT + (cc * TS + 16 * tq + 8) * 2) = (u32x4v){kt0[4], kt0[5], kt0[6], kt0[7]};
                *(LAS u32x4v*)(L + L_KT + ((cc + 1) * TS + 16 * tq) * 2) = (u32x4v){kt1[0], kt1[1], kt1[2], kt1[3]}; *(LAS u32x4v*)(L + L_KT + ((cc + 1) * TS + 16 * tq + 8) * 2) = (u32x4v){kt1[4], kt1[5], kt1[6], kt1[7]};
            }
            float v0[8], v1[8], wv[8];
#pragma unroll
            for (int i = 0; i < 8; ++i) { v0[i] = lo_bf(vraw[i]); v1[i] = hi_bf(vraw[i]); wv[i] = rdl(wk, 8 * sg + i); }
            *(LAS u32x4v*)(L + L_VT + ((2 * e2) * TS + 8 * sg) * 2) = (u32x4v){cvtpk(v0[0], v0[1]), cvtpk(v0[2], v0[3]), cvtpk(v0[4], v0[5]), cvtpk(v0[6], v0[7])};
            *(LAS u32x4v*)(L + L_VT + ((2 * e2 + 1) * TS + 8 * sg) * 2) = (u32x4v){cvtpk(v1[0], v1[1]), cvtpk(v1[2], v1[3]), cvtpk(v1[4], v1[5]), cvtpk(v1[6], v1[7])};
            *(LAS u32x4v*)(L + L_WVT + ((2 * e2) * TS + 8 * sg) * 2) = (u32x4v){cvtpk(v0[0] * wv[0], v0[1] * wv[1]), cvtpk(v0[2] * wv[2], v0[3] * wv[3]), cvtpk(v0[4] * wv[4], v0[5] * wv[5]), cvtpk(v0[6] * wv[6], v0[7] * wv[7])};
            *(LAS u32x4v*)(L + L_WVT + ((2 * e2 + 1) * TS + 8 * sg) * 2) = (u32x4v){cvtpk(v1[0] * wv[0], v1[1] * wv[1]), cvtpk(v1[2] * wv[2], v1[3] * wv[3]), cvtpk(v1[4] * wv[4], v1[5] * wv[5]), cvtpk(v1[6] * wv[6], v1[7] * wv[7])};
            if (wid == 0) *(LAS unsigned short*)(L + L_WVT + (128 * TS + lane) * 2) = (unsigned short)f2bf(wk);
        }
        if (it + F.G < BATCH * MLH * 32) MP_LOAD(it + F.G);
        MP_BAR();
        {
            const int tt = wid >> 1;
#pragma unroll
            for (int si = 0; si < 2; ++si) {
                const int ss = 2 * (wid & 1) + si;
                f32x4v acc = (f32x4v){0.f, 0.f, 0.f, 0.f};
                if (ss <= tt) {
#pragma unroll
                    for (int kd = 0; kd < 4; ++kd) {
                        const bf16x8 a = *(const LAS bf16x8*)(L + L_Q + ((16 * tt + l15) * QS + 32 * kd + 8 * q4) * 2);
                        const bf16x8 bb = *(const LAS bf16x8*)(L + L_K + ((16 * ss + l15) * QS + 32 * kd + 8 * q4) * 2);
                        acc = __builtin_amdgcn_mfma_f32_16x16x32_bf16(a, bb, acc, 0, 0, 0);
                    }
                }
                const int s = 16 * ss + l15; const float as_ = bperm(aval, s);
#pragma unroll
                for (int j = 0; j < 4; ++j) { const int t = 16 * tt + 4 * q4 + j; const float rt = bperm(rowterm, t);
                    const float dv = (s <= t) ? acc[j] * __expf(rt + as_) : 0.f;
                    *(LAS unsigned short*)(L + L_SC + (t * TS + s) * 2) = (unsigned short)f2bf(dv); }
            }
        }
        {
            const int db = wid;
#pragma unroll
            for (int eg = 0; eg < 9; ++eg) {
                f32x4v acc = (f32x4v){0.f, 0.f, 0.f, 0.f};
#pragma unroll
                for (int ks = 0; ks < 2; ++ks) {
                    const bf16x8 a = *(const LAS bf16x8*)(L + L_KT + ((16 * db + l15) * TS + 32 * ks + 8 * q4) * 2);
                    const bf16x8 bb = *(const LAS bf16x8*)(L + L_WVT + ((16 * eg + l15) * TS + 32 * ks + 8 * q4) * 2);
                    acc = __builtin_amdgcn_mfma_f32_16x16x32_bf16(a, bb, acc, 0, 0, 0);
                }
                if (eg < 8) { const int e = 16 * eg + l15;
                    __builtin_amdgcn_raw_buffer_store_b64((u32x2v){cvtpk(acc[0], acc[1]), cvtpk(acc[2], acc[3])}, rsS, (unsigned)((((q4 >> 1) * 16 + l15) * 16) + 8 * (q4 & 1)), S_UT + ((it * 8 + eg) * 4 + (db >> 1)) * 1024 + ((2 * db) & 3) * 256, 0); (void)e; }
                else if (l15 == 0) *(u32x2v*)((char*)UN + ((size_t)(it * 4 + (db >> 1)) * 4 + (((2 * db) & 3) + (q4 >> 1))) * 16 + 8 * (q4 & 1)) = (u32x2v){cvtpk(acc[0], acc[1]), cvtpk(acc[2], acc[3])};
            }
        }
        MP_BAR();
        for (int p = wid; p < 36; p += NWAVES) {
            const int tt = p & 3, eg = p >> 2;
            f32x4v acc = (f32x4v){0.f, 0.f, 0.f, 0.f};
#pragma unroll
            for (int ks = 0; ks < 2; ++ks) {
                const bf16x8 a = *(const LAS bf16x8*)(L + L_VT + ((16 * eg + l15) * TS + 32 * ks + 8 * q4) * 2);
                const bf16x8 bb = *(const LAS bf16x8*)(L + L_SC + ((16 * tt + l15) * TS + 32 * ks + 8 * q4) * 2);
                acc = __builtin_amdgcn_mfma_f32_16x16x32_bf16(a, bb, acc, 0, 0, 0);
            }
            if (eg < 8) __builtin_amdgcn_raw_buffer_store_b64((u32x2v){cvtpk(acc[0], acc[1]), cvtpk(acc[2], acc[3])}, rsS, (unsigned)lane * 8u, S_NL + ((it * 8 + eg) * 4 + tt) * 512, 0);
            else if (q4 == 0) DL[(size_t)(row0 + 16 * tt + l15) * 4 + h] = acc[0];
        }
        MP_BAR();
    }
#undef MP_LOAD
#undef MP_BAR
}
__device__ __forceinline__ void phase_mchain(Frame& F, const bf16* SCR, const bf16* PB, bf16* AO) {
    using namespace mls;
    const int tid = opaque_tid(F.wave), lane = tid & 63, wid = __builtin_amdgcn_readfirstlane(tid >> 6), l15 = lane & 15, q4 = lane >> 4;
    const float* GEM = (const float*)(F.ws + G_EM); const float* GCD = (const float*)(F.ws + G_CD); const float* DL = (const float*)(F.ws + G_DL); const float* UN = (const float*)(F.ws + G_UN);
    constexpr int S_QI = 0, S_UT = M * 512 * 2, S_NL = M * 1536 * 2;
    const __amdgpu_buffer_rsrc_t rsP = __builtin_amdgcn_make_buffer_rsrc((void*)SCR, 0, M * D * 4, 0x00020000), rsB = __builtin_amdgcn_make_buffer_rsrc((void*)PB, 0, M * PJB * 2, 0x00020000),
                                 rsO = __builtin_amdgcn_make_buffer_rsrc((void*)AO, 0, M * D * 2, 0x00020000), rsE = __builtin_amdgcn_make_buffer_rsrc((void*)GEM, 0, BATCH * MLH * SEQ * 4, 0x00020000),
                                 rsD = __builtin_amdgcn_make_buffer_rsrc((void*)DL, 0, M * 16, 0x00020000), rsU = __builtin_amdgcn_make_buffer_rsrc((void*)UN, 0, BATCH * MLH * 32 * 128 * 2, 0x00020000);
    const unsigned lo_o = (unsigned)(l15 * D + 4 * q4) * 2u, lo_m = (unsigned)(l15 * PJB + 4 * q4) * 2u, lo_d = (unsigned)l15 * 16u, lo_e = (unsigned)l15 * 4u;
    const int th = wid >> 2;
    for (int id = blockIdx.x * 4 + (wid & 3); id < BATCH * MLH * 8; id += F.G * 4) {
        const int bh = id >> 3, eg = id & 7, b = bh >> 2, h = bh & 3;
        const int r00 = b * SEQ;
        float Cst[4][8], nst[4][8];
#pragma unroll
        for (int kd = 0; kd < 4; ++kd)
#pragma unroll
            for (int j = 0; j < 8; ++j) { Cst[kd][j] = 0.f; nst[kd][j] = 0.f; }
        u32x4v qfA[2][4], qfB[2][4], ut[4], un[4]; u32x2v nlA[2], moA[2], nlB[2], moB[2]; float dlA[2], emA[2], dlB[2], emB[2], cd;
#define MC_LOADQ(c, qf) do { const int it_ = bh * 32 + (c); \
            _Pragma("unroll") for (int t2_ = 0; t2_ < 2; ++t2_) \
                _Pragma("unroll") for (int kd_ = 0; kd_ < 4; ++kd_) qf[t2_][kd_] = __builtin_amdgcn_raw_buffer_load_b128(rsP, (unsigned)lane * 16u, S_QI + ((it_ * 4 + 2 * th + t2_) * 4 + kd_) * 1024, 0); } while (0)
#define MC_LOADS(c, nl, mo, dl, em) do { const int r0_ = r00 + 64 * (c), it_ = bh * 32 + (c); \
            _Pragma("unroll") for (int t2_ = 0; t2_ < 2; ++t2_) { const int rt_ = r0_ + 16 * (2 * th + t2_); \
                nl[t2_] = __builtin_amdgcn_raw_buffer_load_b64(rsP, (unsigned)lane * 8u, S_NL + ((it_ * 8 + eg) * 4 + 2 * th + t2_) * 512, 0); mo[t2_] = __builtin_amdgcn_raw_buffer_load_b64(rsB, lo_m, (rt_ * PJB + PB_MO + h * 128 + 16 * eg) * 2, 0); \
                dl[t2_] = __builtin_bit_cast(float, __builtin_amdgcn_raw_buffer_load_b32(rsD, lo_d, (rt_ * 4 + h) * 4, 0)); em[t2_] = __builtin_bit_cast(float, __builtin_amdgcn_raw_buffer_load_b32(rsE, lo_e, (bh * SEQ + 64 * (c) + 16 * (2 * th + t2_)) * 4, 0)); } } while (0)
#define MC_LOADU(c) do { const int it_ = bh * 32 + (c); \
            _Pragma("unroll") for (int kd_ = 0; kd_ < 4; ++kd_) { ut[kd_] = __builtin_amdgcn_raw_buffer_load_b128(rsP, (unsigned)lane * 16u, S_UT + ((it_ * 8 + eg) * 4 + kd_) * 1024, 0); \
                un[kd_] = __builtin_amdgcn_raw_buffer_load_b128(rsU, (unsigned)q4 * 16u, (it_ * 4 + kd_) * 64, 0); } \
            cd = GCD[it_]; } while (0)
#define MC_STEP(c, qf, nl, mo, dl, em, qfN, nlN, moN, dlN, emN) do { const int r0_ = r00 + 64 * (c); \
            if ((c) + 1 < SEQ / 64) { MC_LOADQ((c) + 1, qfN); MC_LOADS((c) + 1, nlN, moN, dlN, emN); } \
            f32x4v acc_[2], accd_[2]; \
            _Pragma("unroll") for (int t2_ = 0; t2_ < 2; ++t2_) { acc_[t2_] = (f32x4v){lo_bf(nl[t2_].x), hi_bf(nl[t2_].x), lo_bf(nl[t2_].y), hi_bf(nl[t2_].y)}; accd_[t2_] = (f32x4v){q4 == 0 ? dl[t2_] : 0.f, 0.f, 0.f, 0.f}; } \
            _Pragma("unroll") for (int kd_ = 0; kd_ < 4; ++kd_) { \
                const bf16x8 af_ = __builtin_bit_cast(bf16x8, (u32x4v){cvtpk(Cst[kd_][0], Cst[kd_][1]), cvtpk(Cst[kd_][2], Cst[kd_][3]), cvtpk(Cst[kd_][4], Cst[kd_][5]), cvtpk(Cst[kd_][6], Cst[kd_][7])}); \
                const bf16x8 nf_ = __builtin_bit_cast(bf16x8, (u32x4v){cvtpk(nst[kd_][0], nst[kd_][1]), cvtpk(nst[kd_][2], nst[kd_][3]), cvtpk(nst[kd_][4], nst[kd_][5]), cvtpk(nst[kd_][6], nst[kd_][7])}); \
                _Pragma("unroll") for (int t2_ = 0; t2_ < 2; ++t2_) { acc_[t2_] = __builtin_amdgcn_mfma_f32_16x16x32_bf16(af_, __builtin_bit_cast(bf16x8, qf[t2_][kd_]), acc_[t2_], 0, 0, 0); \
                    accd_[t2_] = __builtin_amdgcn_mfma_f32_16x16x32_bf16(nf_, __builtin_bit_cast(bf16x8, qf[t2_][kd_]), accd_[t2_], 0, 0, 0); } } \
            _Pragma("unroll") for (int t2_ = 0; t2_ < 2; ++t2_) { \
                const float den_ = bperm(accd_[t2_][0], l15); const float rd_ = 1.0f / fmaxf(fabsf(den_), em[t2_]); \
                const float o0_ = acc_[t2_][0] * rd_ * lo_bf(mo[t2_].x), o1_ = acc_[t2_][1] * rd_ * hi_bf(mo[t2_].x), o2_ = acc_[t2_][2] * rd_ * lo_bf(mo[t2_].y), o3_ = acc_[t2_][3] * rd_ * hi_bf(mo[t2_].y); \
                __builtin_amdgcn_raw_buffer_store_b64((u32x2v){cvtpk(o0_, o1_), cvtpk(o2_, o3_)}, rsO, lo_o, ((r0_ + 16 * (2 * th + t2_)) * D + 512 + h * 128 + 16 * eg) * 2, 0); } \
            _Pragma("unroll") for (int kd_ = 0; kd_ < 4; ++kd_) { const unsigned uw_[4] = {ut[kd_].x, ut[kd_].y, ut[kd_].z, ut[kd_].w}; const unsigned nw_[4] = {un[kd_].x, un[kd_].y, un[kd_].z, un[kd_].w}; \
                _Pragma("unroll") for (int j_ = 0; j_ < 4; ++j_) { Cst[kd_][2 * j_] = cd * Cst[kd_][2 * j_] + lo_bf(uw_[j_]); Cst[kd_][2 * j_ + 1] = cd * Cst[kd_][2 * j_ + 1] + hi_bf(uw_[j_]); \
                    nst[kd_][2 * j_] = (l15 == 0) ? cd * nst[kd_][2 * j_] + lo_bf(nw_[j_]) : 0.f; nst[kd_][2 * j_ + 1] = (l15 == 0) ? cd * nst[kd_][2 * j_ + 1] + hi_bf(nw_[j_]) : 0.f; } } \
            if ((c) + 1 < SEQ / 64) MC_LOADU((c) + 1); } while (0)
        MC_LOADQ(0, qfA); MC_LOADS(0, nlA, moA, dlA, emA); MC_LOADU(0);
        for (int c = 0; c < SEQ / 64; c += 2) {
            MC_STEP(c, qfA, nlA, moA, dlA, emA, qfB, nlB, moB, dlB, emB);
            MC_STEP(c + 1, qfB, nlB, moB, dlB, emB, qfA, nlA, moA, dlA, emA);
        }
#undef MC_LOADQ
#undef MC_LOADS
#undef MC_LOADU
#undef MC_STEP
    }
}

__device__ __forceinline__ void phase_mlstm_fused(Frame& F, const bf16* P, const bf16* PBg, const float* SG, const float* convw, const float* convb, bf16* AO) {
    using namespace mls;
    constexpr int L_Q = 0, L_QI = 17408, L_K = 34816, L_KT = 52224, L_VT = 70656, L_WVT = 82176, L_SC = 93696, L_CT = 102912, L_DEN = 124672;
    const float* GA = (const float*)(F.ws + G_A); const float* GPM = (const float*)(F.ws + G_RT); const float* GB = (const float*)(F.ws + G_IT); const float* GP63 = (const float*)(F.ws + G_WK); const float* GG = GP63 + BATCH * MLH * 32;
#define ML_BAR() asm volatile("s_waitcnt lgkmcnt(0)\n\ts_barrier" ::: "memory")
    const int tid = opaque_tid(F.wave), lane = tid & 63, wid = __builtin_amdgcn_readfirstlane(tid >> 6), l15 = lane & 15, q4 = lane >> 4;
    LAS unsigned char* L = F.lds;
    for (int it = blockIdx.x; it < BATCH * MLH * 2; it += F.G) {
        const int vh = it & 1, bh = it >> 1, b = bh / MLH, h = bh % MLH;
        const size_t row00 = (size_t)b * SEQ;
        const int ch2 = tid & 127, tq = __builtin_amdgcn_readfirstlane(tid >> 7); const bool isk = (wid & 1) != 0;
        const int cc = (ch2 & 63) * 2;
        const int pcol = (isk ? PC_MK : PC_MQ) + h * 128 + cc, cch = (isk ? 512 : 0) + h * 128 + cc;
        float w0[2], w1[2], w2[2], w3[2], cb[2];
#pragma unroll
        for (int i = 0; i < 2; ++i) { w0[i] = convw[cch + i]; w1[i] = convw[1024 + cch + i]; w2[i] = convw[2048 + cch + i]; w3[i] = convw[3072 + cch + i]; cb[i] = convb[cch + i]; }
        const int e2 = tid & 31, sg = tid >> 5;
        const int vcol = PC_MV + h * 128 + vh * 64 + 2 * e2;
        f32x4v Cacc[8];
#pragma unroll
        for (int i = 0; i < 8; ++i) Cacc[i] = (f32x4v){0.f, 0.f, 0.f, 0.f};
        float mcar = 0.f;
        __syncthreads();
        for (int i = tid; i < 80 * QS / 2; i += NTHR) ((LAS unsigned*)(L + L_CT))[i] = 0u;
        for (int i = tid; i < 16 * TS / 2; i += NTHR) { ((LAS unsigned*)(L + L_VT + 64 * TS * 2))[i] = (i < TS / 2) ? 0x3F803F80u : 0u; ((LAS unsigned*)(L + L_WVT + 64 * TS * 2))[i] = 0u; }
        unsigned raw[19], vraw[4]; float g_a, g_pm, g_b, g_p63, g_g;
        const unsigned lo_raw = (unsigned)pcol * 2u, lo_v = (unsigned)((4 * sg) * PJA + vcol) * 2u, lo_o = (unsigned)((4 * q4) * PJB + l15) * 2u, lo_ao = (unsigned)((4 * q4) * D + l15) * 2u;
        const __amdgpu_buffer_rsrc_t rsP = __builtin_amdgcn_make_buffer_rsrc((void*)P, 0, M * PJA * 2, 0x00020000), rsB = __builtin_amdgcn_make_buffer_rsrc((void*)PBg, 0, M * PJB * 2, 0x00020000),
                                     rsO = __builtin_amdgcn_make_buffer_rsrc((void*)AO, 0, M * D * 2, 0x00020000);
        const int r00 = (int)row00;
#define MLS_LOAD(c) do { _Pragma("unroll") for (int i_ = 0; i_ < 19; ++i_) { const int tr_ = 64 * (c) + 16 * tq - 3 + i_; raw[i_] = (tr_ >= 0) ? __builtin_amdgcn_raw_buffer_load_b32(rsP, lo_raw, (r00 + tr_) * (PJA * 2), 0) : 0u; } \
        _Pragma("unroll") for (int i_ = 0; i_ < 4; ++i_) vraw[i_] = __builtin_amdgcn_raw_buffer_load_b32(rsP, lo_v, (r00 + 64 * (c) + i_) * (PJA * 2), 0); \
        { const size_t gi_ = (size_t)bh * SEQ + 64 * (c) + lane; g_a = GA[gi_]; g_pm = GPM[gi_]; g_b = GB[gi_]; g_p63 = GP63[bh * 32 + (c)]; g_g = GG[bh * 32 + (c)]; } } while (0)
        MLS_LOAD(0);
        for (int c = 0; c < SEQ / 64; ++c) {
            const size_t row0 = row00 + 64 * c;
            const float bcum = g_b, aval = g_a, pm = g_pm, pm63 = g_p63, gsum = g_g;
            const float Mx = fmaxf(mcar, pm63), mrow = fmaxf(pm, mcar);
            const float rowterm = -mrow, inter = __expf(mcar - mrow), emt = __expf(-(bcum + mrow)), wk = __expf(aval - Mx), cdec = __expf(mcar - Mx);
            mcar = gsum + Mx;
            {
                unsigned kt0[8], kt1[8];
#pragma unroll
                for (int i = 0; i < 16; i += 2) {
                    float y[2][2];
#pragma unroll
                    for (int u = 0; u < 2; ++u) {
                        float a0 = w0[0] * lo_bf(raw[i + u]) + w1[0] * lo_bf(raw[i + u + 1]) + w2[0] * lo_bf(raw[i + u + 2]) + w3[0] * lo_bf(raw[i + u + 3]) + cb[0];
                        float a1 = w0[1] * hi_bf(raw[i + u]) + w1[1] * hi_bf(raw[i + u + 1]) + w2[1] * hi_bf(raw[i + u + 2]) + w3[1] * hi_bf(raw[i + u + 3]) + cb[1];
                        y[u][0] = fsilu(a0); y[u][1] = fsilu(a1);
                        const int t = 16 * tq + i + u;
                        if (!isk) { const float q0 = y[u][0] * QK_SCALE, q1 = y[u][1] * QK_SCALE; const float itv = rdl(inter, t);
                            *(LAS unsigned*)(L + L_Q + (t * QS + cc) * 2) = cvtpk(q0, q1); *(LAS unsigned*)(L + L_QI + (t * QS + cc) * 2) = cvtpk(q0 * itv, q1 * itv); }
                        else *(LAS unsigned*)(L + L_K + (t * QS + cc) * 2) = cvtpk(y[u][0], y[u][1]);
                    }
                    kt0[i >> 1] = cvtpk(y[0][0], y[1][0]); kt1[i >> 1] = cvtpk(y[0][1], y[1][1]);
                }
                if (isk) {
                    *(LAS u32x4v*)(L + L_KT + (cc * TS + 16 * tq) * 2) = (u32x4v){kt0[0], kt0[1], kt0[2], kt0[3]}; *(LAS u32x4v*)(L + L_KT + (cc * TS + 16 * tq + 8) * 2) = (u32x4v){kt0[4], kt0[5], kt0[6], kt0[7]};
                    *(LAS u32x4v*)(L + L_KT + ((cc + 1) * TS + 16 * tq) * 2) = (u32x4v){kt1[0], kt1[1], kt1[2], kt1[3]}; *(LAS u32x4v*)(L + L_KT + ((cc + 1) * TS + 16 * tq + 8) * 2) = (u32x4v){kt1[4], kt1[5], kt1[6], kt1[7]};
                }
            }
            {
                float v0[4], v1[4], wv[4];
#pragma unroll
                for (int i = 0; i < 4; ++i) { v0[i] = lo_bf(vraw[i]); v1[i] = hi_bf(vraw[i]); wv[i] = bperm(wk, 4 * sg + i); }
                *(LAS u32x2v*)(L + L_VT + ((2 * e2) * TS + 4 * sg) * 2) = (u32x2v){cvtpk(v0[0], v0[1]), cvtpk(v0[2], v0[3])};
                *(LAS u32x2v*)(L + L_VT + ((2 * e2 + 1) * TS + 4 * sg) * 2) = (u32x2v){cvtpk(v1[0], v1[1]), cvtpk(v1[2], v1[3])};
                *(LAS u32x2v*)(L + L_WVT + ((2 * e2) * TS + 4 * sg) * 2) = (u32x2v){cvtpk(v0[0] * wv[0], v0[1] * wv[1]), cvtpk(v0[2] * wv[2], v0[3] * wv[3])};
                *(LAS u32x2v*)(L + L_WVT + ((2 * e2 + 1) * TS + 4 * sg) * 2) = (u32x2v){cvtpk(v1[0] * wv[0], v1[1] * wv[1]), cvtpk(v1[2] * wv[2], v1[3] * wv[3])};
                if (wid == 0) *(LAS unsigned short*)(L + L_WVT + (64 * TS + lane) * 2) = (unsigned short)f2bf(wk);
            }
            if (c + 1 < SEQ / 64) MLS_LOAD(c + 1);
            ML_BAR();
            {
                const int tt = wid >> 1;
#pragma unroll
                for (int si = 0; si < 2; ++si) {
                    const int ss = 2 * (wid & 1) + si;
                    f32x4v acc = (f32x4v){0.f, 0.f, 0.f, 0.f};
                    if (ss <= tt) {
#pragma unroll
                        for (int kd = 0; kd < 4; ++kd) {
                            const bf16x8 a = *(const LAS bf16x8*)(L + L_Q + ((16 * tt + l15) * QS + 32 * kd + 8 * q4) * 2);
                            const bf16x8 bb = *(const LAS bf16x8*)(L + L_K + ((16 * ss + l15) * QS + 32 * kd + 8 * q4) * 2);
                            acc = __builtin_amdgcn_mfma_f32_16x16x32_bf16(a, bb, acc, 0, 0, 0);
                        }
                    }
                    const int s = 16 * ss + l15; const float as_ = bperm(aval, s);
#pragma unroll
                    for (int j = 0; j < 4; ++j) { const int t = 16 * tt + 4 * q4 + j; const float rt = bperm(rowterm, t);
                        const float dv = (s <= t) ? acc[j] * __expf(rt + as_) : 0.f;
                        *(LAS unsigned short*)(L + L_SC + (t * TS + s) * 2) = (unsigned short)f2bf(dv); }
                }
            }
            unsigned short mog[16];
            if (wid < 4) {
#pragma unroll
                for (int tt = 0; tt < 4; ++tt)
#pragma unroll
                    for (int j = 0; j < 4; ++j) mog[tt * 4 + j] = __builtin_amdgcn_raw_buffer_load_b16(rsB, lo_o, (((int)row0 + 16 * tt + j) * PJB + PB_MO + h * 128 + vh * 64 + 16 * wid) * 2, 0);
            }
            ML_BAR();
            f32x4v acc[4];
            if (wid < 5) {
                const int eg = wid;
#pragma unroll
                for (int tt = 0; tt < 4; ++tt) {
                    acc[tt] = (f32x4v){0.f, 0.f, 0.f, 0.f};
#pragma unroll
                    for (int ks = 0; ks < 2; ++ks) {
                        const bf16x8 a = *(const LAS bf16x8*)(L + L_SC + ((16 * tt + l15) * TS + 32 * ks + 8 * q4) * 2);
                        const bf16x8 bb = *(const LAS bf16x8*)(L + L_VT + ((16 * eg + l15) * TS + 32 * ks + 8 * q4) * 2);
                        acc[tt] = __builtin_amdgcn_mfma_f32_16x16x32_bf16(a, bb, acc[tt], 0, 0, 0);
                    }
#pragma unroll
                    for (int kd = 0; kd < 4; ++kd) {
                        const bf16x8 a = *(const LAS bf16x8*)(L + L_QI + ((16 * tt + l15) * QS + 32 * kd + 8 * q4) * 2);
                        const bf16x8 bb = *(const LAS bf16x8*)(L + L_CT + ((16 * eg + l15) * QS + 32 * kd + 8 * q4) * 2);
                        acc[tt] = __builtin_amdgcn_mfma_f32_16x16x32_bf16(a, bb, acc[tt], 0, 0, 0);
                    }
                }
                asm volatile("s_waitcnt lgkmcnt(0)" ::: "memory");
#pragma unroll
                for (int db = 0; db < 8; ++db) {
                    Cacc[db] = Cacc[db] * cdec;
#pragma unroll
                    for (int ks = 0; ks < 2; ++ks) {
                        const bf16x8 a = *(const LAS bf16x8*)(L + L_KT + ((16 * db + l15) * TS + 32 * ks + 8 * q4) * 2);
                        const bf16x8 bb = *(const LAS bf16x8*)(L + L_WVT + ((16 * eg + l15) * TS + 32 * ks + 8 * q4) * 2);
                        Cacc[db] = __builtin_amdgcn_mfma_f32_16x16x32_bf16(a, bb, Cacc[db], 0, 0, 0);
                    }
                    *(LAS u32x2v*)(L + L_CT + ((16 * eg + l15) * QS + 16 * db + 4 * q4) * 2) = (u32x2v){cvtpk(Cacc[db][0], Cacc[db][1]), cvtpk(Cacc[db][2], Cacc[db][3])};
                }
                if (wid == 4 && l15 == 0) {
#pragma unroll
                    for (int tt = 0; tt < 4; ++tt) *(LAS f32x4v*)(L + L_DEN + (16 * tt + 4 * q4) * 4) = acc[tt];
                }
            }
            ML_BAR();
            if (wid < 4) {
#pragma unroll
                for (int tt = 0; tt < 4; ++tt) {
                    const f32x4v den = *(const LAS f32x4v*)(L + L_DEN + (16 * tt + 4 * q4) * 4);
#pragma unroll
                    for (int j = 0; j < 4; ++j) { const int t = 16 * tt + 4 * q4 + j; const float et = bperm(emt, t);
                        const float hv = acc[tt][j] / fmaxf(fabsf(den[j]), et);
                        __builtin_amdgcn_raw_buffer_store_b16((unsigned short)f2bf(hv * bf2f(mog[tt * 4 + j])), rsO, lo_ao, (((int)row0 + 16 * tt + j) * D + 512 + h * 128 + vh * 64 + 16 * wid) * 2, 0); }
                }
            }
        }
#undef MLS_LOAD
#undef ML_BAR
    }
}


__device__ __forceinline__ void phase_mlstm_full(Frame& F, const bf16* P, const bf16* PBg, const float* convw, const float* convb, bf16* AO, int item0, int item_stride) {
    using namespace mls;
    constexpr int L_Q = 0, L_K = 17408, L_KT = 34816, L_VT = 53248, L_WVT = 71680, L_SC = 90112, L_DEN = 99328  , L_NS = 100096  , L_WK = 100608  , L_IT = 100864, L_EM = 101120;
    const float* GA = (const float*)(F.ws + G_A); const float* GPM = (const float*)(F.ws + G_RT); const float* GB = (const float*)(F.ws + G_IT); const float* GP63 = (const float*)(F.ws + G_WK); const float* GG = GP63 + BATCH * MLH * 32;
#define ML_BAR() asm volatile("s_waitcnt lgkmcnt(0)\n\ts_barrier" ::: "memory")
    const int tid = opaque_tid(F.wave), lane = tid & 63, wid = __builtin_amdgcn_readfirstlane(tid >> 6), l15 = lane & 15, q4 = lane >> 4;
    LAS unsigned char* L = F.lds;
    for (int bh = item0; bh < BATCH * MLH; bh += item_stride) {
        const int b = bh >> 2, h = bh & 3;
        const int r00 = b * SEQ;
        const int ch2 = tid & 127, tq = __builtin_amdgcn_readfirstlane(tid >> 7); const bool isk = (wid & 1) != 0;
        const int cc = (ch2 & 63) * 2;
        const int pcol = (isk ? PC_MK : PC_MQ) + h * 128 + cc, cch = (isk ? 512 : 0) + h * 128 + cc;
        float w0[2], w1[2], w2[2], w3[2], cb[2];
#pragma unroll
        for (int i = 0; i < 2; ++i) { w0[i] = convw[cch + i]; w1[i] = convw[1024 + cch + i]; w2[i] = convw[2048 + cch + i]; w3[i] = convw[3072 + cch + i]; cb[i] = convb[cch + i]; }
        const int e2 = tid & 63, sg = wid;
        f32x4v Cacc[8];
#pragma unroll
        for (int i = 0; i < 8; ++i) Cacc[i] = (f32x4v){0.f, 0.f, 0.f, 0.f};
        float mcar = 0.f;
        __syncthreads();
        if (tid < 128) *(LAS float*)(L + L_NS + tid * 4) = 0.f;
        unsigned raw[19], vraw[8]; float g_a, g_pm, g_b, g_p63, g_g;
        const unsigned lo_raw = (unsigned)pcol * 2u, lo_v = (unsigned)(PC_MV + h * 128 + 2 * e2) * 2u, lo_o = (unsigned)(l15 * PJB + 4 * q4) * 2u, lo_ao = (unsigned)(l15 * D + 4 * q4) * 2u;
        const __amdgpu_buffer_rsrc_t rsP = __builtin_amdgcn_make_buffer_rsrc((void*)P, 0, M * PJA * 2, 0x00020000), rsB = __builtin_amdgcn_make_buffer_rsrc((void*)PBg, 0, M * PJB * 2, 0x00020000),
                                     rsO = __builtin_amdgcn_make_buffer_rsrc((void*)AO, 0, M * D * 2, 0x00020000);
#define MLF_LOAD(c) do { _Pragma("unroll") for (int i_ = 0; i_ < 19; ++i_) { const int tr_ = 64 * (c) + 16 * tq - 3 + i_; raw[i_] = (tr_ >= 0) ? __builtin_amdgcn_raw_buffer_load_b32(rsP, lo_raw, (r00 + tr_) * (PJA * 2), 0) : 0u; } \
        _Pragma("unroll") for (int i_ = 0; i_ < 8; ++i_) vraw[i_] = __builtin_amdgcn_raw_buffer_load_b32(rsP, lo_v, (r00 + 64 * (c) + 8 * sg + i_) * (PJA * 2), 0); \
        { const size_t gi_ = (size_t)bh * SEQ + 64 * (c) + lane; g_a = GA[gi_]; g_pm = GPM[gi_]; g_b = GB[gi_]; g_p63 = GP63[bh * 32 + (c)]; g_g = GG[bh * 32 + (c)]; } } while (0)
        MLF_LOAD(0);
        for (int c = 0; c < SEQ / 64; ++c) {
            const int row0 = r00 + 64 * c;
            const float Mx = fmaxf(mcar, g_p63), mrow = fmaxf(g_pm, mcar);
            const float rowterm = -mrow, inter = __expf(mcar - mrow), emt = __expf(-(g_b + mrow)), aval = g_a, wk = __expf(g_a - Mx), cdec = __expf(mcar - Mx);
            mcar = g_g + Mx;
            {
                unsigned kt0[8], kt1[8];
#pragma unroll
                for (int i = 0; i < 16; i += 2) {
                    float y[2][2];
#pragma unroll
                    for (int u = 0; u < 2; ++u) {
                        const float a0 = w0[0] * lo_bf(raw[i + u]) + w1[0] * lo_bf(raw[i + u + 1]) + w2[0] * lo_bf(raw[i + u + 2]) + w3[0] * lo_bf(raw[i + u + 3]) + cb[0];
                        const float a1 = w0[1] * hi_bf(raw[i + u]) + w1[1] * hi_bf(raw[i + u + 1]) + w2[1] * hi_bf(raw[i + u + 2]) + w3[1] * hi_bf(raw[i + u + 3]) + cb[1];
                        y[u][0] = fsilu(a0); y[u][1] = fsilu(a1);
                        const int t = 16 * tq + i + u;
                        if (!isk) *(LAS unsigned*)(L + L_Q + (t * QS + cc) * 2) = cvtpk(y[u][0] * QK_SCALE, y[u][1] * QK_SCALE);
                        else *(LAS unsigned*)(L + L_K + (t * QS + cc) * 2) = cvtpk(y[u][0], y[u][1]);
                    }
                    kt0[i >> 1] = cvtpk(y[0][0], y[1][0]); kt1[i >> 1] = cvtpk(y[0][1], y[1][1]);
                }
                if (isk) {
                    *(LAS u32x4v*)(L + L_KT + (cc * TS + 16 * tq) * 2) = (u32x4v){kt0[0], kt0[1], kt0[2], kt0[3]}; *(LAS u32x4v*)(L + L_KT + (cc * TS + 16 * tq + 8) * 2) = (u32x4v){kt0[4], kt0[5], kt0[6], kt0[7]};
                    *(LAS u32x4v*)(L + L_KT + ((cc + 1) * TS + 16 * tq) * 2) = (u32x4v){kt1[0], kt1[1], kt1[2], kt1[3]}; *(LAS u32x4v*)(L + L_KT + ((cc + 1) * TS + 16 * tq + 8) * 2) = (u32x4v){kt1[4], kt1[5], kt1[6], kt1[7]};
                }
                float v0[8], v1[8], wv[8];
#pragma unroll
                for (int i = 0; i < 8; ++i) { v0[i] = lo_bf(vraw[i]); v1[i] = hi_bf(vraw[i]); wv[i] = rdl(wk, 8 * sg + i); }
                *(LAS u32x4v*)(L + L_VT + ((2 * e2) * TS + 8 * sg) * 2) = (u32x4v){cvtpk(v0[0], v0[1]), cvtpk(v0[2], v0[3]), cvtpk(v0[4], v0[5]), cvtpk(v0[6], v0[7])};
                *(LAS u32x4v*)(L + L_VT + ((2 * e2 + 1) * TS + 8 * sg) * 2) = (u32x4v){cvtpk(v1[0], v1[1]), cvtpk(v1[2], v1[3]), cvtpk(v1[4], v1[5]), cvtpk(v1[6], v1[7])};
                *(LAS u32x4v*)(L + L_WVT + ((2 * e2) * TS + 8 * sg) * 2) = (u32x4v){cvtpk(v0[0] * wv[0], v0[1] * wv[1]), cvtpk(v0[2] * wv[2], v0[3] * wv[3]), cvtpk(v0[4] * wv[4], v0[5] * wv[5]), cvtpk(v0[6] * wv[6], v0[7] * wv[7])};
                *(LAS u32x4v*)(L + L_WVT + ((2 * e2 + 1) * TS + 8 * sg) * 2) = (u32x4v){cvtpk(v1[0] * wv[0], v1[1] * wv[1]), cvtpk(v1[2] * wv[2], v1[3] * wv[3]), cvtpk(v1[4] * wv[4], v1[5] * wv[5]), cvtpk(v1[6] * wv[6], v1[7] * wv[7])};
                if (wid == 0) { *(LAS float*)(L + L_WK + lane * 4) = wk; *(LAS float*)(L + L_IT + lane * 4) = inter; *(LAS float*)(L + L_EM + lane * 4) = emt; }
            }
            if (c + 1 < SEQ / 64) MLF_LOAD(c + 1);
            ML_BAR();
            {
                const int tt = wid >> 1; float rs[4] = {0.f, 0.f, 0.f, 0.f};
#pragma unroll
                for (int si = 0; si < 2; ++si) {
                    const int ss = 2 * (wid & 1) + si;
                    f32x4v acc = (f32x4v){0.f, 0.f, 0.f, 0.f};
                    if (ss <= tt) {
#pragma unroll
                        for (int kd = 0; kd < 4; ++kd) {
                            const bf16x8 a = *(const LAS bf16x8*)(L + L_Q + ((16 * tt + l15) * QS + 32 * kd + 8 * q4) * 2);
                            const bf16x8 bb = *(const LAS bf16x8*)(L + L_K + ((16 * ss + l15) * QS + 32 * kd + 8 * q4) * 2);
                            acc = __builtin_amdgcn_mfma_f32_16x16x32_bf16(a, bb, acc, 0, 0, 0);
                        }
                    }
                    const int s = 16 * ss + l15; const float as_ = bperm(aval, s);
#pragma unroll
                    for (int j = 0; j < 4; ++j) { const int t = 16 * tt + 4 * q4 + j; const float rt = bperm(rowterm, t);
                        const float dv = (s <= t) ? acc[j] * __expf(rt + as_) : 0.f; const unsigned db_ = cvtpk(dv, 0.f);
                        *(LAS unsigned short*)(L + L_SC + (t * TS + s) * 2) = (unsigned short)db_; rs[j] += lo_bf(db_); }
                }
#pragma unroll
                for (int j = 0; j < 4; ++j) {
#pragma unroll
                    for (int o = 1; o < 16; o <<= 1) rs[j] += shx(rs[j], lane, o);
                    if (l15 == 0) *(LAS float*)(L + L_DEN + ((wid & 1) * 64 + 16 * tt + 4 * q4 + j) * 4) = rs[j]; }
                { const int t = tid >> 3, dg = tid & 7; float dn = 0.f;
#pragma unroll
                  for (int i4 = 0; i4 < 2; ++i4) { const u32x4v qw = *(const LAS u32x4v*)(L + L_Q + (t * QS + 16 * dg + 8 * i4) * 2); const f32x4v n0 = *(const LAS f32x4v*)(L + L_NS + (16 * dg + 8 * i4) * 4), n1 = *(const LAS f32x4v*)(L + L_NS + (16 * dg + 8 * i4 + 4) * 4);
                      dn += lo_bf(qw.x) * n0[0] + hi_bf(qw.x) * n0[1] + lo_bf(qw.y) * n0[2] + hi_bf(qw.y) * n0[3] + lo_bf(qw.z) * n1[0] + hi_bf(qw.z) * n1[1] + lo_bf(qw.w) * n1[2] + hi_bf(qw.w) * n1[3]; }
                  dn += shx(dn, lane, 1); dn += shx(dn, lane, 2); dn += shx(dn, lane, 4);
                  if (dg == 0) *(LAS float*)(L + L_DEN + (128 + t) * 4) = dn * *(const LAS float*)(L + L_IT + t * 4); }
            }
            u32x2v mog[4];
#pragma unroll
            for (int tt = 0; tt < 4; ++tt) mog[tt] = __builtin_amdgcn_raw_buffer_load_b64(rsB, lo_o, ((row0 + 16 * tt) * PJB + PB_MO + h * 128 + 16 * wid) * 2, 0);
            ML_BAR();
            {
                const int g = wid;
                bf16x8 cf[4];
#pragma unroll
                for (int kd = 0; kd < 4; ++kd) cf[kd] = __builtin_bit_cast(bf16x8, (u32x4v){cvtpk(Cacc[2 * kd][0], Cacc[2 * kd][1]), cvtpk(Cacc[2 * kd][2], Cacc[2 * kd][3]), cvtpk(Cacc[2 * kd + 1][0], Cacc[2 * kd + 1][1]), cvtpk(Cacc[2 * kd + 1][2], Cacc[2 * kd + 1][3])});
#pragma unroll
                for (int tt = 0; tt < 4; ++tt) {
                    f32x4v acc = (f32x4v){0.f, 0.f, 0.f, 0.f}, acc2 = (f32x4v){0.f, 0.f, 0.f, 0.f};
#pragma unroll
                    for (int ks = 0; ks < 2; ++ks) {
                        const bf16x8 a = *(const LAS bf16x8*)(L + L_VT + ((16 * g + l15) * TS + 32 * ks + 8 * q4) * 2);
                        const bf16x8 bb = *(const LAS bf16x8*)(L + L_SC + ((16 * tt + l15) * TS + 32 * ks + 8 * q4) * 2);
                        acc = __builtin_amdgcn_mfma_f32_16x16x32_bf16(a, bb, acc, 0, 0, 0);
                    }
#pragma unroll
                    for (int kd = 0; kd < 4; ++kd) {
                        const u32x2v qa = *(const LAS u32x2v*)(L + L_Q + ((16 * tt + l15) * QS + 32 * kd + 4 * q4) * 2), qb = *(const LAS u32x2v*)(L + L_Q + ((16 * tt + l15) * QS + 32 * kd + 16 + 4 * q4) * 2);
                        acc2 = __builtin_amdgcn_mfma_f32_16x16x32_bf16(cf[kd], __builtin_bit_cast(bf16x8, (u32x4v){qa.x, qa.y, qb.x, qb.y}), acc2, 0, 0, 0);
                    }
                    const int t = 16 * tt + l15;
                    const float itv = *(const LAS float*)(L + L_IT + t * 4), etv = *(const LAS float*)(L + L_EM + t * 4);
                    const float den = (*(const LAS float*)(L + L_DEN + t * 4) + *(const LAS float*)(L + L_DEN + (64 + t) * 4)) + *(const LAS float*)(L + L_DEN + (128 + t) * 4);
                    const float rd = 1.0f / fmaxf(fabsf(den), etv);
                    const float o0 = (acc[0] + itv * acc2[0]) * rd * lo_bf(mog[tt].x), o1 = (acc[1] + itv * acc2[1]) * rd * hi_bf(mog[tt].x), o2 = (acc[2] + itv * acc2[2]) * rd * lo_bf(mog[tt].y), o3 = (acc[3] + itv * acc2[3]) * rd * hi_bf(mog[tt].y);
                    __builtin_amdgcn_raw_buffer_store_b64((u32x2v){cvtpk(o0, o1), cvtpk(o2, o3)}, rsO, lo_ao, ((row0 + 16 * tt) * D + 512 + h * 128 + 16 * g) * 2, 0);
                }
#pragma unroll
                for (int db = 0; db < 8; ++db) {
                    Cacc[db] = Cacc[db] * cdec;
#pragma unroll
                    for (int ks = 0; ks < 2; ++ks) {
                        const bf16x8 a = *(const LAS bf16x8*)(L + L_KT + ((16 * db + l15) * TS + 32 * ks + 8 * q4) * 2);
                        const bf16x8 bb = *(const LAS bf16x8*)(L + L_WVT + ((16 * g + l15) * TS + 32 * ks + 8 * q4) * 2);
                        Cacc[db] = __builtin_amdgcn_mfma_f32_16x16x32_bf16(a, bb, Cacc[db], 0, 0, 0);
                    }
                }
                { const int d = tid >> 2, sq = tid & 3; float p = 0.f;
#pragma unroll
                  for (int i8 = 0; i8 < 2; ++i8) { const u32x4v kw = *(const LAS u32x4v*)(L + L_KT + (d * TS + 16 * sq + 8 * i8) * 2); const f32x4v a0 = *(const LAS f32x4v*)(L + L_WK + (16 * sq + 8 * i8) * 4), a1 = *(const LAS f32x4v*)(L + L_WK + (16 * sq + 8 * i8 + 4) * 4);
                      p += lo_bf(kw.x) * a0[0] + hi_bf(kw.x) * a0[1] + lo_bf(kw.y) * a0[2] + hi_bf(kw.y) * a0[3] + lo_bf(kw.z) * a1[0] + hi_bf(kw.z) * a1[1] + lo_bf(kw.w) * a1[2] + hi_bf(kw.w) * a1[3]; }
                  p += shx(p, lane, 1); p += shx(p, lane, 2);
                  if (sq == 0) { LAS float* np = (LAS float*)(L + L_NS + d * 4); *np = cdec * *np + p; } }
            }
            ML_BAR();
        }
#undef MLF_LOAD
    }
#undef ML_BAR
}

__global__ void __launch_bounds__(NTHR, 2) fwd_kernel(Args args) {
    extern __shared__ __attribute__((aligned(16))) unsigned char lds[];
    Frame F;
    F.lds = (LAS unsigned char*)lds;
    F.MISC = (volatile LAS unsigned*)(F.lds + MISC_OFF);
    F.wave = __builtin_amdgcn_readfirstlane((int)threadIdx.x >> 6);
    F.G = gridDim.x;
    F.ws = args.ws; F.out = args.out;
#pragma unroll
    for (int i = 0; i < 18; ++i) F.in[i] = args.in[i];
    F.ctl = (gu32*)(F.ws + WS_CTL);
    for (int u = threadIdx.x; u < (LDS_BYTES - LDSCTL_OFF) / 4; u += NTHR) ((LAS unsigned*)(F.lds + LDSCTL_OFF))[u] = 0u;
    __syncthreads();
    XcdBarrier bar = xcd_barrier_post((unsigned*)(F.ctl + CW_BAR), F.MISC + 8, F.wave);
#define GRID_BAR() xcd_barrier(bar)

    const float* x = F.in[0];
    bf16* XB = (bf16*)(F.ws + WS_XB); bf16* AO = (bf16*)(F.ws + WS_AO); bf16* PA = (bf16*)(F.ws + WS_PA); bf16* PB = (bf16*)(F.ws + WS_PB);
    bf16* HB = PA; bf16* MG = PA;
    float* SG = (float*)(F.ws + WS_SG); float* CUM = (float*)(F.ws + WS_CUM); float* SS = (float*)(F.ws + WS_SS);
    float* out = F.out;
    const bf16* W1IN = (const bf16*)(F.ws + WS_W1IN); const bf16* W1OUT = (const bf16*)(F.ws + WS_W1OUT); const bf16* WIN = (const bf16*)(F.ws + WS_WIN);
    const bf16* WCAT = (const bf16*)(F.ws + WS_WCAT); const bf16* WOUT = (const bf16*)(F.ws + WS_WOUT); const bf16* W2IN = (const bf16*)(F.ws + WS_W2IN); const bf16* W2OUT = (const bf16*)(F.ws + WS_W2OUT);
#define STAGGER(step) do { if (STAG_ON) { const unsigned long long t0_ = __builtin_amdgcn_s_memrealtime(); const unsigned long long w_ = (unsigned long long)((blockIdx.x & 7u) * (unsigned)(step)); while (__builtin_amdgcn_s_memrealtime() - t0_ < w_) __builtin_amdgcn_s_sleep(8); } } while (0)
#define GEMM_PHASE(EpiT, gobj, eobj) do { pg8::StaticOrder S_; S_.init((gobj).M, (gobj).N, F.G, (int)blockIdx.x); pg8::gemm_phase<EpiT, pg8::StaticOrder, true, true>(F.lds, gobj, S_, eobj, F.wave); } while (0)
#define REP(b) ((REP_MASK >> (b)) & 1)

    phase_weights(F);
    phase_x_prep(F, x, XB, SS);
    GRID_BAR();
    STAGGER(430);
    { pg8::Gemm g{XB, W1IN, M, NFF, D, D, D}; pg8::EpiSwigluF E{HB, SS}; GEMM_PHASE(pg8::EpiSwigluF, g, E); if (REP(0)) GEMM_PHASE(pg8::EpiSwigluF, g, E); }
    GRID_BAR();
    { pg8::Gemm g{HB, W1OUT, M, D, DFF, DFF, DFF}; pg8::EpiResidB<false> E{XB, nullptr, SS, 0.5f}; GEMM_PHASE(pg8::EpiResidB<false>, g, E); }
    GRID_BAR();
    STAGGER(460);
    { pg8::Gemm g{XB, WIN, M, NPJ, D, D, D}; pg8::EpiProjF E{PA, PB, SG, SS, F.in[6], F.in[9], F.in[10], (unsigned*)(F.ctl + CW_QKN)}; GEMM_PHASE(pg8::EpiProjF, g, E); if (REP(2)) GEMM_PHASE(pg8::EpiProjF, g, E); }
    GRID_BAR();
    phase_cumsum(F, SG, CUM);
    phase_mgates(F, SG);
    GRID_BAR();
    if (MLSTM_FUSED == 2) {
        if ((blockIdx.x & 1) == 0) phase_mlstm_full(F, PA, PB, F.in[7], F.in[8], AO, (int)(blockIdx.x >> 1), (int)((F.G + 1) >> 1));
        const attn_body::AttnTensors AT{(const attn_body::bf16*)(PA + PC_FQ), (const attn_body::bf16*)(PA + PC_FK), (const attn_body::bf16*)(PA + PC_FV), (attn_body::bf16*)AO, CUM, (const unsigned*)(F.ctl + CW_QKN)};
        __syncthreads();
        attn_body::attn_phase_queue((char*)lds, AT, (unsigned*)(F.ctl + CW_AQ), F.MISC + 16, F.wave);
    } else {
    if (MLSTM_FUSED) { phase_mlstm_fused(F, PA, PB, SG, F.in[7], F.in[8], AO); if (REP(3)) phase_mlstm_fused(F, PA, PB, SG, F.in[7], F.in[8], AO); }
    else {
    phase_mprep(F, PA, F.in[7], F.in[8], (bf16*)out);
    if (REP(3)) phase_mprep(F, PA, F.in[7], F.in[8], (bf16*)out);
    GRID_BAR();
    phase_mchain(F, (const bf16*)out, PB, AO);
    if (REP(7)) phase_mchain(F, (const bf16*)out, PB, AO);
    }
    { const attn_body::AttnTensors AT{(const attn_body::bf16*)(PA + PC_FQ), (const attn_body::bf16*)(PA + PC_FK), (const attn_body::bf16*)(PA + PC_FV), (attn_body::bf16*)AO, CUM, (const unsigned*)(F.ctl + CW_QKN)};
      const attn_body::StaticOrder SA((int)F.G, (int)blockIdx.x); attn_body::attn_phase<attn_body::StaticOrder>((char*)lds, AT, SA, F.wave);
      if (REP(4)) attn_body::attn_phase<attn_body::StaticOrder>((char*)lds, AT, SA, F.wave); }
    }
    GRID_BAR();
    { pg8::Gemm g{AO, WCAT, M, D, D, D, D}; pg8::EpiMergeF E{PB, MG}; GEMM_PHASE(pg8::EpiMergeF, g, E); if (REP(5)) GEMM_PHASE(pg8::EpiMergeF, g, E); }
    GRID_BAR();
    { pg8::Gemm g{MG, WOUT, M, D, D, D, D}; pg8::EpiResidB<false> E{XB, nullptr, SS, 1.0f}; GEMM_PHASE(pg8::EpiResidB<false>, g, E); }
    GRID_BAR();
    STAGGER(430);
    { pg8::Gemm g{XB, W2IN, M, NFF, D, D, D}; pg8::EpiSwigluF E{HB, SS}; GEMM_PHASE(pg8::EpiSwigluF, g, E); }
    GRID_BAR();
    { pg8::Gemm g{HB, W2OUT, M, D, DFF, DFF, DFF}; pg8::EpiResidB<false> E{XB, nullptr, SS, 0.5f}; GEMM_PHASE(pg8::EpiResidB<false>, g, E); }
    GRID_BAR();
    phase_final_scale(F, XB, out, SS, F.in[17]);
}

extern "C" void kernel_launch(void* const* d_in, const int* in_sizes, int n_in, void* d_out, int out_size, void* d_ws, size_t ws_size, hipStream_t stream) {
    static int grid = 0;
    if (grid == 0) {
        if (n_in != 18 || in_sizes[0] != M * D || out_size != M * D || ws_size < WS_END) { fprintf(stderr, "kernel_launch: unexpected shapes (n_in %d, in0 %d, out %d, ws %zu)\n", n_in, n_in > 0 ? in_sizes[0] : -1, out_size, ws_size); grid = -1; return; }
        int dev = 0, cus = 0, per_cu = 0;
        if (hipGetDevice(&dev) != hipSuccess || hipDeviceGetAttribute(&cus, hipDeviceAttributeMultiprocessorCount, dev) != hipSuccess) { grid = -1; return; }
        if (hipFuncSetAttribute((const void*)fwd_kernel, hipFuncAttributeMaxDynamicSharedMemorySize, LDS_BYTES) != hipSuccess) { grid = -1; return; }
        if (hipOccupancyMaxActiveBlocksPerMultiprocessor(&per_cu, (const void*)fwd_kernel, NTHR, LDS_BYTES) != hipSuccess || per_cu < 1) { fprintf(stderr, "occupancy query says %d\n", per_cu); }
        (void)hipGetLastError();
        grid = cus;
    }
    if (grid < 0) return;
    if (hipMemsetAsync((char*)d_ws + WS_CTL, 0, CTL_ZERO_BYTES, stream) != hipSuccess) return;
    Args a{};
    for (int i = 0; i < 18; ++i) a.in[i] = (const float*)d_in[i];
    a.out = (float*)d_out; a.ws = (unsigned char*)d_ws;
    hipLaunchKernelGGL(fwd_kernel, dim3(grid), dim3(NTHR), LDS_BYTES, stream, a);
}
```
